# Optimizing an MI355X kernel written in HIP

```python
import math
import jax, jax.numpy as jnp
from jax import lax
import numpy as np

D_MODEL = 1024
BATCH = 8
SEQ = 2048
DEPTH = 2
DEC_BATCH = 4
DEC_SEQ = 4096
PAST_LEN = 128

GRID_W = 64
MLA_HEADS = 8
MLA_NOPE = 64
MLA_ROPE = 32
MLA_V = 64
Q_LORA = 384
KV_LORA = 256
ROPE_BASE = 10000.0
Q_BLOCK = 128
NA_HEADS = 8
NA_HD = 64
NA_KH = 8
NA_KW = 16
D_RNN = 1024
LRU_BLOCKS = 8
LRU_BW = D_RNN // LRU_BLOCKS
REC_CONV = 4
LRU_C = 8.0
D_FF = 4096
FFN_CONV = 3
EPS = 1e-6

ATTN_IN = Q_LORA + KV_LORA + MLA_ROPE + 3 * NA_HEADS * NA_HD
ATTN_OUT = MLA_HEADS * MLA_V + NA_HEADS * NA_HD
N_EVEN = (DEPTH + 1) // 2
N_ODD = DEPTH // 2

kernel_name = 'hybrid_mla_natten_rglru_encoder'


def rmsnorm(x, g):
    xf = x.astype(jnp.float32)
    y = xf * lax.rsqrt(jnp.mean(xf * xf, axis=-1, keepdims=True) + EPS)
    return (y * g.astype(jnp.float32)).astype(x.dtype)


def dwconv(x, w, b):
    K = w.shape[0]
    S = x.shape[1]
    left = (K - 1) // 2
    xp = jnp.pad(x, ((0, 0), (left, K - 1 - left), (0, 0)))
    y = w[0] * xp[:, 0:S]
    for k in range(1, K):
        y = y + w[k] * xp[:, k:k + S]
    return y + b


def rope(x, cos, sin):
    half = x.shape[-1] // 2
    x1, x2 = x[..., :half], x[..., half:]
    cos = cos.astype(x.dtype)
    sin = sin.astype(x.dtype)
    return jnp.concatenate([x1 * cos - x2 * sin, x2 * cos + x1 * sin], axis=-1)


def mla(q_lat, kv_lat, k_pe_raw, q_norm, w_uq, kv_norm, w_ukv):
    B, S, _ = q_lat.shape
    q = (rmsnorm(q_lat, q_norm) @ w_uq).reshape(B, S, MLA_HEADS, MLA_NOPE + MLA_ROPE)
    kv = (rmsnorm(kv_lat, kv_norm) @ w_ukv).reshape(B, S, MLA_HEADS, MLA_NOPE + MLA_V)
    q_nope, q_pe = q[..., :MLA_NOPE], q[..., MLA_NOPE:]
    k_nope, v = kv[..., :MLA_NOPE], kv[..., MLA_NOPE:]
    pos = jnp.arange(S, dtype=jnp.float32)
    inv = ROPE_BASE ** (-jnp.arange(0, MLA_ROPE, 2, dtype=jnp.float32) / MLA_ROPE)
    ang = pos[:, None] * inv[None, :]
    cos, sin = jnp.cos(ang), jnp.sin(ang)
    q_pe = rope(q_pe, cos[:, None, :], sin[:, None, :])
    k_pe = rope(k_pe_raw, cos, sin)
    scale = (MLA_NOPE + MLA_ROPE) ** -0.5
    nqb = S // Q_BLOCK

    def q_block(xq):
        qn, qp = xq
        s = (jnp.einsum('bqhd,bkhd->bhqk', qn, k_nope)
             + jnp.einsum('bqhr,bkr->bhqk', qp, k_pe))
        p = jax.nn.softmax(s.astype(jnp.float32) * scale, axis=-1).astype(v.dtype)
        return jnp.einsum('bhqk,bkhv->bqhv', p, v)

    def to_blocks(t):
        return jnp.moveaxis(t.reshape(B, nqb, Q_BLOCK, *t.shape[2:]), 1, 0)

    o = lax.map(q_block, (to_blocks(q_nope), to_blocks(q_pe)))
    return jnp.moveaxis(o, 0, 1).reshape(B, S, MLA_HEADS * MLA_V)


def neighborhood_attn(q, k, v, rpb):
    B, S, H, d = q.shape
    rows = S // GRID_W
    kh = min(NA_KH, rows)
    qg = q.reshape(B, rows, GRID_W, H, d)
    kg = k.reshape(B, rows, GRID_W, H, d)
    vg = v.reshape(B, rows, GRID_W, H, d)
    cols = np.arange(GRID_W)
    col_start = np.clip(cols - NA_KW // 2, 0, GRID_W - NA_KW)
    col_idx = col_start[:, None] + np.arange(NA_KW)[None, :]
    col_bias_idx = col_idx - cols[:, None] + (NA_KW - 1)
    scale = d ** -0.5

    def row_block(r):
        rs = jnp.clip(r - kh // 2, 0, rows - kh)
        q_row = lax.dynamic_index_in_dim(qg, r, axis=1, keepdims=False)
        k_win = lax.dynamic_slice_in_dim(kg, rs, kh, axis=1)[:, :, col_idx]
        v_win = lax.dynamic_slice_in_dim(vg, rs, kh, axis=1)[:, :, col_idx]
        row_bias_idx = rs + jnp.arange(kh) - r + (NA_KH - 1)
        bias = rpb[:, row_bias_idx[None, :, None], col_bias_idx[:, None, :]]
        s = (jnp.einsum('bqhd,bkqwhd->bhqkw', q_row, k_win).astype(jnp.float32) * scale
             + bias.astype(jnp.float32)[None])
        p = jax.nn.softmax(s.reshape(B, H, GRID_W, kh * NA_KW), axis=-1)
        p = p.reshape(s.shape).astype(v.dtype)
        return jnp.einsum('bhqkw,bkqwhd->bqhd', p, v_win)

    o = lax.map(row_block, jnp.arange(rows))
    return jnp.moveaxis(o, 0, 1).reshape(B, S, H * d)


def attn_mixer(h, w_in, q_norm, w_uq, kv_norm, w_ukv, rpb, w_out):
    B, S, _ = h.shape
    z = h @ w_in
    q_lat, kv_lat, k_pe, na_qkv = jnp.split(
        z, [Q_LORA, Q_LORA + KV_LORA, Q_LORA + KV_LORA + MLA_ROPE], axis=-1)
    na_qkv = na_qkv.reshape(B, S, 3, NA_HEADS, NA_HD)
    o_mla = mla(q_lat, kv_lat, k_pe, q_norm, w_uq, kv_norm, w_ukv)
    o_na = neighborhood_attn(na_qkv[:, :, 0], na_qkv[:, :, 1], na_qkv[:, :, 2], rpb)
    return jnp.concatenate([o_mla, o_na], axis=-1) @ w_out


def _lin_combine(left, right):
    a_l, b_l = left
    a_r, b_r = right
    return a_r * a_l, a_r * b_l + b_r


def rglru_mixer(h, w_in, conv_w, conv_b, ga_w, ga_b, gx_w, gx_b, lam, w_out):
    B, S, _ = h.shape
    gate, xb = jnp.split(h @ w_in, 2, axis=-1)
    xb = dwconv(xb, conv_w, conv_b)
    xr = xb.reshape(B, S, LRU_BLOCKS, LRU_BW)
    r = jax.nn.sigmoid((jnp.einsum('bsnc,encd->ebsnd', xr, ga_w).reshape(2, B, S, D_RNN)
                        + ga_b[:, None, None, :]).astype(jnp.float32))
    i = jax.nn.sigmoid((jnp.einsum('bsnc,encd->ebsnd', xr, gx_w).reshape(2, B, S, D_RNN)
                        + gx_b[:, None, None, :]).astype(jnp.float32))
    log_a = -LRU_C * r * jax.nn.softplus(-lam.astype(jnp.float32))[:, None, None, :]
    a = jnp.exp(log_a)
    b = jnp.sqrt(-jnp.expm1(2.0 * log_a)) * (i * xb.astype(jnp.float32)[None])
    h_fwd = lax.associative_scan(_lin_combine, (a[0], b[0]), axis=1)[1]
    h_bwd = lax.associative_scan(_lin_combine, (a[1], b[1]), axis=1, reverse=True)[1]
    y = (h_fwd + h_bwd).astype(h.dtype) * jax.nn.gelu(gate, approximate=True)
    return y @ w_out


def conv_ffn(h, w_up, conv_w, conv_b, w_down):
    u = dwconv(h @ w_up, conv_w, conv_b)
    g, val = jnp.split(u, 2, axis=-1)
    return (jax.nn.gelu(g, approximate=True) * val) @ w_down


def _trunk(x, norm_mix_pre, norm_mix_post, norm_ffn_pre, norm_ffn_post,
           w_in_attn, q_norm, w_uq, kv_norm, w_ukv, na_rpb, w_out_attn,
           w_in_rec, conv_w_rec, conv_b_rec, gate_a_w, gate_a_b, gate_x_w, gate_x_b,
           lru_lambda, w_out_rec, w_ffn_up, conv_w_ffn, conv_b_ffn, w_ffn_down):
    for li in range(DEPTH):
        j = li // 2
        h = rmsnorm(x, norm_mix_pre[li])
        if li % 2 == 0:
            m = attn_mixer(h, w_in_attn[j], q_norm[j], w_uq[j], kv_norm[j], w_ukv[j],
                           na_rpb[j], w_out_attn[j])
        else:
            m = rglru_mixer(h, w_in_rec[j], conv_w_rec[j], conv_b_rec[j], gate_a_w[j],
                            gate_a_b[j], gate_x_w[j], gate_x_b[j], lru_lambda[j], w_out_rec[j])
        x = x + rmsnorm(m, norm_mix_post[li])
        h = rmsnorm(x, norm_ffn_pre[li])
        f = conv_ffn(h, w_ffn_up[li], conv_w_ffn[li], conv_b_ffn[li], w_ffn_down[li])
        x = x + rmsnorm(f, norm_ffn_post[li])
    return x


def setup_inputs(seed: int = 0) -> dict:
    key = jax.random.key(seed)
    ks = jax.random.split(key, 26)
    f32 = jnp.float32

    def nrm(k, shape, s):
        return jax.random.normal(k, shape, f32) * s

    def gain(k, shape):
        return 1.0 + 0.05 * jax.random.normal(k, shape, f32)

    a0 = jax.random.uniform(ks[20], (N_ODD, 2, D_RNN), f32, minval=0.9, maxval=0.999)
    p = a0 ** (1.0 / LRU_C)
    lru_lambda = jnp.log(p) - jnp.log1p(-p)
    return {
        'x_prompt': nrm(ks[0], (BATCH, SEQ, D_MODEL), 1.0),
        'x_sample': nrm(ks[1], (DEC_BATCH, DEC_SEQ, D_MODEL), 1.0),
        'norm_mix_pre': gain(ks[2], (DEPTH, D_MODEL)),
        'norm_mix_post': gain(ks[3], (DEPTH, D_MODEL)),
        'norm_ffn_pre': gain(ks[4], (DEPTH, D_MODEL)),
        'norm_ffn_post': gain(ks[5], (DEPTH, D_MODEL)),
        'w_in_attn': nrm(ks[6], (N_EVEN, D_MODEL, ATTN_IN), D_MODEL ** -0.5),
        'q_norm': gain(ks[7], (N_EVEN, Q_LORA)),
        'w_uq': nrm(ks[8], (N_EVEN, Q_LORA, MLA_HEADS * (MLA_NOPE + MLA_ROPE)), Q_LORA ** -0.5),
        'kv_norm': gain(ks[9], (N_EVEN, KV_LORA)),
        'w_ukv': nrm(ks[10], (N_EVEN, KV_LORA, MLA_HEADS * (MLA_NOPE + MLA_V)), KV_LORA ** -0.5),
        'na_rpb': nrm(ks[11], (N_EVEN, NA_HEADS, 2 * NA_KH - 1, 2 * NA_KW - 1), 0.1),
        'w_out_attn': nrm(ks[12], (N_EVEN, ATTN_OUT, D_MODEL), ATTN_OUT ** -0.5),
        'w_in_rec': nrm(ks[13], (N_ODD, D_MODEL, 2 * D_RNN), D_MODEL ** -0.5),
        'conv_w_rec': nrm(ks[14], (N_ODD, REC_CONV, D_RNN), REC_CONV ** -0.5),
        'conv_b_rec': nrm(ks[15], (N_ODD, D_RNN), 0.01),
        'gate_a_w': nrm(ks[16], (N_ODD, 2, LRU_BLOCKS, LRU_BW, LRU_BW), LRU_BW ** -0.5),
        'gate_a_b': nrm(ks[17], (N_ODD, 2, D_RNN), 0.01),
        'gate_x_w': nrm(ks[18], (N_ODD, 2, LRU_BLOCKS, LRU_BW, LRU_BW), LRU_BW ** -0.5),
        'gate_x_b': nrm(ks[19], (N_ODD, 2, D_RNN), 0.01),
        'lru_lambda': lru_lambda,
        'w_out_rec': nrm(ks[21], (N_ODD, D_RNN, D_MODEL), D_RNN ** -0.5),
        'w_ffn_up': nrm(ks[22], (DEPTH, D_MODEL, 2 * D_FF), D_MODEL ** -0.5),
        'conv_w_ffn': nrm(ks[23], (DEPTH, FFN_CONV, 2 * D_FF), FFN_CONV ** -0.5),
        'conv_b_ffn': nrm(ks[24], (DEPTH, 2 * D_FF), 0.01),
        'w_ffn_down': nrm(ks[25], (DEPTH, D_FF, D_MODEL), D_FF ** -0.5),
    }


def reference(x_prompt, x_sample, norm_mix_pre, norm_mix_post, norm_ffn_pre, norm_ffn_post,
              w_in_attn, q_norm, w_uq, kv_norm, w_ukv, na_rpb, w_out_attn,
              w_in_rec, conv_w_rec, conv_b_rec, gate_a_w, gate_a_b, gate_x_w, gate_x_b,
              lru_lambda, w_out_rec, w_ffn_up, conv_w_ffn, conv_b_ffn, w_ffn_down):
    weights = (norm_mix_pre, norm_mix_post, norm_ffn_pre, norm_ffn_post,
               w_in_attn, q_norm, w_uq, kv_norm, w_ukv, na_rpb, w_out_attn,
               w_in_rec, conv_w_rec, conv_b_rec, gate_a_w, gate_a_b, gate_x_w, gate_x_b,
               lru_lambda, w_out_rec, w_ffn_up, conv_w_ffn, conv_b_ffn, w_ffn_down)
    y_prompt = _trunk(x_prompt, *weights)
    y_sample = _trunk(x_sample, *weights)
    return (y_prompt, y_sample)
```

```cpp
#include <hip/hip_runtime.h>
#include <hip/hip_cooperative_groups.h>
#include <cstdio>
#include <cstdint>
namespace cg = cooperative_groups;

#define LAS __attribute__((address_space(3)))
typedef unsigned short bf16_t;
typedef short bf16x8 __attribute__((ext_vector_type(8)));
typedef short s16x4 __attribute__((ext_vector_type(4)));
typedef float f32x4 __attribute__((ext_vector_type(4)));
typedef float f32x16 __attribute__((ext_vector_type(16)));
typedef unsigned u32x4 __attribute__((ext_vector_type(4)));
typedef unsigned u32x2 __attribute__((ext_vector_type(2)));

__device__ __forceinline__ unsigned cvt_pk_bf16(float lo, float hi) { unsigned r; asm volatile("v_cvt_pk_bf16_f32 %0, %1, %2" : "=v"(r) : "v"(lo), "v"(hi)); return r; }
__device__ __forceinline__ float bf2f(bf16_t v) { return __uint_as_float(((unsigned)v) << 16); }
__device__ __forceinline__ float bflo(unsigned w) { return __uint_as_float(w << 16); }
__device__ __forceinline__ float bfhi(unsigned w) { return __uint_as_float(w & 0xffff0000u); }
__device__ __forceinline__ bf16_t f2bf(float f) { return (bf16_t)(cvt_pk_bf16(f, 0.f) & 0xffffu); }
__device__ __forceinline__ float fexp2(float x) { return __builtin_amdgcn_exp2f(x); }
__device__ __forceinline__ float frcp(float x) { return __builtin_amdgcn_rcpf(x); }
__device__ __forceinline__ float gelu_tanh(float x) {
    const float u = x * (1.0f + 0.044715f * x * x) * (-2.0f * 0.7978845608028654f * 1.4426950408889634f);
    return x * frcp(1.0f + fexp2(u));
}
__device__ __forceinline__ float sigmoidf_(float x) { return frcp(1.0f + fexp2(-1.4426950408889634f * x)); }
__device__ __forceinline__ float bperm_f(int src_lane, float v) { return __int_as_float(__builtin_amdgcn_ds_bpermute(src_lane << 2, __float_as_int(v))); }
__device__ __forceinline__ float wave_sum(float v, int l  ) {
#pragma unroll
    for (int o = 1; o < 64; o <<= 1) v += bperm_f(l ^ o, v);
    return v;
}
__device__ __forceinline__ float xor32_max(float v) { auto rr = __builtin_amdgcn_permlane32_swap(__float_as_uint(v), __float_as_uint(v), false, false); return fmaxf(__uint_as_float(rr[0]), __uint_as_float(rr[1])); }
__device__ __forceinline__ float xor32_sum(float v) { auto rr = __builtin_amdgcn_permlane32_swap(__float_as_uint(v), __float_as_uint(v), false, false); return __uint_as_float(rr[0]) + __uint_as_float(rr[1]); }

namespace pg8 {
constexpr int BM = 256, BK = 64, HALF = 128, HTB = HALF * BK * 2, STAGE_BYTES = 8 * HTB, NXCD = 8, WGM = 8;
__host__ __device__ __forceinline__ int lds_byte(int r, int c) { const int st = (r >> 4) * 2 + (c >> 5), rr = r & 15, cc = c & 31, ob = rr * 64 + cc * 2; return st * 1024 + (ob ^ (((ob >> 9) & 1) << 5)); }
__host__ __device__ __forceinline__ void stage_rc(int b, int& R, int& C) { const int st = b / 1024, sb = b % 1024, swz = sb ^ (((sb >> 9) & 1) << 5); R = (st >> 1) * 16 + swz / 64; C = (st & 1) * 32 + (swz % 64) / 2; }
__host__ __device__ __forceinline__ int perm32(int rho) { const int n = rho >> 4, i = rho & 15; return 8 * (i >> 2) + 4 * n + (i & 3); }

struct Unit { int pm, pn; };
struct Gemm { const bf16_t* A; const bf16_t* Bt; int lda, ldb, K; size_t tA, hA, tB, hB; int a_seg; int a_pn_shift; size_t a_pn_step; };
__device__ __forceinline__ Gemm make_gemm(const bf16_t* A, int lda, const bf16_t* Bt, int ldb, int K) {
    Gemm g; g.A = A; g.Bt = Bt; g.lda = lda; g.ldb = ldb; g.K = K; g.tA = (size_t)256 * lda * 2; g.hA = (size_t)128 * lda * 2; g.tB = (size_t)256 * ldb * 2; g.hB = (size_t)128 * ldb * 2;
    g.a_seg = 0; g.a_pn_shift = 0; g.a_pn_step = 0; return g;
}

struct StaticOrder {
    int nM, nN, nwg, G, c;
    __device__ void init(int nM_, int nN_, int G_, int c_) { nM = nM_; nN = nN_; nwg = nM * nN; G = G_; c = c_; }
    __device__ bool next(int i, Unit& u) const {
        const long L = (long)i * G + c; if (L >= nwg) return false;
        int wgid = (int)L; { const int q = nwg / NXCD, r = nwg % NXCD, xcd = wgid % NXCD, off = wgid / NXCD; wgid = (xcd < r ? xcd * (q + 1) : r * (q + 1) + (xcd - r) * q) + off; }
        const int nig = WGM * nN, gid = wgid / nig, fm = gid * WGM, gsz = (nM - fm) < WGM ? (nM - fm) : WGM;
        u.pm = fm + ((wgid % nig) % gsz); u.pn = (wgid % nig) / gsz; return true;
    }
};

template <class Epi>
__device__ __forceinline__ void gemm_phase(LAS unsigned char* lds, const Gemm g, const StaticOrder& S, const Epi& E) {
    constexpr bool SP2 = true, ALIGN_EPI = true;
    int tid_ = threadIdx.x; asm volatile("" : "+v"(tid_));
    const int tid = tid_, wid = __builtin_amdgcn_readfirstlane(tid >> 6), lane = tid & 63, wr = wid >> 2, wc = wid & 3, fr = lane & 15, fq = lane >> 4;
    int K_ = g.K; asm volatile("" : "+s"(K_)); const int K = K_, nt = K / BK;
    unsigned voffA[2], voffB[2];
#pragma unroll
    for (int i = 0; i < 2; ++i) { int R, C; stage_rc(tid * 16 + i * 8192, R, C); const int Rb = Epi::PERM ? ((R & ~31) + perm32(R & 31)) : R;
        const int Ra = g.a_seg ? (128 * (R >> 6) + (R & 63)) : R;
        voffA[i] = (unsigned)(Ra * g.lda + C) * 2u; voffB[i] = (unsigned)(Rb * g.ldb + C) * 2u; }
    const size_t kstep = (size_t)(BK * 2);
    const size_t hstepA = g.hA, hstepB = g.hB;
    const unsigned ldsw = (unsigned)wid * 1024u;
    const int aoff = lds_byte(wr * 64 + fr, fq * 8), boff = lds_byte(wc * 32 + fr, fq * 8);
#define PG8_SA(b, h) (((b) * 2 + (h)) * HTB)
#define PG8_SB(b, h) ((4 + (b) * 2 + (h)) * HTB)
#define PG8_STAGE(bufoff, gbase, voff) do { _Pragma("unroll") for (int _i = 0; _i < 2; ++_i) \
        __builtin_amdgcn_global_load_lds((const unsigned*)((const char*)(gbase) + (voff)[_i]), (LAS unsigned*)(lds + (bufoff) + ldsw + _i * 8192), 16, 0, 0); } while (0)
#define PG8_LDA(dst, b, h) do { _Pragma("unroll") for (int m = 0; m < 4; ++m) _Pragma("unroll") for (int k = 0; k < 2; ++k) dst[m][k] = *(const LAS bf16x8*)(lds + PG8_SA(b, h) + aoff + m * 2048 + k * 1024); } while (0)
#define PG8_LDB(dst, b, h) do { _Pragma("unroll") for (int n = 0; n < 2; ++n) _Pragma("unroll") for (int k = 0; k < 2; ++k) dst[n][k] = *(const LAS bf16x8*)(lds + PG8_SB(b, h) + boff + n * 2048 + k * 1024); } while (0)
#define PG8_MMA(ai, bj, At, Bt) do { __builtin_amdgcn_s_setprio(1); _Pragma("unroll") for (int m = 0; m < 4; ++m) _Pragma("unroll") for (int n = 0; n < 2; ++n) _Pragma("unroll") for (int k = 0; k < 2; ++k) \
        acc[ai][bj][m][n] = __builtin_amdgcn_mfma_f32_16x16x32_bf16(Bt[n][k], At[m][k], acc[ai][bj][m][n], 0, 0, 0); __builtin_amdgcn_s_setprio(0); } while (0)
#define PG8_WAIT_V(n) asm volatile("s_waitcnt vmcnt(" #n ")" ::: "memory")
#define PG8_WAIT_L(n) asm volatile("s_waitcnt lgkmcnt(" #n ")" ::: "memory")
#define PG8_BAR __builtin_amdgcn_s_barrier()
#define PG8_SCHED __builtin_amdgcn_sched_barrier(0)
#define PG8_APTR(u) ((const char*)g.A + (size_t)(u).pm * g.tA + (size_t)((u).pn >> g.a_pn_shift) * g.a_pn_step)
#define PG8_BPTR(u) ((const char*)g.Bt + (size_t)(u).pn * g.tB)
    Unit cur, nxt; int ui = 0;
    if (!S.next(0, cur)) return;
    f32x4 acc[2][2][4][2];
#pragma unroll
    for (int a = 0; a < 2; ++a)
#pragma unroll
        for (int b = 0; b < 2; ++b)
#pragma unroll
            for (int m = 0; m < 4; ++m)
#pragma unroll
                for (int n = 0; n < 2; ++n) acc[a][b][m][n] = (f32x4){0.f, 0.f, 0.f, 0.f};
    bf16x8 At[4][2], B0[2][2], B1[2][2];
    const char* cA = PG8_APTR(cur); const char* cB = PG8_BPTR(cur);
    {
        PG8_STAGE(PG8_SB(0, 0), cB, voffB); PG8_STAGE(PG8_SB(0, 1), cB + hstepB, voffB); PG8_STAGE(PG8_SA(0, 0), cA, voffA); PG8_STAGE(PG8_SA(0, 1), cA + hstepA, voffA);
        if (wr == 1) PG8_BAR;
        PG8_WAIT_V(2); PG8_BAR;
        PG8_STAGE(PG8_SB(1, 0), cB + kstep, voffB); PG8_STAGE(PG8_SA(1, 0), cA + kstep, voffA); PG8_STAGE(PG8_SB(1, 1), cB + hstepB + kstep, voffB);
        PG8_WAIT_V(6); PG8_BAR;
    }
    for (;;) {
        const bool has_next = S.next(ui + 1, nxt);
        const char* nA = has_next ? PG8_APTR(nxt) : cA; const char* nB = has_next ? PG8_BPTR(nxt) : cB;
        for (int t = 0; t < nt; t += 2) {
            const bool last = (t == nt - 2);
            const char* a1 = cA + (size_t)(t + 1) * kstep;
            const char* a2 = last ? nA : cA + (size_t)(t + 2) * kstep; const char* b2 = last ? nB : cB + (size_t)(t + 2) * kstep;
            const char* a3 = a2 + kstep; const char* b3 = b2 + kstep;
            PG8_LDB(B0, 0, 0); PG8_LDB(B1, 0, 1); PG8_SCHED; PG8_LDA(At, 0, 0); PG8_STAGE(PG8_SA(1, 1), a1 + hstepA, voffA);
            PG8_WAIT_V(8); PG8_WAIT_L(0); PG8_BAR; PG8_MMA(0, 0, At, B0); PG8_MMA(0, 1, At, B1); PG8_BAR; PG8_SCHED;
            PG8_LDA(At, 0, 1); PG8_STAGE(PG8_SB(0, 0), b2, voffB); PG8_STAGE(PG8_SB(0, 1), b2 + hstepB, voffB); PG8_STAGE(PG8_SA(0, 0), a2, voffA);
            PG8_WAIT_V(8); PG8_WAIT_L(0); PG8_BAR; PG8_MMA(1, 0, At, B0); PG8_MMA(1, 1, At, B1); PG8_BAR; PG8_SCHED;
            PG8_LDB(B0, 1, 0); PG8_LDB(B1, 1, 1); PG8_SCHED; PG8_LDA(At, 1, 0); PG8_STAGE(PG8_SA(0, 1), a2 + hstepA, voffA);
            PG8_WAIT_V(8); PG8_WAIT_L(0); PG8_BAR; PG8_MMA(0, 0, At, B0); PG8_MMA(0, 1, At, B1); PG8_BAR; PG8_SCHED;
            PG8_LDA(At, 1, 1); PG8_STAGE(PG8_SB(1, 0), b3, voffB); PG8_STAGE(PG8_SB(1, 1), b3 + hstepB, voffB); PG8_STAGE(PG8_SA(1, 0), a3, voffA);
            PG8_WAIT_V(8); PG8_WAIT_L(0); PG8_BAR; PG8_MMA(1, 0, At, B0); PG8_MMA(1, 1, At, B1); PG8_BAR; PG8_SCHED;
        }
        if constexpr (ALIGN_EPI) { if (wr == 0) PG8_BAR; }
        E(acc, cur, wr, wc, fr, fq);
        if (!has_next) break;
#pragma unroll
        for (int a = 0; a < 2; ++a)
#pragma unroll
            for (int b = 0; b < 2; ++b)
#pragma unroll
                for (int m = 0; m < 4; ++m)
#pragma unroll
                    for (int n = 0; n < 2; ++n) acc[a][b][m][n] = (f32x4){0.f, 0.f, 0.f, 0.f};
        cur = nxt; cA = nA; cB = nB; ++ui;
        if constexpr (ALIGN_EPI) { if (wr == 1) PG8_BAR; }
    }
    PG8_WAIT_V(0);
    if constexpr (!ALIGN_EPI) { if (wr == 0) PG8_BAR; }
    PG8_BAR;
#undef PG8_SA
#undef PG8_SB
#undef PG8_STAGE
#undef PG8_LDA
#undef PG8_LDB
#undef PG8_MMA
#undef PG8_WAIT_V
#undef PG8_WAIT_L
#undef PG8_BAR
#undef PG8_SCHED
#undef PG8_APTR
#undef PG8_BPTR
}
}
constexpr int TH = 16384;
constexpr int DM = 1024, ZP = 2304, DFF = 4096, TQ = 8192;
constexpr size_t MiB = 1u << 20;
constexpr size_t WS_RSQ = 0, WS_RSKV = 64 * 1024, WS_ROPE = 128 * 1024;
constexpr size_t WS_AGG = 1 * MiB;
constexpr size_t WS_CARRY = 3 * MiB;
constexpr size_t WS_YB = 5 * MiB;
constexpr size_t WS_W_INATT = 13 * MiB;
constexpr size_t WS_W_UQ = WS_W_INATT + (size_t)2304 * 1024 * 2;
constexpr size_t WS_W_UKV = WS_W_UQ + (size_t)768 * 384 * 2;
constexpr size_t WS_W_OUTATT = WS_W_UKV + (size_t)1024 * 256 * 2;
constexpr size_t WS_W_INREC = WS_W_OUTATT + 2 * MiB;
constexpr size_t WS_W_GATES = WS_W_INREC + 4 * MiB;
constexpr size_t WS_W_OUTREC = WS_W_GATES + 1 * MiB;
constexpr size_t WS_W_UP = WS_W_OUTREC + 2 * MiB;
constexpr size_t WS_W_DOWN = WS_W_UP + 32 * MiB;
constexpr size_t WS_W_END = WS_W_DOWN + 16 * MiB;
static_assert(WS_W_END <= 76 * MiB, "weights");
constexpr size_t WS_XN = 76 * MiB;
constexpr size_t WS_BIG = 108 * MiB;
constexpr size_t WS_Z = WS_BIG;
constexpr size_t WS_Q = WS_Z + 72 * MiB;
constexpr size_t WS_KN = WS_Q + 24 * MiB;
constexpr size_t WS_VTM = WS_KN + 16 * MiB;
constexpr size_t WS_VTN = WS_VTM + 16 * MiB;
constexpr size_t WS_KPE = WS_VTN + 16 * MiB;
static_assert(WS_KPE + 1 * MiB <= 256 * MiB, "L0 overlay");
constexpr size_t WS_ACT = WS_BIG;
constexpr size_t WS_GATE = WS_BIG;
constexpr size_t WS_XB = WS_BIG + 32 * MiB;
constexpr size_t WS_XBR = WS_BIG + 64 * MiB;
constexpr size_t WS_GQ = WS_XBR;
constexpr size_t WS_END = 256 * MiB;

using pg8::Unit;

struct EpiBf16 {
    static constexpr bool PERM = true;
    bf16_t* O; int ldc; int split_cols; size_t split_stride;
    __device__ __forceinline__ void operator()(f32x4 (&acc)[2][2][4][2], const Unit& u, int wr, int wc, int fr, int fq) const {
        const int row0 = u.pm * 256 + wr * 64 + fr; int colt = u.pn * 256; bf16_t* base = O;
        if (split_cols) { const int t = colt / split_cols; base += (size_t)t * split_stride; colt -= t * split_cols; }
        const int col0 = colt + wc * 32 + 8 * fq;
#pragma unroll
        for (int ai = 0; ai < 2; ++ai)
#pragma unroll
            for (int m = 0; m < 4; ++m) { bf16_t* rowp = base + (size_t)(row0 + ai * 128 + m * 16) * ldc + col0;
#pragma unroll
                for (int bj = 0; bj < 2; ++bj) { const f32x4 v0 = acc[ai][bj][m][0], v1 = acc[ai][bj][m][1];
                    u32x4 w; w.x = cvt_pk_bf16(v0[0], v0[1]); w.y = cvt_pk_bf16(v0[2], v0[3]); w.z = cvt_pk_bf16(v1[0], v1[1]); w.w = cvt_pk_bf16(v1[2], v1[3]);
                    *(u32x4*)(rowp + bj * 128) = w; } }
    }
};

struct EpiZ {
    static constexpr bool PERM = true;
    bf16_t* Z; bf16_t* VTn;
    __device__ __forceinline__ void operator()(f32x4 (&acc)[2][2][4][2], const Unit& u, int wr, int wc, int fr, int fq) const {
        const int row0 = u.pm * 256 + wr * 64 + fr; const int col0 = u.pn * 256 + wc * 32 + 8 * fq;
#pragma unroll
        for (int ai = 0; ai < 2; ++ai)
#pragma unroll
            for (int m = 0; m < 4; ++m) { const int row = row0 + ai * 128 + m * 16; bf16_t* rowp = Z + (size_t)row * ZP + col0;
#pragma unroll
                for (int bj = 0; bj < 2; ++bj) { const f32x4 v0 = acc[ai][bj][m][0], v1 = acc[ai][bj][m][1];
                    u32x4 w; w.x = cvt_pk_bf16(v0[0], v0[1]); w.y = cvt_pk_bf16(v0[2], v0[3]); w.z = cvt_pk_bf16(v1[0], v1[1]); w.w = cvt_pk_bf16(v1[2], v1[3]);
                    *(u32x4*)(rowp + bj * 128) = w;
                    const int c = col0 + bj * 128;
                    if (c >= 1696 && c < 2208) { bf16_t* vt = VTn + (size_t)(c - 1696) * TH + row;
                        vt[0] = (bf16_t)(w.x & 0xffffu); vt[TH] = (bf16_t)(w.x >> 16); vt[2 * TH] = (bf16_t)(w.y & 0xffffu); vt[3 * TH] = (bf16_t)(w.y >> 16);
                        vt[4 * TH] = (bf16_t)(w.z & 0xffffu); vt[5 * TH] = (bf16_t)(w.z >> 16); vt[6 * TH] = (bf16_t)(w.w & 0xffffu); vt[7 * TH] = (bf16_t)(w.w >> 16); } } }
    }
};

struct EpiQ {
    static constexpr bool PERM = false;
    bf16_t* Q; const float* rsq; const float2* rope; int smask;
    __device__ __forceinline__ void operator()(f32x4 (&acc)[2][2][4][2], const Unit& u, int wr, int wc, int fr, int fq) const {
        const float SC = 0.10206207261596577f * 1.4426950408889634f;
        const int row0 = u.pm * 256 + wr * 64 + fr;
#pragma unroll
        for (int ai = 0; ai < 2; ++ai)
#pragma unroll
            for (int m = 0; m < 4; ++m) { const int row = row0 + ai * 128 + m * 16; const float rs = rsq[row] * SC; const int pos = row & smask;
#pragma unroll
                for (int bj = 0; bj < 2; ++bj) { const int cg = u.pn * 256 + bj * 128 + wc * 32;
                    f32x4 v0 = acc[ai][bj][m][0] * rs, v1 = acc[ai][bj][m][1] * rs;
                    if ((cg % 96) == 64) {
                        const float2* rp = rope + (size_t)pos * 16 + 4 * fq;
#pragma unroll
                        for (int i = 0; i < 4; ++i) { const float2 cs = rp[i]; const float x1 = v0[i], x2 = v1[i]; v0[i] = x1 * cs.x - x2 * cs.y; v1[i] = x2 * cs.x + x1 * cs.y; }
                    }
                    bf16_t* p = Q + (size_t)row * 768 + cg + 4 * fq;
                    u32x2 w0; w0.x = cvt_pk_bf16(v0[0], v0[1]); w0.y = cvt_pk_bf16(v0[2], v0[3]); *(u32x2*)p = w0;
                    u32x2 w1; w1.x = cvt_pk_bf16(v1[0], v1[1]); w1.y = cvt_pk_bf16(v1[2], v1[3]); *(u32x2*)(p + 16) = w1; } }
    }
};

struct EpiKV {
    static constexpr bool PERM = true;
    bf16_t* KN; bf16_t* VTm; const float* rskv;
    __device__ __forceinline__ void operator()(f32x4 (&acc)[2][2][4][2], const Unit& u, int wr, int wc, int fr, int fq) const {
        const int row0 = u.pm * 256 + wr * 64 + fr;
#pragma unroll
        for (int ai = 0; ai < 2; ++ai)
#pragma unroll
            for (int m = 0; m < 4; ++m) { const int row = row0 + ai * 128 + m * 16; const float rs = rskv[row];
#pragma unroll
                for (int bj = 0; bj < 2; ++bj) { const int c = u.pn * 256 + bj * 128 + wc * 32 + 8 * fq;
                    const f32x4 v0 = acc[ai][bj][m][0] * rs, v1 = acc[ai][bj][m][1] * rs;
                    u32x4 w; w.x = cvt_pk_bf16(v0[0], v0[1]); w.y = cvt_pk_bf16(v0[2], v0[3]); w.z = cvt_pk_bf16(v1[0], v1[1]); w.w = cvt_pk_bf16(v1[2], v1[3]);
                    const int h = c >> 7, j = c & 127;
                    if (j < 64) { *(u32x4*)(KN + (size_t)row * 512 + h * 64 + j) = w; }
                    else { bf16_t* vt = VTm + (size_t)(h * 64 + j - 64) * TH + row;
                        vt[0] = (bf16_t)(w.x & 0xffffu); vt[TH] = (bf16_t)(w.x >> 16); vt[2 * TH] = (bf16_t)(w.y & 0xffffu); vt[3 * TH] = (bf16_t)(w.y >> 16);
                        vt[4 * TH] = (bf16_t)(w.z & 0xffffu); vt[5 * TH] = (bf16_t)(w.z >> 16); vt[6 * TH] = (bf16_t)(w.w & 0xffffu); vt[7 * TH] = (bf16_t)(w.w >> 16); } } }
    }
};

struct EpiUp {
    static constexpr bool PERM = true;
    bf16_t* ACT; bf16_t* YB; const float* cw; const float* cb;
    __device__ __forceinline__ void operator()(f32x4 (&acc)[2][2][4][2], const Unit& u, int wr, int wc, int fr_, int fq_) const {
        int fr = fr_, fq = fq_; asm volatile("" : "+v"(fr), "+v"(fq));
        const int lane = fq * 16 + fr;
        const int tok0 = u.pm * 256 + wr * 128 + fr;
        const int ch0 = u.pn * 128 + wc * 32 + 8 * fq;
        const int seg = u.pm * 2 + wr;
        if (fr < 2 || fr >= 14) {
            const int slot = fr < 2 ? fr : fr - 12; const int ai = fr < 2 ? 0 : 1, m = fr < 2 ? 0 : 3;
            bf16_t* yb = YB + ((size_t)seg * 4 + slot) * 8192 + ch0;
#pragma unroll
            for (int bj = 0; bj < 2; ++bj) { const f32x4 v0 = ai ? acc[1][bj][3][0] : acc[0][bj][0][0], v1 = ai ? acc[1][bj][3][1] : acc[0][bj][0][1]; (void)m;
                u32x4 w; w.x = cvt_pk_bf16(v0[0], v0[1]); w.y = cvt_pk_bf16(v0[2], v0[3]); w.z = cvt_pk_bf16(v1[0], v1[1]); w.w = cvt_pk_bf16(v1[2], v1[3]);
                *(u32x4*)(yb + bj * 4096) = w; }
        }
        const int src_up = (lane & ~15) | ((fr - 1) & 15), src_dn = (lane & ~15) | ((fr + 1) & 15);
#pragma unroll
        for (int n = 0; n < 2; ++n)
#pragma unroll
            for (int i = 0; i < 4; ++i) {
                float ug[8], uv[8];
#pragma unroll
                for (int bj = 0; bj < 2; ++bj) {
                    const int ch = bj * 4096 + ch0 + 4 * n + i;
                    const float w0 = cw[ch], w1 = cw[8192 + ch], w2 = cw[2 * 8192 + ch], b = cb[ch];
#pragma unroll
                    for (int q = 0; q < 8; ++q) {
                        const float v = acc[q >> 2][bj][q & 3][n][i];
                        const float vp = q > 0 ? acc[(q - 1) >> 2][bj][(q - 1) & 3][n][i] : 0.f;
                        const float vn = q < 7 ? acc[(q + 1) >> 2][bj][(q + 1) & 3][n][i] : 0.f;
                        const float up = bperm_f(src_up, fr == 15 ? vp : v);
                        const float dn = bperm_f(src_dn, fr == 0 ? vn : v);
                        const float r = w0 * up + w1 * v + w2 * dn + b;
                        if (bj == 0) ug[q] = r; else uv[q] = r;
                    }
                }
#pragma unroll
                for (int q = 0; q < 8; ++q) acc[q >> 2][0][q & 3][n][i] = gelu_tanh(ug[q]) * uv[q];
            }
#pragma unroll
        for (int ai = 0; ai < 2; ++ai)
#pragma unroll
            for (int m = 0; m < 4; ++m) { const f32x4 v0 = acc[ai][0][m][0], v1 = acc[ai][0][m][1];
                u32x4 w; w.x = cvt_pk_bf16(v0[0], v0[1]); w.y = cvt_pk_bf16(v0[2], v0[3]); w.z = cvt_pk_bf16(v1[0], v1[1]); w.w = cvt_pk_bf16(v1[2], v1[3]);
                *(u32x4*)(ACT + (size_t)(tok0 + 64 * ai + 16 * m) * DFF + ch0) = w; }
    }
};
constexpr float EPS = 1e-6f;
constexpr float LOG2E = 1.4426950408889634f;

__device__ __forceinline__ void transpose_item(const float* W, int K, int N, bf16_t* WT, int row_off, const float* kscale, LAS float* scr, int item, int lane) {
    const int nblk = N / 32, kb = item / nblk, nb = item % nblk, k0 = 64 * kb, n0 = 32 * nb;
#pragma unroll 8
    for (int i = 0; i < 32; ++i) { const int kk = 2 * i + (lane >> 5); float v = W[(size_t)(k0 + kk) * N + n0 + (lane & 31)]; if (kscale) v *= kscale[k0 + kk]; scr[kk * 33 + (lane & 31)] = v; }
    asm volatile("s_waitcnt lgkmcnt(0)" ::: "memory");
    const int c = lane & 7;
#pragma unroll
    for (int j = 0; j < 4; ++j) { const int n = (lane >> 3) + 8 * j; const LAS float* s = scr + (8 * c) * 33 + n;
        u32x4 o; o.x = cvt_pk_bf16(s[0 * 33], s[1 * 33]); o.y = cvt_pk_bf16(s[2 * 33], s[3 * 33]); o.z = cvt_pk_bf16(s[4 * 33], s[5 * 33]); o.w = cvt_pk_bf16(s[6 * 33], s[7 * 33]);
        *(u32x4*)(WT + (size_t)(row_off + n0 + n) * K + k0 + 8 * c) = o; }
    asm volatile("s_waitcnt lgkmcnt(0)" ::: "memory");
}

__device__ __forceinline__ void xn_row(const float* xrow, const float* gain, bf16_t* orow, int lane) {
    const f32x4* xr = (const f32x4*)xrow + lane; const f32x4* gr = (const f32x4*)gain + lane;
    f32x4 v[4]; float s = 0.f;
#pragma unroll
    for (int j = 0; j < 4; ++j) { v[j] = xr[64 * j]; s += (v[j].x * v[j].x + v[j].y * v[j].y) + (v[j].z * v[j].z + v[j].w * v[j].w); }
    const float rs = 1.0f / sqrtf(wave_sum(s, lane) * (1.f / DM) + EPS);
    u32x2* o8 = (u32x2*)orow + lane;
#pragma unroll
    for (int j = 0; j < 4; ++j) { const f32x4 g = gr[64 * j]; u32x2 w; w.x = cvt_pk_bf16(v[j].x * rs * g.x, v[j].y * rs * g.y); w.y = cvt_pk_bf16(v[j].z * rs * g.z, v[j].w * rs * g.w); o8[64 * j] = w; }
}

__device__ __forceinline__ void res_row(const bf16_t* mrow, const float* xi, float* xo, const float* gpost, const float* gnext, bf16_t* xnrow, int lane) {
    const u32x2* mr = (const u32x2*)mrow + lane; const f32x4* xr = (const f32x4*)xi + lane; const f32x4* gp = (const f32x4*)gpost + lane;
    f32x4 mv[4]; float s = 0.f;
#pragma unroll
    for (int j = 0; j < 4; ++j) { const u32x2 w = mr[64 * j]; mv[j] = (f32x4){bflo(w.x), bfhi(w.x), bflo(w.y), bfhi(w.y)}; s += (mv[j].x * mv[j].x + mv[j].y * mv[j].y) + (mv[j].z * mv[j].z + mv[j].w * mv[j].w); }
    const float rs = 1.0f / sqrtf(wave_sum(s, lane) * (1.f / DM) + EPS);
    f32x4 x[4]; float s2 = 0.f;
#pragma unroll
    for (int j = 0; j < 4; ++j) { const f32x4 g = gp[64 * j]; x[j] = xr[64 * j] + mv[j] * rs * g; s2 += (x[j].x * x[j].x + x[j].y * x[j].y) + (x[j].z * x[j].z + x[j].w * x[j].w); }
    f32x4* xw = (f32x4*)xo + lane;
#pragma unroll
    for (int j = 0; j < 4; ++j) xw[64 * j] = x[j];
    if (gnext) {
        const float rs2 = 1.0f / sqrtf(wave_sum(s2, lane) * (1.f / DM) + EPS);
        const f32x4* gn = (const f32x4*)gnext + lane; u32x2* o8 = (u32x2*)xnrow + lane;
#pragma unroll
        for (int j = 0; j < 4; ++j) { const f32x4 g = gn[64 * j]; u32x2 w; w.x = cvt_pk_bf16(x[j].x * rs2 * g.x, x[j].y * rs2 * g.y); w.y = cvt_pk_bf16(x[j].z * rs2 * g.z, x[j].w * rs2 * g.w); o8[64 * j] = w; }
    }
}

__device__ __forceinline__ void mla_unit(LAS unsigned char* lds, const bf16_t* Q, const bf16_t* KN, const bf16_t* KPE, const bf16_t* VT, bf16_t* AO, int tokbase, int S, int h, int qb, int tid) {
    constexpr int KP = 208, VP = 144, KBYTES = 64 * KP, VBYTES = 64 * VP, BUF = KBYTES + VBYTES;
    const int lane = tid & 63, wid = tid >> 6, r32 = lane & 31, hi = lane >> 5;
    const int kkey0 = tid / 12, kc0 = tid % 12, kkey1 = (tid + 512) / 12, kc1 = (tid + 512) % 12; const bool has1 = tid < 256;
    const int vd = tid >> 3, vc = tid & 7;
    const bf16_t* ksrc0 = kc0 < 8 ? KN + (size_t)(tokbase + kkey0) * 512 + h * 64 + 8 * kc0 : KPE + (size_t)(tokbase + kkey0) * 32 + 8 * (kc0 - 8);
    const size_t kst0 = kc0 < 8 ? 512 : 32;
    const bf16_t* ksrc1 = kc1 < 8 ? KN + (size_t)(tokbase + kkey1) * 512 + h * 64 + 8 * kc1 : KPE + (size_t)(tokbase + kkey1) * 32 + 8 * (kc1 - 8);
    const size_t kst1 = kc1 < 8 ? 512 : 32;
    const bf16_t* vsrc = VT + (size_t)(h * 64 + vd) * TH + tokbase + 8 * vc;
    const int kd0 = kkey0 * KP + 16 * kc0, kd1 = kkey1 * KP + 16 * kc1, vdst = KBYTES + vd * VP + 16 * vc;
    const int NT = S / 64;
    const int qtok = tokbase + 256 * qb + 32 * wid + r32;
    bf16x8 qr[6];
#pragma unroll
    for (int d0 = 0; d0 < 6; ++d0) qr[d0] = *(const bf16x8*)(Q + (size_t)qtok * 768 + h * 96 + 16 * d0 + 8 * hi);
    u32x4 rk0, rk1 = (u32x4){0, 0, 0, 0}, rv;
    rk0 = *(const u32x4*)ksrc0; if (has1) rk1 = *(const u32x4*)ksrc1; rv = *(const u32x4*)vsrc;
    *(LAS u32x4*)(lds + kd0) = rk0; if (has1) *(LAS u32x4*)(lds + kd1) = rk1; *(LAS u32x4*)(lds + vdst) = rv;
    __syncthreads();
    f32x16 o0, o1;
#pragma unroll
    for (int r = 0; r < 16; ++r) { o0[r] = 0.f; o1[r] = 0.f; }
    float m_run = -1e30f, l_run = 0.f;
    for (int t = 0; t < NT; ++t) {
        if (t + 1 < NT) { const size_t ko = (size_t)(t + 1) * 64; rk0 = *(const u32x4*)(ksrc0 + ko * kst0); if (has1) rk1 = *(const u32x4*)(ksrc1 + ko * kst1); rv = *(const u32x4*)(vsrc + ko); }
        const LAS unsigned char* kb = lds + (t & 1) * BUF; const LAS unsigned char* vb = kb + KBYTES;
        f32x16 p0, p1;
#pragma unroll
        for (int r = 0; r < 16; ++r) { p0[r] = 0.f; p1[r] = 0.f; }
#pragma unroll
        for (int d0 = 0; d0 < 6; ++d0) {
            const bf16x8 a0 = *(const LAS bf16x8*)(kb + r32 * KP + 32 * d0 + 16 * hi);
            const bf16x8 a1 = *(const LAS bf16x8*)(kb + (32 + r32) * KP + 32 * d0 + 16 * hi);
            p0 = __builtin_amdgcn_mfma_f32_32x32x16_bf16(a0, qr[d0], p0, 0, 0, 0);
            p1 = __builtin_amdgcn_mfma_f32_32x32x16_bf16(a1, qr[d0], p1, 0, 0, 0);
        }
        float mx = fmaxf(p0[0], p1[0]);
#pragma unroll
        for (int r = 1; r < 16; ++r) mx = fmaxf(mx, fmaxf(p0[r], p1[r]));
        mx = xor32_max(mx);
        const float m_new = fmaxf(m_run, mx), alpha = fexp2(m_run - m_new); m_run = m_new;
        float ls = 0.f;
#pragma unroll
        for (int r = 0; r < 16; ++r) { p0[r] = fexp2(p0[r] - m_new); p1[r] = fexp2(p1[r] - m_new); ls += p0[r] + p1[r]; }
        l_run = l_run * alpha + ls;
#pragma unroll
        for (int r = 0; r < 16; ++r) { o0[r] *= alpha; o1[r] *= alpha; }
#pragma unroll
        for (int ks = 0; ks < 4; ++ks) {
            u32x4 pw;
            if (ks == 0) { pw.x = cvt_pk_bf16(p0[0], p0[1]); pw.y = cvt_pk_bf16(p0[2], p0[3]); pw.z = cvt_pk_bf16(p0[4], p0[5]); pw.w = cvt_pk_bf16(p0[6], p0[7]); }
            else if (ks == 1) { pw.x = cvt_pk_bf16(p0[8], p0[9]); pw.y = cvt_pk_bf16(p0[10], p0[11]); pw.z = cvt_pk_bf16(p0[12], p0[13]); pw.w = cvt_pk_bf16(p0[14], p0[15]); }
            else if (ks == 2) { pw.x = cvt_pk_bf16(p1[0], p1[1]); pw.y = cvt_pk_bf16(p1[2], p1[3]); pw.z = cvt_pk_bf16(p1[4], p1[5]); pw.w = cvt_pk_bf16(p1[6], p1[7]); }
            else { pw.x = cvt_pk_bf16(p1[8], p1[9]); pw.y = cvt_pk_bf16(p1[10], p1[11]); pw.z = cvt_pk_bf16(p1[12], p1[13]); pw.w = cvt_pk_bf16(p1[14], p1[15]); }
            const bf16x8 pa = __builtin_bit_cast(bf16x8, pw);
            const LAS unsigned char* vp = vb + r32 * VP + (16 * ks + 4 * hi) * 2;
            const u32x2 a_lo = *(const LAS u32x2*)(vp), a_hi = *(const LAS u32x2*)(vp + 16);
            const u32x2 b_lo = *(const LAS u32x2*)(vp + 32 * VP), b_hi = *(const LAS u32x2*)(vp + 32 * VP + 16);
            const bf16x8 vf0 = __builtin_bit_cast(bf16x8, ((u32x4){a_lo.x, a_lo.y, a_hi.x, a_hi.y}));
            const bf16x8 vf1 = __builtin_bit_cast(bf16x8, ((u32x4){b_lo.x, b_lo.y, b_hi.x, b_hi.y}));
            o0 = __builtin_amdgcn_mfma_f32_32x32x16_bf16(vf0, pa, o0, 0, 0, 0);
            o1 = __builtin_amdgcn_mfma_f32_32x32x16_bf16(vf1, pa, o1, 0, 0, 0);
        }
        if (t + 1 < NT) { LAS unsigned char* nb = lds + ((t + 1) & 1) * BUF; *(LAS u32x4*)(nb + kd0) = rk0; if (has1) *(LAS u32x4*)(nb + kd1) = rk1; *(LAS u32x4*)(nb + vdst) = rv; }
        __syncthreads();
    }
    const float l = xor32_sum(l_run); const float inv = 1.0f / l;
    bf16_t* orow = AO + (size_t)qtok * 1024 + h * 64 + 4 * hi;
#pragma unroll
    for (int rg = 0; rg < 4; ++rg) {
        u32x2 w; w.x = cvt_pk_bf16(o0[4 * rg] * inv, o0[4 * rg + 1] * inv); w.y = cvt_pk_bf16(o0[4 * rg + 2] * inv, o0[4 * rg + 3] * inv); *(u32x2*)(orow + 8 * rg) = w;
        u32x2 w2; w2.x = cvt_pk_bf16(o1[4 * rg] * inv, o1[4 * rg + 1] * inv); w2.y = cvt_pk_bf16(o1[4 * rg + 2] * inv, o1[4 * rg + 3] * inv); *(u32x2*)(orow + 32 + 8 * rg) = w2;
    }
}

__device__ __forceinline__ unsigned na_vmask(int qc, int kh, int hi) {
    int cs = qc - 8; cs = cs < 0 ? 0 : cs; cs = cs > 48 ? 48 : cs; unsigned mk = 0u;
#pragma unroll
    for (int r = 0; r < 16; ++r) { const int kc = 32 * kh + (r & 3) + 8 * (r >> 2) + 4 * hi; mk |= ((kc >= cs) && (kc < cs + 16)) ? (1u << r) : 0u; }
    return mk;
}
__device__ __forceinline__ void na_qs(const bf16x8 (&kf)[4], const bf16x8 (&vf)[2][2], const bf16x8 (&qf)[4], const LAS float* brow, int qc, int kh, int hi, unsigned vmsel,
                                      float& m_run, float& l_run, f32x16& o0, f32x16& o1) {
    const float SCL = 0.125f * LOG2E;
    f32x16 p;
#pragma unroll
    for (int r = 0; r < 16; ++r) p[r] = 0.f;
#pragma unroll
    for (int d0 = 0; d0 < 4; ++d0) p = __builtin_amdgcn_mfma_f32_32x32x16_bf16(kf[d0], qf[d0], p, 0, 0, 0);
    unsigned vm = vmsel; asm volatile("" : "+v"(vm));
    float mx = -1e30f;
#pragma unroll
    for (int r = 0; r < 16; ++r) { const int kc = 32 * kh + (r & 3) + 8 * (r >> 2) + 4 * hi;
        int bi = kc - qc + 15; bi = bi < 0 ? 0 : bi; bi = bi > 30 ? 30 : bi;
        const float sc = p[r] * SCL + brow[bi]; p[r] = ((vm >> r) & 1u) ? sc : -1e30f; mx = fmaxf(mx, p[r]); }
    mx = xor32_max(mx);
    const float m_new = fmaxf(m_run, mx), alpha = fexp2(m_run - m_new); m_run = m_new;
    const float m_use = fmaxf(m_new, -1e20f);
    float ls = 0.f;
#pragma unroll
    for (int r = 0; r < 16; ++r) { const float e = fexp2(p[r] - m_use); p[r] = e; ls += e; }
    l_run = l_run * alpha + ls;
#pragma unroll
    for (int r = 0; r < 16; ++r) { o0[r] *= alpha; o1[r] *= alpha; }
#pragma unroll
    for (int k2 = 0; k2 < 2; ++k2) {
        u32x4 pw; pw.x = cvt_pk_bf16(p[8 * k2 + 0], p[8 * k2 + 1]); pw.y = cvt_pk_bf16(p[8 * k2 + 2], p[8 * k2 + 3]); pw.z = cvt_pk_bf16(p[8 * k2 + 4], p[8 * k2 + 5]); pw.w = cvt_pk_bf16(p[8 * k2 + 6], p[8 * k2 + 7]);
        const bf16x8 pa = __builtin_bit_cast(bf16x8, pw);
        o0 = __builtin_amdgcn_mfma_f32_32x32x16_bf16(vf[0][k2], pa, o0, 0, 0, 0);
        o1 = __builtin_amdgcn_mfma_f32_32x32x16_bf16(vf[1][k2], pa, o1, 0, 0, 0);
    }
}
__device__ __forceinline__ void na_store(bf16_t* orow, const f32x16& o0, const f32x16& o1, float l_run) {
    const float l = xor32_sum(l_run); const float inv = 1.0f / l;
#pragma unroll
    for (int rg = 0; rg < 4; ++rg) {
        u32x2 w; w.x = cvt_pk_bf16(o0[4 * rg] * inv, o0[4 * rg + 1] * inv); w.y = cvt_pk_bf16(o0[4 * rg + 2] * inv, o0[4 * rg + 3] * inv); *(u32x2*)(orow + 8 * rg) = w;
        u32x2 w2; w2.x = cvt_pk_bf16(o1[4 * rg] * inv, o1[4 * rg + 1] * inv); w2.y = cvt_pk_bf16(o1[4 * rg + 2] * inv, o1[4 * rg + 3] * inv); *(u32x2*)(orow + 32 + 8 * rg) = w2;
    }
}
__device__ __forceinline__ void na_unit(const LAS float* biasT, const bf16_t* Z, const bf16_t* VTn, bf16_t* AO, int tokbase, int S, int rr, int tid) {
    const int lane = tid & 63, h = tid >> 6, r32 = lane & 31, hi = lane >> 5;
    const int rows = S / 64; int rs = rr - 4; rs = rs < 0 ? 0 : rs; rs = rs > rows - 8 ? rows - 8 : rs;
    bf16x8 qfa[4], qfb[4];
#pragma unroll
    for (int d0 = 0; d0 < 4; ++d0) { qfa[d0] = *(const bf16x8*)(Z + (size_t)(tokbase + rr * 64 + r32) * ZP + 672 + h * 64 + 16 * d0 + 8 * hi);
                                      qfb[d0] = *(const bf16x8*)(Z + (size_t)(tokbase + rr * 64 + 32 + r32) * ZP + 672 + h * 64 + 16 * d0 + 8 * hi); }
    f32x16 oa0, oa1, ob0, ob1; float ma = -1e30f, mb = -1e30f, la = 0.f, lb = 0.f;
#pragma unroll
    for (int r = 0; r < 16; ++r) { oa0[r] = 0.f; oa1[r] = 0.f; ob0[r] = 0.f; ob1[r] = 0.f; }
    const unsigned va0 = na_vmask(r32, 0, hi), va1 = na_vmask(r32, 1, hi), vb0 = na_vmask(32 + r32, 0, hi), vb1 = na_vmask(32 + r32, 1, hi);
    const bf16_t* kbase = Z + (size_t)(tokbase + rs * 64 + r32) * ZP + 672 + 512 + h * 64 + 8 * hi;
    const bf16_t* vbase0 = VTn + (size_t)(h * 64 + r32) * TH + tokbase + rs * 64 + 4 * hi;
#pragma unroll 1
    for (int it = 0; it < 16; ++it) {
        const int kr = it >> 1, kh = it & 1;
        const LAS float* brow = biasT + (h * 15 + (rs + kr - rr + 7)) * 31;
        const bf16_t* kp = kbase + (size_t)(kr * 64 + kh * 32) * ZP;
        bf16x8 kf[4];
#pragma unroll
        for (int d0 = 0; d0 < 4; ++d0) kf[d0] = *(const bf16x8*)(kp + 16 * d0);
        const bf16_t* vp0 = vbase0 + kr * 64 + kh * 32; const bf16_t* vp1 = vp0 + (size_t)32 * TH;
        bf16x8 vf[2][2];
#pragma unroll
        for (int k2 = 0; k2 < 2; ++k2) { const u32x2 lo = *(const u32x2*)(vp0 + 16 * k2), hi2 = *(const u32x2*)(vp0 + 16 * k2 + 8); vf[0][k2] = __builtin_bit_cast(bf16x8, ((u32x4){lo.x, lo.y, hi2.x, hi2.y}));
            const u32x2 lo1 = *(const u32x2*)(vp1 + 16 * k2), hi3 = *(const u32x2*)(vp1 + 16 * k2 + 8); vf[1][k2] = __builtin_bit_cast(bf16x8, ((u32x4){lo1.x, lo1.y, hi3.x, hi3.y})); }
        na_qs(kf, vf, qfa, brow, r32, kh, hi, kh ? va1 : va0, ma, la, oa0, oa1);
        na_qs(kf, vf, qfb, brow, 32 + r32, kh, hi, kh ? vb1 : vb0, mb, lb, ob0, ob1);
    }
    na_store(AO + (size_t)(tokbase + rr * 64 + r32) * 1024 + 512 + h * 64 + 4 * hi, oa0, oa1, la);
    na_store(AO + (size_t)(tokbase + rr * 64 + 32 + r32) * 1024 + 512 + h * 64 + 4 * hi, ob0, ob1, lb);
}
constexpr int LDS_BYTES = 147456;
constexpr int NTHR = 512;
struct Args { const float* in[26]; float* out; unsigned char* ws; };

__device__ __forceinline__ void lru_ab(float ga, float gx, float gab, float gxb, float spl  , float xb, float& a, float& b) {
    const float r = sigmoidf_(ga + gab), ii = sigmoidf_(gx + gxb);
    const float la = -8.0f * r * spl;
    a = fexp2(la * LOG2E);
    const float om = -expm1f(2.0f * la);
    b = sqrtf(om) * (ii * xb);
}

__global__ void __launch_bounds__(NTHR, 2) mk_fwd(Args a) {
    extern __shared__ __attribute__((aligned(16))) unsigned char lds_raw[];
    LAS unsigned char* lds = (LAS unsigned char*)lds_raw;
    cg::grid_group grid = cg::this_grid();
    typedef const __attribute__((address_space(4))) Args* ArgP;
    ArgP ap0 = (ArgP)__builtin_amdgcn_kernarg_segment_ptr();
#define PH_BEGIN ArgP ap = ap0; asm volatile("" : "+s"(ap)); unsigned char* ws = ap->ws; (void)ws; int tid_ = threadIdx.x; asm volatile("" : "+v"(tid_)); const int tid = tid_, lane = tid & 63, wave = tid >> 6; int G_ = gridDim.x, bid_ = blockIdx.x; asm volatile("" : "+s"(G_), "+s"(bid_)); const int G = G_, bid = bid_; const int gw = bid * 8 + wave, NGW = G * 8; const int gt = bid * NTHR + tid, NGT = G * NTHR; (void)lane; (void)gw; (void)NGW; (void)gt; (void)NGT;
#define IN(k) (ap->in[k])
#define rsq ((float*)(ws + WS_RSQ))
#define rskv ((float*)(ws + WS_RSKV))
#define rope ((float2*)(ws + WS_ROPE))
#define AGG ((float2*)(ws + WS_AGG))
#define CARRY ((float*)(ws + WS_CARRY))
#define YB ((bf16_t*)(ws + WS_YB))
#define W_INATT ((bf16_t*)(ws + WS_W_INATT))
#define W_UQ ((bf16_t*)(ws + WS_W_UQ))
#define W_UKV ((bf16_t*)(ws + WS_W_UKV))
#define W_OUTATT ((bf16_t*)(ws + WS_W_OUTATT))
#define W_INREC ((bf16_t*)(ws + WS_W_INREC))
#define W_GATES ((bf16_t*)(ws + WS_W_GATES))
#define W_OUTREC ((bf16_t*)(ws + WS_W_OUTREC))
#define W_UP ((bf16_t*)(ws + WS_W_UP))
#define W_DOWN ((bf16_t*)(ws + WS_W_DOWN))
#define XN ((bf16_t*)(ws + WS_XN))
#define Zb ((bf16_t*)(ws + WS_Z))
#define Qb ((bf16_t*)(ws + WS_Q))
#define KN ((bf16_t*)(ws + WS_KN))
#define VTM ((bf16_t*)(ws + WS_VTM))
#define VTN ((bf16_t*)(ws + WS_VTN))
#define KPE ((bf16_t*)(ws + WS_KPE))
#define ACT ((bf16_t*)(ws + WS_ACT))
#define GATE ((bf16_t*)(ws + WS_GATE))
#define XB ((bf16_t*)(ws + WS_XB))
#define XBR ((bf16_t*)(ws + WS_XBR))
#define GQ ((bf16_t*)(ws + WS_GQ))
#define AO XN
#define Fb XN
#define YR XN
#define M0 Zb
#define M1 XBR
#define XIN (IN(half))
#define XST (ap->out + (size_t)half * TH * DM)
    { PH_BEGIN
    {
        LAS float* scr = (LAS float*)(lds + wave * 16384);
        constexpr int I_INATT = 16 * 69, I_UQ = 6 * 24, I_UKV = 4 * 32, I_SQ = 16 * 32, I_INREC = 16 * 64, I_UP = 16 * 256, I_DOWN = 64 * 32, I_GATE = 32 * 8;
        constexpr int NITEMS = I_INATT + I_UQ + I_UKV + 2 * I_SQ + I_INREC + 2 * I_UP + 2 * I_DOWN + I_GATE;
        for (int it = gw; it < NITEMS; it += NGW) {
            int r = it;
            if (r < I_INATT) { transpose_item(IN(6), 1024, 2208, W_INATT, 0, nullptr, scr, r, lane); continue; } r -= I_INATT;
            if (r < I_UQ) { transpose_item(IN(8), 384, 768, W_UQ, 0, IN(7), scr, r, lane); continue; } r -= I_UQ;
            if (r < I_UKV) { transpose_item(IN(10), 256, 1024, W_UKV, 0, IN(9), scr, r, lane); continue; } r -= I_UKV;
            if (r < I_SQ) { transpose_item(IN(12), 1024, 1024, W_OUTATT, 0, nullptr, scr, r, lane); continue; } r -= I_SQ;
            if (r < I_SQ) { transpose_item(IN(21), 1024, 1024, W_OUTREC, 0, nullptr, scr, r, lane); continue; } r -= I_SQ;
            if (r < I_INREC) { transpose_item(IN(13), 1024, 2048, W_INREC, 0, nullptr, scr, r, lane); continue; } r -= I_INREC;
            if (r < 2 * I_UP) { const int li = r / I_UP; transpose_item(IN(22) + (size_t)li * 1024 * 8192, 1024, 8192, W_UP + (size_t)li * 8192 * 1024, 0, nullptr, scr, r % I_UP, lane); continue; } r -= 2 * I_UP;
            if (r < 2 * I_DOWN) { const int li = r / I_DOWN; transpose_item(IN(25) + (size_t)li * 4096 * 1024, 4096, 1024, W_DOWN + (size_t)li * 1024 * 4096, 0, nullptr, scr, r % I_DOWN, lane); continue; } r -= 2 * I_DOWN;
            { const int mat = r / 8, sub = r % 8; const int type = mat >> 4, e = (mat >> 3) & 1, n = mat & 7;
              transpose_item(IN(type ? 18 : 16) + (size_t)(e * 8 + n) * 128 * 128, 128, 128, W_GATES, n * 512 + (type * 2 + e) * 128, nullptr, scr, sub, lane); }
        }
        for (int i = gt; i < 96 * 1024 / 8; i += NGT) ((u32x4*)(W_INATT + (size_t)2208 * 1024))[i] = (u32x4){0, 0, 0, 0};
        for (int i = gt; i < 4096 * 16; i += NGT) { const int pos = i >> 4, j = i & 15;
            const double inv = exp2(-(double)j * (13.287712379549449 / 16.0));
            const double rev = (double)pos * inv * 0.15915494309189535; const float fr = (float)(rev - floor(rev));
            rope[i] = make_float2(__builtin_amdgcn_cosf(fr), __builtin_amdgcn_sinf(fr)); }
    }

    }
    for (int half = 0; half < 2; ++half) {
        const int S = half ? 4096 : 2048, nseq = TH / S;
                { PH_BEGIN
        for (int m = gw; m < TH; m += NGW) xn_row(XIN + (size_t)m * DM, IN(2), XN + (size_t)m * DM, lane);
        }
        grid.sync();
        { PH_BEGIN
        { pg8::Gemm g = pg8::make_gemm(XN, DM, W_INATT, DM, DM); pg8::StaticOrder so; so.init(TH / 256, ZP / 256, G, bid);
          EpiZ E{Zb, VTN};
#ifndef NO_G1
pg8::gemm_phase<EpiZ>(lds, g, so, E);
#endif
 }
        }
        grid.sync();
        { PH_BEGIN
        for (int t = gw; t < TH; t += NGW) {
            const bf16_t* z = Zb + (size_t)t * ZP;
            float sq = 0.f, skv = 0.f;
            { const unsigned* p = (const unsigned*)z + lane * 3;
#pragma unroll
              for (int j = 0; j < 3; ++j) { const unsigned w = p[j]; const float x0 = bflo(w), x1 = bfhi(w); sq += x0 * x0 + x1 * x1; } }
            { const unsigned* p = (const unsigned*)(z + 384) + lane * 2;
#pragma unroll
              for (int j = 0; j < 2; ++j) { const unsigned w = p[j]; const float x0 = bflo(w), x1 = bfhi(w); skv += x0 * x0 + x1 * x1; } }
            sq = wave_sum(sq, lane); skv = wave_sum(skv, lane);
            if (lane == 0) { rsq[t] = 1.0f / sqrtf(sq * (1.f / 384.f) + EPS); rskv[t] = 1.0f / sqrtf(skv * (1.f / 256.f) + EPS); }
            if (lane < 16) { const float x1 = bf2f(z[640 + lane]), x2 = bf2f(z[656 + lane]); const float2 cs = rope[(size_t)(t & (S - 1)) * 16 + lane];
                KPE[(size_t)t * 32 + lane] = f2bf(x1 * cs.x - x2 * cs.y); KPE[(size_t)t * 32 + 16 + lane] = f2bf(x2 * cs.x + x1 * cs.y); }
        }
        }
        grid.sync();
        { PH_BEGIN
        { pg8::Gemm g = pg8::make_gemm(Zb, ZP, W_UQ, 384, 384); pg8::StaticOrder so; so.init(TH / 256, 3, G, bid);
          EpiQ E{Qb, rsq, rope, S - 1};
#ifndef NO_G2
pg8::gemm_phase<EpiQ>(lds, g, so, E);
#endif
 }
        { pg8::Gemm g = pg8::make_gemm(Zb + 384, ZP, W_UKV, 256, 256); pg8::StaticOrder so; so.init(TH / 256, 4, G, bid);
          EpiKV E{KN, VTM, rskv};
#ifndef NO_G3
pg8::gemm_phase<EpiKV>(lds, g, so, E);
#endif
 }
        }
        grid.sync();
        { PH_BEGIN
        {
            LAS float* biasT = (LAS float*)(lds + 65536);
            for (int i = tid; i < 8 * 15 * 31; i += NTHR) biasT[i] = IN(11)[i] * LOG2E;
            __syncthreads();
            const int nqb = S / 256, nunits = nseq * 8 * nqb;
#ifndef NO_MLA
            for (int u = bid; u < nunits; u += G) { const int qb = u % nqb, h = (u / nqb) & 7, s = u / (nqb * 8);
                mla_unit(lds, Qb, KN, KPE, VTM, AO, s * S, S, h, qb, tid); }
#endif
            const int rows = S / 64, nna = nseq * rows;
#ifndef NO_NA
            for (int u = bid; u < nna; u += G) na_unit(biasT, Zb, VTN, AO, (u / rows) * S, S, u % rows, tid);
#endif
        }
        }
        grid.sync();
        { PH_BEGIN
        { pg8::Gemm g = pg8::make_gemm(AO, DM, W_OUTATT, DM, DM); pg8::StaticOrder so; so.init(TH / 256, 4, G, bid);
          EpiBf16 E{M0, DM, 0, 0};
#ifndef NO_G4
pg8::gemm_phase<EpiBf16>(lds, g, so, E);
#endif
 }
        }
        grid.sync();
        { PH_BEGIN
        for (int m = gw; m < TH; m += NGW) res_row(M0 + (size_t)m * DM, XIN + (size_t)m * DM, XST + (size_t)m * DM, IN(3), IN(4), XN + (size_t)m * DM, lane);
        }
        grid.sync();

        for (int li = 0; li < 2; ++li) {
            if (li == 1) {
                { PH_BEGIN
                { pg8::Gemm g = pg8::make_gemm(XN, DM, W_INREC, DM, DM); pg8::StaticOrder so; so.init(TH / 256, 8, G, bid);
                  EpiBf16 E{GATE, DM, 1024, (size_t)(WS_XBR - WS_GATE) / 2};
#ifndef NO_G5
pg8::gemm_phase<EpiBf16>(lds, g, so, E);
#endif
 }
                }
                grid.sync();
                { PH_BEGIN
                for (int i = gt; i < TH * 128; i += NGT) { const int t = i >> 7, c8 = (i & 127) * 8; const int pos = t & (S - 1);
                    float accv[8];
#pragma unroll
                    for (int j = 0; j < 8; ++j) accv[j] = IN(15)[c8 + j];
#pragma unroll
                    for (int k = 0; k < 4; ++k) { const int p2 = pos + k - 1; if (p2 < 0 || p2 >= S) continue;
                        const u32x4 w = *(const u32x4*)(XBR + (size_t)(t + k - 1) * DM + c8); const float* cwk = IN(14) + k * 1024 + c8;
                        accv[0] += cwk[0] * bflo(w.x); accv[1] += cwk[1] * bfhi(w.x); accv[2] += cwk[2] * bflo(w.y); accv[3] += cwk[3] * bfhi(w.y);
                        accv[4] += cwk[4] * bflo(w.z); accv[5] += cwk[5] * bfhi(w.z); accv[6] += cwk[6] * bflo(w.w); accv[7] += cwk[7] * bfhi(w.w); }
                    u32x4 o; o.x = cvt_pk_bf16(accv[0], accv[1]); o.y = cvt_pk_bf16(accv[2], accv[3]); o.z = cvt_pk_bf16(accv[4], accv[5]); o.w = cvt_pk_bf16(accv[6], accv[7]);
                    *(u32x4*)(XB + (size_t)t * DM + c8) = o; }
                }
                grid.sync();
                for (int qt = 0; qt < 2; ++qt) {
                    const int t0 = qt * TQ;
                    { PH_BEGIN
                    { pg8::Gemm g = pg8::make_gemm(XB + (size_t)t0 * DM, DM, W_GATES, 128, 128); g.a_pn_shift = 1; g.a_pn_step = 256;
                      pg8::StaticOrder so; so.init(TQ / 256, 16, G, bid);
                      EpiBf16 E{GQ, 4096, 0, 0};
#ifndef NO_G6
pg8::gemm_phase<EpiBf16>(lds, g, so, E);
#endif
 }
                    }
                    grid.sync();
                    { PH_BEGIN
                    for (int i = gt; i < 128 * 2 * 1024; i += NGT) { const int ch = i & 1023, e = (i >> 10) & 1, c = i >> 11; const int n = ch >> 7, d = ch & 127;
                        const float gab = IN(17)[e * 1024 + ch], gxb = IN(19)[e * 1024 + ch]; const float lam = IN(20)[e * 1024 + ch];
                        const float spl = log1pf(expf(-lam));
                        float A = 1.f, B = 0.f;
                        for (int s = 0; s < 64; ++s) { const int tl = c * 64 + (e ? 63 - s : s);
                            const bf16_t* gq = GQ + (size_t)tl * 4096 + n * 512 + d;
                            float av, bv; lru_ab(bf2f(gq[e * 128]), bf2f(gq[(2 + e) * 128]), gab, gxb, spl, bf2f(XB[(size_t)(t0 + tl) * DM + ch]), av, bv);
                            A *= av; B = av * B + bv; }
                        AGG[i] = make_float2(A, B); }
                    }
                    grid.sync();
                    { PH_BEGIN
                    { const int cps = S / 64, nsq = TQ / S;
                      for (int i = gt; i < nsq * 2 * 1024; i += NGT) { const int ch = i & 1023, e = (i >> 10) & 1, sq = i >> 11;
                          float hcar = 0.f;
                          for (int k = 0; k < cps; ++k) { const int c = sq * cps + (e ? cps - 1 - k : k); const int idx = (c * 2 + e) * 1024 + ch;
                              CARRY[idx] = hcar; const float2 ab = AGG[idx]; hcar = ab.x * hcar + ab.y; } } }
                    }
                    grid.sync();
                    { PH_BEGIN
#ifndef NO_R6
                    for (int i = gt; i < 128 * 1024; i += NGT) { const int ch = i & 1023, c = i >> 10; const int n = ch >> 7, d = ch & 127;
                        const float spl0 = log1pf(expf(-IN(20)[ch])), spl1 = log1pf(expf(-IN(20)[1024 + ch]));
                        const float gab0 = IN(17)[ch], gab1 = IN(17)[1024 + ch], gxb0 = IN(19)[ch], gxb1 = IN(19)[1024 + ch];
                        float hc = CARRY[(c * 2 + 0) * 1024 + ch];
#pragma unroll 4
                        for (int s = 0; s < 64; ++s) { const int tl = c * 64 + s; const bf16_t* gq = GQ + (size_t)tl * 4096 + n * 512 + d;
                            float av, bv; lru_ab(bf2f(gq[0]), bf2f(gq[256]), gab0, gxb0, spl0, bf2f(XB[(size_t)(t0 + tl) * DM + ch]), av, bv);
                            hc = av * hc + bv; YR[(size_t)(t0 + tl) * DM + ch] = f2bf(hc); }
                        hc = CARRY[(c * 2 + 1) * 1024 + ch];
#pragma unroll 4
                        for (int s = 63; s >= 0; --s) { const int tl = c * 64 + s; const bf16_t* gq = GQ + (size_t)tl * 4096 + n * 512 + d;
                            float av, bv; lru_ab(bf2f(gq[128]), bf2f(gq[384]), gab1, gxb1, spl1, bf2f(XB[(size_t)(t0 + tl) * DM + ch]), av, bv);
                            hc = av * hc + bv;
                            const float gt_ = bf2f(GATE[(size_t)(t0 + tl) * DM + ch]); const float hfw = bf2f(YR[(size_t)(t0 + tl) * DM + ch]);
                            YR[(size_t)(t0 + tl) * DM + ch] = f2bf((hfw + hc) * gelu_tanh(gt_)); }
                    }
#endif
                    }
                    grid.sync();
                }
                { PH_BEGIN
                { pg8::Gemm g = pg8::make_gemm(YR, DM, W_OUTREC, DM, DM); pg8::StaticOrder so; so.init(TH / 256, 4, G, bid);
                  EpiBf16 E{M1, DM, 0, 0};
#ifndef NO_G7
pg8::gemm_phase<EpiBf16>(lds, g, so, E);
#endif
 }
                }
                grid.sync();
                { PH_BEGIN
                for (int m = gw; m < TH; m += NGW) res_row(M1 + (size_t)m * DM, XST + (size_t)m * DM, XST + (size_t)m * DM, IN(3) + 1024, IN(4) + 1024, XN + (size_t)m * DM, lane);
                }
                grid.sync();
            }
            { PH_BEGIN
            { pg8::Gemm g = pg8::make_gemm(XN, DM, W_UP + (size_t)li * 8192 * 1024, DM, DM);
              g.a_seg = 1; g.hA = (size_t)64 * DM * 2; g.tB = (size_t)128 * DM * 2; g.hB = (size_t)4096 * DM * 2;
              pg8::StaticOrder so; so.init(TH / 256, 32, G, bid);
#ifndef NO_UP
              EpiUp E{ACT, YB, IN(23) + (size_t)li * 3 * 8192, IN(24) + (size_t)li * 8192}; pg8::gemm_phase<EpiUp>(lds, g, so, E);
#endif
 }
            }
            grid.sync();
            { PH_BEGIN
            for (int b = bid; b < 256; b += G) { const int seg = b >> 1, which = b & 1; const int t = seg * 128 + (which ? 127 : 0); const int pos = t & (S - 1);
                const float* cw = IN(23) + (size_t)li * 3 * 8192; const float* cb = IN(24) + (size_t)li * 8192;
                const bool hasp = which ? true : (pos != 0), hasn = which ? (pos != S - 1) : true;
                const bf16_t* yp = which ? YB + ((size_t)seg * 4 + 2) * 8192 : YB + ((size_t)(seg - 1) * 4 + 3) * 8192;
                const bf16_t* yc = YB + ((size_t)seg * 4 + (which ? 3 : 0)) * 8192;
                const bf16_t* yn = which ? YB + ((size_t)(seg + 1) * 4 + 0) * 8192 : YB + ((size_t)seg * 4 + 1) * 8192;
                for (int c = tid; c < 4096; c += NTHR) {
                    float u2[2];
#pragma unroll
                    for (int bj = 0; bj < 2; ++bj) { const int ch = bj * 4096 + c;
                        float r = cw[8192 + ch] * bf2f(yc[ch]) + cb[ch];
                        if (hasp) r += cw[ch] * bf2f(yp[ch]);
                        if (hasn) r += cw[2 * 8192 + ch] * bf2f(yn[ch]);
                        u2[bj] = r; }
                    ACT[(size_t)t * DFF + c] = f2bf(gelu_tanh(u2[0]) * u2[1]); } }
            }
            grid.sync();
            { PH_BEGIN
            { pg8::Gemm g = pg8::make_gemm(ACT, DFF, W_DOWN + (size_t)li * 1024 * 4096, DFF, DFF); pg8::StaticOrder so; so.init(TH / 256, 4, G, bid);
              EpiBf16 E{Fb, DM, 0, 0};
#ifndef NO_G8
pg8::gemm_phase<EpiBf16>(lds, g, so, E);
#endif
 }
            }
            grid.sync();
            { PH_BEGIN
            for (int m = gw; m < TH; m += NGW) res_row(Fb + (size_t)m * DM, XST + (size_t)m * DM, XST + (size_t)m * DM, IN(5) + li * 1024, li == 0 ? IN(2) + 1024 : nullptr, XN + (size_t)m * DM, lane);
            }
            grid.sync();
        }
    }
}

extern "C" void kernel_launch(void* const* d_in, const int* in_sizes, int n_in, void* d_out, int out_size, void* d_ws, size_t ws_size, hipStream_t stream) {
    static int grid = 0;
    if (grid == 0) {
        int dev = 0, cus = 0, per_cu = 0;
        (void)hipGetDevice(&dev);
        (void)hipDeviceGetAttribute(&cus, hipDeviceAttributeMultiprocessorCount, dev);
        (void)hipFuncSetAttribute((const void*)mk_fwd, hipFuncAttributeMaxDynamicSharedMemorySize, LDS_BYTES);
        (void)hipOccupancyMaxActiveBlocksPerMultiprocessor(&per_cu, (const void*)mk_fwd, NTHR, LDS_BYTES);
        if (per_cu < 1) per_cu = 1;
        grid = cus * per_cu;
        if (ws_size < WS_END || n_in != 26) { fprintf(stderr, "kernel_launch: unexpected ws_size %zu / n_in %d\n", ws_size, n_in); }
    }
    Args a{};
    for (int i = 0; i < 26; ++i) a.in[i] = (const float*)d_in[i];
    a.out = (float*)d_out; a.ws = (unsigned char*)d_ws;
    void* args[] = {&a};
    hipError_t e = hipLaunchCooperativeKernel((const void*)mk_fwd, dim3(grid), dim3(NTHR), args, LDS_BYTES, stream);
    if (e != hipSuccess) fprintf(stderr, "cooperative launch failed: %s (grid %d)\n", hipGetErrorString(e), grid);
}
```

```cpp
#include <hip/hip_runtime.h>
#include <hip/hip_cooperative_groups.h>
#include <cstdio>
#include <cstdint>
namespace cg = cooperative_groups;

#define LAS __attribute__((address_space(3)))
typedef unsigned short bf16_t;
typedef short bf16x8 __attribute__((ext_vector_type(8)));
typedef short s16x4 __attribute__((ext_vector_type(4)));
typedef float f32x4 __attribute__((ext_vector_type(4)));
typedef float f32x16 __attribute__((ext_vector_type(16)));
typedef unsigned u32x4 __attribute__((ext_vector_type(4)));
typedef unsigned u32x2 __attribute__((ext_vector_type(2)));

__device__ __forceinline__ unsigned cvt_pk_bf16(float lo, float hi) { unsigned r; asm volatile("v_cvt_pk_bf16_f32 %0, %1, %2" : "=v"(r) : "v"(lo), "v"(hi)); return r; }
__device__ __forceinline__ float bf2f(bf16_t v) { return __uint_as_float(((unsigned)v) << 16); }
__device__ __forceinline__ float bflo(unsigned w) { return __uint_as_float(w << 16); }
__device__ __forceinline__ float bfhi(unsigned w) { return __uint_as_float(w & 0xffff0000u); }
__device__ __forceinline__ bf16_t f2bf(float f) { return (bf16_t)(cvt_pk_bf16(f, 0.f) & 0xffffu); }
__device__ __forceinline__ float fexp2(float x) { return __builtin_amdgcn_exp2f(x); }
__device__ __forceinline__ float frcp(float x) { return __builtin_amdgcn_rcpf(x); }
__device__ __forceinline__ float gelu_tanh(float x) {
    const float u = x * (1.0f + 0.044715f * x * x) * (-2.0f * 0.7978845608028654f * 1.4426950408889634f);
    return x * frcp(1.0f + fexp2(u));
}
__device__ __forceinline__ float sigmoidf_(float x) { return frcp(1.0f + fexp2(-1.4426950408889634f * x)); }
__device__ __forceinline__ float bperm_f(int src_lane, float v) { return __int_as_float(__builtin_amdgcn_ds_bpermute(src_lane << 2, __float_as_int(v))); }
__device__ __forceinline__ float wave_sum(float v, int l  ) {
#pragma unroll
    for (int o = 1; o < 64; o <<= 1) v += bperm_f(l ^ o, v);
    return v;
}
__device__ __forceinline__ float xor32_max(float v) { auto rr = __builtin_amdgcn_permlane32_swap(__float_as_uint(v), __float_as_uint(v), false, false); return fmaxf(__uint_as_float(rr[0]), __uint_as_float(rr[1])); }
__device__ __forceinline__ float xor32_sum(float v) { auto rr = __builtin_amdgcn_permlane32_swap(__float_as_uint(v), __float_as_uint(v), false, false); return __uint_as_float(rr[0]) + __uint_as_float(rr[1]); }

namespace pg8 {
constexpr int BM = 256, BK = 64, HALF = 128, HTB = HALF * BK * 2, STAGE_BYTES = 8 * HTB, NXCD = 8, WGM = 8;
__host__ __device__ __forceinline__ int lds_byte(int r, int c) { const int st = (r >> 4) * 2 + (c >> 5), rr = r & 15, cc = c & 31, ob = rr * 64 + cc * 2; return st * 1024 + (ob ^ (((ob >> 9) & 1) << 5)); }
__host__ __device__ __forceinline__ void stage_rc(int b, int& R, int& C) { const int st = b / 1024, sb = b % 1024, swz = sb ^ (((sb >> 9) & 1) << 5); R = (st >> 1) * 16 + swz / 64; C = (st & 1) * 32 + (swz % 64) / 2; }
__host__ __device__ __forceinline__ int perm32(int rho) { const int n = rho >> 4, i = rho & 15; return 8 * (i >> 2) + 4 * n + (i & 3); }

struct Unit { int pm, pn; };
struct Gemm { const bf16_t* A; const bf16_t* Bt; int lda, ldb, K; size_t tA, hA, tB, hB; int a_seg; int a_pn_shift; size_t a_pn_step; };
__device__ __forceinline__ Gemm make_gemm(const bf16_t* A, int lda, const bf16_t* Bt, int ldb, int K) {
    Gemm g; g.A = A; g.Bt = Bt; g.lda = lda; g.ldb = ldb; g.K = K; g.tA = (size_t)256 * lda * 2; g.hA = (size_t)128 * lda * 2; g.tB = (size_t)256 * ldb * 2; g.hB = (size_t)128 * ldb * 2;
    g.a_seg = 0; g.a_pn_shift = 0; g.a_pn_step = 0; return g;
}

struct StaticOrder {
    int nM, nN, nwg, G, c;
    __device__ void init(int nM_, int nN_, int G_, int c_) { nM = nM_; nN = nN_; nwg = nM * nN; G = G_; c = c_; }
    __device__ bool next(int i, Unit& u) const {
        const long L = (long)i * G + c; if (L >= nwg) return false;
        int wgid = (int)L; { const int q = nwg / NXCD, r = nwg % NXCD, xcd = wgid % NXCD, off = wgid / NXCD; wgid = (xcd < r ? xcd * (q + 1) : r * (q + 1) + (xcd - r) * q) + off; }
        const int nig = WGM * nN, gid = wgid / nig, fm = gid * WGM, gsz = (nM - fm) < WGM ? (nM - fm) : WGM;
        u.pm = fm + ((wgid % nig) % gsz); u.pn = (wgid % nig) / gsz; return true;
    }
};

template <class Epi>
__device__ __forceinline__ void gemm_phase(LAS unsigned char* lds, const Gemm g, const StaticOrder& S, const Epi& E) {
    constexpr bool SP2 = true, ALIGN_EPI = true;
    int tid_ = threadIdx.x; asm volatile("" : "+v"(tid_));
    const int tid = tid_, wid = __builtin_amdgcn_readfirstlane(tid >> 6), lane = tid & 63, wr = wid >> 2, wc = wid & 3, fr = lane & 15, fq = lane >> 4;
    int K_ = g.K; asm volatile("" : "+s"(K_)); const int K = K_, nt = K / BK;
    unsigned voffA[2], voffB[2];
#pragma unroll
    for (int i = 0; i < 2; ++i) { int R, C; stage_rc(tid * 16 + i * 8192, R, C); const int Rb = Epi::PERM ? ((R & ~31) + perm32(R & 31)) : R;
        const int Ra = g.a_seg ? (128 * (R >> 6) + (R & 63)) : R;
        voffA[i] = (unsigned)(Ra * g.lda + C) * 2u; voffB[i] = (unsigned)(Rb * g.ldb + C) * 2u; }
    const size_t kstep = (size_t)(BK * 2);
    const size_t hstepA = g.hA, hstepB = g.hB;
    const unsigned ldsw = (unsigned)wid * 1024u;
    const int aoff = lds_byte(wr * 64 + fr, fq * 8), boff = lds_byte(wc * 32 + fr, fq * 8);
#define PG8_SA(b, h) (((b) * 2 + (h)) * HTB)
#define PG8_SB(b, h) ((4 + (b) * 2 + (h)) * HTB)
#define PG8_STAGE(bufoff, gbase, voff) do { _Pragma("unroll") for (int _i = 0; _i < 2; ++_i) \
        __builtin_amdgcn_global_load_lds((const unsigned*)((const char*)(gbase) + (voff)[_i]), (LAS unsigned*)(lds + (bufoff) + ldsw + _i * 8192), 16, 0, 0); } while (0)
#define PG8_LDA(dst, b, h) do { _Pragma("unroll") for (int m = 0; m < 4; ++m) _Pragma("unroll") for (int k = 0; k < 2; ++k) dst[m][k] = *(const LAS bf16x8*)(lds + PG8_SA(b, h) + aoff + m * 2048 + k * 1024); } while (0)
#define PG8_LDB(dst, b, h) do { _Pragma("unroll") for (int n = 0; n < 2; ++n) _Pragma("unroll") for (int k = 0; k < 2; ++k) dst[n][k] = *(const LAS bf16x8*)(lds + PG8_SB(b, h) + boff + n * 2048 + k * 1024); } while (0)
#define PG8_MMA(ai, bj, At, Bt) do { __builtin_amdgcn_s_setprio(1); _Pragma("unroll") for (int m = 0; m < 4; ++m) _Pragma("unroll") for (int n = 0; n < 2; ++n) _Pragma("unroll") for (int k = 0; k < 2; ++k) \
        acc[ai][bj][m][n] = __builtin_amdgcn_mfma_f32_16x16x32_bf16(Bt[n][k], At[m][k], acc[ai][bj][m][n], 0, 0, 0); __builtin_amdgcn_s_setprio(0); } while (0)
#define PG8_WAIT_V(n) asm volatile("s_waitcnt vmcnt(" #n ")" ::: "memory")
#define PG8_WAIT_L(n) asm volatile("s_waitcnt lgkmcnt(" #n ")" ::: "memory")
#define PG8_BAR __builtin_amdgcn_s_barrier()
#define PG8_SCHED __builtin_amdgcn_sched_barrier(0)
#define PG8_APTR(u) ((const char*)g.A + (size_t)(u).pm * g.tA + (size_t)((u).pn >> g.a_pn_shift) * g.a_pn_step)
#define PG8_BPTR(u) ((const char*)g.Bt + (size_t)(u).pn * g.tB)
    Unit cur, nxt; int ui = 0;
    if (!S.next(0, cur)) return;
    f32x4 acc[2][2][4][2];
#pragma unroll
    for (int a = 0; a < 2; ++a)
#pragma unroll
        for (int b = 0; b < 2; ++b)
#pragma unroll
            for (int m = 0; m < 4; ++m)
#pragma unroll
                for (int n = 0; n < 2; ++n) acc[a][b][m][n] = (f32x4){0.f, 0.f, 0.f, 0.f};
    bf16x8 At[4][2], B0[2][2], B1[2][2];
    const char* cA = PG8_APTR(cur); const char* cB = PG8_BPTR(cur);
    {
        PG8_STAGE(PG8_SB(0, 0), cB, voffB); PG8_STAGE(PG8_SB(0, 1), cB + hstepB, voffB); PG8_STAGE(PG8_SA(0, 0), cA, voffA); PG8_STAGE(PG8_SA(0, 1), cA + hstepA, voffA);
        if (wr == 1) PG8_BAR;
        PG8_WAIT_V(2); PG8_BAR;
        PG8_STAGE(PG8_SB(1, 0), cB + kstep, voffB); PG8_STAGE(PG8_SA(1, 0), cA + kstep, voffA); PG8_STAGE(PG8_SB(1, 1), cB + hstepB + kstep, voffB);
        PG8_WAIT_V(6); PG8_BAR;
    }
    for (;;) {
        const bool has_next = S.next(ui + 1, nxt);
        const char* nA = has_next ? PG8_APTR(nxt) : cA; const char* nB = has_next ? PG8_BPTR(nxt) : cB;
        for (int t = 0; t < nt; t += 2) {
            const bool last = (t == nt - 2);
            const char* a1 = cA + (size_t)(t + 1) * kstep;
            const char* a2 = last ? nA : cA + (size_t)(t + 2) * kstep; const char* b2 = last ? nB : cB + (size_t)(t + 2) * kstep;
            const char* a3 = a2 + kstep; const char* b3 = b2 + kstep;
            PG8_LDB(B0, 0, 0); PG8_LDB(B1, 0, 1); PG8_SCHED; PG8_LDA(At, 0, 0); PG8_STAGE(PG8_SA(1, 1), a1 + hstepA, voffA);
            PG8_WAIT_V(8); PG8_WAIT_L(0); PG8_BAR; PG8_MMA(0, 0, At, B0); PG8_MMA(0, 1, At, B1); PG8_BAR; PG8_SCHED;
            PG8_LDA(At, 0, 1); PG8_STAGE(PG8_SB(0, 0), b2, voffB); PG8_STAGE(PG8_SB(0, 1), b2 + hstepB, voffB); PG8_STAGE(PG8_SA(0, 0), a2, voffA);
            PG8_WAIT_V(8); PG8_WAIT_L(0); PG8_BAR; PG8_MMA(1, 0, At, B0); PG8_MMA(1, 1, At, B1); PG8_BAR; PG8_SCHED;
            PG8_LDB(B0, 1, 0); PG8_LDB(B1, 1, 1); PG8_SCHED; PG8_LDA(At, 1, 0); PG8_STAGE(PG8_SA(0, 1), a2 + hstepA, voffA);
            PG8_WAIT_V(8); PG8_WAIT_L(0); PG8_BAR; PG8_MMA(0, 0, At, B0); PG8_MMA(0, 1, At, B1); PG8_BAR; PG8_SCHED;
            PG8_LDA(At, 1, 1); PG8_STAGE(PG8_SB(1, 0), b3, voffB); PG8_STAGE(PG8_SB(1, 1), b3 + hstepB, voffB); PG8_STAGE(PG8_SA(1, 0), a3, voffA);
            PG8_WAIT_V(8); PG8_WAIT_L(0); PG8_BAR; PG8_MMA(1, 0, At, B0); PG8_MMA(1, 1, At, B1); PG8_BAR; PG8_SCHED;
        }
        if constexpr (ALIGN_EPI) { if (wr == 0) PG8_BAR; }
        E(acc, cur, wr, wc, fr, fq);
        if (!has_next) break;
#pragma unroll
        for (int a = 0; a < 2; ++a)
#pragma unroll
            for (int b = 0; b < 2; ++b)
#pragma unroll
                for (int m = 0; m < 4; ++m)
#pragma unroll
                    for (int n = 0; n < 2; ++n) acc[a][b][m][n] = (f32x4){0.f, 0.f, 0.f, 0.f};
        cur = nxt; cA = nA; cB = nB; ++ui;
        if constexpr (ALIGN_EPI) { if (wr == 1) PG8_BAR; }
    }
    PG8_WAIT_V(0);
    if constexpr (!ALIGN_EPI) { if (wr == 0) PG8_BAR; }
    PG8_BAR;
#undef PG8_SA
#undef PG8_SB
#undef PG8_STAGE
#undef PG8_LDA
#undef PG8_LDB
#undef PG8_MMA
#undef PG8_WAIT_V
#undef PG8_WAIT_L
#undef PG8_BAR
#undef PG8_SCHED
#undef PG8_APTR
#undef PG8_BPTR
}
}
constexpr int TH = 16384;
constexpr int DM = 1024, ZP = 2304, DFF = 4096, TQ = 8192;
constexpr size_t MiB = 1u << 20;
constexpr size_t WS_RSQ = 0, WS_RSKV = 64 * 1024, WS_ROPE = 128 * 1024;
constexpr size_t WS_AGG = 1 * MiB;
constexpr size_t WS_CARRY = 3 * MiB;
constexpr size_t WS_BAR = 4 * MiB;
constexpr size_t WS_YB = 5 * MiB;
constexpr size_t WS_W_INATT = 13 * MiB;
constexpr size_t WS_W_UQ = WS_W_INATT + (size_t)2304 * 1024 * 2;
constexpr size_t WS_W_UKV = WS_W_UQ + (size_t)768 * 384 * 2;
constexpr size_t WS_W_OUTATT = WS_W_UKV + (size_t)1024 * 256 * 2;
constexpr size_t WS_W_INREC = WS_W_OUTATT + 2 * MiB;
constexpr size_t WS_W_GATES = WS_W_INREC + 4 * MiB;
constexpr size_t WS_W_OUTREC = WS_W_GATES + 1 * MiB;
constexpr size_t WS_W_UP = WS_W_OUTREC + 2 * MiB;
constexpr size_t WS_W_DOWN = WS_W_UP + 32 * MiB;
constexpr size_t WS_W_END = WS_W_DOWN + 16 * MiB;
static_assert(WS_W_END <= 76 * MiB, "weights");
constexpr size_t WS_XN = 76 * MiB;
constexpr size_t WS_BIG = 108 * MiB;
constexpr size_t WS_Z = WS_BIG;
constexpr size_t WS_Q = WS_Z + 72 * MiB;
constexpr size_t WS_KN = WS_Q + 24 * MiB;
constexpr size_t WS_VTM = WS_KN + 16 * MiB;
constexpr size_t WS_VTN = WS_VTM + 16 * MiB;
constexpr size_t WS_KPE = WS_VTN + 16 * MiB;
static_assert(WS_KPE + 1 * MiB <= 256 * MiB, "L0 overlay");
constexpr size_t WS_ACT = WS_BIG;
constexpr size_t WS_GATE = WS_BIG;
constexpr size_t WS_XB = WS_BIG + 32 * MiB;
constexpr size_t WS_XBR = WS_BIG + 64 * MiB;
constexpr size_t WS_GQ = WS_XBR;
constexpr size_t WS_END = 256 * MiB;

using pg8::Unit;

struct EpiBf16 {
    static constexpr bool PERM = true;
    bf16_t* O; int ldc; int split_cols; size_t split_stride;
    __device__ __forceinline__ void operator()(f32x4 (&acc)[2][2][4][2], const Unit& u, int wr, int wc, int fr, int fq) const {
        const int row0 = u.pm * 256 + wr * 64 + fr; int colt = u.pn * 256; bf16_t* base = O;
        if (split_cols) { const int t = colt / split_cols; base += (size_t)t * split_stride; colt -= t * split_cols; }
        const int col0 = colt + wc * 32 + 8 * fq;
#pragma unroll
        for (int ai = 0; ai < 2; ++ai)
#pragma unroll
            for (int m = 0; m < 4; ++m) { bf16_t* rowp = base + (size_t)(row0 + ai * 128 + m * 16) * ldc + col0;
#pragma unroll
                for (int bj = 0; bj < 2; ++bj) { const f32x4 v0 = acc[ai][bj][m][0], v1 = acc[ai][bj][m][1];
                    u32x4 w; w.x = cvt_pk_bf16(v0[0], v0[1]); w.y = cvt_pk_bf16(v0[2], v0[3]); w.z = cvt_pk_bf16(v1[0], v1[1]); w.w = cvt_pk_bf16(v1[2], v1[3]);
                    *(u32x4*)(rowp + bj * 128) = w; } }
    }
};

struct EpiZ {
    static constexpr bool PERM = true;
    bf16_t* Z; bf16_t* VTn;
    __device__ __forceinline__ void operator()(f32x4 (&acc)[2][2][4][2], const Unit& u, int wr, int wc, int fr, int fq) const {
        const int row0 = u.pm * 256 + wr * 64 + fr; const int col0 = u.pn * 256 + wc * 32 + 8 * fq;
#pragma unroll
        for (int ai = 0; ai < 2; ++ai)
#pragma unroll
            for (int m = 0; m < 4; ++m) { const int row = row0 + ai * 128 + m * 16; bf16_t* rowp = Z + (size_t)row * ZP + col0;
#pragma unroll
                for (int bj = 0; bj < 2; ++bj) { const f32x4 v0 = acc[ai][bj][m][0], v1 = acc[ai][bj][m][1];
                    u32x4 w; w.x = cvt_pk_bf16(v0[0], v0[1]); w.y = cvt_pk_bf16(v0[2], v0[3]); w.z = cvt_pk_bf16(v1[0], v1[1]); w.w = cvt_pk_bf16(v1[2], v1[3]);
                    *(u32x4*)(rowp + bj * 128) = w;
                    const int c = col0 + bj * 128;
                    if (c >= 1696 && c < 2208) { bf16_t* vt = VTn + (size_t)(c - 1696) * TH + row;
                        vt[0] = (bf16_t)(w.x & 0xffffu); vt[TH] = (bf16_t)(w.x >> 16); vt[2 * TH] = (bf16_t)(w.y & 0xffffu); vt[3 * TH] = (bf16_t)(w.y >> 16);
                        vt[4 * TH] = (bf16_t)(w.z & 0xffffu); vt[5 * TH] = (bf16_t)(w.z >> 16); vt[6 * TH] = (bf16_t)(w.w & 0xffffu); vt[7 * TH] = (bf16_t)(w.w >> 16); } } }
    }
};

struct EpiQ {
    static constexpr bool PERM = false;
    bf16_t* Q; const float* rsq; const float2* rope; int smask;
    __device__ __forceinline__ void operator()(f32x4 (&acc)[2][2][4][2], const Unit& u, int wr, int wc, int fr, int fq) const {
        const float SC = 0.10206207261596577f * 1.4426950408889634f;
        const int row0 = u.pm * 256 + wr * 64 + fr;
#pragma unroll
        for (int ai = 0; ai < 2; ++ai)
#pragma unroll
            for (int m = 0; m < 4; ++m) { const int row = row0 + ai * 128 + m * 16; const float rs = rsq[row] * SC; const int pos = row & smask;
#pragma unroll
                for (int bj = 0; bj < 2; ++bj) { const int cg = u.pn * 256 + bj * 128 + wc * 32;
                    f32x4 v0 = acc[ai][bj][m][0] * rs, v1 = acc[ai][bj][m][1] * rs;
                    if ((cg % 96) == 64) {
                        const float2* rp = rope + (size_t)pos * 16 + 4 * fq;
#pragma unroll
                        for (int i = 0; i < 4; ++i) { const float2 cs = rp[i]; const float x1 = v0[i], x2 = v1[i]; v0[i] = x1 * cs.x - x2 * cs.y; v1[i] = x2 * cs.x + x1 * cs.y; }
                    }
                    bf16_t* p = Q + (size_t)row * 768 + cg + 4 * fq;
                    u32x2 w0; w0.x = cvt_pk_bf16(v0[0], v0[1]); w0.y = cvt_pk_bf16(v0[2], v0[3]); *(u32x2*)p = w0;
                    u32x2 w1; w1.x = cvt_pk_bf16(v1[0], v1[1]); w1.y = cvt_pk_bf16(v1[2], v1[3]); *(u32x2*)(p + 16) = w1; } }
    }
};

struct EpiKV {
    static constexpr bool PERM = true;
    bf16_t* KN; bf16_t* VTm; const float* rskv;
    __device__ __forceinline__ void operator()(f32x4 (&acc)[2][2][4][2], const Unit& u, int wr, int wc, int fr, int fq) const {
        const int row0 = u.pm * 256 + wr * 64 + fr;
#pragma unroll
        for (int ai = 0; ai < 2; ++ai)
#pragma unroll
            for (int m = 0; m < 4; ++m) { const int row = row0 + ai * 128 + m * 16; const float rs = rskv[row];
#pragma unroll
                for (int bj = 0; bj < 2; ++bj) { const int c = u.pn * 256 + bj * 128 + wc * 32 + 8 * fq;
                    const f32x4 v0 = acc[ai][bj][m][0] * rs, v1 = acc[ai][bj][m][1] * rs;
                    u32x4 w; w.x = cvt_pk_bf16(v0[0], v0[1]); w.y = cvt_pk_bf16(v0[2], v0[3]); w.z = cvt_pk_bf16(v1[0], v1[1]); w.w = cvt_pk_bf16(v1[2], v1[3]);
                    const int h = c >> 7, j = c & 127;
                    if (j < 64) { *(u32x4*)(KN + (size_t)row * 512 + h * 64 + j) = w; }
                    else { bf16_t* vt = VTm + (size_t)(h * 64 + j - 64) * TH + row;
                        vt[0] = (bf16_t)(w.x & 0xffffu); vt[TH] = (bf16_t)(w.x >> 16); vt[2 * TH] = (bf16_t)(w.y & 0xffffu); vt[3 * TH] = (bf16_t)(w.y >> 16);
                        vt[4 * TH] = (bf16_t)(w.z & 0xffffu); vt[5 * TH] = (bf16_t)(w.z >> 16); vt[6 * TH] = (bf16_t)(w.w & 0xffffu); vt[7 * TH] = (bf16_t)(w.w >> 16); } } }
    }
};

struct EpiUp {
    static constexpr bool PERM = true;
    bf16_t* ACT; bf16_t* YB; const float* cw; const float* cb;
    __device__ __forceinline__ void operator()(f32x4 (&acc)[2][2][4][2], const Unit& u, int wr, int wc, int fr_, int fq_) const {
        int fr = fr_, fq = fq_; asm volatile("" : "+v"(fr), "+v"(fq));
        const int lane = fq * 16 + fr;
        const int tok0 = u.pm * 256 + wr * 128 + fr;
        const int ch0 = u.pn * 128 + wc * 32 + 8 * fq;
        const int seg = u.pm * 2 + wr;
        if (fr < 2 || fr >= 14) {
            const int slot = fr < 2 ? fr : fr - 12; const int ai = fr < 2 ? 0 : 1, m = fr < 2 ? 0 : 3;
            bf16_t* yb = YB + ((size_t)seg * 4 + slot) * 8192 + ch0;
#pragma unroll
            for (int bj = 0; bj < 2; ++bj) { const f32x4 v0 = ai ? acc[1][bj][3][0] : acc[0][bj][0][0], v1 = ai ? acc[1][bj][3][1] : acc[0][bj][0][1]; (void)m;
                u32x4 w; w.x = cvt_pk_bf16(v0[0], v0[1]); w.y = cvt_pk_bf16(v0[2], v0[3]); w.z = cvt_pk_bf16(v1[0], v1[1]); w.w = cvt_pk_bf16(v1[2], v1[3]);
                *(u32x4*)(yb + bj * 4096) = w; }
        }
        const int src_up = (lane & ~15) | ((fr - 1) & 15), src_dn = (lane & ~15) | ((fr + 1) & 15);
#pragma unroll
        for (int n = 0; n < 2; ++n)
#pragma unroll
            for (int i = 0; i < 4; ++i) {
                float ug[8], uv[8];
#pragma unroll
                for (int bj = 0; bj < 2; ++bj) {
                    const int ch = bj * 4096 + ch0 + 4 * n + i;
                    const float w0 = cw[ch], w1 = cw[8192 + ch], w2 = cw[2 * 8192 + ch], b = cb[ch];
#pragma unroll
                    for (int q = 0; q < 8; ++q) {
                        const float v = acc[q >> 2][bj][q & 3][n][i];
                        const float vp = q > 0 ? acc[(q - 1) >> 2][bj][(q - 1) & 3][n][i] : 0.f;
                        const float vn = q < 7 ? acc[(q + 1) >> 2][bj][(q + 1) & 3][n][i] : 0.f;
                        const float up = bperm_f(src_up, fr == 15 ? vp : v);
                        const float dn = bperm_f(src_dn, fr == 0 ? vn : v);
                        const float r = w0 * up + w1 * v + w2 * dn + b;
                        if (bj == 0) ug[q] = r; else uv[q] = r;
                    }
                }
#pragma unroll
                for (int q = 0; q < 8; ++q) acc[q >> 2][0][q & 3][n][i] = gelu_tanh(ug[q]) * uv[q];
            }
#pragma unroll
        for (int ai = 0; ai < 2; ++ai)
#pragma unroll
            for (int m = 0; m < 4; ++m) { const f32x4 v0 = acc[ai][0][m][0], v1 = acc[ai][0][m][1];
                u32x4 w; w.x = cvt_pk_bf16(v0[0], v0[1]); w.y = cvt_pk_bf16(v0[2], v0[3]); w.z = cvt_pk_bf16(v1[0], v1[1]); w.w = cvt_pk_bf16(v1[2], v1[3]);
                *(u32x4*)(ACT + (size_t)(tok0 + 64 * ai + 16 * m) * DFF + ch0) = w; }
    }
};
constexpr float EPS = 1e-6f;
constexpr float LOG2E = 1.4426950408889634f;

__device__ __forceinline__ void transpose_item(const float* W, int K, int N, bf16_t* WT, int row_off, const float* kscale, LAS float* scr, int item, int lane) {
    const int nblk = N / 32, kb = item / nblk, nb = item % nblk, k0 = 64 * kb, n0 = 32 * nb;
#pragma unroll 8
    for (int i = 0; i < 32; ++i) { const int kk = 2 * i + (lane >> 5); float v = W[(size_t)(k0 + kk) * N + n0 + (lane & 31)]; if (kscale) v *= kscale[k0 + kk]; scr[kk * 33 + (lane & 31)] = v; }
    asm volatile("s_waitcnt lgkmcnt(0)" ::: "memory");
    const int c = lane & 7;
#pragma unroll
    for (int j = 0; j < 4; ++j) { const int n = (lane >> 3) + 8 * j; const LAS float* s = scr + (8 * c) * 33 + n;
        u32x4 o; o.x = cvt_pk_bf16(s[0 * 33], s[1 * 33]); o.y = cvt_pk_bf16(s[2 * 33], s[3 * 33]); o.z = cvt_pk_bf16(s[4 * 33], s[5 * 33]); o.w = cvt_pk_bf16(s[6 * 33], s[7 * 33]);
        *(u32x4*)(WT + (size_t)(row_off + n0 + n) * K + k0 + 8 * c) = o; }
    asm volatile("s_waitcnt lgkmcnt(0)" ::: "memory");
}

__device__ __forceinline__ void xn_row(const float* xrow, const float* gain, bf16_t* orow, int lane) {
    const f32x4* xr = (const f32x4*)xrow + lane; const f32x4* gr = (const f32x4*)gain + lane;
    f32x4 v[4]; float s = 0.f;
#pragma unroll
    for (int j = 0; j < 4; ++j) { v[j] = xr[64 * j]; s += (v[j].x * v[j].x + v[j].y * v[j].y) + (v[j].z * v[j].z + v[j].w * v[j].w); }
    const float rs = 1.0f / sqrtf(wave_sum(s, lane) * (1.f / DM) + EPS);
    u32x2* o8 = (u32x2*)orow + lane;
#pragma unroll
    for (int j = 0; j < 4; ++j) { const f32x4 g = gr[64 * j]; u32x2 w; w.x = cvt_pk_bf16(v[j].x * rs * g.x, v[j].y * rs * g.y); w.y = cvt_pk_bf16(v[j].z * rs * g.z, v[j].w * rs * g.w); o8[64 * j] = w; }
}

__device__ __forceinline__ void res_row(const bf16_t* mrow, const float* xi, float* xo, const float* gpost, const float* gnext, bf16_t* xnrow, int lane) {
    const u32x2* mr = (const u32x2*)mrow + lane; const f32x4* xr = (const f32x4*)xi + lane; const f32x4* gp = (const f32x4*)gpost + lane;
    f32x4 mv[4]; float s = 0.f;
#pragma unroll
    for (int j = 0; j < 4; ++j) { const u32x2 w = mr[64 * j]; mv[j] = (f32x4){bflo(w.x), bfhi(w.x), bflo(w.y), bfhi(w.y)}; s += (mv[j].x * mv[j].x + mv[j].y * mv[j].y) + (mv[j].z * mv[j].z + mv[j].w * mv[j].w); }
    const float rs = 1.0f / sqrtf(wave_sum(s, lane) * (1.f / DM) + EPS);
    f32x4 x[4]; float s2 = 0.f;
#pragma unroll
    for (int j = 0; j < 4; ++j) { const f32x4 g = gp[64 * j]; x[j] = xr[64 * j] + mv[j] * rs * g; s2 += (x[j].x * x[j].x + x[j].y * x[j].y) + (x[j].z * x[j].z + x[j].w * x[j].w); }
    f32x4* xw = (f32x4*)xo + lane;
#pragma unroll
    for (int j = 0; j < 4; ++j) xw[64 * j] = x[j];
    if (gnext) {
        const float rs2 = 1.0f / sqrtf(wave_sum(s2, lane) * (1.f / DM) + EPS);
        const f32x4* gn = (const f32x4*)gnext + lane; u32x2* o8 = (u32x2*)xnrow + lane;
#pragma unroll
        for (int j = 0; j < 4; ++j) { const f32x4 g = gn[64 * j]; u32x2 w; w.x = cvt_pk_bf16(x[j].x * rs2 * g.x, x[j].y * rs2 * g.y); w.y = cvt_pk_bf16(x[j].z * rs2 * g.z, x[j].w * rs2 * g.w); o8[64 * j] = w; }
    }
}

__device__ __forceinline__ void mla_unit(LAS unsigned char* lds, const bf16_t* Q, const bf16_t* KN, const bf16_t* KPE, const bf16_t* VT, bf16_t* AO, int tokbase, int S, int h, int qb, int tid) {
    constexpr int KP = 208, VP = 144, KBYTES = 64 * KP, VBYTES = 64 * VP, BUF = KBYTES + VBYTES;
    const int lane = tid & 63, wid = tid >> 6, r32 = lane & 31, hi = lane >> 5;
    const int kkey0 = tid / 12, kc0 = tid % 12, kkey1 = (tid + 512) / 12, kc1 = (tid + 512) % 12; const bool has1 = tid < 256;
    const int vd = tid >> 3, vc = tid & 7;
    const bf16_t* ksrc0 = kc0 < 8 ? KN + (size_t)(tokbase + kkey0) * 512 + h * 64 + 8 * kc0 : KPE + (size_t)(tokbase + kkey0) * 32 + 8 * (kc0 - 8);
    const size_t kst0 = kc0 < 8 ? 512 : 32;
    const bf16_t* ksrc1 = kc1 < 8 ? KN + (size_t)(tokbase + kkey1) * 512 + h * 64 + 8 * kc1 : KPE + (size_t)(tokbase + kkey1) * 32 + 8 * (kc1 - 8);
    const size_t kst1 = kc1 < 8 ? 512 : 32;
    const bf16_t* vsrc = VT + (size_t)(h * 64 + vd) * TH + tokbase + 8 * vc;
    const int kd0 = kkey0 * KP + 16 * kc0, kd1 = kkey1 * KP + 16 * kc1, vdst = KBYTES + vd * VP + 16 * vc;
    const int NT = S / 64;
    const int qtok = tokbase + 256 * qb + 32 * wid + r32;
    bf16x8 qr[6];
#pragma unroll
    for (int d0 = 0; d0 < 6; ++d0) qr[d0] = *(const bf16x8*)(Q + (size_t)qtok * 768 + h * 96 + 16 * d0 + 8 * hi);
    u32x4 rk0, rk1 = (u32x4){0, 0, 0, 0}, rv;
    rk0 = *(const u32x4*)ksrc0; if (has1) rk1 = *(const u32x4*)ksrc1; rv = *(const u32x4*)vsrc;
    *(LAS u32x4*)(lds + kd0) = rk0; if (has1) *(LAS u32x4*)(lds + kd1) = rk1; *(LAS u32x4*)(lds + vdst) = rv;
    __syncthreads();
    f32x16 o0, o1;
#pragma unroll
    for (int r = 0; r < 16; ++r) { o0[r] = 0.f; o1[r] = 0.f; }
    float m_run = -1e30f, l_run = 0.f;
    for (int t = 0; t < NT; ++t) {
        if (t + 1 < NT) { const size_t ko = (size_t)(t + 1) * 64; rk0 = *(const u32x4*)(ksrc0 + ko * kst0); if (has1) rk1 = *(const u32x4*)(ksrc1 + ko * kst1); rv = *(const u32x4*)(vsrc + ko); }
        const LAS unsigned char* kb = lds + (t & 1) * BUF; const LAS unsigned char* vb = kb + KBYTES;
        f32x16 p0, p1;
#pragma unroll
        for (int r = 0; r < 16; ++r) { p0[r] = 0.f; p1[r] = 0.f; }
#pragma unroll
        for (int d0 = 0; d0 < 6; ++d0) {
            const bf16x8 a0 = *(const LAS bf16x8*)(kb + r32 * KP + 32 * d0 + 16 * hi);
            const bf16x8 a1 = *(const LAS bf16x8*)(kb + (32 + r32) * KP + 32 * d0 + 16 * hi);
            p0 = __builtin_amdgcn_mfma_f32_32x32x16_bf16(a0, qr[d0], p0, 0, 0, 0);
            p1 = __builtin_amdgcn_mfma_f32_32x32x16_bf16(a1, qr[d0], p1, 0, 0, 0);
        }
        float mx = fmaxf(p0[0], p1[0]);
#pragma unroll
        for (int r = 1; r < 16; ++r) mx = fmaxf(mx, fmaxf(p0[r], p1[r]));
        mx = xor32_max(mx);
        const float m_new = fmaxf(m_run, mx), alpha = fexp2(m_run - m_new); m_run = m_new;
        float ls = 0.f;
#pragma unroll
        for (int r = 0; r < 16; ++r) { p0[r] = fexp2(p0[r] - m_new); p1[r] = fexp2(p1[r] - m_new); ls += p0[r] + p1[r]; }
        l_run = l_run * alpha + ls;
#pragma unroll
        for (int r = 0; r < 16; ++r) { o0[r] *= alpha; o1[r] *= alpha; }
#pragma unroll
        for (int ks = 0; ks < 4; ++ks) {
            u32x4 pw;
            if (ks == 0) { pw.x = cvt_pk_bf16(p0[0], p0[1]); pw.y = cvt_pk_bf16(p0[2], p0[3]); pw.z = cvt_pk_bf16(p0[4], p0[5]); pw.w = cvt_pk_bf16(p0[6], p0[7]); }
            else if (ks == 1) { pw.x = cvt_pk_bf16(p0[8], p0[9]); pw.y = cvt_pk_bf16(p0[10], p0[11]); pw.z = cvt_pk_bf16(p0[12], p0[13]); pw.w = cvt_pk_bf16(p0[14], p0[15]); }
            else if (ks == 2) { pw.x = cvt_pk_bf16(p1[0], p1[1]); pw.y = cvt_pk_bf16(p1[2], p1[3]); pw.z = cvt_pk_bf16(p1[4], p1[5]); pw.w = cvt_pk_bf16(p1[6], p1[7]); }
            else { pw.x = cvt_pk_bf16(p1[8], p1[9]); pw.y = cvt_pk_bf16(p1[10], p1[11]); pw.z = cvt_pk_bf16(p1[12], p1[13]); pw.w = cvt_pk_bf16(p1[14], p1[15]); }
            const bf16x8 pa = __builtin_bit_cast(bf16x8, pw);
            const LAS unsigned char* vp = vb + r32 * VP + (16 * ks + 4 * hi) * 2;
            const u32x2 a_lo = *(const LAS u32x2*)(vp), a_hi = *(const LAS u32x2*)(vp + 16);
            const u32x2 b_lo = *(const LAS u32x2*)(vp + 32 * VP), b_hi = *(const LAS u32x2*)(vp + 32 * VP + 16);
            const bf16x8 vf0 = __builtin_bit_cast(bf16x8, ((u32x4){a_lo.x, a_lo.y, a_hi.x, a_hi.y}));
            const bf16x8 vf1 = __builtin_bit_cast(bf16x8, ((u32x4){b_lo.x, b_lo.y, b_hi.x, b_hi.y}));
            o0 = __builtin_amdgcn_mfma_f32_32x32x16_bf16(vf0, pa, o0, 0, 0, 0);
            o1 = __builtin_amdgcn_mfma_f32_32x32x16_bf16(vf1, pa, o1, 0, 0, 0);
        }
        if (t + 1 < NT) { LAS unsigned char* nb = lds + ((t + 1) & 1) * BUF; *(LAS u32x4*)(nb + kd0) = rk0; if (has1) *(LAS u32x4*)(nb + kd1) = rk1; *(LAS u32x4*)(nb + vdst) = rv; }
        __syncthreads();
    }
    const float l = xor32_sum(l_run); const float inv = 1.0f / l;
    bf16_t* orow = AO + (size_t)qtok * 1024 + h * 64 + 4 * hi;
#pragma unroll
    for (int rg = 0; rg < 4; ++rg) {
        u32x2 w; w.x = cvt_pk_bf16(o0[4 * rg] * inv, o0[4 * rg + 1] * inv); w.y = cvt_pk_bf16(o0[4 * rg + 2] * inv, o0[4 * rg + 3] * inv); *(u32x2*)(orow + 8 * rg) = w;
        u32x2 w2; w2.x = cvt_pk_bf16(o1[4 * rg] * inv, o1[4 * rg + 1] * inv); w2.y = cvt_pk_bf16(o1[4 * rg + 2] * inv, o1[4 * rg + 3] * inv); *(u32x2*)(orow + 32 + 8 * rg) = w2;
    }
}

__device__ __forceinline__ unsigned na_vmask(int qc, int kh, int hi) {
    int cs = qc - 8; cs = cs < 0 ? 0 : cs; cs = cs > 48 ? 48 : cs; unsigned mk = 0u;
#pragma unroll
    for (int r = 0; r < 16; ++r) { const int kc = 32 * kh + (r & 3) + 8 * (r >> 2) + 4 * hi; mk |= ((kc >= cs) && (kc < cs + 16)) ? (1u << r) : 0u; }
    return mk;
}
__device__ __forceinline__ void na_qs(const bf16x8 (&kf)[4], const bf16x8 (&vf)[2][2], const bf16x8 (&qf)[4], const LAS float* brow, int qc, int kh, int hi, unsigned vmsel,
                                      float& m_run, float& l_run, f32x16& o0, f32x16& o1) {
    const float SCL = 0.125f * LOG2E;
    f32x16 p;
#pragma unroll
    for (int r = 0; r < 16; ++r) p[r] = 0.f;
#pragma unroll
    for (int d0 = 0; d0 < 4; ++d0) p = __builtin_amdgcn_mfma_f32_32x32x16_bf16(kf[d0], qf[d0], p, 0, 0, 0);
    unsigned vm = vmsel; asm volatile("" : "+v"(vm));
    float mx = -1e30f;
#pragma unroll
    for (int r = 0; r < 16; ++r) { const int kc = 32 * kh + (r & 3) + 8 * (r >> 2) + 4 * hi;
        int bi = kc - qc + 15; bi = bi < 0 ? 0 : bi; bi = bi > 30 ? 30 : bi;
        const float sc = p[r] * SCL + brow[bi]; p[r] = ((vm >> r) & 1u) ? sc : -1e30f; mx = fmaxf(mx, p[r]); }
    mx = xor32_max(mx);
    const float m_new = fmaxf(m_run, mx), alpha = fexp2(m_run - m_new); m_run = m_new;
    const float m_use = fmaxf(m_new, -1e20f);
    float ls = 0.f;
#pragma unroll
    for (int r = 0; r < 16; ++r) { const float e = fexp2(p[r] - m_use); p[r] = e; ls += e; }
    l_run = l_run * alpha + ls;
#pragma unroll
    for (int r = 0; r < 16; ++r) { o0[r] *= alpha; o1[r] *= alpha; }
#pragma unroll
    for (int k2 = 0; k2 < 2; ++k2) {
        u32x4 pw; pw.x = cvt_pk_bf16(p[8 * k2 + 0], p[8 * k2 + 1]); pw.y = cvt_pk_bf16(p[8 * k2 + 2], p[8 * k2 + 3]); pw.z = cvt_pk_bf16(p[8 * k2 + 4], p[8 * k2 + 5]); pw.w = cvt_pk_bf16(p[8 * k2 + 6], p[8 * k2 + 7]);
        const bf16x8 pa = __builtin_bit_cast(bf16x8, pw);
        o0 = __builtin_amdgcn_mfma_f32_32x32x16_bf16(vf[0][k2], pa, o0, 0, 0, 0);
        o1 = __builtin_amdgcn_mfma_f32_32x32x16_bf16(vf[1][k2], pa, o1, 0, 0, 0);
    }
}
__device__ __forceinline__ void na_store(bf16_t* orow, const f32x16& o0, const f32x16& o1, float l_run) {
    const float l = xor32_sum(l_run); const float inv = 1.0f / l;
#pragma unroll
    for (int rg = 0; rg < 4; ++rg) {
        u32x2 w; w.x = cvt_pk_bf16(o0[4 * rg] * inv, o0[4 * rg + 1] * inv); w.y = cvt_pk_bf16(o0[4 * rg + 2] * inv, o0[4 * rg + 3] * inv); *(u32x2*)(orow + 8 * rg) = w;
        u32x2 w2; w2.x = cvt_pk_bf16(o1[4 * rg] * inv, o1[4 * rg + 1] * inv); w2.y = cvt_pk_bf16(o1[4 * rg + 2] * inv, o1[4 * rg + 3] * inv); *(u32x2*)(orow + 32 + 8 * rg) = w2;
    }
}
__device__ __forceinline__ void na_unit(const LAS float* biasT, const bf16_t* Z, const bf16_t* VTn, bf16_t* AO, int tokbase, int S, int rr, int tid) {
    const int lane = tid & 63, h = tid >> 6, r32 = lane & 31, hi = lane >> 5;
    const int rows = S / 64; int rs = rr - 4; rs = rs < 0 ? 0 : rs; rs = rs > rows - 8 ? rows - 8 : rs;
    bf16x8 qfa[4], qfb[4];
#pragma unroll
    for (int d0 = 0; d0 < 4; ++d0) { qfa[d0] = *(const bf16x8*)(Z + (size_t)(tokbase + rr * 64 + r32) * ZP + 672 + h * 64 + 16 * d0 + 8 * hi);
                                      qfb[d0] = *(const bf16x8*)(Z + (size_t)(tokbase + rr * 64 + 32 + r32) * ZP + 672 + h * 64 + 16 * d0 + 8 * hi); }
    f32x16 oa0, oa1, ob0, ob1; float ma = -1e30f, mb = -1e30f, la = 0.f, lb = 0.f;
#pragma unroll
    for (int r = 0; r < 16; ++r) { oa0[r] = 0.f; oa1[r] = 0.f; ob0[r] = 0.f; ob1[r] = 0.f; }
    const unsigned va0 = na_vmask(r32, 0, hi), va1 = na_vmask(r32, 1, hi), vb0 = na_vmask(32 + r32, 0, hi), vb1 = na_vmask(32 + r32, 1, hi);
    const bf16_t* kbase = Z + (size_t)(tokbase + rs * 64 + r32) * ZP + 672 + 512 + h * 64 + 8 * hi;
    const bf16_t* vbase0 = VTn + (size_t)(h * 64 + r32) * TH + tokbase + rs * 64 + 4 * hi;
#pragma unroll 1
    for (int it = 0; it < 16; ++it) {
        const int kr = it >> 1, kh = it & 1;
        const LAS float* brow = biasT + (h * 15 + (rs + kr - rr + 7)) * 31;
        const bf16_t* kp = kbase + (size_t)(kr * 64 + kh * 32) * ZP;
        bf16x8 kf[4];
#pragma unroll
        for (int d0 = 0; d0 < 4; ++d0) kf[d0] = *(const bf16x8*)(kp + 16 * d0);
        const bf16_t* vp0 = vbase0 + kr * 64 + kh * 32; const bf16_t* vp1 = vp0 + (size_t)32 * TH;
        bf16x8 vf[2][2];
#pragma unroll
        for (int k2 = 0; k2 < 2; ++k2) { const u32x2 lo = *(const u32x2*)(vp0 + 16 * k2), hi2 = *(const u32x2*)(vp0 + 16 * k2 + 8); vf[0][k2] = __builtin_bit_cast(bf16x8, ((u32x4){lo.x, lo.y, hi2.x, hi2.y}));
            const u32x2 lo1 = *(const u32x2*)(vp1 + 16 * k2), hi3 = *(const u32x2*)(vp1 + 16 * k2 + 8); vf[1][k2] = __builtin_bit_cast(bf16x8, ((u32x4){lo1.x, lo1.y, hi3.x, hi3.y})); }
        na_qs(kf, vf, qfa, brow, r32, kh, hi, kh ? va1 : va0, ma, la, oa0, oa1);
        na_qs(kf, vf, qfb, brow, 32 + r32, kh, hi, kh ? vb1 : vb0, mb, lb, ob0, ob1);
    }
    na_store(AO + (size_t)(tokbase + rr * 64 + r32) * 1024 + 512 + h * 64 + 4 * hi, oa0, oa1, la);
    na_store(AO + (size_t)(tokbase + rr * 64 + 32 + r32) * 1024 + 512 + h * 64 + 4 * hi, ob0, ob1, lb);
}
#ifndef REP_SYNC
#define REP_SYNC 1
#endif
#ifndef REP_MLA
#define REP_MLA 1
#endif
#ifndef REP_NA
#define REP_NA 1
#endif
#ifndef REP_SCAN
#define REP_SCAN 1
#endif
#ifndef REP_UP
#define REP_UP 1
#endif
#ifndef REP_GEMM
#define REP_GEMM 1
#endif
#define GSYNC() do { for (int r_ = 0; r_ < REP_SYNC; ++r_) xcd_barrier((unsigned*)(ap0->ws + WS_BAR), bst); } while (0)
constexpr int LDS_BYTES = 147456;
constexpr int NTHR = 512;
struct Args { const float* in[26]; float* out; unsigned char* ws; };


#define XB_TMO      128
#define XB_XCNT(j)  (256  + 64 * (j))
#define XB_XSUB(j)  (1280 + 64 * (j))
#define XB_XGEN(j)  (2304 + 64 * (j))
#define XB_TOP      3328
#define XB_TOPGEN   3392
#define XCD_BAR_WORDS 3456
#define XB_SPIN_CAP (1u << 22)
__device__ __forceinline__ unsigned xb_ld(unsigned* p)              { return __hip_atomic_load(p, __ATOMIC_RELAXED, __HIP_MEMORY_SCOPE_AGENT); }
__device__ __forceinline__ unsigned xb_add(unsigned* p, unsigned v) { return __hip_atomic_fetch_add(p, v, __ATOMIC_RELAXED, __HIP_MEMORY_SCOPE_AGENT); }
__device__ __forceinline__ unsigned xb_xcc_id() { return (unsigned)__builtin_amdgcn_s_getreg((3 << 11) | 20) & 0xFu; }
#define XB_SPIN(cond, bar) do { unsigned _sp = 0; while (cond) { __builtin_amdgcn_s_sleep(1); \
    if ((++_sp & 255u) == 0u) { if (xb_ld(&(bar)[XB_TMO])) break; if (_sp > XB_SPIN_CAP) { atomicAdd(&(bar)[XB_TMO], 1u); break; } } } } while (0)
__device__ __forceinline__ void xcd_barrier_complete(unsigned* bar, unsigned x, unsigned& nloc, unsigned& nx) {
    const unsigned G = gridDim.x;
    unsigned sum, cnt, mine, sp = 0u;
    for (;;) {
        sum = 0u; cnt = 0u; mine = 0u;
#pragma unroll
        for (unsigned j = 0; j < 16; ++j) { const unsigned c = xb_ld(&bar[XB_XCNT(j)]); sum += c; cnt += (c > 0u) ? 1u : 0u; mine = (j == x) ? c : mine; }
        if (sum == G) break;
        __builtin_amdgcn_s_sleep(1);
        if ((++sp & 255u) == 0u) { if (xb_ld(&bar[XB_TMO])) break; if (sp > XB_SPIN_CAP) { atomicAdd(&bar[XB_TMO], 1u); break; } }
    }
    nloc = mine > 0u ? mine : 1u; nx = cnt > 0u ? cnt : 1u;
}
__device__ __forceinline__ void xcd_barrier(unsigned* bar, volatile LAS unsigned* st) {
    asm volatile("s_waitcnt vmcnt(0)" ::: "memory");
    __syncthreads();
    if (threadIdx.x == 0) {
        __builtin_amdgcn_s_waitcnt(0);
        const unsigned x = xb_xcc_id();
        unsigned nloc = st[0], nx = st[1];
        if (nloc == 0u) { xcd_barrier_complete(bar, x, nloc, nx); st[0] = nloc; st[1] = nx; }
        const unsigned old = xb_add(&bar[XB_XSUB(x)], 1u);
        const unsigned gen = old / nloc;
        if (old + 1u == (gen + 1u) * nloc) {
            __builtin_amdgcn_fence(__ATOMIC_RELEASE, "agent");
            asm volatile("s_waitcnt vmcnt(0)" ::: "memory");
            const unsigned og = xb_add(&bar[XB_TOP], 1u);
            const unsigned tg = og / nx;
            if (og + 1u == (tg + 1u) * nx) xb_add(&bar[XB_TOPGEN], 1u);
            else XB_SPIN(xb_ld(&bar[XB_TOPGEN]) == tg, bar);
            __builtin_amdgcn_fence(__ATOMIC_ACQUIRE, "agent");
            xb_add(&bar[XB_XGEN(x)], 1u);
            asm volatile("s_waitcnt vmcnt(0)" ::: "memory");
        } else {
            XB_SPIN(xb_ld(&bar[XB_XGEN(x)]) == gen, bar);
            __builtin_amdgcn_fence(__ATOMIC_ACQUIRE, "agent");
            asm volatile("s_waitcnt vmcnt(0)" ::: "memory");
        }
    }
    __syncthreads();
}

__device__ __forceinline__ void lru_ab(float ga, float gx, float gab, float gxb, float spl  , float xb, float& a, float& b) {
    const float r = sigmoidf_(ga + gab), ii = sigmoidf_(gx + gxb);
    const float la = -8.0f * r * spl;
    a = fexp2(la * LOG2E);
    const float om = -expm1f(2.0f * la);
    b = sqrtf(om) * (ii * xb);
}

__global__ void __launch_bounds__(NTHR, 2) mk_fwd(Args a) {
    extern __shared__ __attribute__((aligned(16))) unsigned char lds_raw[];
    LAS unsigned char* lds = (LAS unsigned char*)lds_raw;
    cg::grid_group grid = cg::this_grid();
    volatile LAS unsigned* bst = (volatile LAS unsigned*)(lds + LDS_BYTES - 64);
    if (threadIdx.x == 0) { bst[0] = 0u; bst[1] = 0u; }
    typedef const __attribute__((address_space(4))) Args* ArgP;
    ArgP ap0 = (ArgP)__builtin_amdgcn_kernarg_segment_ptr();
#define PH_BEGIN ArgP ap = ap0; asm volatile("" : "+s"(ap)); unsigned char* ws = ap->ws; (void)ws; int tid_ = threadIdx.x; asm volatile("" : "+v"(tid_)); const int tid = tid_, lane = tid & 63, wave = tid >> 6; int G_ = gridDim.x, bid_ = blockIdx.x; asm volatile("" : "+s"(G_), "+s"(bid_)); const int G = G_, bid = bid_; const int gw = bid * 8 + wave, NGW = G * 8; const int gt = bid * NTHR + tid, NGT = G * NTHR; (void)lane; (void)gw; (void)NGW; (void)gt; (void)NGT;
#define IN(k) (ap->in[k])
#define rsq ((float*)(ws + WS_RSQ))
#define rskv ((float*)(ws + WS_RSKV))
#define rope ((float2*)(ws + WS_ROPE))
#define AGG ((float2*)(ws + WS_AGG))
#define CARRY ((float*)(ws + WS_CARRY))
#define YB ((bf16_t*)(ws + WS_YB))
#define W_INATT ((bf16_t*)(ws + WS_W_INATT))
#define W_UQ ((bf16_t*)(ws + WS_W_UQ))
#define W_UKV ((bf16_t*)(ws + WS_W_UKV))
#define W_OUTATT ((bf16_t*)(ws + WS_W_OUTATT))
#define W_INREC ((bf16_t*)(ws + WS_W_INREC))
#define W_GATES ((bf16_t*)(ws + WS_W_GATES))
#define W_OUTREC ((bf16_t*)(ws + WS_W_OUTREC))
#define W_UP ((bf16_t*)(ws + WS_W_UP))
#define W_DOWN ((bf16_t*)(ws + WS_W_DOWN))
#define XN ((bf16_t*)(ws + WS_XN))
#define Zb ((bf16_t*)(ws + WS_Z))
#define Qb ((bf16_t*)(ws + WS_Q))
#define KN ((bf16_t*)(ws + WS_KN))
#define VTM ((bf16_t*)(ws + WS_VTM))
#define VTN ((bf16_t*)(ws + WS_VTN))
#define KPE ((bf16_t*)(ws + WS_KPE))
#define ACT ((bf16_t*)(ws + WS_ACT))
#define GATE ((bf16_t*)(ws + WS_GATE))
#define XB ((bf16_t*)(ws + WS_XB))
#define XBR ((bf16_t*)(ws + WS_XBR))
#define GQ ((bf16_t*)(ws + WS_GQ))
#define AO XN
#define Fb XN
#define YR XN
#define M0 Zb
#define M1 XBR
#define XIN (IN(half))
#define XST (ap->out + (size_t)half * TH * DM)
    { PH_BEGIN
    {
        LAS float* scr = (LAS float*)(lds + wave * 16384);
        constexpr int I_INATT = 16 * 69, I_UQ = 6 * 24, I_UKV = 4 * 32, I_SQ = 16 * 32, I_INREC = 16 * 64, I_UP = 16 * 256, I_DOWN = 64 * 32, I_GATE = 32 * 8;
        constexpr int NITEMS = I_INATT + I_UQ + I_UKV + 2 * I_SQ + I_INREC + 2 * I_UP + 2 * I_DOWN + I_GATE;
        for (int it = gw; it < NITEMS; it += NGW) {
            int r = it;
            if (r < I_INATT) { transpose_item(IN(6), 1024, 2208, W_INATT, 0, nullptr, scr, r, lane); continue; } r -= I_INATT;
            if (r < I_UQ) { transpose_item(IN(8), 384, 768, W_UQ, 0, IN(7), scr, r, lane); continue; } r -= I_UQ;
            if (r < I_UKV) { transpose_item(IN(10), 256, 1024, W_UKV, 0, IN(9), scr, r, lane); continue; } r -= I_UKV;
            if (r < I_SQ) { transpose_item(IN(12), 1024, 1024, W_OUTATT, 0, nullptr, scr, r, lane); continue; } r -= I_SQ;
            if (r < I_SQ) { transpose_item(IN(21), 1024, 1024, W_OUTREC, 0, nullptr, scr, r, lane); continue; } r -= I_SQ;
            if (r < I_INREC) { transpose_item(IN(13), 1024, 2048, W_INREC, 0, nullptr, scr, r, lane); continue; } r -= I_INREC;
            if (r < 2 * I_UP) { const int li = r / I_UP; transpose_item(IN(22) + (size_t)li * 1024 * 8192, 1024, 8192, W_UP + (size_t)li * 8192 * 1024, 0, nullptr, scr, r % I_UP, lane); continue; } r -= 2 * I_UP;
            if (r < 2 * I_DOWN) { const int li = r / I_DOWN; transpose_item(IN(25) + (size_t)li * 4096 * 1024, 4096, 1024, W_DOWN + (size_t)li * 1024 * 4096, 0, nullptr, scr, r % I_DOWN, lane); continue; } r -= 2 * I_DOWN;
            { const int mat = r / 8, sub = r % 8; const int type = mat >> 4, e = (mat >> 3) & 1, n = mat & 7;
              transpose_item(IN(type ? 18 : 16) + (size_t)(e * 8 + n) * 128 * 128, 128, 128, W_GATES, n * 512 + (type * 2 + e) * 128, nullptr, scr, sub, lane); }
        }
        if (bid == 0) for (int i = tid; i < XCD_BAR_WORDS; i += NTHR) ((unsigned*)(ws + WS_BAR))[i] = 0u;
        for (int i = gt; i < 96 * 1024 / 8; i += NGT) ((u32x4*)(W_INATT + (size_t)2208 * 1024))[i] = (u32x4){0, 0, 0, 0};
        for (int i = gt; i < 4096 * 16; i += NGT) { const int pos = i >> 4, j = i & 15;
            const double inv = exp2(-(double)j * (13.287712379549449 / 16.0));
            const double rev = (double)pos * inv * 0.15915494309189535; const float fr = (float)(rev - floor(rev));
            rope[i] = make_float2(__builtin_amdgcn_cosf(fr), __builtin_amdgcn_sinf(fr)); }
    }

    }
    grid.sync();
    if (threadIdx.x == 0) (void)xb_add((unsigned*)(ap0->ws + WS_BAR) + XB_XCNT(xb_xcc_id()), 1u);
    for (int half = 0; half < 2; ++half) {
        const int S = half ? 4096 : 2048, nseq = TH / S;
                { PH_BEGIN
        for (int m = gw; m < TH; m += NGW) xn_row(XIN + (size_t)m * DM, IN(2), XN + (size_t)m * DM, lane);
        }
        GSYNC();
        { PH_BEGIN
        { pg8::Gemm g = pg8::make_gemm(XN, DM, W_INATT, DM, DM); pg8::StaticOrder so; so.init(TH / 256, ZP / 256, G, bid);
          EpiZ E{Zb, VTN};
#ifndef NO_G1
pg8::gemm_phase<EpiZ>(lds, g, so, E);
#endif
 }
        }
        GSYNC();
        { PH_BEGIN
        for (int t = gw; t < TH; t += NGW) {
            const bf16_t* z = Zb + (size_t)t * ZP;
            float sq = 0.f, skv = 0.f;
            { const unsigned* p = (const unsigned*)z + lane * 3;
#pragma unroll
              for (int j = 0; j < 3; ++j) { const unsigned w = p[j]; const float x0 = bflo(w), x1 = bfhi(w); sq += x0 * x0 + x1 * x1; } }
            { const unsigned* p = (const unsigned*)(z + 384) + lane * 2;
#pragma unroll
              for (int j = 0; j < 2; ++j) { const unsigned w = p[j]; const float x0 = bflo(w), x1 = bfhi(w); skv += x0 * x0 + x1 * x1; } }
            sq = wave_sum(sq, lane); skv = wave_sum(skv, lane);
            if (lane == 0) { rsq[t] = 1.0f / sqrtf(sq * (1.f / 384.f) + EPS); rskv[t] = 1.0f / sqrtf(skv * (1.f / 256.f) + EPS); }
            if (lane < 16) { const float x1 = bf2f(z[640 + lane]), x2 = bf2f(z[656 + lane]); const float2 cs = rope[(size_t)(t & (S - 1)) * 16 + lane];
                KPE[(size_t)t * 32 + lane] = f2bf(x1 * cs.x - x2 * cs.y); KPE[(size_t)t * 32 + 16 + lane] = f2bf(x2 * cs.x + x1 * cs.y); }
        }
        }
        GSYNC();
        { PH_BEGIN
        { pg8::Gemm g = pg8::make_gemm(Zb, ZP, W_UQ, 384, 384); pg8::StaticOrder so; so.init(TH / 256, 3, G, bid);
          EpiQ E{Qb, rsq, rope, S - 1};
#ifndef NO_G2
pg8::gemm_phase<EpiQ>(lds, g, so, E);
#endif
 }
        { pg8::Gemm g = pg8::make_gemm(Zb + 384, ZP, W_UKV, 256, 256); pg8::StaticOrder so; so.init(TH / 256, 4, G, bid);
          EpiKV E{KN, VTM, rskv};
#ifndef NO_G3
pg8::gemm_phase<EpiKV>(lds, g, so, E);
#endif
 }
        }
        GSYNC();
        { PH_BEGIN
        {
            LAS float* biasT = (LAS float*)(lds + 65536);
            for (int i = tid; i < 8 * 15 * 31; i += NTHR) biasT[i] = IN(11)[i] * LOG2E;
            __syncthreads();
            const int nqb = S / 256, nunits = nseq * 8 * nqb;
#ifndef NO_MLA
            for (int rep_ = 0; rep_ < REP_MLA; ++rep_)
            for (int u = bid; u < nunits; u += G) { const int qb = u % nqb, h = (u / nqb) & 7, s = u / (nqb * 8);
                mla_unit(lds, Qb, KN, KPE, VTM, AO, s * S, S, h, qb, tid); }
#endif
            const int rows = S / 64, nna = nseq * rows;
#ifndef NO_NA
            for (int rep_ = 0; rep_ < REP_NA; ++rep_)
            for (int u = bid; u < nna; u += G) na_unit(biasT, Zb, VTN, AO, (u / rows) * S, S, u % rows, tid);
#endif
        }
        }
        GSYNC();
        { PH_BEGIN
        { pg8::Gemm g = pg8::make_gemm(AO, DM, W_OUTATT, DM, DM); pg8::StaticOrder so; so.init(TH / 256, 4, G, bid);
          EpiBf16 E{M0, DM, 0, 0};
#ifndef NO_G4
pg8::gemm_phase<EpiBf16>(lds, g, so, E);
#endif
 }
        }
        GSYNC();
        { PH_BEGIN
        for (int m = gw; m < TH; m += NGW) res_row(M0 + (size_t)m * DM, XIN + (size_t)m * DM, XST + (size_t)m * DM, IN(3), IN(4), XN + (size_t)m * DM, lane);
        }
        GSYNC();

        for (int li = 0; li < 2; ++li) {
            if (li == 1) {
                { PH_BEGIN
                { pg8::Gemm g = pg8::make_gemm(XN, DM, W_INREC, DM, DM); pg8::StaticOrder so; so.init(TH / 256, 8, G, bid);
                  EpiBf16 E{GATE, DM, 1024, (size_t)(WS_XBR - WS_GATE) / 2};
#ifndef NO_G5
pg8::gemm_phase<EpiBf16>(lds, g, so, E);
#endif
 }
                }
                GSYNC();
                { PH_BEGIN
                for (int i = gt; i < TH * 128; i += NGT) { const int t = i >> 7, c8 = (i & 127) * 8; const int pos = t & (S - 1);
                    float accv[8];
#pragma unroll
                    for (int j = 0; j < 8; ++j) accv[j] = IN(15)[c8 + j];
#pragma unroll
                    for (int k = 0; k < 4; ++k) { const int p2 = pos + k - 1; if (p2 < 0 || p2 >= S) continue;
                        const u32x4 w = *(const u32x4*)(XBR + (size_t)(t + k - 1) * DM + c8); const float* cwk = IN(14) + k * 1024 + c8;
                        accv[0] += cwk[0] * bflo(w.x); accv[1] += cwk[1] * bfhi(w.x); accv[2] += cwk[2] * bflo(w.y); accv[3] += cwk[3] * bfhi(w.y);
                        accv[4] += cwk[4] * bflo(w.z); accv[5] += cwk[5] * bfhi(w.z); accv[6] += cwk[6] * bflo(w.w); accv[7] += cwk[7] * bfhi(w.w); }
                    u32x4 o; o.x = cvt_pk_bf16(accv[0], accv[1]); o.y = cvt_pk_bf16(accv[2], accv[3]); o.z = cvt_pk_bf16(accv[4], accv[5]); o.w = cvt_pk_bf16(accv[6], accv[7]);
                    *(u32x4*)(XB + (size_t)t * DM + c8) = o; }
                }
                GSYNC();
                for (int qt = 0; qt < 2; ++qt) {
                    const int t0 = qt * TQ;
                    { PH_BEGIN
                    { pg8::Gemm g = pg8::make_gemm(XB + (size_t)t0 * DM, DM, W_GATES, 128, 128); g.a_pn_shift = 1; g.a_pn_step = 256;
                      pg8::StaticOrder so; so.init(TQ / 256, 16, G, bid);
                      EpiBf16 E{GQ, 4096, 0, 0};
#ifndef NO_G6
pg8::gemm_phase<EpiBf16>(lds, g, so, E);
#endif
 }
                    }
                    GSYNC();
                    { PH_BEGIN
                    for (int i = gt; i < 128 * 2 * 1024; i += NGT) { const int ch = i & 1023, e = (i >> 10) & 1, c = i >> 11; const int n = ch >> 7, d = ch & 127;
                        const float gab = IN(17)[e * 1024 + ch], gxb = IN(19)[e * 1024 + ch]; const float lam = IN(20)[e * 1024 + ch];
                        const float spl = log1pf(expf(-lam));
                        float A = 1.f, B = 0.f;
                        for (int s = 0; s < 64; ++s) { const int tl = c * 64 + (e ? 63 - s : s);
                            const bf16_t* gq = GQ + (size_t)tl * 4096 + n * 512 + d;
                            float av, bv; lru_ab(bf2f(gq[e * 128]), bf2f(gq[(2 + e) * 128]), gab, gxb, spl, bf2f(XB[(size_t)(t0 + tl) * DM + ch]), av, bv);
                            A *= av; B = av * B + bv; }
                        AGG[i] = make_float2(A, B); }
                    }
                    GSYNC();
                    { PH_BEGIN
                    { const int cps = S / 64, nsq = TQ / S;
                      for (int i = gt; i < nsq * 2 * 1024; i += NGT) { const int ch = i & 1023, e = (i >> 10) & 1, sq = i >> 11;
                          float hcar = 0.f;
                          for (int k = 0; k < cps; ++k) { const int c = sq * cps + (e ? cps - 1 - k : k); const int idx = (c * 2 + e) * 1024 + ch;
                              CARRY[idx] = hcar; const float2 ab = AGG[idx]; hcar = ab.x * hcar + ab.y; } } }
                    }
                    GSYNC();
                    { PH_BEGIN
#ifndef NO_R6
                    for (int i = gt; i < 128 * 1024; i += NGT) { const int ch = i & 1023, c = i >> 10; const int n = ch >> 7, d = ch & 127;
                        const float spl0 = log1pf(expf(-IN(20)[ch])), spl1 = log1pf(expf(-IN(20)[1024 + ch]));
                        const float gab0 = IN(17)[ch], gab1 = IN(17)[1024 + ch], gxb0 = IN(19)[ch], gxb1 = IN(19)[1024 + ch];
                        float hc = CARRY[(c * 2 + 0) * 1024 + ch];
#pragma unroll 4
                        for (int s = 0; s < 64; ++s) { const int tl = c * 64 + s; const bf16_t* gq = GQ + (size_t)tl * 4096 + n * 512 + d;
                            float av, bv; lru_ab(bf2f(gq[0]), bf2f(gq[256]), gab0, gxb0, spl0, bf2f(XB[(size_t)(t0 + tl) * DM + ch]), av, bv);
                            hc = av * hc + bv; YR[(size_t)(t0 + tl) * DM + ch] = f2bf(hc); }
                        hc = CARRY[(c * 2 + 1) * 1024 + ch];
#pragma unroll 4
                        for (int s = 63; s >= 0; --s) { const int tl = c * 64 + s; const bf16_t* gq = GQ + (size_t)tl * 4096 + n * 512 + d;
                            float av, bv; lru_ab(bf2f(gq[128]), bf2f(gq[384]), gab1, gxb1, spl1, bf2f(XB[(size_t)(t0 + tl) * DM + ch]), av, bv);
                            hc = av * hc + bv;
                            const float gt_ = bf2f(GATE[(size_t)(t0 + tl) * DM + ch]); const float hfw = bf2f(YR[(size_t)(t0 + tl) * DM + ch]);
                            YR[(size_t)(t0 + tl) * DM + ch] = f2bf((hfw + hc) * gelu_tanh(gt_)); }
                    }
#endif
                    }
                    GSYNC();
                }
                { PH_BEGIN
                { pg8::Gemm g = pg8::make_gemm(YR, DM, W_OUTREC, DM, DM); pg8::StaticOrder so; so.init(TH / 256, 4, G, bid);
                  EpiBf16 E{M1, DM, 0, 0};
#ifndef NO_G7
pg8::gemm_phase<EpiBf16>(lds, g, so, E);
#endif
 }
                }
                GSYNC();
                { PH_BEGIN
                for (int m = gw; m < TH; m += NGW) res_row(M1 + (size_t)m * DM, XST + (size_t)m * DM, XST + (size_t)m * DM, IN(3) + 1024, IN(4) + 1024, XN + (size_t)m * DM, lane);
                }
                GSYNC();
            }
            { PH_BEGIN
            { pg8::Gemm g = pg8::make_gemm(XN, DM, W_UP + (size_t)li * 8192 * 1024, DM, DM);
              g.a_seg = 1; g.hA = (size_t)64 * DM * 2; g.tB = (size_t)128 * DM * 2; g.hB = (size_t)4096 * DM * 2;
              pg8::StaticOrder so; so.init(TH / 256, 32, G, bid);
#ifndef NO_UP
              EpiUp E{ACT, YB, IN(23) + (size_t)li * 3 * 8192, IN(24) + (size_t)li * 8192}; pg8::gemm_phase<EpiUp>(lds, g, so, E);
#endif
 }
            }
            GSYNC();
            { PH_BEGIN
            for (int b = bid; b < 256; b += G) { const int seg = b >> 1, which = b & 1; const int t = seg * 128 + (which ? 127 : 0); const int pos = t & (S - 1);
                const float* cw = IN(23) + (size_t)li * 3 * 8192; const float* cb = IN(24) + (size_t)li * 8192;
                const bool hasp = which ? true : (pos != 0), hasn = which ? (pos != S - 1) : true;
                const bf16_t* yp = which ? YB + ((size_t)seg * 4 + 2) * 8192 : YB + ((size_t)(seg - 1) * 4 + 3) * 8192;
                const bf16_t* yc = YB + ((size_t)seg * 4 + (which ? 3 : 0)) * 8192;
                const bf16_t* yn = which ? YB + ((size_t)(seg + 1) * 4 + 0) * 8192 : YB + ((size_t)seg * 4 + 1) * 8192;
                for (int c = tid; c < 4096; c += NTHR) {
                    float u2[2];
#pragma unroll
                    for (int bj = 0; bj < 2; ++bj) { const int ch = bj * 4096 + c;
                        float r = cw[8192 + ch] * bf2f(yc[ch]) + cb[ch];
                        if (hasp) r += cw[ch] * bf2f(yp[ch]);
                        if (hasn) r += cw[2 * 8192 + ch] * bf2f(yn[ch]);
                        u2[bj] = r; }
                    ACT[(size_t)t * DFF + c] = f2bf(gelu_tanh(u2[0]) * u2[1]); } }
            }
            GSYNC();
            { PH_BEGIN
            { pg8::Gemm g = pg8::make_gemm(ACT, DFF, W_DOWN + (size_t)li * 1024 * 4096, DFF, DFF); pg8::StaticOrder so; so.init(TH / 256, 4, G, bid);
              EpiBf16 E{Fb, DM, 0, 0};
#ifndef NO_G8
pg8::gemm_phase<EpiBf16>(lds, g, so, E);
#endif
 }
            }
            GSYNC();
            { PH_BEGIN
            for (int m = gw; m < TH; m += NGW) res_row(Fb + (size_t)m * DM, XST + (size_t)m * DM, XST + (size_t)m * DM, IN(5) + li * 1024, li == 0 ? IN(2) + 1024 : nullptr, XN + (size_t)m * DM, lane);
            }
            GSYNC();
        }
    }
}

extern "C" void kernel_launch(void* const* d_in, const int* in_sizes, int n_in, void* d_out, int out_size, void* d_ws, size_t ws_size, hipStream_t stream) {
    static int grid = 0;
    if (grid == 0) {
        int dev = 0, cus = 0, per_cu = 0;
        (void)hipGetDevice(&dev);
        (void)hipDeviceGetAttribute(&cus, hipDeviceAttributeMultiprocessorCount, dev);
        (void)hipFuncSetAttribute((const void*)mk_fwd, hipFuncAttributeMaxDynamicSharedMemorySize, LDS_BYTES);
        (void)hipOccupancyMaxActiveBlocksPerMultiprocessor(&per_cu, (const void*)mk_fwd, NTHR, LDS_BYTES);
        if (per_cu < 1) per_cu = 1;
        grid = cus * per_cu;
        if (ws_size < WS_END || n_in != 26) { fprintf(stderr, "kernel_launch: unexpected ws_size %zu / n_in %d\n", ws_size, n_in); }
    }
    Args a{};
    for (int i = 0; i < 26; ++i) a.in[i] = (const float*)d_in[i];
    a.out = (float*)d_out; a.ws = (unsigned char*)d_ws;
    void* args[] = {&a};
    hipError_t e = hipLaunchCooperativeKernel((const void*)mk_fwd, dim3(grid), dim3(NTHR), args, LDS_BYTES, stream);
    if (e != hipSuccess) fprintf(stderr, "cooperative launch failed: %s (grid %d)\n", hipGetErrorString(e), grid);
}
```

```cpp
#include <hip/hip_runtime.h>
#include <hip/hip_cooperative_groups.h>
#include <cstdio>
#include <cstdint>
namespace cg = cooperative_groups;

#define LAS __attribute__((address_space(3)))
typedef unsigned short bf16_t;
typedef short bf16x8 __attribute__((ext_vector_type(8)));
typedef short s16x4 __attribute__((ext_vector_type(4)));
typedef float f32x4 __attribute__((ext_vector_type(4)));
typedef float f32x16 __attribute__((ext_vector_type(16)));
typedef unsigned u32x4 __attribute__((ext_vector_type(4)));
typedef unsigned u32x2 __attribute__((ext_vector_type(2)));

__device__ __forceinline__ unsigned cvt_pk_bf16(float lo, float hi) { unsigned r; asm volatile("v_cvt_pk_bf16_f32 %0, %1, %2" : "=v"(r) : "v"(lo), "v"(hi)); return r; }
__device__ __forceinline__ float bf2f(bf16_t v) { return __uint_as_float(((unsigned)v) << 16); }
__device__ __forceinline__ float bflo(unsigned w) { return __uint_as_float(w << 16); }
__device__ __forceinline__ float bfhi(unsigned w) { return __uint_as_float(w & 0xffff0000u); }
__device__ __forceinline__ bf16_t f2bf(float f) { return (bf16_t)(cvt_pk_bf16(f, 0.f) & 0xffffu); }
__device__ __forceinline__ float fexp2(float x) { return __builtin_amdgcn_exp2f(x); }
__device__ __forceinline__ float frcp(float x) { return __builtin_amdgcn_rcpf(x); }
__device__ __forceinline__ float gelu_tanh(float x) {
    const float u = x * (1.0f + 0.044715f * x * x) * (-2.0f * 0.7978845608028654f * 1.4426950408889634f);
    return x * frcp(1.0f + fexp2(u));
}
__device__ __forceinline__ float sigmoidf_(float x) { return frcp(1.0f + fexp2(-1.4426950408889634f * x)); }
__device__ __forceinline__ float bperm_f(int src_lane, float v) { return __int_as_float(__builtin_amdgcn_ds_bpermute(src_lane << 2, __float_as_int(v))); }
__device__ __forceinline__ float wave_sum(float v, int l  ) {
#pragma unroll
    for (int o = 1; o < 64; o <<= 1) v += bperm_f(l ^ o, v);
    return v;
}
__device__ __forceinline__ float xor32_max(float v) { auto rr = __builtin_amdgcn_permlane32_swap(__float_as_uint(v), __float_as_uint(v), false, false); return fmaxf(__uint_as_float(rr[0]), __uint_as_float(rr[1])); }
__device__ __forceinline__ float xor32_sum(float v) { auto rr = __builtin_amdgcn_permlane32_swap(__float_as_uint(v), __float_as_uint(v), false, false); return __uint_as_float(rr[0]) + __uint_as_float(rr[1]); }

namespace pg8 {
constexpr int BM = 256, BK = 64, HALF = 128, HTB = HALF * BK * 2, STAGE_BYTES = 8 * HTB, NXCD = 8, WGM = 8;
__host__ __device__ __forceinline__ int lds_byte(int r, int c) { const int st = (r >> 4) * 2 + (c >> 5), rr = r & 15, cc = c & 31, ob = rr * 64 + cc * 2; return st * 1024 + (ob ^ (((ob >> 9) & 1) << 5)); }
__host__ __device__ __forceinline__ void stage_rc(int b, int& R, int& C) { const int st = b / 1024, sb = b % 1024, swz = sb ^ (((sb >> 9) & 1) << 5); R = (st >> 1) * 16 + swz / 64; C = (st & 1) * 32 + (swz % 64) / 2; }
__host__ __device__ __forceinline__ int perm32(int rho) { const int n = rho >> 4, i = rho & 15; return 8 * (i >> 2) + 4 * n + (i & 3); }

struct Unit { int pm, pn; };
struct Gemm { const bf16_t* A; const bf16_t* Bt; int lda, ldb, K; size_t tA, hA, tB, hB; int a_seg; int a_pn_shift; size_t a_pn_step; };
__device__ __forceinline__ Gemm make_gemm(const bf16_t* A, int lda, const bf16_t* Bt, int ldb, int K) {
    Gemm g; g.A = A; g.Bt = Bt; g.lda = lda; g.ldb = ldb; g.K = K; g.tA = (size_t)256 * lda * 2; g.hA = (size_t)128 * lda * 2; g.tB = (size_t)256 * ldb * 2; g.hB = (size_t)128 * ldb * 2;
    g.a_seg = 0; g.a_pn_shift = 0; g.a_pn_step = 0; return g;
}

struct StaticOrder {
    int nM, nN, nwg, G, c;
    __device__ __forceinline__ void init(int nM_, int nN_, int G_, int c_) { nM = nM_; nN = nN_; nwg = nM * nN; G = G_; c = c_; }
    __device__ __forceinline__ bool next(int i, Unit& u) const {
        const long L = (long)i * G + c; if (L >= nwg) return false;
        int wgid = (int)L; { const int q = nwg / NXCD, r = nwg % NXCD, xcd = wgid % NXCD, off = wgid / NXCD; wgid = (xcd < r ? xcd * (q + 1) : r * (q + 1) + (xcd - r) * q) + off; }
        const int nig = WGM * nN, gid = wgid / nig, fm = gid * WGM, gsz = (nM - fm) < WGM ? (nM - fm) : WGM;
        u.pm = fm + ((wgid % nig) % gsz); u.pn = (wgid % nig) / gsz; return true;
    }
};

template <class Epi>
__device__ __forceinline__ void gemm_phase(LAS unsigned char* lds, const Gemm g, const StaticOrder& S, const Epi& E) {
    constexpr bool SP2 = true, ALIGN_EPI = true;
    int tid_ = threadIdx.x; asm volatile("" : "+v"(tid_));
    const int tid = tid_, wid = __builtin_amdgcn_readfirstlane(tid >> 6), lane = tid & 63, wr = wid >> 2, wc = wid & 3, fr = lane & 15, fq = lane >> 4;
    int K_ = g.K; asm volatile("" : "+s"(K_)); const int K = K_, nt = K / BK;
    unsigned voffA[2], voffB[2];
#pragma unroll
    for (int i = 0; i < 2; ++i) { int R, C; stage_rc(tid * 16 + i * 8192, R, C); const int Rb = Epi::PERM ? ((R & ~31) + perm32(R & 31)) : R;
        const int Ra = g.a_seg ? (128 * (R >> 6) + (R & 63)) : R;
        voffA[i] = (unsigned)(Ra * g.lda + C) * 2u; voffB[i] = (unsigned)(Rb * g.ldb + C) * 2u; }
    const size_t kstep = (size_t)(BK * 2);
    const size_t hstepA = g.hA, hstepB = g.hB;
    const unsigned ldsw = (unsigned)wid * 1024u;
    const int aoff = lds_byte(wr * 64 + fr, fq * 8), boff = lds_byte(wc * 32 + fr, fq * 8);
#define PG8_SA(b, h) (((b) * 2 + (h)) * HTB)
#define PG8_SB(b, h) ((4 + (b) * 2 + (h)) * HTB)
#define PG8_STAGE(bufoff, gbase, voff) do { _Pragma("unroll") for (int _i = 0; _i < 2; ++_i) \
        __builtin_amdgcn_global_load_lds((const unsigned*)((const char*)(gbase) + (voff)[_i]), (LAS unsigned*)(lds + (bufoff) + ldsw + _i * 8192), 16, 0, 0); } while (0)
#define PG8_LDA(dst, b, h) do { _Pragma("unroll") for (int m = 0; m < 4; ++m) _Pragma("unroll") for (int k = 0; k < 2; ++k) dst[m][k] = *(const LAS bf16x8*)(lds + PG8_SA(b, h) + aoff + m * 2048 + k * 1024); } while (0)
#define PG8_LDB(dst, b, h) do { _Pragma("unroll") for (int n = 0; n < 2; ++n) _Pragma("unroll") for (int k = 0; k < 2; ++k) dst[n][k] = *(const LAS bf16x8*)(lds + PG8_SB(b, h) + boff + n * 2048 + k * 1024); } while (0)
#define PG8_MMA(ai, bj, At, Bt) do { __builtin_amdgcn_s_setprio(1); _Pragma("unroll") for (int m = 0; m < 4; ++m) _Pragma("unroll") for (int n = 0; n < 2; ++n) _Pragma("unroll") for (int k = 0; k < 2; ++k) \
        acc[ai][bj][m][n] = __builtin_amdgcn_mfma_f32_16x16x32_bf16(Bt[n][k], At[m][k], acc[ai][bj][m][n], 0, 0, 0); __builtin_amdgcn_s_setprio(0); } while (0)
#define PG8_WAIT_V(n) asm volatile("s_waitcnt vmcnt(" #n ")" ::: "memory")
#define PG8_WAIT_L(n) asm volatile("s_waitcnt lgkmcnt(" #n ")" ::: "memory")
#define PG8_BAR __builtin_amdgcn_s_barrier()
#define PG8_SCHED __builtin_amdgcn_sched_barrier(0)
#define PG8_APTR(u) ((const char*)g.A + (size_t)(u).pm * g.tA + (size_t)((u).pn >> g.a_pn_shift) * g.a_pn_step)
#define PG8_BPTR(u) ((const char*)g.Bt + (size_t)(u).pn * g.tB)
    Unit cur, nxt; int ui = 0;
    if (!S.next(0, cur)) return;
    f32x4 acc[2][2][4][2];
#pragma unroll
    for (int a = 0; a < 2; ++a)
#pragma unroll
        for (int b = 0; b < 2; ++b)
#pragma unroll
            for (int m = 0; m < 4; ++m)
#pragma unroll
                for (int n = 0; n < 2; ++n) acc[a][b][m][n] = (f32x4){0.f, 0.f, 0.f, 0.f};
    bf16x8 At[4][2], B0[2][2], B1[2][2];
    const char* cA = PG8_APTR(cur); const char* cB = PG8_BPTR(cur);
    {
        PG8_STAGE(PG8_SB(0, 0), cB, voffB); PG8_STAGE(PG8_SB(0, 1), cB + hstepB, voffB); PG8_STAGE(PG8_SA(0, 0), cA, voffA); PG8_STAGE(PG8_SA(0, 1), cA + hstepA, voffA);
        if (wr == 1) PG8_BAR;
        PG8_WAIT_V(2); PG8_BAR;
        PG8_STAGE(PG8_SB(1, 0), cB + kstep, voffB); PG8_STAGE(PG8_SA(1, 0), cA + kstep, voffA); PG8_STAGE(PG8_SB(1, 1), cB + hstepB + kstep, voffB);
        PG8_WAIT_V(6); PG8_BAR;
    }
    for (;;) {
        const bool has_next = S.next(ui + 1, nxt);
        const char* nA = has_next ? PG8_APTR(nxt) : cA; const char* nB = has_next ? PG8_BPTR(nxt) : cB;
        for (int t = 0; t < nt; t += 2) {
            const bool last = (t == nt - 2);
            const char* a1 = cA + (size_t)(t + 1) * kstep;
            const char* a2 = last ? nA : cA + (size_t)(t + 2) * kstep; const char* b2 = last ? nB : cB + (size_t)(t + 2) * kstep;
            const char* a3 = a2 + kstep; const char* b3 = b2 + kstep;
            PG8_LDB(B0, 0, 0); PG8_LDB(B1, 0, 1); PG8_SCHED; PG8_LDA(At, 0, 0); PG8_STAGE(PG8_SA(1, 1), a1 + hstepA, voffA);
            PG8_WAIT_V(8); PG8_WAIT_L(0); PG8_BAR; PG8_MMA(0, 0, At, B0); PG8_MMA(0, 1, At, B1); PG8_BAR; PG8_SCHED;
            PG8_LDA(At, 0, 1); PG8_STAGE(PG8_SB(0, 0), b2, voffB); PG8_STAGE(PG8_SB(0, 1), b2 + hstepB, voffB); PG8_STAGE(PG8_SA(0, 0), a2, voffA);
            PG8_WAIT_V(8); PG8_WAIT_L(0); PG8_BAR; PG8_MMA(1, 0, At, B0); PG8_MMA(1, 1, At, B1); PG8_BAR; PG8_SCHED;
            PG8_LDB(B0, 1, 0); PG8_LDB(B1, 1, 1); PG8_SCHED; PG8_LDA(At, 1, 0); PG8_STAGE(PG8_SA(0, 1), a2 + hstepA, voffA);
            PG8_WAIT_V(8); PG8_WAIT_L(0); PG8_BAR; PG8_MMA(0, 0, At, B0); PG8_MMA(0, 1, At, B1); PG8_BAR; PG8_SCHED;
            PG8_LDA(At, 1, 1); PG8_STAGE(PG8_SB(1, 0), b3, voffB); PG8_STAGE(PG8_SB(1, 1), b3 + hstepB, voffB); PG8_STAGE(PG8_SA(1, 0), a3, voffA);
            PG8_WAIT_V(8); PG8_WAIT_L(0); PG8_BAR; PG8_MMA(1, 0, At, B0); PG8_MMA(1, 1, At, B1); PG8_BAR; PG8_SCHED;
        }
        if constexpr (ALIGN_EPI) { if (wr == 0) PG8_BAR; }
        if constexpr (!Epi::AFTER_DRAIN) E(acc, cur, wr, wc, fr, fq);
        if (!has_next) break;
#pragma unroll
        for (int a = 0; a < 2; ++a)
#pragma unroll
            for (int b = 0; b < 2; ++b)
#pragma unroll
                for (int m = 0; m < 4; ++m)
#pragma unroll
                    for (int n = 0; n < 2; ++n) acc[a][b][m][n] = (f32x4){0.f, 0.f, 0.f, 0.f};
        cur = nxt; cA = nA; cB = nB; ++ui;
        if constexpr (ALIGN_EPI) { if (wr == 1) PG8_BAR; }
    }
    PG8_WAIT_V(0);
    if constexpr (!ALIGN_EPI) { if (wr == 0) PG8_BAR; }
    PG8_BAR;
    if constexpr (Epi::AFTER_DRAIN) E.fused(acc, cur, wr, wc, fr, fq, lds, wid, lane);
#undef PG8_SA
#undef PG8_SB
#undef PG8_STAGE
#undef PG8_LDA
#undef PG8_LDB
#undef PG8_MMA
#undef PG8_WAIT_V
#undef PG8_WAIT_L
#undef PG8_BAR
#undef PG8_SCHED
#undef PG8_APTR
#undef PG8_BPTR
}
}
constexpr int TH = 16384;
constexpr int DM = 1024, ZP = 2304, DFF = 4096, TQ = 8192;
constexpr size_t MiB = 1u << 20;
constexpr size_t WS_RSQ = 0, WS_RSKV = 64 * 1024, WS_ROPE = 128 * 1024;
constexpr size_t WS_AGG = 5 * MiB;
constexpr size_t WS_CARRY = 9 * MiB;
constexpr size_t WS_XBUF = 1 * MiB;
constexpr size_t WS_SQP = 1 * MiB + 512 * 1024;
constexpr size_t WS_CNT = 3 * MiB;
constexpr size_t WS_BAR = 4 * MiB;
constexpr size_t WS_YB = 5 * MiB;
constexpr size_t WS_W_INATT = 13 * MiB;
constexpr size_t WS_W_UQ = WS_W_INATT + (size_t)2304 * 1024 * 2;
constexpr size_t WS_W_UKV = WS_W_UQ + (size_t)768 * 384 * 2;
constexpr size_t WS_W_OUTATT = WS_W_UKV + (size_t)1024 * 256 * 2;
constexpr size_t WS_W_INREC = WS_W_OUTATT + 2 * MiB;
constexpr size_t WS_W_GATES = WS_W_INREC + 4 * MiB;
constexpr size_t WS_W_OUTREC = WS_W_GATES + 1 * MiB;
constexpr size_t WS_W_UP = WS_W_OUTREC + 2 * MiB;
constexpr size_t WS_W_DOWN = WS_W_UP + 32 * MiB;
constexpr size_t WS_W_END = WS_W_DOWN + 16 * MiB;
static_assert(WS_W_END <= 76 * MiB, "weights");
constexpr size_t WS_XN = 76 * MiB;
constexpr size_t WS_BIG = 108 * MiB;
constexpr size_t WS_Z = WS_BIG;
constexpr size_t WS_Q = WS_Z + 72 * MiB;
constexpr size_t WS_KN = WS_Q + 24 * MiB;
constexpr size_t WS_VTM = WS_KN + 16 * MiB;
constexpr size_t WS_VTN = WS_VTM + 16 * MiB;
constexpr size_t WS_KPE = WS_VTN + 16 * MiB;
static_assert(WS_KPE + 1 * MiB <= 256 * MiB, "L0 overlay");
constexpr size_t WS_ACT = WS_BIG;
constexpr size_t WS_GATE = WS_BIG;
constexpr size_t WS_XB = WS_BIG + 32 * MiB;
constexpr size_t WS_XBR = WS_BIG + 64 * MiB;
constexpr size_t WS_GQ = WS_XBR;
constexpr size_t WS_END = 256 * MiB;

using pg8::Unit;

struct EpiBf16 {
    static constexpr bool PERM = true, AFTER_DRAIN = false;
    bf16_t* O; int ldc; int split_cols; size_t split_stride;
    __device__ __forceinline__ void operator()(f32x4 (&acc)[2][2][4][2], const Unit& u, int wr, int wc, int fr, int fq) const {
        const int row0 = u.pm * 256 + wr * 64 + fr; int colt = u.pn * 256; bf16_t* base = O;
        if (split_cols) { const int t = colt / split_cols; base += (size_t)t * split_stride; colt -= t * split_cols; }
        const int col0 = colt + wc * 32 + 8 * fq;
#pragma unroll
        for (int ai = 0; ai < 2; ++ai)
#pragma unroll
            for (int m = 0; m < 4; ++m) { bf16_t* rowp = base + (size_t)(row0 + ai * 128 + m * 16) * ldc + col0;
#pragma unroll
                for (int bj = 0; bj < 2; ++bj) { const f32x4 v0 = acc[ai][bj][m][0], v1 = acc[ai][bj][m][1];
                    u32x4 w; w.x = cvt_pk_bf16(v0[0], v0[1]); w.y = cvt_pk_bf16(v0[2], v0[3]); w.z = cvt_pk_bf16(v1[0], v1[1]); w.w = cvt_pk_bf16(v1[2], v1[3]);
                    *(u32x4*)(rowp + bj * 128) = w; } }
    }
};

struct EpiZ {
    static constexpr bool PERM = true, AFTER_DRAIN = false;
    bf16_t* Z; bf16_t* VTn; float* SQ; float* SKV; bf16_t* KPE; const float2* rope; int smask;
    __device__ __forceinline__ void operator()(f32x4 (&acc)[2][2][4][2], const Unit& u, int wr, int wc, int fr, int fq) const {
        const int lane = fq * 16 + fr;
        const int row0 = u.pm * 256 + wr * 64 + fr; const int col0 = u.pn * 256 + wc * 32 + 8 * fq;
#pragma unroll
        for (int ai = 0; ai < 2; ++ai)
#pragma unroll
            for (int m = 0; m < 4; ++m) { const int row = row0 + ai * 128 + m * 16; bf16_t* rowp = Z + (size_t)row * ZP + col0;
#pragma unroll
                for (int bj = 0; bj < 2; ++bj) { const f32x4 v0 = acc[ai][bj][m][0], v1 = acc[ai][bj][m][1];
                    u32x4 w; w.x = cvt_pk_bf16(v0[0], v0[1]); w.y = cvt_pk_bf16(v0[2], v0[3]); w.z = cvt_pk_bf16(v1[0], v1[1]); w.w = cvt_pk_bf16(v1[2], v1[3]);
                    *(u32x4*)(rowp + bj * 128) = w;
                    const int c = col0 + bj * 128; const int g32 = (u.pn * 256 + bj * 128 + wc * 32) >> 5;
                    if (g32 < 20) {
                        float s = (v0[0] * v0[0] + v0[1] * v0[1]) + (v0[2] * v0[2] + v0[3] * v0[3]) + ((v1[0] * v1[0] + v1[1] * v1[1]) + (v1[2] * v1[2] + v1[3] * v1[3]));
                        s += bperm_f(lane ^ 16, s); s += bperm_f(lane ^ 32, s);
                        if (fq == 0) SQ[(size_t)row * 20 + g32] = s;
                    } else if (g32 == 20) {
                        const float2* rp = rope + (size_t)(row & smask) * 16 + 8 * (fq & 1);
                        float o[8];
#pragma unroll
                        for (int k = 0; k < 8; ++k) { const float mine = k < 4 ? v0[k] : v1[k - 4]; const float other = bperm_f(lane ^ 32, mine); const float2 cs = rp[k];
                            o[k] = fq < 2 ? mine * cs.x - other * cs.y : mine * cs.x + other * cs.y; }
                        u32x4 wk; wk.x = cvt_pk_bf16(o[0], o[1]); wk.y = cvt_pk_bf16(o[2], o[3]); wk.z = cvt_pk_bf16(o[4], o[5]); wk.w = cvt_pk_bf16(o[6], o[7]);
                        *(u32x4*)(KPE + (size_t)row * 32 + 8 * fq) = wk;
                    }
                    if (c >= 1696 && c < 2208) { bf16_t* vt = VTn + (size_t)(c - 1696) * TH + row;
                        vt[0] = (bf16_t)(w.x & 0xffffu); vt[TH] = (bf16_t)(w.x >> 16); vt[2 * TH] = (bf16_t)(w.y & 0xffffu); vt[3 * TH] = (bf16_t)(w.y >> 16);
                        vt[4 * TH] = (bf16_t)(w.z & 0xffffu); vt[5 * TH] = (bf16_t)(w.z >> 16); vt[6 * TH] = (bf16_t)(w.w & 0xffffu); vt[7 * TH] = (bf16_t)(w.w >> 16); } } }
    }
};

struct EpiQ {
    static constexpr bool PERM = false, AFTER_DRAIN = false;
    bf16_t* Q; const float* rsq; const float2* rope; int smask;
    __device__ __forceinline__ void operator()(f32x4 (&acc)[2][2][4][2], const Unit& u, int wr, int wc, int fr, int fq) const {
        const float SC = 0.10206207261596577f * 1.4426950408889634f;
        const int row0 = u.pm * 256 + wr * 64 + fr;
#pragma unroll
        for (int ai = 0; ai < 2; ++ai)
#pragma unroll
            for (int m = 0; m < 4; ++m) { const int row = row0 + ai * 128 + m * 16; float ssq = 0.f;
#pragma unroll
                for (int k = 0; k < 12; ++k) ssq += rsq[(size_t)row * 20 + k];
                const float rs = SC / sqrtf(ssq * (1.f / 384.f) + 1e-6f); const int pos = row & smask;
#pragma unroll
                for (int bj = 0; bj < 2; ++bj) { const int cg = u.pn * 256 + bj * 128 + wc * 32;
                    f32x4 v0 = acc[ai][bj][m][0] * rs, v1 = acc[ai][bj][m][1] * rs;
                    if ((cg % 96) == 64) {
                        const float2* rp = rope + (size_t)pos * 16 + 4 * fq;
#pragma unroll
                        for (int i = 0; i < 4; ++i) { const float2 cs = rp[i]; const float x1 = v0[i], x2 = v1[i]; v0[i] = x1 * cs.x - x2 * cs.y; v1[i] = x2 * cs.x + x1 * cs.y; }
                    }
                    bf16_t* p = Q + (size_t)row * 768 + cg + 4 * fq;
                    u32x2 w0; w0.x = cvt_pk_bf16(v0[0], v0[1]); w0.y = cvt_pk_bf16(v0[2], v0[3]); *(u32x2*)p = w0;
                    u32x2 w1; w1.x = cvt_pk_bf16(v1[0], v1[1]); w1.y = cvt_pk_bf16(v1[2], v1[3]); *(u32x2*)(p + 16) = w1; } }
    }
};

struct EpiKV {
    static constexpr bool PERM = true, AFTER_DRAIN = false;
    bf16_t* KN; bf16_t* VTm; const float* rskv;
    __device__ __forceinline__ void operator()(f32x4 (&acc)[2][2][4][2], const Unit& u, int wr, int wc, int fr, int fq) const {
        const int row0 = u.pm * 256 + wr * 64 + fr;
#pragma unroll
        for (int ai = 0; ai < 2; ++ai)
#pragma unroll
            for (int m = 0; m < 4; ++m) { const int row = row0 + ai * 128 + m * 16; float ssq = 0.f;
#pragma unroll
                for (int k = 12; k < 20; ++k) ssq += rskv[(size_t)row * 20 + k];
                const float rs = 1.0f / sqrtf(ssq * (1.f / 256.f) + 1e-6f);
#pragma unroll
                for (int bj = 0; bj < 2; ++bj) { const int c = u.pn * 256 + bj * 128 + wc * 32 + 8 * fq;
                    const f32x4 v0 = acc[ai][bj][m][0] * rs, v1 = acc[ai][bj][m][1] * rs;
                    u32x4 w; w.x = cvt_pk_bf16(v0[0], v0[1]); w.y = cvt_pk_bf16(v0[2], v0[3]); w.z = cvt_pk_bf16(v1[0], v1[1]); w.w = cvt_pk_bf16(v1[2], v1[3]);
                    const int h = c >> 7, j = c & 127;
                    if (j < 64) { *(u32x4*)(KN + (size_t)row * 512 + h * 64 + j) = w; }
                    else { bf16_t* vt = VTm + (size_t)(h * 64 + j - 64) * TH + row;
                        vt[0] = (bf16_t)(w.x & 0xffffu); vt[TH] = (bf16_t)(w.x >> 16); vt[2 * TH] = (bf16_t)(w.y & 0xffffu); vt[3 * TH] = (bf16_t)(w.y >> 16);
                        vt[4 * TH] = (bf16_t)(w.z & 0xffffu); vt[5 * TH] = (bf16_t)(w.z >> 16); vt[6 * TH] = (bf16_t)(w.w & 0xffffu); vt[7 * TH] = (bf16_t)(w.w >> 16); } } }
    }
};

struct EpiUp {
    static constexpr bool PERM = true, AFTER_DRAIN = false;
    bf16_t* ACT; bf16_t* YB; const float* cw; const float* cb;
    __device__ __forceinline__ void operator()(f32x4 (&acc)[2][2][4][2], const Unit& u, int wr, int wc, int fr_, int fq_) const {
        int fr = fr_, fq = fq_; asm volatile("" : "+v"(fr), "+v"(fq));
        const int lane = fq * 16 + fr;
        const int tok0 = u.pm * 256 + wr * 128 + fr;
        const int ch0 = u.pn * 128 + wc * 32 + 8 * fq;
        const int seg = u.pm * 2 + wr;
        if (fr < 2 || fr >= 14) {
            const int slot = fr < 2 ? fr : fr - 12; const int ai = fr < 2 ? 0 : 1, m = fr < 2 ? 0 : 3;
            bf16_t* yb = YB + ((size_t)seg * 4 + slot) * 8192 + ch0;
#pragma unroll
            for (int bj = 0; bj < 2; ++bj) { const f32x4 v0 = ai ? acc[1][bj][3][0] : acc[0][bj][0][0], v1 = ai ? acc[1][bj][3][1] : acc[0][bj][0][1]; (void)m;
                u32x4 w; w.x = cvt_pk_bf16(v0[0], v0[1]); w.y = cvt_pk_bf16(v0[2], v0[3]); w.z = cvt_pk_bf16(v1[0], v1[1]); w.w = cvt_pk_bf16(v1[2], v1[3]);
                *(u32x4*)(yb + bj * 4096) = w; }
        }
        const int src_up = (lane & ~15) | ((fr - 1) & 15), src_dn = (lane & ~15) | ((fr + 1) & 15);
#pragma unroll
        for (int n = 0; n < 2; ++n)
#pragma unroll
            for (int i = 0; i < 4; ++i) {
                float ug[8], uv[8];
#pragma unroll
                for (int bj = 0; bj < 2; ++bj) {
                    const int ch = bj * 4096 + ch0 + 4 * n + i;
                    const float w0 = cw[ch], w1 = cw[8192 + ch], w2 = cw[2 * 8192 + ch], b = cb[ch];
#pragma unroll
                    for (int q = 0; q < 8; ++q) {
                        const float v = acc[q >> 2][bj][q & 3][n][i];
                        const float vp = q > 0 ? acc[(q - 1) >> 2][bj][(q - 1) & 3][n][i] : 0.f;
                        const float vn = q < 7 ? acc[(q + 1) >> 2][bj][(q + 1) & 3][n][i] : 0.f;
                        const float up = bperm_f(src_up, fr == 15 ? vp : v);
                        const float dn = bperm_f(src_dn, fr == 0 ? vn : v);
                        const float r = w0 * up + w1 * v + w2 * dn + b;
                        if (bj == 0) ug[q] = r; else uv[q] = r;
                    }
                }
#pragma unroll
                for (int q = 0; q < 8; ++q) acc[q >> 2][0][q & 3][n][i] = gelu_tanh(ug[q]) * uv[q];
            }
#pragma unroll
        for (int ai = 0; ai < 2; ++ai)
#pragma unroll
            for (int m = 0; m < 4; ++m) { const f32x4 v0 = acc[ai][0][m][0], v1 = acc[ai][0][m][1];
                u32x4 w; w.x = cvt_pk_bf16(v0[0], v0[1]); w.y = cvt_pk_bf16(v0[2], v0[3]); w.z = cvt_pk_bf16(v1[0], v1[1]); w.w = cvt_pk_bf16(v1[2], v1[3]);
                *(u32x4*)(ACT + (size_t)(tok0 + 64 * ai + 16 * m) * DFF + ch0) = w; }
    }
};

struct EpiRms {
    static constexpr bool PERM = false, AFTER_DRAIN = true;
    float* x; bf16_t* xn; const float* gpost; const float* gnext; float* xbuf1; float* xbuf2; unsigned* cnt1; unsigned* cnt2;
    __device__ __forceinline__ void operator()(f32x4 (&)[2][2][4][2], const Unit&, int, int, int, int) const {}
    __device__ __forceinline__ void stats(const f32x4 (&v)[2][2][4][2], const Unit& u, int wr, int wc, int fr, int fq, LAS unsigned char* lds, int wid, int lane, float* xbuf, unsigned* cnt) const {
        LAS float* P = (LAS float*)lds; LAS float* Sx = (LAS float*)(lds + 4096);
#pragma unroll
        for (int ai = 0; ai < 2; ++ai)
#pragma unroll
            for (int m = 0; m < 4; ++m) { float s = 0.f;
#pragma unroll
                for (int bj = 0; bj < 2; ++bj)
#pragma unroll
                    for (int n = 0; n < 2; ++n) { const f32x4 t = v[ai][bj][m][n]; s += (t[0] * t[0] + t[1] * t[1]) + (t[2] * t[2] + t[3] * t[3]); }
                s += bperm_f(lane ^ 16, s); s += bperm_f(lane ^ 32, s);
                if (fq == 0) P[(ai * 128 + wr * 64 + m * 16 + fr) * 4 + wc] = s; }
        asm volatile("s_waitcnt lgkmcnt(0)" ::: "memory"); __builtin_amdgcn_s_barrier(); asm volatile("" ::: "memory");
        const int row = wid * 32 + (lane & 31);
        if (lane < 32) { const float t = (P[row * 4 + 0] + P[row * 4 + 1]) + (P[row * 4 + 2] + P[row * 4 + 3]);
            __hip_atomic_store(xbuf + (size_t)(u.pm * 256 + row) * 4 + u.pn, t, __ATOMIC_RELAXED, __HIP_MEMORY_SCOPE_AGENT); }
        asm volatile("s_waitcnt vmcnt(0)" ::: "memory");
        if (lane == 0) __hip_atomic_fetch_add(cnt + 64 * u.pm, 1u, __ATOMIC_RELAXED, __HIP_MEMORY_SCOPE_AGENT);
        if (wid == 0) { unsigned sp = 0;
            while ((unsigned)__builtin_amdgcn_readfirstlane(__hip_atomic_load(cnt + 64 * u.pm, __ATOMIC_RELAXED, __HIP_MEMORY_SCOPE_AGENT)) < 32u) { __builtin_amdgcn_s_sleep(2); if (++sp > (1u << 22)) break; }
            __builtin_amdgcn_fence(__ATOMIC_ACQUIRE, "agent"); }
        asm volatile("s_waitcnt vmcnt(0) lgkmcnt(0)" ::: "memory"); __builtin_amdgcn_s_barrier(); asm volatile("" ::: "memory");
        if (lane < 32) { const float* slot = xbuf + (size_t)(u.pm * 256 + row) * 4; float t = 0.f;
#pragma unroll
            for (int k = 0; k < 4; ++k) t += __hip_atomic_load(slot + k, __ATOMIC_RELAXED, __HIP_MEMORY_SCOPE_AGENT);
            Sx[row] = 1.0f / sqrtf(t * (1.f / 1024.f) + 1e-6f); }
        asm volatile("s_waitcnt lgkmcnt(0)" ::: "memory"); __builtin_amdgcn_s_barrier(); asm volatile("" ::: "memory");
    }
    __device__ __forceinline__ void fused(f32x4 (&acc)[2][2][4][2], const Unit& u, int wr, int wc, int fr, int fq, LAS unsigned char* lds, int wid, int lane) const {
        const LAS float* Sx = (const LAS float*)(lds + 4096);
        const int col0 = u.pn * 256 + wc * 32 + 4 * fq;
        stats(acc, u, wr, wc, fr, fq, lds, wid, lane, xbuf1, cnt1);
#pragma unroll
        for (int ai = 0; ai < 2; ++ai)
#pragma unroll
            for (int m = 0; m < 4; ++m) { const int r = ai * 128 + wr * 64 + m * 16 + fr; const float rs = Sx[r]; float* xr = x + (size_t)(u.pm * 256 + r) * DM + col0;
#pragma unroll
                for (int bj = 0; bj < 2; ++bj)
#pragma unroll
                    for (int n = 0; n < 2; ++n) { const f32x4 g = *(const f32x4*)(gpost + col0 + bj * 128 + n * 16); const f32x4 bs = *(const f32x4*)(xr + bj * 128 + n * 16);
                        const f32x4 o = bs + acc[ai][bj][m][n] * rs * g; acc[ai][bj][m][n] = o; *(f32x4*)(xr + bj * 128 + n * 16) = o; }
                if (m & 1) asm volatile("" ::: "memory"); }
        if (xn) {
            stats(acc, u, wr, wc, fr, fq, lds, wid, lane, xbuf2, cnt2);
#pragma unroll
            for (int ai = 0; ai < 2; ++ai)
#pragma unroll
                for (int m = 0; m < 4; ++m) { const int r = ai * 128 + wr * 64 + m * 16 + fr; const float rs = Sx[r]; bf16_t* xr = xn + (size_t)(u.pm * 256 + r) * DM + col0;
#pragma unroll
                    for (int bj = 0; bj < 2; ++bj)
#pragma unroll
                        for (int n = 0; n < 2; ++n) { const f32x4 g = *(const f32x4*)(gnext + col0 + bj * 128 + n * 16); const f32x4 o = acc[ai][bj][m][n] * rs * g;
                            u32x2 w; w.x = cvt_pk_bf16(o[0], o[1]); w.y = cvt_pk_bf16(o[2], o[3]); *(u32x2*)(xr + bj * 128 + n * 16) = w; } }
        }
    }
};
constexpr float EPS = 1e-6f;
constexpr float LOG2E = 1.4426950408889634f;

__device__ __forceinline__ void transpose_item(const float* W, int K, int N, bf16_t* WT, int row_off, const float* kscale, LAS float* scr, int item, int lane) {
    const int nblk = N / 32, kb = item / nblk, nb = item % nblk, k0 = 64 * kb, n0 = 32 * nb;
#pragma unroll 8
    for (int i = 0; i < 32; ++i) { const int kk = 2 * i + (lane >> 5); float v = W[(size_t)(k0 + kk) * N + n0 + (lane & 31)]; if (kscale) v *= kscale[k0 + kk]; scr[kk * 33 + (lane & 31)] = v; }
    asm volatile("s_waitcnt lgkmcnt(0)" ::: "memory");
    const int c = lane & 7;
#pragma unroll
    for (int j = 0; j < 4; ++j) { const int n = (lane >> 3) + 8 * j; const LAS float* s = scr + (8 * c) * 33 + n;
        u32x4 o; o.x = cvt_pk_bf16(s[0 * 33], s[1 * 33]); o.y = cvt_pk_bf16(s[2 * 33], s[3 * 33]); o.z = cvt_pk_bf16(s[4 * 33], s[5 * 33]); o.w = cvt_pk_bf16(s[6 * 33], s[7 * 33]);
        *(u32x4*)(WT + (size_t)(row_off + n0 + n) * K + k0 + 8 * c) = o; }
    asm volatile("s_waitcnt lgkmcnt(0)" ::: "memory");
}

__device__ __forceinline__ void xn_row(const float* xrow, const float* gain, bf16_t* orow, int lane) {
    const f32x4* xr = (const f32x4*)xrow + lane; const f32x4* gr = (const f32x4*)gain + lane;
    f32x4 v[4]; float s = 0.f;
#pragma unroll
    for (int j = 0; j < 4; ++j) { v[j] = xr[64 * j]; s += (v[j].x * v[j].x + v[j].y * v[j].y) + (v[j].z * v[j].z + v[j].w * v[j].w); }
    const float rs = 1.0f / sqrtf(wave_sum(s, lane) * (1.f / DM) + EPS);
    u32x2* o8 = (u32x2*)orow + lane;
#pragma unroll
    for (int j = 0; j < 4; ++j) { const f32x4 g = gr[64 * j]; u32x2 w; w.x = cvt_pk_bf16(v[j].x * rs * g.x, v[j].y * rs * g.y); w.y = cvt_pk_bf16(v[j].z * rs * g.z, v[j].w * rs * g.w); o8[64 * j] = w; }
}

__device__ __forceinline__ void res_row(const bf16_t* mrow, const float* xi, float* xo, const float* gpost, const float* gnext, bf16_t* xnrow, int lane) {
    const u32x2* mr = (const u32x2*)mrow + lane; const f32x4* xr = (const f32x4*)xi + lane; const f32x4* gp = (const f32x4*)gpost + lane;
    f32x4 mv[4]; float s = 0.f;
#pragma unroll
    for (int j = 0; j < 4; ++j) { const u32x2 w = mr[64 * j]; mv[j] = (f32x4){bflo(w.x), bfhi(w.x), bflo(w.y), bfhi(w.y)}; s += (mv[j].x * mv[j].x + mv[j].y * mv[j].y) + (mv[j].z * mv[j].z + mv[j].w * mv[j].w); }
    const float rs = 1.0f / sqrtf(wave_sum(s, lane) * (1.f / DM) + EPS);
    f32x4 x[4]; float s2 = 0.f;
#pragma unroll
    for (int j = 0; j < 4; ++j) { const f32x4 g = gp[64 * j]; x[j] = xr[64 * j] + mv[j] * rs * g; s2 += (x[j].x * x[j].x + x[j].y * x[j].y) + (x[j].z * x[j].z + x[j].w * x[j].w); }
    f32x4* xw = (f32x4*)xo + lane;
#pragma unroll
    for (int j = 0; j < 4; ++j) xw[64 * j] = x[j];
    if (gnext) {
        const float rs2 = 1.0f / sqrtf(wave_sum(s2, lane) * (1.f / DM) + EPS);
        const f32x4* gn = (const f32x4*)gnext + lane; u32x2* o8 = (u32x2*)xnrow + lane;
#pragma unroll
        for (int j = 0; j < 4; ++j) { const f32x4 g = gn[64 * j]; u32x2 w; w.x = cvt_pk_bf16(x[j].x * rs2 * g.x, x[j].y * rs2 * g.y); w.y = cvt_pk_bf16(x[j].z * rs2 * g.z, x[j].w * rs2 * g.w); o8[64 * j] = w; }
    }
}

#define MLA_PACK(P, B) ((u32x4){cvt_pk_bf16(P[B], P[B + 1]), cvt_pk_bf16(P[B + 2], P[B + 3]), cvt_pk_bf16(P[B + 4], P[B + 5]), cvt_pk_bf16(P[B + 6], P[B + 7])})
__device__ __forceinline__ void mla_softmax(f32x16& p0, f32x16& p1, float& m_run, float& l_run, f32x16& o0, f32x16& o1) {
    float mx = fmaxf(p0[0], p1[0]);
#pragma unroll
    for (int r = 1; r < 16; ++r) mx = fmaxf(mx, fmaxf(p0[r], p1[r]));
    mx = xor32_max(mx);
    const float m_new = fmaxf(m_run, mx), alpha = fexp2(m_run - m_new); m_run = m_new;
    p0 = p0 - m_new; p1 = p1 - m_new;
#pragma unroll
    for (int r = 0; r < 16; ++r) { p0[r] = fexp2(p0[r]); p1[r] = fexp2(p1[r]); }
    const f32x16 ps = p0 + p1;
    const float ls = ((ps[0] + ps[1]) + (ps[2] + ps[3])) + ((ps[4] + ps[5]) + (ps[6] + ps[7])) + (((ps[8] + ps[9]) + (ps[10] + ps[11])) + ((ps[12] + ps[13]) + (ps[14] + ps[15])));
    l_run = l_run * alpha + ls;
    o0 = o0 * alpha; o1 = o1 * alpha;
}
__device__ __forceinline__ void mla_store(bf16_t* orow, const f32x16& o0, const f32x16& o1, float l_run) {
    const float inv = 1.0f / xor32_sum(l_run);
#pragma unroll
    for (int rg = 0; rg < 4; ++rg) {
        u32x2 w; w.x = cvt_pk_bf16(o0[4 * rg] * inv, o0[4 * rg + 1] * inv); w.y = cvt_pk_bf16(o0[4 * rg + 2] * inv, o0[4 * rg + 3] * inv); *(u32x2*)(orow + 8 * rg) = w;
        u32x2 w2; w2.x = cvt_pk_bf16(o1[4 * rg] * inv, o1[4 * rg + 1] * inv); w2.y = cvt_pk_bf16(o1[4 * rg + 2] * inv, o1[4 * rg + 3] * inv); *(u32x2*)(orow + 32 + 8 * rg) = w2;
    }
}
template <int MODE>
__device__ __forceinline__ void mla_unit(LAS unsigned char* lds, const bf16_t* Q, const bf16_t* KN, const bf16_t* KPE, const bf16_t* VT, bf16_t* AO, int tokbase, int S, int h, int qb, int tid) {
    constexpr int KBYTES = 12288, BUF = 20480;
    const int lane = tid & 63, wid = __builtin_amdgcn_readfirstlane(tid >> 6), r32 = lane & 31, hi = lane >> 5;
    const bf16_t* ks0 = KN + (size_t)(tokbase + lane) * 512 + h * 64 + 8 * wid;
    const bf16_t* ks1 = KPE + (size_t)(tokbase + lane) * 32 + 8 * (wid & 3);
    const bf16_t* vs = VT + (size_t)(h * 64 + lane) * TH + tokbase + 8 * wid;
#define MLA_DMA(T, B) do { LAS unsigned char* sb_ = lds + (B) * BUF; \
        __builtin_amdgcn_global_load_lds((const unsigned*)(ks0 + (size_t)(T) * (64 * 512)), (LAS unsigned*)(sb_ + wid * 1024), 16, 0, 0); \
        if (wid < 4) __builtin_amdgcn_global_load_lds((const unsigned*)(ks1 + (size_t)(T) * (64 * 32)), (LAS unsigned*)(sb_ + (8 + wid) * 1024), 16, 0, 0); \
        __builtin_amdgcn_global_load_lds((const unsigned*)(vs + (size_t)(T) * 64), (LAS unsigned*)(sb_ + KBYTES + wid * 1024), 16, 0, 0); } while (0)
#define MLA_WAITBAR_KEEP() do { if (wid < 4) asm volatile("s_waitcnt vmcnt(3)" ::: "memory"); else asm volatile("s_waitcnt vmcnt(2)" ::: "memory"); \
        asm volatile("s_waitcnt lgkmcnt(0)" ::: "memory"); __builtin_amdgcn_s_barrier(); asm volatile("" ::: "memory"); } while (0)
#define MLA_WAITBAR_ALL() do { asm volatile("s_waitcnt vmcnt(0) lgkmcnt(0)" ::: "memory"); __builtin_amdgcn_s_barrier(); asm volatile("" ::: "memory"); } while (0)
    const int NT = S / 64;
    const int qtokA = tokbase + 512 * qb + 64 * wid + r32, qtokB = qtokA + 32;
    bf16x8 qa[6], qbv[6];
#pragma unroll
    for (int d0 = 0; d0 < 6; ++d0) { qa[d0] = *(const bf16x8*)(Q + (size_t)qtokA * 768 + h * 96 + 16 * d0 + 8 * hi); qbv[d0] = *(const bf16x8*)(Q + (size_t)qtokB * 768 + h * 96 + 16 * d0 + 8 * hi); }
    asm volatile("s_waitcnt vmcnt(0)" ::: "memory");
    if (MODE != 5) { MLA_DMA(0, 0); MLA_DMA(1, 1); }
    MLA_WAITBAR_ALL();
    f32x16 oa0, oa1, ob0, ob1;
#pragma unroll
    for (int r = 0; r < 16; ++r) { oa0[r] = 0.f; oa1[r] = 0.f; ob0[r] = 0.f; ob1[r] = 0.f; }
    float ma = -1e30f, la = 0.f, mb = -1e30f, lb = 0.f;
    for (int t = 0; t < NT; ++t) {
        if (MODE != 5) { if (t + 2 < NT) MLA_DMA(t + 2, (t + 2) & 3); }
        const LAS unsigned char* kb = lds + (t & 3) * BUF; const LAS unsigned char* vb = kb + KBYTES;
        f32x16 pa0, pa1, pb0, pb1;
#pragma unroll
        for (int r = 0; r < 16; ++r) { pa0[r] = 0.f; pa1[r] = 0.f; pb0[r] = 0.f; pb1[r] = 0.f; }
        const LAS unsigned char* kfp = kb + hi * 1024 + r32 * 16;
        bf16x8 a0 = *(const LAS bf16x8*)(kfp), a1 = *(const LAS bf16x8*)(kfp + 512);
#pragma unroll
        for (int d0 = 0; d0 < 6; ++d0) {
            bf16x8 n0 = a0, n1 = a1;
            if (d0 < 5) { n0 = *(const LAS bf16x8*)(kfp + (d0 + 1) * 2048); n1 = *(const LAS bf16x8*)(kfp + (d0 + 1) * 2048 + 512); }
            __builtin_amdgcn_sched_barrier(0);
            pa0 = __builtin_amdgcn_mfma_f32_32x32x16_bf16(a0, qa[d0], pa0, 0, 0, 0);
            pa1 = __builtin_amdgcn_mfma_f32_32x32x16_bf16(a1, qa[d0], pa1, 0, 0, 0);
            pb0 = __builtin_amdgcn_mfma_f32_32x32x16_bf16(a0, qbv[d0], pb0, 0, 0, 0);
            pb1 = __builtin_amdgcn_mfma_f32_32x32x16_bf16(a1, qbv[d0], pb1, 0, 0, 0);
            __builtin_amdgcn_sched_barrier(0);
            a0 = n0; a1 = n1;
        }
        const LAS unsigned char* vfp = vb + r32 * 16 + 8 * hi;
        u32x2 c_alo = *(const LAS u32x2*)(vfp), c_ahi = *(const LAS u32x2*)(vfp + 1024), c_blo = *(const LAS u32x2*)(vfp + 512), c_bhi = *(const LAS u32x2*)(vfp + 1024 + 512);
        if (MODE != 3) { mla_softmax(pa0, pa1, ma, la, oa0, oa1);
        mla_softmax(pb0, pb1, mb, lb, ob0, ob1); }
#pragma unroll
        for (int ks = 0; ks < 4; ++ks) {
            u32x2 n_alo = c_alo, n_ahi = c_ahi, n_blo = c_blo, n_bhi = c_bhi;
            if (ks < 3) { const LAS unsigned char* vp = vfp + (2 * (ks + 1)) * 1024; n_alo = *(const LAS u32x2*)(vp); n_ahi = *(const LAS u32x2*)(vp + 1024); n_blo = *(const LAS u32x2*)(vp + 512); n_bhi = *(const LAS u32x2*)(vp + 1024 + 512); }
            const u32x4 pwa = ks == 0 ? MLA_PACK(pa0, 0) : ks == 1 ? MLA_PACK(pa0, 8) : ks == 2 ? MLA_PACK(pa1, 0) : MLA_PACK(pa1, 8);
            const u32x4 pwb = ks == 0 ? MLA_PACK(pb0, 0) : ks == 1 ? MLA_PACK(pb0, 8) : ks == 2 ? MLA_PACK(pb1, 0) : MLA_PACK(pb1, 8);
            const bf16x8 paa = __builtin_bit_cast(bf16x8, pwa), pab = __builtin_bit_cast(bf16x8, pwb);
            const bf16x8 vf0 = __builtin_bit_cast(bf16x8, ((u32x4){c_alo.x, c_alo.y, c_ahi.x, c_ahi.y}));
            const bf16x8 vf1 = __builtin_bit_cast(bf16x8, ((u32x4){c_blo.x, c_blo.y, c_bhi.x, c_bhi.y}));
            oa0 = __builtin_amdgcn_mfma_f32_32x32x16_bf16(vf0, paa, oa0, 0, 0, 0);
            oa1 = __builtin_amdgcn_mfma_f32_32x32x16_bf16(vf1, paa, oa1, 0, 0, 0);
            ob0 = __builtin_amdgcn_mfma_f32_32x32x16_bf16(vf0, pab, ob0, 0, 0, 0);
            ob1 = __builtin_amdgcn_mfma_f32_32x32x16_bf16(vf1, pab, ob1, 0, 0, 0);
            c_alo = n_alo; c_ahi = n_ahi; c_blo = n_blo; c_bhi = n_bhi;
        }
        if (MODE != 5) { if (t & 1) MLA_WAITBAR_ALL(); }
    }
#undef MLA_DMA
#undef MLA_WAITBAR_KEEP
#undef MLA_WAITBAR_ALL
    if (MODE != 0 && !(la + lb + oa0[0] + ob1[3] == 12345.678f)) return;
    mla_store(AO + (size_t)qtokA * 1024 + h * 64 + 4 * hi, oa0, oa1, la);
    mla_store(AO + (size_t)qtokB * 1024 + h * 64 + 4 * hi, ob0, ob1, lb);
}

__device__ __forceinline__ unsigned na_vmask(int qc, int kh, int hi) {
    int cs = qc - 8; cs = cs < 0 ? 0 : cs; cs = cs > 48 ? 48 : cs; unsigned mk = 0u;
#pragma unroll
    for (int r = 0; r < 16; ++r) { const int kc = 32 * kh + (r & 3) + 8 * (r >> 2) + 4 * hi; mk |= ((kc >= cs) && (kc < cs + 16)) ? (1u << r) : 0u; }
    return mk;
}
__device__ __forceinline__ void na_qs(const bf16x8 (&kf)[4], const bf16x8 (&vf)[2][2], const bf16x8 (&qf)[4], const LAS float* brow, int qc, int kh, int hi, unsigned vmsel,
                                      float& m_run, float& l_run, f32x16& o0, f32x16& o1) {
    const float SCL = 0.125f * LOG2E;
    f32x16 p;
#pragma unroll
    for (int r = 0; r < 16; ++r) p[r] = 0.f;
#pragma unroll
    for (int d0 = 0; d0 < 4; ++d0) p = __builtin_amdgcn_mfma_f32_32x32x16_bf16(kf[d0], qf[d0], p, 0, 0, 0);
    unsigned vm = vmsel; asm volatile("" : "+v"(vm));
    float mx = -1e30f;
#pragma unroll
    for (int r = 0; r < 16; ++r) { const int kc = 32 * kh + (r & 3) + 8 * (r >> 2) + 4 * hi;
        int bi = kc - qc + 15; bi = bi < 0 ? 0 : bi; bi = bi > 30 ? 30 : bi;
        const float sc = p[r] * SCL + brow[bi]; p[r] = ((vm >> r) & 1u) ? sc : -1e30f; mx = fmaxf(mx, p[r]); }
    mx = xor32_max(mx);
    const float m_new = fmaxf(m_run, mx), alpha = fexp2(m_run - m_new); m_run = m_new;
    const float m_use = fmaxf(m_new, -1e20f);
    float ls = 0.f;
#pragma unroll
    for (int r = 0; r < 16; ++r) { const float e = fexp2(p[r] - m_use); p[r] = e; ls += e; }
    l_run = l_run * alpha + ls;
#pragma unroll
    for (int r = 0; r < 16; ++r) { o0[r] *= alpha; o1[r] *= alpha; }
#pragma unroll
    for (int k2 = 0; k2 < 2; ++k2) {
        u32x4 pw; pw.x = cvt_pk_bf16(p[8 * k2 + 0], p[8 * k2 + 1]); pw.y = cvt_pk_bf16(p[8 * k2 + 2], p[8 * k2 + 3]); pw.z = cvt_pk_bf16(p[8 * k2 + 4], p[8 * k2 + 5]); pw.w = cvt_pk_bf16(p[8 * k2 + 6], p[8 * k2 + 7]);
        const bf16x8 pa = __builtin_bit_cast(bf16x8, pw);
        o0 = __builtin_amdgcn_mfma_f32_32x32x16_bf16(vf[0][k2], pa, o0, 0, 0, 0);
        o1 = __builtin_amdgcn_mfma_f32_32x32x16_bf16(vf[1][k2], pa, o1, 0, 0, 0);
    }
}
__device__ __forceinline__ void na_store(bf16_t* orow, const f32x16& o0, const f32x16& o1, float l_run) {
    const float l = xor32_sum(l_run); const float inv = 1.0f / l;
#pragma unroll
    for (int rg = 0; rg < 4; ++rg) {
        u32x2 w; w.x = cvt_pk_bf16(o0[4 * rg] * inv, o0[4 * rg + 1] * inv); w.y = cvt_pk_bf16(o0[4 * rg + 2] * inv, o0[4 * rg + 3] * inv); *(u32x2*)(orow + 8 * rg) = w;
        u32x2 w2; w2.x = cvt_pk_bf16(o1[4 * rg] * inv, o1[4 * rg + 1] * inv); w2.y = cvt_pk_bf16(o1[4 * rg + 2] * inv, o1[4 * rg + 3] * inv); *(u32x2*)(orow + 32 + 8 * rg) = w2;
    }
}
__device__ __forceinline__ void na_unit(const LAS float* biasT, const bf16_t* Z, const bf16_t* VTn, bf16_t* AO, int tokbase, int S, int rr, int tid) {
    const int lane = tid & 63, h = tid >> 6, r32 = lane & 31, hi = lane >> 5;
    const int rows = S / 64; int rs = rr - 4; rs = rs < 0 ? 0 : rs; rs = rs > rows - 8 ? rows - 8 : rs;
    bf16x8 qfa[4], qfb[4];
#pragma unroll
    for (int d0 = 0; d0 < 4; ++d0) { qfa[d0] = *(const bf16x8*)(Z + (size_t)(tokbase + rr * 64 + r32) * ZP + 672 + h * 64 + 16 * d0 + 8 * hi);
                                      qfb[d0] = *(const bf16x8*)(Z + (size_t)(tokbase + rr * 64 + 32 + r32) * ZP + 672 + h * 64 + 16 * d0 + 8 * hi); }
    f32x16 oa0, oa1, ob0, ob1; float ma = -1e30f, mb = -1e30f, la = 0.f, lb = 0.f;
#pragma unroll
    for (int r = 0; r < 16; ++r) { oa0[r] = 0.f; oa1[r] = 0.f; ob0[r] = 0.f; ob1[r] = 0.f; }
    const unsigned va0 = na_vmask(r32, 0, hi), va1 = na_vmask(r32, 1, hi), vb0 = na_vmask(32 + r32, 0, hi), vb1 = na_vmask(32 + r32, 1, hi);
    const bf16_t* kbase = Z + (size_t)(tokbase + rs * 64 + r32) * ZP + 672 + 512 + h * 64 + 8 * hi;
    const bf16_t* vbase0 = VTn + (size_t)(h * 64 + r32) * TH + tokbase + rs * 64 + 4 * hi;
#define NA_LOADK(KF, IT) do { const int kr_ = (IT) >> 1, kh_ = (IT) & 1; const bf16_t* kp_ = kbase + (size_t)(kr_ * 64 + kh_ * 32) * ZP; \
        _Pragma("unroll") for (int d0 = 0; d0 < 4; ++d0) KF[d0] = *(const bf16x8*)(kp_ + 16 * d0); } while (0)
#define NA_LOADV(VF, IT) do { const int kr_ = (IT) >> 1, kh_ = (IT) & 1; const bf16_t* vp0_ = vbase0 + kr_ * 64 + kh_ * 32; const bf16_t* vp1_ = vp0_ + (size_t)32 * TH; \
        _Pragma("unroll") for (int k2 = 0; k2 < 2; ++k2) { const u32x2 lo = *(const u32x2*)(vp0_ + 16 * k2), hi2 = *(const u32x2*)(vp0_ + 16 * k2 + 8); VF[0][k2] = __builtin_bit_cast(bf16x8, ((u32x4){lo.x, lo.y, hi2.x, hi2.y})); \
            const u32x2 lo1 = *(const u32x2*)(vp1_ + 16 * k2), hi3 = *(const u32x2*)(vp1_ + 16 * k2 + 8); VF[1][k2] = __builtin_bit_cast(bf16x8, ((u32x4){lo1.x, lo1.y, hi3.x, hi3.y})); } } while (0)
    bf16x8 kf[4];
    NA_LOADK(kf, 0);
#pragma unroll 1
    for (int it = 0; it < 16; ++it) {
        const int kr = it >> 1, kh = it & 1;
        const LAS float* brow = biasT + (h * 15 + (rs + kr - rr + 7)) * 31;
        bf16x8 vf[2][2], kn[4];
        NA_LOADV(vf, it);
        const int itn = it + 1 < 16 ? it + 1 : 15;
        NA_LOADK(kn, itn);
        na_qs(kf, vf, qfa, brow, r32, kh, hi, kh ? va1 : va0, ma, la, oa0, oa1);
        na_qs(kf, vf, qfb, brow, 32 + r32, kh, hi, kh ? vb1 : vb0, mb, lb, ob0, ob1);
#pragma unroll
        for (int d0 = 0; d0 < 4; ++d0) kf[d0] = kn[d0];
    }
#undef NA_LOADK
#undef NA_LOADV
    na_store(AO + (size_t)(tokbase + rr * 64 + r32) * 1024 + 512 + h * 64 + 4 * hi, oa0, oa1, la);
    na_store(AO + (size_t)(tokbase + rr * 64 + 32 + r32) * 1024 + 512 + h * 64 + 4 * hi, ob0, ob1, lb);
}
#ifndef REP_SYNC
#define REP_SYNC 1
#endif
#ifndef REP_MLA
#define REP_MLA 1
#endif
#ifndef REP_NA
#define REP_NA 1
#endif
#ifndef REP_SCAN
#define REP_SCAN 1
#endif
#ifndef REP_UP
#define REP_UP 1
#endif
#ifndef REP_PASS
#define REP_PASS 1
#endif
#ifndef REP_GEMM
#define REP_GEMM 1
#endif
#define GSYNC() do { for (int r_ = 0; r_ < REP_SYNC; ++r_) xcd_barrier((unsigned*)(ap0->ws + WS_BAR), bst); } while (0)
constexpr int LDS_BYTES = 147456;
constexpr int NTHR = 512;
struct Args { const float* in[26]; float* out; unsigned char* ws; };


#define XB_TMO      128
#define XB_XCNT(j)  (256  + 64 * (j))
#define XB_XSUB(j)  (1280 + 64 * (j))
#define XB_XGEN(j)  (2304 + 64 * (j))
#define XB_TOP      3328
#define XB_TOPGEN   3392
#define XCD_BAR_WORDS 3456
#define XB_SPIN_CAP (1u << 22)
__device__ __forceinline__ unsigned xb_ld(unsigned* p)              { return __hip_atomic_load(p, __ATOMIC_RELAXED, __HIP_MEMORY_SCOPE_AGENT); }
__device__ __forceinline__ unsigned xb_add(unsigned* p, unsigned v) { return __hip_atomic_fetch_add(p, v, __ATOMIC_RELAXED, __HIP_MEMORY_SCOPE_AGENT); }
__device__ __forceinline__ unsigned xb_xcc_id() { return (unsigned)__builtin_amdgcn_s_getreg((3 << 11) | 20) & 0xFu; }
#define XB_SPIN(cond, bar) do { unsigned _sp = 0; while (cond) { __builtin_amdgcn_s_sleep(1); \
    if ((++_sp & 255u) == 0u) { if (xb_ld(&(bar)[XB_TMO])) break; if (_sp > XB_SPIN_CAP) { atomicAdd(&(bar)[XB_TMO], 1u); break; } } } } while (0)
__device__ __forceinline__ void xcd_barrier_complete(unsigned* bar, unsigned x, unsigned& nloc, unsigned& nx) {
    const unsigned G = gridDim.x;
    unsigned sum, cnt, mine, sp = 0u;
    for (;;) {
        sum = 0u; cnt = 0u; mine = 0u;
#pragma unroll
        for (unsigned j = 0; j < 16; ++j) { const unsigned c = xb_ld(&bar[XB_XCNT(j)]); sum += c; cnt += (c > 0u) ? 1u : 0u; mine = (j == x) ? c : mine; }
        if (sum == G) break;
        __builtin_amdgcn_s_sleep(1);
        if ((++sp & 255u) == 0u) { if (xb_ld(&bar[XB_TMO])) break; if (sp > XB_SPIN_CAP) { atomicAdd(&bar[XB_TMO], 1u); break; } }
    }
    nloc = mine > 0u ? mine : 1u; nx = cnt > 0u ? cnt : 1u;
}
__device__ __forceinline__ void xcd_barrier(unsigned* bar, volatile LAS unsigned* st) {
    asm volatile("s_waitcnt vmcnt(0)" ::: "memory");
    __syncthreads();
    if (threadIdx.x == 0) {
        __builtin_amdgcn_s_waitcnt(0);
        const unsigned x = xb_xcc_id();
        unsigned nloc = st[0], nx = st[1];
        if (nloc == 0u) { xcd_barrier_complete(bar, x, nloc, nx); st[0] = nloc; st[1] = nx; }
        const unsigned old = xb_add(&bar[XB_XSUB(x)], 1u);
        const unsigned gen = old / nloc;
        if (old + 1u == (gen + 1u) * nloc) {
            __builtin_amdgcn_fence(__ATOMIC_RELEASE, "agent");
            asm volatile("s_waitcnt vmcnt(0)" ::: "memory");
            const unsigned og = xb_add(&bar[XB_TOP], 1u);
            const unsigned tg = og / nx;
            if (og + 1u == (tg + 1u) * nx) xb_add(&bar[XB_TOPGEN], 1u);
            else XB_SPIN(xb_ld(&bar[XB_TOPGEN]) == tg, bar);
            __builtin_amdgcn_fence(__ATOMIC_ACQUIRE, "agent");
            xb_add(&bar[XB_XGEN(x)], 1u);
            asm volatile("s_waitcnt vmcnt(0)" ::: "memory");
        } else {
            XB_SPIN(xb_ld(&bar[XB_XGEN(x)]) == gen, bar);
            __builtin_amdgcn_fence(__ATOMIC_ACQUIRE, "agent");
            asm volatile("s_waitcnt vmcnt(0)" ::: "memory");
        }
    }
    __syncthreads();
}

__device__ __forceinline__ void lru_ab(float ga, float gx, float gab, float gxb, float spl  , float xb, float& a, float& b) {
    const float r = sigmoidf_(ga + gab), ii = sigmoidf_(gx + gxb);
    const float la2 = (-8.0f * LOG2E) * r * spl;
    a = fexp2(la2);
    const float om = 1.0f - a * a;
    b = __builtin_amdgcn_sqrtf(om) * (ii * xb);
}

__global__ void __launch_bounds__(NTHR, 2) mk_fwd(Args a) {
    extern __shared__ __attribute__((aligned(16))) unsigned char lds_raw[];
    LAS unsigned char* lds = (LAS unsigned char*)lds_raw;
    cg::grid_group grid = cg::this_grid();
    volatile LAS unsigned* bst = (volatile LAS unsigned*)(lds + LDS_BYTES - 64);
    if (threadIdx.x == 0) { bst[0] = 0u; bst[1] = 0u; }
    typedef const __attribute__((address_space(4))) Args* ArgP;
    ArgP ap0 = (ArgP)__builtin_amdgcn_kernarg_segment_ptr();
#define PH_BEGIN ArgP ap = ap0; asm volatile("" : "+s"(ap)); unsigned char* ws = ap->ws; (void)ws; int tid_ = threadIdx.x; asm volatile("" : "+v"(tid_)); const int tid = tid_, lane = tid & 63, wave = tid >> 6; int G_ = gridDim.x, bid_ = blockIdx.x; asm volatile("" : "+s"(G_), "+s"(bid_)); const int G = G_, bid = bid_; const int gw = bid * 8 + wave, NGW = G * 8; const int gt = bid * NTHR + tid, NGT = G * NTHR; (void)lane; (void)gw; (void)NGW; (void)gt; (void)NGT;
#define IN(k) (ap->in[k])
#define rsq ((float*)(ws + WS_RSQ))
#define rskv ((float*)(ws + WS_RSKV))
#define rope ((float2*)(ws + WS_ROPE))
#define AGG ((float2*)(ws + WS_AGG))
#define CARRY ((float*)(ws + WS_CARRY))
#define YB ((bf16_t*)(ws + WS_YB))
#define W_INATT ((bf16_t*)(ws + WS_W_INATT))
#define W_UQ ((bf16_t*)(ws + WS_W_UQ))
#define W_UKV ((bf16_t*)(ws + WS_W_UKV))
#define W_OUTATT ((bf16_t*)(ws + WS_W_OUTATT))
#define W_INREC ((bf16_t*)(ws + WS_W_INREC))
#define W_GATES ((bf16_t*)(ws + WS_W_GATES))
#define W_OUTREC ((bf16_t*)(ws + WS_W_OUTREC))
#define W_UP ((bf16_t*)(ws + WS_W_UP))
#define W_DOWN ((bf16_t*)(ws + WS_W_DOWN))
#define XN ((bf16_t*)(ws + WS_XN))
#define Zb ((bf16_t*)(ws + WS_Z))
#define Qb ((bf16_t*)(ws + WS_Q))
#define KN ((bf16_t*)(ws + WS_KN))
#define VTM ((bf16_t*)(ws + WS_VTM))
#define VTN ((bf16_t*)(ws + WS_VTN))
#define KPE ((bf16_t*)(ws + WS_KPE))
#define ACT ((bf16_t*)(ws + WS_ACT))
#define GATE ((bf16_t*)(ws + WS_GATE))
#define XB ((bf16_t*)(ws + WS_XB))
#define XBR ((bf16_t*)(ws + WS_XBR))
#define GQ ((bf16_t*)(ws + WS_GQ))
#define AO XN
#define Fb XN
#define YR XN
#define M0 Zb
#define M1 XBR
#define XIN (IN(half))
#define XST (ap->out + (size_t)half * TH * DM)
    { PH_BEGIN
    {
        LAS float* scr = (LAS float*)(lds + wave * 16384);
        constexpr int I_INATT = 16 * 69, I_UQ = 6 * 24, I_UKV = 4 * 32, I_SQ = 16 * 32, I_INREC = 16 * 64, I_UP = 16 * 256, I_DOWN = 64 * 32, I_GATE = 32 * 8;
        constexpr int NITEMS = I_INATT + I_UQ + I_UKV + 2 * I_SQ + I_INREC + 2 * I_UP + 2 * I_DOWN + I_GATE;
        for (int rep_ = 0; rep_ < REP_PASS; ++rep_)
        for (int it = gw; it < NITEMS; it += NGW) {
            int r = it;
            if (r < I_INATT) { transpose_item(IN(6), 1024, 2208, W_INATT, 0, nullptr, scr, r, lane); continue; } r -= I_INATT;
            if (r < I_UQ) { transpose_item(IN(8), 384, 768, W_UQ, 0, IN(7), scr, r, lane); continue; } r -= I_UQ;
            if (r < I_UKV) { transpose_item(IN(10), 256, 1024, W_UKV, 0, IN(9), scr, r, lane); continue; } r -= I_UKV;
            if (r < I_SQ) { transpose_item(IN(12), 1024, 1024, W_OUTATT, 0, nullptr, scr, r, lane); continue; } r -= I_SQ;
            if (r < I_SQ) { transpose_item(IN(21), 1024, 1024, W_OUTREC, 0, nullptr, scr, r, lane); continue; } r -= I_SQ;
            if (r < I_INREC) { transpose_item(IN(13), 1024, 2048, W_INREC, 0, nullptr, scr, r, lane); continue; } r -= I_INREC;
            if (r < 2 * I_UP) { const int li = r / I_UP; transpose_item(IN(22) + (size_t)li * 1024 * 8192, 1024, 8192, W_UP + (size_t)li * 8192 * 1024, 0, nullptr, scr, r % I_UP, lane); continue; } r -= 2 * I_UP;
            if (r < 2 * I_DOWN) { const int li = r / I_DOWN; transpose_item(IN(25) + (size_t)li * 4096 * 1024, 4096, 1024, W_DOWN + (size_t)li * 1024 * 4096, 0, nullptr, scr, r % I_DOWN, lane); continue; } r -= 2 * I_DOWN;
            { const int mat = r / 8, sub = r % 8; const int type = mat >> 4, e = (mat >> 3) & 1, n = mat & 7;
              transpose_item(IN(type ? 18 : 16) + (size_t)(e * 8 + n) * 128 * 128, 128, 128, W_GATES, n * 512 + (type * 2 + e) * 128, nullptr, scr, sub, lane); }
        }
        if (bid == 0) for (int i = tid; i < XCD_BAR_WORDS; i += NTHR) ((unsigned*)(ws + WS_BAR))[i] = 0u;
        for (int i = gt; i < 8 * 64 * 64; i += NGT) ((unsigned*)(ws + WS_CNT))[i] = 0u;
        for (int i = gt; i < 96 * 1024 / 8; i += NGT) ((u32x4*)(W_INATT + (size_t)2208 * 1024))[i] = (u32x4){0, 0, 0, 0};
        for (int m = gw; m < TH; m += NGW) xn_row(IN(0) + (size_t)m * DM, IN(2), XN + (size_t)m * DM, lane);
        for (int i = gt; i < 4096 * 16; i += NGT) { const int pos = i >> 4, j = i & 15;
            const double inv = exp2(-(double)j * (13.287712379549449 / 16.0));
            const double rev = (double)pos * inv * 0.15915494309189535; const float fr = (float)(rev - floor(rev));
            rope[i] = make_float2(__builtin_amdgcn_cosf(fr), __builtin_amdgcn_sinf(fr)); }
    }

    }
    grid.sync();
    if (threadIdx.x == 0) (void)xb_add((unsigned*)(ap0->ws + WS_BAR) + XB_XCNT(xb_xcc_id()), 1u);
    for (int half = 0; half < 2; ++half) {
        const int S = half ? 4096 : 2048, nseq = TH / S;
        if (half == 1 && gridDim.x != 256) {
                { PH_BEGIN
        for (int m = gw; m < TH; m += NGW) xn_row(XIN + (size_t)m * DM, IN(2), XN + (size_t)m * DM, lane);
        }
        GSYNC();
        }
        { PH_BEGIN
        { pg8::Gemm g = pg8::make_gemm(XN, DM, W_INATT, DM, DM); pg8::StaticOrder so; so.init(TH / 256, ZP / 256, G, bid);
          EpiZ E{Zb, VTN, (float*)(ws + WS_SQP), nullptr, KPE, rope, S - 1};
#ifndef NO_G1
for (int rep_ = 0; rep_ < REP_GEMM; ++rep_) pg8::gemm_phase<EpiZ>(lds, g, so, E);
#endif
 }
        }
        GSYNC();
        { PH_BEGIN
        { pg8::Gemm g = pg8::make_gemm(Zb, ZP, W_UQ, 384, 384); pg8::StaticOrder so; so.init(TH / 256, 3, G, bid);
          EpiQ E{Qb, (const float*)(ws + WS_SQP), rope, S - 1};
#ifndef NO_G2
for (int rep_ = 0; rep_ < REP_GEMM; ++rep_) pg8::gemm_phase<EpiQ>(lds, g, so, E);
#endif
 }
        { pg8::Gemm g = pg8::make_gemm(Zb + 384, ZP, W_UKV, 256, 256); pg8::StaticOrder so; so.init(TH / 256, 4, G, bid);
          EpiKV E{KN, VTM, (const float*)(ws + WS_SQP)};
#ifndef NO_G3
for (int rep_ = 0; rep_ < REP_GEMM; ++rep_) pg8::gemm_phase<EpiKV>(lds, g, so, E);
#endif
 }
        }
        GSYNC();
        { PH_BEGIN
        {
            LAS float* biasT = (LAS float*)(lds + 98304);
            for (int i = tid; i < 8 * 15 * 31; i += NTHR) biasT[i] = IN(11)[i] * LOG2E;
            __syncthreads();
            const int nqb = S / 512, nunits = nseq * 8 * nqb;
            const int vb = (G % 8 == 0) ? (bid % 8) * (G / 8) + bid / 8 : bid;
#ifdef DELAY_P4A
        { const unsigned long long t0_ = __builtin_amdgcn_s_memrealtime(); while (__builtin_amdgcn_s_memrealtime() - t0_ < 40000ull) __builtin_amdgcn_s_sleep(32); }
#endif
#ifndef NO_MLA
            for (int rep_ = 0; rep_ < REP_MLA; ++rep_) {
#ifdef REP_MLA_SYNC
            if (rep_ > 0) GSYNC();
#endif
#ifdef REP_DELAY
            if (rep_ > 0) { const unsigned long long t0_ = __builtin_amdgcn_s_memrealtime(); while (__builtin_amdgcn_s_memrealtime() - t0_ < 40000ull) __builtin_amdgcn_s_sleep(32); continue; }
#endif
            for (int u = vb; u < nunits; u += G) { const int qb = u % nqb, h = (u / nqb) & 7, s = u / (nqb * 8);
                mla_unit<0>(lds, Qb, KN, KPE, VTM, AO, s * S, S, h, qb, tid); }
            }
#endif
#ifdef MLA_TWICE
            for (int u = vb; u < nunits; u += G) { const int qb = u % nqb, h = (u / nqb) & 7, s = u / (nqb * 8);
                mla_unit<MLA_TWICE>(lds, Qb, KN, KPE, VTM, AO, s * S, S, h, qb, tid); }
#endif
            const int rows = S / 64, nna = nseq * rows;
#ifdef DELAY_P4B
        { const unsigned long long t0_ = __builtin_amdgcn_s_memrealtime(); while (__builtin_amdgcn_s_memrealtime() - t0_ < 40000ull) __builtin_amdgcn_s_sleep(32); }
#endif
#ifdef RELOAD_BIAS
            __syncthreads();
            for (int i = tid; i < 8 * 15 * 31; i += NTHR) biasT[i] = IN(11)[i] * LOG2E;
            __syncthreads();
#endif
#ifndef NO_NA
            for (int rep_ = 0; rep_ < REP_NA; ++rep_)
            for (int u = vb; u < nna; u += G) na_unit(biasT, Zb, VTN, AO, (u / rows) * S, S, u % rows, tid);
#endif
        }
        }
        GSYNC();
        { PH_BEGIN
        { pg8::Gemm g = pg8::make_gemm(AO, DM, W_OUTATT, DM, DM); pg8::StaticOrder so; so.init(TH / 256, 4, G, bid);
          EpiBf16 E{M0, DM, 0, 0};
#ifndef NO_G4
for (int rep_ = 0; rep_ < REP_GEMM; ++rep_) pg8::gemm_phase<EpiBf16>(lds, g, so, E);
#endif
 }
        }
        GSYNC();
        { PH_BEGIN
        for (int m = gw; m < TH; m += NGW) res_row(M0 + (size_t)m * DM, XIN + (size_t)m * DM, XST + (size_t)m * DM, IN(3), IN(4), XN + (size_t)m * DM, lane);
        }
        GSYNC();

        for (int li = 0; li < 2; ++li) {
            if (li == 1) {
                { PH_BEGIN
                { pg8::Gemm g = pg8::make_gemm(XN, DM, W_INREC, DM, DM); pg8::StaticOrder so; so.init(TH / 256, 8, G, bid);
                  EpiBf16 E{GATE, DM, 1024, (size_t)(WS_XBR - WS_GATE) / 2};
#ifndef NO_G5
for (int rep_ = 0; rep_ < REP_GEMM; ++rep_) pg8::gemm_phase<EpiBf16>(lds, g, so, E);
#endif
 }
                }
                GSYNC();
                { PH_BEGIN
                for (int rep_ = 0; rep_ < REP_PASS; ++rep_)
                for (int i = gt; i < TH * 128; i += NGT) { const int t = i >> 7, c8 = (i & 127) * 8; const int pos = t & (S - 1);
                    float accv[8];
#pragma unroll
                    for (int j = 0; j < 8; ++j) accv[j] = IN(15)[c8 + j];
#pragma unroll
                    for (int k = 0; k < 4; ++k) { const int p2 = pos + k - 1; if (p2 < 0 || p2 >= S) continue;
                        const u32x4 w = *(const u32x4*)(XBR + (size_t)(t + k - 1) * DM + c8); const float* cwk = IN(14) + k * 1024 + c8;
                        accv[0] += cwk[0] * bflo(w.x); accv[1] += cwk[1] * bfhi(w.x); accv[2] += cwk[2] * bflo(w.y); accv[3] += cwk[3] * bfhi(w.y);
                        accv[4] += cwk[4] * bflo(w.z); accv[5] += cwk[5] * bfhi(w.z); accv[6] += cwk[6] * bflo(w.w); accv[7] += cwk[7] * bfhi(w.w); }
                    u32x4 o; o.x = cvt_pk_bf16(accv[0], accv[1]); o.y = cvt_pk_bf16(accv[2], accv[3]); o.z = cvt_pk_bf16(accv[4], accv[5]); o.w = cvt_pk_bf16(accv[6], accv[7]);
                    *(u32x4*)(XB + (size_t)t * DM + c8) = o; }
                }
                GSYNC();
                for (int qt = 0; qt < 2; ++qt) {
                    const int t0 = qt * TQ;
                    { PH_BEGIN
                    { pg8::Gemm g = pg8::make_gemm(XB + (size_t)t0 * DM, DM, W_GATES, 128, 128); g.a_pn_shift = 1; g.a_pn_step = 256;
                      pg8::StaticOrder so; so.init(TQ / 256, 16, G, bid);
                      EpiBf16 E{GQ, 4096, 0, 0};
#ifndef NO_G6
for (int rep_ = 0; rep_ < REP_GEMM; ++rep_) pg8::gemm_phase<EpiBf16>(lds, g, so, E);
#endif
 }
                    }
                    GSYNC();
                    { PH_BEGIN
                    for (int rep_ = 0; rep_ < REP_SCAN; ++rep_)
                    for (int i = gt; i < 256 * 2 * 512; i += NGT) { const int cp = i & 511, e = (i >> 9) & 1, c = i >> 10; const int ch = 2 * cp, n = ch >> 7, d = ch & 127;
                        const float2 gab = *(const float2*)(IN(17) + e * 1024 + ch), gxb = *(const float2*)(IN(19) + e * 1024 + ch), lam = *(const float2*)(IN(20) + e * 1024 + ch);
                        const float spl0 = log1pf(expf(-lam.x)), spl1 = log1pf(expf(-lam.y));
                        float A0 = 1.f, B0 = 0.f, A1 = 1.f, B1 = 0.f;
                        const bf16_t* gq0 = GQ + (size_t)(c * 32) * 4096 + n * 512 + e * 128 + d; const bf16_t* xb0 = XB + (size_t)(t0 + c * 32) * DM + ch;
#pragma unroll 16
                        for (int s = 0; s < 32; ++s) { const int tl = e ? 31 - s : s;
                            const unsigned ga2 = *(const unsigned*)(gq0 + (size_t)tl * 4096), gx2 = *(const unsigned*)(gq0 + (size_t)tl * 4096 + 256), xb2 = *(const unsigned*)(xb0 + (size_t)tl * DM);
                            float av, bv; lru_ab(bflo(ga2), bflo(gx2), gab.x, gxb.x, spl0, bflo(xb2), av, bv); A0 *= av; B0 = av * B0 + bv;
                            lru_ab(bfhi(ga2), bfhi(gx2), gab.y, gxb.y, spl1, bfhi(xb2), av, bv); A1 *= av; B1 = av * B1 + bv; }
                        *(f32x4*)(AGG + (size_t)(c * 2 + e) * 1024 + ch) = (f32x4){A0, B0, A1, B1}; }
                    }
                    GSYNC();
                    { PH_BEGIN
                    { const int cps = S / 32, nsq = TQ / S;
                      for (int rep_ = 0; rep_ < REP_SCAN; ++rep_)
                      for (int i = gt; i < nsq * 2 * 1024; i += NGT) { const int ch = i & 1023, e = (i >> 10) & 1, sq = i >> 11;
                          float hcar = 0.f;
#pragma unroll 16
                          for (int k = 0; k < cps; ++k) { const int c = sq * cps + (e ? cps - 1 - k : k); const int idx = (c * 2 + e) * 1024 + ch;
                              CARRY[idx] = hcar; const float2 ab = AGG[idx]; hcar = ab.x * hcar + ab.y; } } }
                    }
                    GSYNC();
                    { PH_BEGIN
#ifndef NO_R6
                    for (int rep_ = 0; rep_ < REP_SCAN; ++rep_)
                    for (int i = gt; i < 256 * 512; i += NGT) { const int cp = i & 511, c = i >> 9; const int ch = 2 * cp, n = ch >> 7, d = ch & 127;
                        const float2 lam0 = *(const float2*)(IN(20) + ch), lam1 = *(const float2*)(IN(20) + 1024 + ch);
                        const float2 gab0 = *(const float2*)(IN(17) + ch), gab1 = *(const float2*)(IN(17) + 1024 + ch), gxb0 = *(const float2*)(IN(19) + ch), gxb1 = *(const float2*)(IN(19) + 1024 + ch);
                        const bf16_t* gq0 = GQ + (size_t)(c * 32) * 4096 + n * 512 + d; const bf16_t* xb0 = XB + (size_t)(t0 + c * 32) * DM + ch;
                        bf16_t* yr0 = YR + (size_t)(t0 + c * 32) * DM + ch; const bf16_t* gt0 = GATE + (size_t)(t0 + c * 32) * DM + ch;
                        unsigned hfw[32];
                        { const float spl0 = log1pf(expf(-lam0.x)), spl1 = log1pf(expf(-lam0.y));
                          const float2 hc2 = *(const float2*)(CARRY + (size_t)(c * 2 + 0) * 1024 + ch); float h0 = hc2.x, h1 = hc2.y;
#pragma unroll
                          for (int s = 0; s < 32; ++s) {
                            const unsigned ga2 = *(const unsigned*)(gq0 + (size_t)s * 4096), gx2 = *(const unsigned*)(gq0 + (size_t)s * 4096 + 256), xb2 = *(const unsigned*)(xb0 + (size_t)s * DM);
                            float av, bv; lru_ab(bflo(ga2), bflo(gx2), gab0.x, gxb0.x, spl0, bflo(xb2), av, bv); h0 = av * h0 + bv;
                            lru_ab(bfhi(ga2), bfhi(gx2), gab0.y, gxb0.y, spl1, bfhi(xb2), av, bv); h1 = av * h1 + bv;
                            hfw[s] = cvt_pk_bf16(h0, h1); } }
                        { const float spl0 = log1pf(expf(-lam1.x)), spl1 = log1pf(expf(-lam1.y));
                          const float2 hc2 = *(const float2*)(CARRY + (size_t)(c * 2 + 1) * 1024 + ch); float h0 = hc2.x, h1 = hc2.y;
#pragma unroll
                          for (int s = 31; s >= 0; --s) {
                            const unsigned ga2 = *(const unsigned*)(gq0 + (size_t)s * 4096 + 128), gx2 = *(const unsigned*)(gq0 + (size_t)s * 4096 + 384), xb2 = *(const unsigned*)(xb0 + (size_t)s * DM);
                            float av, bv; lru_ab(bflo(ga2), bflo(gx2), gab1.x, gxb1.x, spl0, bflo(xb2), av, bv); h0 = av * h0 + bv;
                            lru_ab(bfhi(ga2), bfhi(gx2), gab1.y, gxb1.y, spl1, bfhi(xb2), av, bv); h1 = av * h1 + bv;
                            const unsigned g2 = *(const unsigned*)(gt0 + (size_t)s * DM), f2 = hfw[s];
                            *(unsigned*)(yr0 + (size_t)s * DM) = cvt_pk_bf16((bflo(f2) + h0) * gelu_tanh(bflo(g2)), (bfhi(f2) + h1) * gelu_tanh(bfhi(g2))); } }
                    }
#endif
                    }
                    GSYNC();
                }
                { PH_BEGIN
                { pg8::Gemm g = pg8::make_gemm(YR, DM, W_OUTREC, DM, DM); pg8::StaticOrder so; so.init(TH / 256, 4, G, bid);
                  EpiBf16 E{M1, DM, 0, 0};
#ifndef NO_G7
for (int rep_ = 0; rep_ < REP_GEMM; ++rep_) pg8::gemm_phase<EpiBf16>(lds, g, so, E);
#endif
 }
                }
                GSYNC();
                { PH_BEGIN
                for (int m = gw; m < TH; m += NGW) res_row(M1 + (size_t)m * DM, XST + (size_t)m * DM, XST + (size_t)m * DM, IN(3) + 1024, IN(4) + 1024, XN + (size_t)m * DM, lane);
                }
                GSYNC();
            }
            { PH_BEGIN
            { pg8::Gemm g = pg8::make_gemm(XN, DM, W_UP + (size_t)li * 8192 * 1024, DM, DM);
              g.a_seg = 1; g.hA = (size_t)64 * DM * 2; g.tB = (size_t)128 * DM * 2; g.hB = (size_t)4096 * DM * 2;
              pg8::StaticOrder so; so.init(TH / 256, 32, G, bid);
#ifndef NO_UP
              EpiUp E{ACT, YB, IN(23) + (size_t)li * 3 * 8192, IN(24) + (size_t)li * 8192}; for (int rep_ = 0; rep_ < REP_UP; ++rep_) pg8::gemm_phase<EpiUp>(lds, g, so, E);
#endif
 }
            }
            GSYNC();
            { PH_BEGIN
            for (int rep_ = 0; rep_ < REP_PASS; ++rep_)
            for (int b = bid; b < 256; b += G) { const int seg = b >> 1, which = b & 1; const int t = seg * 128 + (which ? 127 : 0); const int pos = t & (S - 1);
                const float* cw = IN(23) + (size_t)li * 3 * 8192; const float* cb = IN(24) + (size_t)li * 8192;
                const bool hasp = which ? true : (pos != 0), hasn = which ? (pos != S - 1) : true;
                const bf16_t* yp = which ? YB + ((size_t)seg * 4 + 2) * 8192 : YB + ((size_t)(seg - 1) * 4 + 3) * 8192;
                const bf16_t* yc = YB + ((size_t)seg * 4 + (which ? 3 : 0)) * 8192;
                const bf16_t* yn = which ? YB + ((size_t)(seg + 1) * 4 + 0) * 8192 : YB + ((size_t)seg * 4 + 1) * 8192;
                for (int c = tid; c < 4096; c += NTHR) {
                    float u2[2];
#pragma unroll
                    for (int bj = 0; bj < 2; ++bj) { const int ch = bj * 4096 + c;
                        float r = cw[8192 + ch] * bf2f(yc[ch]) + cb[ch];
                        if (hasp) r += cw[ch] * bf2f(yp[ch]);
                        if (hasn) r += cw[2 * 8192 + ch] * bf2f(yn[ch]);
                        u2[bj] = r; }
                    ACT[(size_t)t * DFF + c] = f2bf(gelu_tanh(u2[0]) * u2[1]); } }
            }
            GSYNC();
            if (gridDim.x == 256) {
                { PH_BEGIN
                { pg8::Gemm g = pg8::make_gemm(ACT, DFF, W_DOWN + (size_t)li * 1024 * 4096, DFF, DFF); pg8::StaticOrder so; so.init(TH / 256, 4, G, bid);
                  const int use = half * 2 + li;
                  EpiRms E{XST, li == 0 ? XN : nullptr, IN(5) + li * 1024, IN(2) + 1024, (float*)(ws + WS_XBUF), (float*)(ws + WS_XBUF) + (size_t)TH * 4,
                           (unsigned*)(ws + WS_CNT) + (size_t)(use * 2) * 4096, (unsigned*)(ws + WS_CNT) + (size_t)(use * 2 + 1) * 4096};
                  pg8::gemm_phase<EpiRms>(lds, g, so, E); }
                if (half == 0 && li == 1)
                  { for (int m = gw; m < TH; m += NGW) xn_row(IN(1) + (size_t)m * DM, IN(2), XN + (size_t)m * DM, lane);
                  }
                }
                GSYNC();
            } else {
                { PH_BEGIN
                { pg8::Gemm g = pg8::make_gemm(ACT, DFF, W_DOWN + (size_t)li * 1024 * 4096, DFF, DFF); pg8::StaticOrder so; so.init(TH / 256, 4, G, bid);
                  EpiBf16 E{Fb, DM, 0, 0};
                  pg8::gemm_phase<EpiBf16>(lds, g, so, E); }
                }
                GSYNC();
                { PH_BEGIN
                for (int m = gw; m < TH; m += NGW) res_row(Fb + (size_t)m * DM, XST + (size_t)m * DM, XST + (size_t)m * DM, IN(5) + li * 1024, li == 0 ? IN(2) + 1024 : nullptr, XN + (size_t)m * DM, lane);
                }
                GSYNC();
            }
        }
    }
}

extern "C" void kernel_launch(void* const* d_in, const int* in_sizes, int n_in, void* d_out, int out_size, void* d_ws, size_t ws_size, hipStream_t stream) {
    static int grid = 0;
    if (grid == 0) {
        int dev = 0, cus = 0, per_cu = 0;
        (void)hipGetDevice(&dev);
        (void)hipDeviceGetAttribute(&cus, hipDeviceAttributeMultiprocessorCount, dev);
        (void)hipFuncSetAttribute((const void*)mk_fwd, hipFuncAttributeMaxDynamicSharedMemorySize, LDS_BYTES);
        (void)hipOccupancyMaxActiveBlocksPerMultiprocessor(&per_cu, (const void*)mk_fwd, NTHR, LDS_BYTES);
        if (per_cu < 1) per_cu = 1;
        grid = cus * per_cu;
        if (ws_size < WS_END || n_in != 26) { fprintf(stderr, "kernel_launch: unexpected ws_size %zu / n_in %d\n", ws_size, n_in); }
    }
    Args a{};
    for (int i = 0; i < 26; ++i) a.in[i] = (const float*)d_in[i];
    a.out = (float*)d_out; a.ws = (unsigned char*)d_ws;
    void* args[] = {&a};
    hipError_t e = hipLaunchCooperativeKernel((const void*)mk_fwd, dim3(grid), dim3(NTHR), args, LDS_BYTES, stream);
    if (e != hipSuccess) fprintf(stderr, "cooperative launch failed: %s (grid %d)\n", hipGetErrorString(e), grid);
}
```

```cpp
#include <hip/hip_runtime.h>
#include <hip/hip_cooperative_groups.h>
#include <cstdio>
#include <cstdint>
namespace cg = cooperative_groups;

#define LAS __attribute__((address_space(3)))
typedef unsigned short bf16_t;
typedef short bf16x8 __attribute__((ext_vector_type(8)));
typedef short s16x4 __attribute__((ext_vector_type(4)));
typedef float f32x4 __attribute__((ext_vector_type(4)));
typedef float f32x16 __attribute__((ext_vector_type(16)));
typedef unsigned u32x4 __attribute__((ext_vector_type(4)));
typedef unsigned u32x2 __attribute__((ext_vector_type(2)));

__device__ __forceinline__ unsigned cvt_pk_bf16(float lo, float hi) { unsigned r; asm volatile("v_cvt_pk_bf16_f32 %0, %1, %2" : "=v"(r) : "v"(lo), "v"(hi)); return r; }
__device__ __forceinline__ float bf2f(bf16_t v) { return __uint_as_float(((unsigned)v) << 16); }
__device__ __forceinline__ float bflo(unsigned w) { return __uint_as_float(w << 16); }
__device__ __forceinline__ float bfhi(unsigned w) { return __uint_as_float(w & 0xffff0000u); }
__device__ __forceinline__ bf16_t f2bf(float f) { return (bf16_t)(cvt_pk_bf16(f, 0.f) & 0xffffu); }
__device__ __forceinline__ float fexp2(float x) { return __builtin_amdgcn_exp2f(x); }
__device__ __forceinline__ float frcp(float x) { return __builtin_amdgcn_rcpf(x); }
__device__ __forceinline__ float gelu_tanh(float x) {
    const float u = x * (1.0f + 0.044715f * x * x) * (-2.0f * 0.7978845608028654f * 1.4426950408889634f);
    return x * frcp(1.0f + fexp2(u));
}
__device__ __forceinline__ float sigmoidf_(float x) { return frcp(1.0f + fexp2(-1.4426950408889634f * x)); }
__device__ __forceinline__ float bperm_f(int src_lane, float v) { return __int_as_float(__builtin_amdgcn_ds_bpermute(src_lane << 2, __float_as_int(v))); }
__device__ __forceinline__ float wave_sum(float v, int l  ) {
#pragma unroll
    for (int o = 1; o < 64; o <<= 1) v += bperm_f(l ^ o, v);
    return v;
}
__device__ __forceinline__ float xor32_max(float v) { auto rr = __builtin_amdgcn_permlane32_swap(__float_as_uint(v), __float_as_uint(v), false, false); return fmaxf(__uint_as_float(rr[0]), __uint_as_float(rr[1])); }
__device__ __forceinline__ float xor32_sum(float v) { auto rr = __builtin_amdgcn_permlane32_swap(__float_as_uint(v), __float_as_uint(v), false, false); return __uint_as_float(rr[0]) + __uint_as_float(rr[1]); }

namespace pg8 {
constexpr int BM = 256, BK = 64, HALF = 128, HTB = HALF * BK * 2, STAGE_BYTES = 8 * HTB, NXCD = 8, WGM = 8;
__host__ __device__ __forceinline__ int lds_byte(int r, int c) { const int st = (r >> 4) * 2 + (c >> 5), rr = r & 15, cc = c & 31, ob = rr * 64 + cc * 2; return st * 1024 + (ob ^ (((ob >> 9) & 1) << 5)); }
__host__ __device__ __forceinline__ void stage_rc(int b, int& R, int& C) { const int st = b / 1024, sb = b % 1024, swz = sb ^ (((sb >> 9) & 1) << 5); R = (st >> 1) * 16 + swz / 64; C = (st & 1) * 32 + (swz % 64) / 2; }
__host__ __device__ __forceinline__ int perm32(int rho) { const int n = rho >> 4, i = rho & 15; return 8 * (i >> 2) + 4 * n + (i & 3); }

struct Unit { int pm, pn; };
struct Gemm { const bf16_t* A; const bf16_t* Bt; int lda, ldb, K; size_t tA, hA, tB, hB; int a_seg; int a_pn_shift; size_t a_pn_step; };
__device__ __forceinline__ Gemm make_gemm(const bf16_t* A, int lda, const bf16_t* Bt, int ldb, int K) {
    Gemm g; g.A = A; g.Bt = Bt; g.lda = lda; g.ldb = ldb; g.K = K; g.tA = (size_t)256 * lda * 2; g.hA = (size_t)128 * lda * 2; g.tB = (size_t)256 * ldb * 2; g.hB = (size_t)128 * ldb * 2;
    g.a_seg = 0; g.a_pn_shift = 0; g.a_pn_step = 0; return g;
}

struct StaticOrder {
    int nM, nN, nwg, G, c;
    __device__ __forceinline__ void init(int nM_, int nN_, int G_, int c_) { nM = nM_; nN = nN_; nwg = nM * nN; G = G_; c = c_; }
    __device__ __forceinline__ bool next(int i, Unit& u) const {
        const long L = (long)i * G + c; if (L >= nwg) return false;
        int wgid = (int)L; { const int q = nwg / NXCD, r = nwg % NXCD, xcd = wgid % NXCD, off = wgid / NXCD; wgid = (xcd < r ? xcd * (q + 1) : r * (q + 1) + (xcd - r) * q) + off; }
        const int nig = WGM * nN, gid = wgid / nig, fm = gid * WGM, gsz = (nM - fm) < WGM ? (nM - fm) : WGM;
        u.pm = fm + ((wgid % nig) % gsz); u.pn = (wgid % nig) / gsz; return true;
    }
};

template <class Epi>
__device__ __forceinline__ void gemm_phase(LAS unsigned char* lds, const Gemm g, const StaticOrder& S, const Epi& E) {
    constexpr bool SP2 = true, ALIGN_EPI = true;
    int tid_ = threadIdx.x; asm volatile("" : "+v"(tid_));
    const int tid = tid_, wid = __builtin_amdgcn_readfirstlane(tid >> 6), lane = tid & 63, wr = wid >> 2, wc = wid & 3, fr = lane & 15, fq = lane >> 4;
    int K_ = g.K; asm volatile("" : "+s"(K_)); const int K = K_, nt = K / BK;
    unsigned voffA[2], voffB[2];
#pragma unroll
    for (int i = 0; i < 2; ++i) { int R, C; stage_rc(tid * 16 + i * 8192, R, C); const int Rb = Epi::PERM ? ((R & ~31) + perm32(R & 31)) : R;
        const int Ra = g.a_seg ? (128 * (R >> 6) + 8 * (R & 15) + ((R >> 4) & 3)) : R;
        voffA[i] = (unsigned)(Ra * g.lda + C) * 2u; voffB[i] = (unsigned)(Rb * g.ldb + C) * 2u; }
    const size_t kstep = (size_t)(BK * 2);
    const size_t hstepA = g.hA, hstepB = g.hB;
    const unsigned ldsw = (unsigned)wid * 1024u;
    const int aoff = lds_byte(wr * 64 + fr, fq * 8), boff = lds_byte(wc * 32 + fr, fq * 8);
#define PG8_SA(b, h) (((b) * 2 + (h)) * HTB)
#define PG8_SB(b, h) ((4 + (b) * 2 + (h)) * HTB)
#define PG8_STAGE(bufoff, gbase, voff) do { _Pragma("unroll") for (int _i = 0; _i < 2; ++_i) \
        __builtin_amdgcn_global_load_lds((const unsigned*)((const char*)(gbase) + (voff)[_i]), (LAS unsigned*)(lds + (bufoff) + ldsw + _i * 8192), 16, 0, 0); } while (0)
#define PG8_LDA(dst, b, h) do { _Pragma("unroll") for (int m = 0; m < 4; ++m) _Pragma("unroll") for (int k = 0; k < 2; ++k) dst[m][k] = *(const LAS bf16x8*)(lds + PG8_SA(b, h) + aoff + m * 2048 + k * 1024); } while (0)
#define PG8_LDB(dst, b, h) do { _Pragma("unroll") for (int n = 0; n < 2; ++n) _Pragma("unroll") for (int k = 0; k < 2; ++k) dst[n][k] = *(const LAS bf16x8*)(lds + PG8_SB(b, h) + boff + n * 2048 + k * 1024); } while (0)
#define PG8_MMA(ai, bj, At, Bt) do { __builtin_amdgcn_s_setprio(1); _Pragma("unroll") for (int m = 0; m < 4; ++m) _Pragma("unroll") for (int n = 0; n < 2; ++n) _Pragma("unroll") for (int k = 0; k < 2; ++k) \
        acc[ai][bj][m][n] = __builtin_amdgcn_mfma_f32_16x16x32_bf16(Bt[n][k], At[m][k], acc[ai][bj][m][n], 0, 0, 0); __builtin_amdgcn_s_setprio(0); } while (0)
#define PG8_WAIT_V(n) asm volatile("s_waitcnt vmcnt(" #n ")" ::: "memory")
#define PG8_WAIT_L(n) asm volatile("s_waitcnt lgkmcnt(" #n ")" ::: "memory")
#define PG8_BAR __builtin_amdgcn_s_barrier()
#define PG8_SCHED __builtin_amdgcn_sched_barrier(0)
#define PG8_APTR(u) ((const char*)g.A + (size_t)(u).pm * g.tA + (size_t)((u).pn >> g.a_pn_shift) * g.a_pn_step)
#define PG8_BPTR(u) ((const char*)g.Bt + (size_t)(u).pn * g.tB)
    Unit cur, nxt; int ui = 0;
    if (!S.next(0, cur)) return;
    f32x4 acc[2][2][4][2];
#pragma unroll
    for (int a = 0; a < 2; ++a)
#pragma unroll
        for (int b = 0; b < 2; ++b)
#pragma unroll
            for (int m = 0; m < 4; ++m)
#pragma unroll
                for (int n = 0; n < 2; ++n) acc[a][b][m][n] = (f32x4){0.f, 0.f, 0.f, 0.f};
    bf16x8 At[4][2], B0[2][2], B1[2][2];
    const char* cA = PG8_APTR(cur); const char* cB = PG8_BPTR(cur);
    {
        PG8_STAGE(PG8_SB(0, 0), cB, voffB); PG8_STAGE(PG8_SB(0, 1), cB + hstepB, voffB); PG8_STAGE(PG8_SA(0, 0), cA, voffA); PG8_STAGE(PG8_SA(0, 1), cA + hstepA, voffA);
        if (wr == 1) PG8_BAR;
        PG8_WAIT_V(2); PG8_BAR;
        PG8_STAGE(PG8_SB(1, 0), cB + kstep, voffB); PG8_STAGE(PG8_SA(1, 0), cA + kstep, voffA); PG8_STAGE(PG8_SB(1, 1), cB + hstepB + kstep, voffB);
        PG8_WAIT_V(6); PG8_BAR;
    }
    for (;;) {
        const bool has_next = S.next(ui + 1, nxt);
        const char* nA = has_next ? PG8_APTR(nxt) : cA; const char* nB = has_next ? PG8_BPTR(nxt) : cB;
        for (int t = 0; t < nt; t += 2) {
            const bool last = (t == nt - 2);
            const char* a1 = cA + (size_t)(t + 1) * kstep;
            const char* a2 = last ? nA : cA + (size_t)(t + 2) * kstep; const char* b2 = last ? nB : cB + (size_t)(t + 2) * kstep;
            const char* a3 = a2 + kstep; const char* b3 = b2 + kstep;
            PG8_LDB(B0, 0, 0); PG8_LDB(B1, 0, 1); PG8_SCHED; PG8_LDA(At, 0, 0); PG8_STAGE(PG8_SA(1, 1), a1 + hstepA, voffA);
            PG8_WAIT_V(8); PG8_WAIT_L(0); PG8_BAR; PG8_MMA(0, 0, At, B0); PG8_MMA(0, 1, At, B1); PG8_BAR; PG8_SCHED;
            PG8_LDA(At, 0, 1); PG8_STAGE(PG8_SB(0, 0), b2, voffB); PG8_STAGE(PG8_SB(0, 1), b2 + hstepB, voffB); PG8_STAGE(PG8_SA(0, 0), a2, voffA);
            PG8_WAIT_V(8); PG8_WAIT_L(0); PG8_BAR; PG8_MMA(1, 0, At, B0); PG8_MMA(1, 1, At, B1); PG8_BAR; PG8_SCHED;
            PG8_LDB(B0, 1, 0); PG8_LDB(B1, 1, 1); PG8_SCHED; PG8_LDA(At, 1, 0); PG8_STAGE(PG8_SA(0, 1), a2 + hstepA, voffA);
            PG8_WAIT_V(8); PG8_WAIT_L(0); PG8_BAR; PG8_MMA(0, 0, At, B0); PG8_MMA(0, 1, At, B1); PG8_BAR; PG8_SCHED;
            PG8_LDA(At, 1, 1); PG8_STAGE(PG8_SB(1, 0), b3, voffB); PG8_STAGE(PG8_SB(1, 1), b3 + hstepB, voffB); PG8_STAGE(PG8_SA(1, 0), a3, voffA);
            PG8_WAIT_V(8); PG8_WAIT_L(0); PG8_BAR; PG8_MMA(1, 0, At, B0); PG8_MMA(1, 1, At, B1); PG8_BAR; PG8_SCHED;
        }
        if constexpr (ALIGN_EPI) { if (wr == 0) PG8_BAR; }
        if constexpr (!Epi::AFTER_DRAIN) E(acc, cur, wr, wc, fr, fq);
        if (!has_next) break;
#pragma unroll
        for (int a = 0; a < 2; ++a)
#pragma unroll
            for (int b = 0; b < 2; ++b)
#pragma unroll
                for (int m = 0; m < 4; ++m)
#pragma unroll
                    for (int n = 0; n < 2; ++n) acc[a][b][m][n] = (f32x4){0.f, 0.f, 0.f, 0.f};
        cur = nxt; cA = nA; cB = nB; ++ui;
        if constexpr (ALIGN_EPI) { if (wr == 1) PG8_BAR; }
    }
    PG8_WAIT_V(0);
    if constexpr (!ALIGN_EPI) { if (wr == 0) PG8_BAR; }
    PG8_BAR;
    if constexpr (Epi::AFTER_DRAIN) E.fused(acc, cur, wr, wc, fr, fq, lds, wid, lane);
#undef PG8_SA
#undef PG8_SB
#undef PG8_STAGE
#undef PG8_LDA
#undef PG8_LDB
#undef PG8_MMA
#undef PG8_WAIT_V
#undef PG8_WAIT_L
#undef PG8_BAR
#undef PG8_SCHED
#undef PG8_APTR
#undef PG8_BPTR
}
}
constexpr int TH = 16384;
constexpr int DM = 1024, ZP = 2304, DFF = 4096, TQ = 8192;
constexpr size_t MiB = 1u << 20;
constexpr size_t WS_RSQ = 0, WS_RSKV = 64 * 1024, WS_ROPE = 128 * 1024;
constexpr size_t WS_AGG = 5 * MiB;
constexpr size_t WS_CARRY = 9 * MiB;
constexpr size_t WS_XBUF = 1 * MiB;
constexpr size_t WS_SQP = 1 * MiB + 512 * 1024;
constexpr size_t WS_CNT = 3 * MiB;
constexpr size_t WS_BAR = 4 * MiB;
constexpr size_t WS_YB = 5 * MiB;
constexpr size_t WS_W_INATT = 13 * MiB;
constexpr size_t WS_W_UQ = WS_W_INATT + (size_t)2304 * 1024 * 2;
constexpr size_t WS_W_UKV = WS_W_UQ + (size_t)768 * 384 * 2;
constexpr size_t WS_W_OUTATT = WS_W_UKV + (size_t)1024 * 256 * 2;
constexpr size_t WS_W_INREC = WS_W_OUTATT + 2 * MiB;
constexpr size_t WS_W_GATES = WS_W_INREC + 4 * MiB;
constexpr size_t WS_W_OUTREC = WS_W_GATES + 1 * MiB;
constexpr size_t WS_W_UP = WS_W_OUTREC + 2 * MiB;
constexpr size_t WS_W_DOWN = WS_W_UP + 32 * MiB;
constexpr size_t WS_W_END = WS_W_DOWN + 16 * MiB;
static_assert(WS_W_END <= 76 * MiB, "weights");
constexpr size_t WS_XN = 76 * MiB;
constexpr size_t WS_BIG = 108 * MiB;
constexpr size_t WS_Z = WS_BIG;
constexpr size_t WS_Q = WS_Z + 72 * MiB;
constexpr size_t WS_KN = WS_Q + 24 * MiB;
constexpr size_t WS_VTM = WS_KN + 16 * MiB;
constexpr size_t WS_VTN = WS_VTM + 16 * MiB;
constexpr size_t WS_KPE = WS_VTN + 16 * MiB;
static_assert(WS_KPE + 1 * MiB <= 256 * MiB, "L0 overlay");
constexpr size_t WS_ACT = WS_BIG;
constexpr size_t WS_GATE = WS_BIG;
constexpr size_t WS_XB = WS_BIG + 32 * MiB;
constexpr size_t WS_XBR = WS_BIG + 64 * MiB;
constexpr size_t WS_GQ = WS_XBR;
constexpr size_t WS_END = 256 * MiB;

using pg8::Unit;

struct EpiBf16 {
    static constexpr bool PERM = true, AFTER_DRAIN = false;
    bf16_t* O; int ldc; int split_cols; size_t split_stride;
    __device__ __forceinline__ void operator()(f32x4 (&acc)[2][2][4][2], const Unit& u, int wr, int wc, int fr, int fq) const {
        const int row0 = u.pm * 256 + wr * 64 + fr; int colt = u.pn * 256; bf16_t* base = O;
        if (split_cols) { const int t = colt / split_cols; base += (size_t)t * split_stride; colt -= t * split_cols; }
        const int col0 = colt + wc * 32 + 8 * fq;
#pragma unroll
        for (int ai = 0; ai < 2; ++ai)
#pragma unroll
            for (int m = 0; m < 4; ++m) { bf16_t* rowp = base + (size_t)(row0 + ai * 128 + m * 16) * ldc + col0;
#pragma unroll
                for (int bj = 0; bj < 2; ++bj) { const f32x4 v0 = acc[ai][bj][m][0], v1 = acc[ai][bj][m][1];
                    u32x4 w; w.x = cvt_pk_bf16(v0[0], v0[1]); w.y = cvt_pk_bf16(v0[2], v0[3]); w.z = cvt_pk_bf16(v1[0], v1[1]); w.w = cvt_pk_bf16(v1[2], v1[3]);
                    *(u32x4*)(rowp + bj * 128) = w; } }
    }
};

struct EpiZ {
    static constexpr bool PERM = true, AFTER_DRAIN = false;
    bf16_t* Z; bf16_t* VTn; float* SQ; float* SKV; bf16_t* KPE; const float2* rope; int smask;
    __device__ __forceinline__ void operator()(f32x4 (&acc)[2][2][4][2], const Unit& u, int wr, int wc, int fr, int fq) const {
        const int lane = fq * 16 + fr;
        const int row0 = u.pm * 256 + wr * 64 + fr; const int col0 = u.pn * 256 + wc * 32 + 8 * fq;
#pragma unroll
        for (int ai = 0; ai < 2; ++ai)
#pragma unroll
            for (int m = 0; m < 4; ++m) { const int row = row0 + ai * 128 + m * 16; bf16_t* rowp = Z + (size_t)row * ZP + col0;
#pragma unroll
                for (int bj = 0; bj < 2; ++bj) { const f32x4 v0 = acc[ai][bj][m][0], v1 = acc[ai][bj][m][1];
                    u32x4 w; w.x = cvt_pk_bf16(v0[0], v0[1]); w.y = cvt_pk_bf16(v0[2], v0[3]); w.z = cvt_pk_bf16(v1[0], v1[1]); w.w = cvt_pk_bf16(v1[2], v1[3]);
                    *(u32x4*)(rowp + bj * 128) = w;
                    const int c = col0 + bj * 128; const int g32 = (u.pn * 256 + bj * 128 + wc * 32) >> 5;
                    if (g32 < 20) {
                        float s = (v0[0] * v0[0] + v0[1] * v0[1]) + (v0[2] * v0[2] + v0[3] * v0[3]) + ((v1[0] * v1[0] + v1[1] * v1[1]) + (v1[2] * v1[2] + v1[3] * v1[3]));
                        s += bperm_f(lane ^ 16, s); s += bperm_f(lane ^ 32, s);
                        if (fq == 0) SQ[(size_t)row * 20 + g32] = s;
                    } else if (g32 == 20) {
                        const float2* rp = rope + (size_t)(row & smask) * 16 + 8 * (fq & 1);
                        float o[8];
#pragma unroll
                        for (int k = 0; k < 8; ++k) { const float mine = k < 4 ? v0[k] : v1[k - 4]; const float other = bperm_f(lane ^ 32, mine); const float2 cs = rp[k];
                            o[k] = fq < 2 ? mine * cs.x - other * cs.y : mine * cs.x + other * cs.y; }
                        u32x4 wk; wk.x = cvt_pk_bf16(o[0], o[1]); wk.y = cvt_pk_bf16(o[2], o[3]); wk.z = cvt_pk_bf16(o[4], o[5]); wk.w = cvt_pk_bf16(o[6], o[7]);
                        *(u32x4*)(KPE + (size_t)row * 32 + 8 * fq) = wk;
                    }
                    if (c >= 1696 && c < 2208) { bf16_t* vt = VTn + (size_t)(c - 1696) * TH + row;
                        vt[0] = (bf16_t)(w.x & 0xffffu); vt[TH] = (bf16_t)(w.x >> 16); vt[2 * TH] = (bf16_t)(w.y & 0xffffu); vt[3 * TH] = (bf16_t)(w.y >> 16);
                        vt[4 * TH] = (bf16_t)(w.z & 0xffffu); vt[5 * TH] = (bf16_t)(w.z >> 16); vt[6 * TH] = (bf16_t)(w.w & 0xffffu); vt[7 * TH] = (bf16_t)(w.w >> 16); } } }
    }
};

struct EpiQ {
    static constexpr bool PERM = false, AFTER_DRAIN = false;
    bf16_t* Q; const float* rsq; const float2* rope; int smask;
    __device__ __forceinline__ void operator()(f32x4 (&acc)[2][2][4][2], const Unit& u, int wr, int wc, int fr, int fq) const {
        const float SC = 0.10206207261596577f * 1.4426950408889634f;
        const int row0 = u.pm * 256 + wr * 64 + fr;
#pragma unroll
        for (int ai = 0; ai < 2; ++ai)
#pragma unroll
            for (int m = 0; m < 4; ++m) { const int row = row0 + ai * 128 + m * 16; float ssq = 0.f;
#pragma unroll
                for (int k = 0; k < 12; ++k) ssq += rsq[(size_t)row * 20 + k];
                const float rs = SC / sqrtf(ssq * (1.f / 384.f) + 1e-6f); const int pos = row & smask;
#pragma unroll
                for (int bj = 0; bj < 2; ++bj) { const int cg = u.pn * 256 + bj * 128 + wc * 32;
                    f32x4 v0 = acc[ai][bj][m][0] * rs, v1 = acc[ai][bj][m][1] * rs;
                    if ((cg % 96) == 64) {
                        const float2* rp = rope + (size_t)pos * 16 + 4 * fq;
#pragma unroll
                        for (int i = 0; i < 4; ++i) { const float2 cs = rp[i]; const float x1 = v0[i], x2 = v1[i]; v0[i] = x1 * cs.x - x2 * cs.y; v1[i] = x2 * cs.x + x1 * cs.y; }
                    }
                    bf16_t* p = Q + (size_t)row * 768 + cg + 4 * fq;
                    u32x2 w0; w0.x = cvt_pk_bf16(v0[0], v0[1]); w0.y = cvt_pk_bf16(v0[2], v0[3]); *(u32x2*)p = w0;
                    u32x2 w1; w1.x = cvt_pk_bf16(v1[0], v1[1]); w1.y = cvt_pk_bf16(v1[2], v1[3]); *(u32x2*)(p + 16) = w1; } }
    }
};

struct EpiKV {
    static constexpr bool PERM = true, AFTER_DRAIN = false;
    bf16_t* KN; bf16_t* VTm; const float* rskv;
    __device__ __forceinline__ void operator()(f32x4 (&acc)[2][2][4][2], const Unit& u, int wr, int wc, int fr, int fq) const {
        const int row0 = u.pm * 256 + wr * 64 + fr;
#pragma unroll
        for (int ai = 0; ai < 2; ++ai)
#pragma unroll
            for (int m = 0; m < 4; ++m) { const int row = row0 + ai * 128 + m * 16; float ssq = 0.f;
#pragma unroll
                for (int k = 12; k < 20; ++k) ssq += rskv[(size_t)row * 20 + k];
                const float rs = 1.0f / sqrtf(ssq * (1.f / 256.f) + 1e-6f);
#pragma unroll
                for (int bj = 0; bj < 2; ++bj) { const int c = u.pn * 256 + bj * 128 + wc * 32 + 8 * fq;
                    const f32x4 v0 = acc[ai][bj][m][0] * rs, v1 = acc[ai][bj][m][1] * rs;
                    u32x4 w; w.x = cvt_pk_bf16(v0[0], v0[1]); w.y = cvt_pk_bf16(v0[2], v0[3]); w.z = cvt_pk_bf16(v1[0], v1[1]); w.w = cvt_pk_bf16(v1[2], v1[3]);
                    const int h = c >> 7, j = c & 127;
                    if (j < 64) { *(u32x4*)(KN + (size_t)row * 512 + h * 64 + j) = w; }
                    else { bf16_t* vt = VTm + (size_t)(h * 64 + j - 64) * TH + row;
                        vt[0] = (bf16_t)(w.x & 0xffffu); vt[TH] = (bf16_t)(w.x >> 16); vt[2 * TH] = (bf16_t)(w.y & 0xffffu); vt[3 * TH] = (bf16_t)(w.y >> 16);
                        vt[4 * TH] = (bf16_t)(w.z & 0xffffu); vt[5 * TH] = (bf16_t)(w.z >> 16); vt[6 * TH] = (bf16_t)(w.w & 0xffffu); vt[7 * TH] = (bf16_t)(w.w >> 16); } } }
    }
};

struct EpiUp {
    static constexpr bool PERM = true, AFTER_DRAIN = false;
    bf16_t* ACT; bf16_t* YB; const float* cw; const float* cb;
    __device__ __forceinline__ void operator()(f32x4 (&acc)[2][2][4][2], const Unit& u, int wr, int wc, int fr_, int fq_) const {
        int fr = fr_, fq = fq_; asm volatile("" : "+v"(fr), "+v"(fq));
        const int lane = fq * 16 + fr;
        const int tok0 = u.pm * 256 + wr * 128 + 8 * fr;
        const int ch0 = u.pn * 128 + wc * 32 + 8 * fq;
        const int seg = u.pm * 2 + wr;
        if (fr == 0 || fr == 15) {
#pragma unroll
            for (int k = 0; k < 2; ++k) {
                const int slot = fr == 0 ? k : 2 + k;
                bf16_t* yb = YB + ((size_t)seg * 4 + slot) * 8192 + ch0;
#pragma unroll
                for (int bj = 0; bj < 2; ++bj) { const f32x4 v0 = fr == 0 ? acc[0][bj][k][0] : acc[1][bj][2 + k][0], v1 = fr == 0 ? acc[0][bj][k][1] : acc[1][bj][2 + k][1];
                    u32x4 w; w.x = cvt_pk_bf16(v0[0], v0[1]); w.y = cvt_pk_bf16(v0[2], v0[3]); w.z = cvt_pk_bf16(v1[0], v1[1]); w.w = cvt_pk_bf16(v1[2], v1[3]);
                    *(u32x4*)(yb + bj * 4096) = w; }
            }
        }
        const int src_up = (lane & ~15) | ((fr - 1) & 15), src_dn = (lane & ~15) | ((fr + 1) & 15);
#pragma unroll
        for (int n = 0; n < 2; ++n)
#pragma unroll
            for (int i = 0; i < 4; ++i) {
                float ug[8], uv[8];
#pragma unroll
                for (int bj = 0; bj < 2; ++bj) {
                    const int ch = bj * 4096 + ch0 + 4 * n + i;
                    const float w0 = cw[ch], w1 = cw[8192 + ch], w2 = cw[2 * 8192 + ch], b = cb[ch];
                    const float prev7 = bperm_f(src_up, acc[1][bj][3][n][i]);
                    const float next0 = bperm_f(src_dn, acc[0][bj][0][n][i]);
#pragma unroll
                    for (int q = 0; q < 8; ++q) {
                        const float v = acc[q >> 2][bj][q & 3][n][i];
                        const float up = q > 0 ? acc[(q - 1) >> 2][bj][(q - 1) & 3][n][i] : prev7;
                        const float dn = q < 7 ? acc[(q + 1) >> 2][bj][(q + 1) & 3][n][i] : next0;
                        const float r = w0 * up + w1 * v + w2 * dn + b;
                        if (bj == 0) ug[q] = r; else uv[q] = r;
                    }
                }
#pragma unroll
                for (int q = 0; q < 8; ++q) acc[q >> 2][0][q & 3][n][i] = gelu_tanh(ug[q]) * uv[q];
            }
#pragma unroll
        for (int ai = 0; ai < 2; ++ai)
#pragma unroll
            for (int m = 0; m < 4; ++m) { const f32x4 v0 = acc[ai][0][m][0], v1 = acc[ai][0][m][1];
                u32x4 w; w.x = cvt_pk_bf16(v0[0], v0[1]); w.y = cvt_pk_bf16(v0[2], v0[3]); w.z = cvt_pk_bf16(v1[0], v1[1]); w.w = cvt_pk_bf16(v1[2], v1[3]);
                *(u32x4*)(ACT + (size_t)(tok0 + 4 * ai + m) * DFF + ch0) = w; }
    }
};

struct EpiRms {
    static constexpr bool PERM = false, AFTER_DRAIN = true;
    float* x; bf16_t* xn; const float* gpost; const float* gnext; float* xbuf1; float* xbuf2; unsigned* cnt1; unsigned* cnt2;
    __device__ __forceinline__ void operator()(f32x4 (&)[2][2][4][2], const Unit&, int, int, int, int) const {}
    __device__ __forceinline__ void stats(const f32x4 (&v)[2][2][4][2], const Unit& u, int wr, int wc, int fr, int fq, LAS unsigned char* lds, int wid, int lane, float* xbuf, unsigned* cnt) const {
        LAS float* P = (LAS float*)lds; LAS float* Sx = (LAS float*)(lds + 4096);
#pragma unroll
        for (int ai = 0; ai < 2; ++ai)
#pragma unroll
            for (int m = 0; m < 4; ++m) { float s = 0.f;
#pragma unroll
                for (int bj = 0; bj < 2; ++bj)
#pragma unroll
                    for (int n = 0; n < 2; ++n) { const f32x4 t = v[ai][bj][m][n]; s += (t[0] * t[0] + t[1] * t[1]) + (t[2] * t[2] + t[3] * t[3]); }
                s += bperm_f(lane ^ 16, s); s += bperm_f(lane ^ 32, s);
                if (fq == 0) P[(ai * 128 + wr * 64 + m * 16 + fr) * 4 + wc] = s; }
        asm volatile("s_waitcnt lgkmcnt(0)" ::: "memory"); __builtin_amdgcn_s_barrier(); asm volatile("" ::: "memory");
        const int row = wid * 32 + (lane & 31);
        if (lane < 32) { const float t = (P[row * 4 + 0] + P[row * 4 + 1]) + (P[row * 4 + 2] + P[row * 4 + 3]);
            __hip_atomic_store(xbuf + (size_t)(u.pm * 256 + row) * 4 + u.pn, t, __ATOMIC_RELAXED, __HIP_MEMORY_SCOPE_AGENT); }
        asm volatile("s_waitcnt vmcnt(0)" ::: "memory");
        if (lane == 0) __hip_atomic_fetch_add(cnt + 64 * u.pm, 1u, __ATOMIC_RELAXED, __HIP_MEMORY_SCOPE_AGENT);
        if (wid == 0) { unsigned sp = 0;
            while ((unsigned)__builtin_amdgcn_readfirstlane(__hip_atomic_load(cnt + 64 * u.pm, __ATOMIC_RELAXED, __HIP_MEMORY_SCOPE_AGENT)) < 32u) { __builtin_amdgcn_s_sleep(2); if (++sp > (1u << 22)) break; }
            __builtin_amdgcn_fence(__ATOMIC_ACQUIRE, "agent"); }
        asm volatile("s_waitcnt vmcnt(0) lgkmcnt(0)" ::: "memory"); __builtin_amdgcn_s_barrier(); asm volatile("" ::: "memory");
        if (lane < 32) { const float* slot = xbuf + (size_t)(u.pm * 256 + row) * 4; float t = 0.f;
#pragma unroll
            for (int k = 0; k < 4; ++k) t += __hip_atomic_load(slot + k, __ATOMIC_RELAXED, __HIP_MEMORY_SCOPE_AGENT);
            Sx[row] = 1.0f / sqrtf(t * (1.f / 1024.f) + 1e-6f); }
        asm volatile("s_waitcnt lgkmcnt(0)" ::: "memory"); __builtin_amdgcn_s_barrier(); asm volatile("" ::: "memory");
    }
    __device__ __forceinline__ void fused(f32x4 (&acc)[2][2][4][2], const Unit& u, int wr, int wc, int fr, int fq, LAS unsigned char* lds, int wid, int lane) const {
        const LAS float* Sx = (const LAS float*)(lds + 4096);
        const int col0 = u.pn * 256 + wc * 32 + 4 * fq;
        stats(acc, u, wr, wc, fr, fq, lds, wid, lane, xbuf1, cnt1);
#pragma unroll
        for (int ai = 0; ai < 2; ++ai)
#pragma unroll
            for (int m = 0; m < 4; ++m) { const int r = ai * 128 + wr * 64 + m * 16 + fr; const float rs = Sx[r]; float* xr = x + (size_t)(u.pm * 256 + r) * DM + col0;
#pragma unroll
                for (int bj = 0; bj < 2; ++bj)
#pragma unroll
                    for (int n = 0; n < 2; ++n) { const f32x4 g = *(const f32x4*)(gpost + col0 + bj * 128 + n * 16); const f32x4 bs = *(const f32x4*)(xr + bj * 128 + n * 16);
                        const f32x4 o = bs + acc[ai][bj][m][n] * rs * g; acc[ai][bj][m][n] = o; *(f32x4*)(xr + bj * 128 + n * 16) = o; }
                if (m & 1) asm volatile("" ::: "memory"); }
        if (xn) {
            stats(acc, u, wr, wc, fr, fq, lds, wid, lane, xbuf2, cnt2);
#pragma unroll
            for (int ai = 0; ai < 2; ++ai)
#pragma unroll
                for (int m = 0; m < 4; ++m) { const int r = ai * 128 + wr * 64 + m * 16 + fr; const float rs = Sx[r]; bf16_t* xr = xn + (size_t)(u.pm * 256 + r) * DM + col0;
#pragma unroll
                    for (int bj = 0; bj < 2; ++bj)
#pragma unroll
                        for (int n = 0; n < 2; ++n) { const f32x4 g = *(const f32x4*)(gnext + col0 + bj * 128 + n * 16); const f32x4 o = acc[ai][bj][m][n] * rs * g;
                            u32x2 w; w.x = cvt_pk_bf16(o[0], o[1]); w.y = cvt_pk_bf16(o[2], o[3]); *(u32x2*)(xr + bj * 128 + n * 16) = w; } }
        }
    }
};
constexpr float EPS = 1e-6f;
constexpr float LOG2E = 1.4426950408889634f;

__device__ __forceinline__ void transpose_item(const float* W, int K, int N, bf16_t* WT, int row_off, const float* kscale, LAS float* scr, int item, int lane) {
    const int nblk = N / 32, kb = item / nblk, nb = item % nblk, k0 = 64 * kb, n0 = 32 * nb;
#pragma unroll 8
    for (int i = 0; i < 32; ++i) { const int kk = 2 * i + (lane >> 5); float v = W[(size_t)(k0 + kk) * N + n0 + (lane & 31)]; if (kscale) v *= kscale[k0 + kk]; scr[kk * 33 + (lane & 31)] = v; }
    asm volatile("s_waitcnt lgkmcnt(0)" ::: "memory");
    const int c = lane & 7;
#pragma unroll
    for (int j = 0; j < 4; ++j) { const int n = (lane >> 3) + 8 * j; const LAS float* s = scr + (8 * c) * 33 + n;
        u32x4 o; o.x = cvt_pk_bf16(s[0 * 33], s[1 * 33]); o.y = cvt_pk_bf16(s[2 * 33], s[3 * 33]); o.z = cvt_pk_bf16(s[4 * 33], s[5 * 33]); o.w = cvt_pk_bf16(s[6 * 33], s[7 * 33]);
        *(u32x4*)(WT + (size_t)(row_off + n0 + n) * K + k0 + 8 * c) = o; }
    asm volatile("s_waitcnt lgkmcnt(0)" ::: "memory");
}

__device__ __forceinline__ void xn_row(const float* xrow, const float* gain, bf16_t* orow, int lane) {
    const f32x4* xr = (const f32x4*)xrow + lane; const f32x4* gr = (const f32x4*)gain + lane;
    f32x4 v[4]; float s = 0.f;
#pragma unroll
    for (int j = 0; j < 4; ++j) { v[j] = xr[64 * j]; s += (v[j].x * v[j].x + v[j].y * v[j].y) + (v[j].z * v[j].z + v[j].w * v[j].w); }
    const float rs = 1.0f / sqrtf(wave_sum(s, lane) * (1.f / DM) + EPS);
    u32x2* o8 = (u32x2*)orow + lane;
#pragma unroll
    for (int j = 0; j < 4; ++j) { const f32x4 g = gr[64 * j]; u32x2 w; w.x = cvt_pk_bf16(v[j].x * rs * g.x, v[j].y * rs * g.y); w.y = cvt_pk_bf16(v[j].z * rs * g.z, v[j].w * rs * g.w); o8[64 * j] = w; }
}

__device__ __forceinline__ void res_row(const bf16_t* mrow, const float* xi, float* xo, const float* gpost, const float* gnext, bf16_t* xnrow, int lane) {
    const u32x2* mr = (const u32x2*)mrow + lane; const f32x4* xr = (const f32x4*)xi + lane; const f32x4* gp = (const f32x4*)gpost + lane;
    f32x4 mv[4]; float s = 0.f;
#pragma unroll
    for (int j = 0; j < 4; ++j) { const u32x2 w = mr[64 * j]; mv[j] = (f32x4){bflo(w.x), bfhi(w.x), bflo(w.y), bfhi(w.y)}; s += (mv[j].x * mv[j].x + mv[j].y * mv[j].y) + (mv[j].z * mv[j].z + mv[j].w * mv[j].w); }
    const float rs = 1.0f / sqrtf(wave_sum(s, lane) * (1.f / DM) + EPS);
    f32x4 x[4]; float s2 = 0.f;
#pragma unroll
    for (int j = 0; j < 4; ++j) { const f32x4 g = gp[64 * j]; x[j] = xr[64 * j] + mv[j] * rs * g; s2 += (x[j].x * x[j].x + x[j].y * x[j].y) + (x[j].z * x[j].z + x[j].w * x[j].w); }
    f32x4* xw = (f32x4*)xo + lane;
#pragma unroll
    for (int j = 0; j < 4; ++j) xw[64 * j] = x[j];
    if (gnext) {
        const float rs2 = 1.0f / sqrtf(wave_sum(s2, lane) * (1.f / DM) + EPS);
        const f32x4* gn = (const f32x4*)gnext + lane; u32x2* o8 = (u32x2*)xnrow + lane;
#pragma unroll
        for (int j = 0; j < 4; ++j) { const f32x4 g = gn[64 * j]; u32x2 w; w.x = cvt_pk_bf16(x[j].x * rs2 * g.x, x[j].y * rs2 * g.y); w.y = cvt_pk_bf16(x[j].z * rs2 * g.z, x[j].w * rs2 * g.w); o8[64 * j] = w; }
    }
}

#define MLA_PACK(P, B) ((u32x4){cvt_pk_bf16(P[B], P[B + 1]), cvt_pk_bf16(P[B + 2], P[B + 3]), cvt_pk_bf16(P[B + 4], P[B + 5]), cvt_pk_bf16(P[B + 6], P[B + 7])})
__device__ __forceinline__ void mla_softmax(f32x16& p0, f32x16& p1, float& m_run, float& l_run, f32x16& o0, f32x16& o1) {
    float mx = fmaxf(p0[0], p1[0]);
#pragma unroll
    for (int r = 1; r < 16; ++r) mx = fmaxf(mx, fmaxf(p0[r], p1[r]));
    mx = xor32_max(mx);
    const float m_new = fmaxf(m_run, mx), alpha = fexp2(m_run - m_new); m_run = m_new;
    p0 = p0 - m_new; p1 = p1 - m_new;
#pragma unroll
    for (int r = 0; r < 16; ++r) { p0[r] = fexp2(p0[r]); p1[r] = fexp2(p1[r]); }
    const f32x16 ps = p0 + p1;
    const float ls = ((ps[0] + ps[1]) + (ps[2] + ps[3])) + ((ps[4] + ps[5]) + (ps[6] + ps[7])) + (((ps[8] + ps[9]) + (ps[10] + ps[11])) + ((ps[12] + ps[13]) + (ps[14] + ps[15])));
    l_run = l_run * alpha + ls;
    o0 = o0 * alpha; o1 = o1 * alpha;
}
__device__ __forceinline__ void mla_store(bf16_t* orow, const f32x16& o0, const f32x16& o1, float l_run) {
    const float inv = 1.0f / xor32_sum(l_run);
#pragma unroll
    for (int rg = 0; rg < 4; ++rg) {
        u32x2 w; w.x = cvt_pk_bf16(o0[4 * rg] * inv, o0[4 * rg + 1] * inv); w.y = cvt_pk_bf16(o0[4 * rg + 2] * inv, o0[4 * rg + 3] * inv); *(u32x2*)(orow + 8 * rg) = w;
        u32x2 w2; w2.x = cvt_pk_bf16(o1[4 * rg] * inv, o1[4 * rg + 1] * inv); w2.y = cvt_pk_bf16(o1[4 * rg + 2] * inv, o1[4 * rg + 3] * inv); *(u32x2*)(orow + 32 + 8 * rg) = w2;
    }
}
__device__ __forceinline__ void mla_unit(LAS unsigned char* lds, const bf16_t* Q, const bf16_t* KN, const bf16_t* KPE, const bf16_t* VT, bf16_t* AO, int tokbase, int S, int h, int qb, int tid) {
    constexpr int KBYTES = 12288, BUF = 20480;
    const int lane = tid & 63, wid = __builtin_amdgcn_readfirstlane(tid >> 6), r32 = lane & 31, hi = lane >> 5;
    const bf16_t* ks0 = KN + (size_t)(tokbase + lane) * 512 + h * 64 + 8 * wid;
    const bf16_t* ks1 = KPE + (size_t)(tokbase + lane) * 32 + 8 * (wid & 3);
    const bf16_t* vs = VT + (size_t)(h * 64 + lane) * TH + tokbase + 8 * wid;
#define MLA_DMA(T, B) do { LAS unsigned char* sb_ = lds + (B) * BUF; \
        __builtin_amdgcn_global_load_lds((const unsigned*)(ks0 + (size_t)(T) * (64 * 512)), (LAS unsigned*)(sb_ + wid * 1024), 16, 0, 0); \
        if (wid < 4) __builtin_amdgcn_global_load_lds((const unsigned*)(ks1 + (size_t)(T) * (64 * 32)), (LAS unsigned*)(sb_ + (8 + wid) * 1024), 16, 0, 0); \
        __builtin_amdgcn_global_load_lds((const unsigned*)(vs + (size_t)(T) * 64), (LAS unsigned*)(sb_ + KBYTES + wid * 1024), 16, 0, 0); } while (0)
#define MLA_WAITBAR_KEEP() do { if (wid < 4) asm volatile("s_waitcnt vmcnt(3)" ::: "memory"); else asm volatile("s_waitcnt vmcnt(2)" ::: "memory"); \
        asm volatile("s_waitcnt lgkmcnt(0)" ::: "memory"); __builtin_amdgcn_s_barrier(); asm volatile("" ::: "memory"); } while (0)
#define MLA_WAITBAR_ALL() do { asm volatile("s_waitcnt vmcnt(0) lgkmcnt(0)" ::: "memory"); __builtin_amdgcn_s_barrier(); asm volatile("" ::: "memory"); } while (0)
    const int NT = S / 64;
    const int qtokA = tokbase + 512 * qb + 64 * wid + r32, qtokB = qtokA + 32;
    bf16x8 qa[6], qbv[6];
#pragma unroll
    for (int d0 = 0; d0 < 6; ++d0) { qa[d0] = *(const bf16x8*)(Q + (size_t)qtokA * 768 + h * 96 + 16 * d0 + 8 * hi); qbv[d0] = *(const bf16x8*)(Q + (size_t)qtokB * 768 + h * 96 + 16 * d0 + 8 * hi); }
    asm volatile("s_waitcnt vmcnt(0)" ::: "memory");
    MLA_DMA(0, 0); MLA_DMA(1, 1);
    MLA_WAITBAR_ALL();
    f32x16 oa0, oa1, ob0, ob1;
#pragma unroll
    for (int r = 0; r < 16; ++r) { oa0[r] = 0.f; oa1[r] = 0.f; ob0[r] = 0.f; ob1[r] = 0.f; }
    float ma = -1e30f, la = 0.f, mb = -1e30f, lb = 0.f;
    for (int t = 0; t < NT; ++t) {
        if (t + 2 < NT) MLA_DMA(t + 2, (t + 2) & 3);
        const LAS unsigned char* kb = lds + (t & 3) * BUF; const LAS unsigned char* vb = kb + KBYTES;
        f32x16 pa0, pa1, pb0, pb1;
#pragma unroll
        for (int r = 0; r < 16; ++r) { pa0[r] = 0.f; pa1[r] = 0.f; pb0[r] = 0.f; pb1[r] = 0.f; }
#pragma unroll
        for (int d0 = 0; d0 < 6; ++d0) {
            const bf16x8 a0 = *(const LAS bf16x8*)(kb + (2 * d0 + hi) * 1024 + r32 * 16);
            const bf16x8 a1 = *(const LAS bf16x8*)(kb + (2 * d0 + hi) * 1024 + (32 + r32) * 16);
            pa0 = __builtin_amdgcn_mfma_f32_32x32x16_bf16(a0, qa[d0], pa0, 0, 0, 0);
            pa1 = __builtin_amdgcn_mfma_f32_32x32x16_bf16(a1, qa[d0], pa1, 0, 0, 0);
            pb0 = __builtin_amdgcn_mfma_f32_32x32x16_bf16(a0, qbv[d0], pb0, 0, 0, 0);
            pb1 = __builtin_amdgcn_mfma_f32_32x32x16_bf16(a1, qbv[d0], pb1, 0, 0, 0);
        }
        mla_softmax(pa0, pa1, ma, la, oa0, oa1);
        mla_softmax(pb0, pb1, mb, lb, ob0, ob1);
#pragma unroll
        for (int ks = 0; ks < 4; ++ks) {
            const u32x4 pwa = ks == 0 ? MLA_PACK(pa0, 0) : ks == 1 ? MLA_PACK(pa0, 8) : ks == 2 ? MLA_PACK(pa1, 0) : MLA_PACK(pa1, 8);
            const u32x4 pwb = ks == 0 ? MLA_PACK(pb0, 0) : ks == 1 ? MLA_PACK(pb0, 8) : ks == 2 ? MLA_PACK(pb1, 0) : MLA_PACK(pb1, 8);
            const bf16x8 paa = __builtin_bit_cast(bf16x8, pwa), pab = __builtin_bit_cast(bf16x8, pwb);
            const LAS unsigned char* vp = vb + (2 * ks) * 1024 + r32 * 16 + 8 * hi;
            const u32x2 a_lo = *(const LAS u32x2*)(vp), a_hi = *(const LAS u32x2*)(vp + 1024);
            const u32x2 b_lo = *(const LAS u32x2*)(vp + 512), b_hi = *(const LAS u32x2*)(vp + 1024 + 512);
            const bf16x8 vf0 = __builtin_bit_cast(bf16x8, ((u32x4){a_lo.x, a_lo.y, a_hi.x, a_hi.y}));
            const bf16x8 vf1 = __builtin_bit_cast(bf16x8, ((u32x4){b_lo.x, b_lo.y, b_hi.x, b_hi.y}));
            oa0 = __builtin_amdgcn_mfma_f32_32x32x16_bf16(vf0, paa, oa0, 0, 0, 0);
            oa1 = __builtin_amdgcn_mfma_f32_32x32x16_bf16(vf1, paa, oa1, 0, 0, 0);
            ob0 = __builtin_amdgcn_mfma_f32_32x32x16_bf16(vf0, pab, ob0, 0, 0, 0);
            ob1 = __builtin_amdgcn_mfma_f32_32x32x16_bf16(vf1, pab, ob1, 0, 0, 0);
        }
        if (t & 1) MLA_WAITBAR_ALL();
    }
#undef MLA_DMA
#undef MLA_WAITBAR_KEEP
#undef MLA_WAITBAR_ALL
    mla_store(AO + (size_t)qtokA * 1024 + h * 64 + 4 * hi, oa0, oa1, la);
    mla_store(AO + (size_t)qtokB * 1024 + h * 64 + 4 * hi, ob0, ob1, lb);
}

__device__ __forceinline__ unsigned na_vmask(int qc, int kh, int hi) {
    int cs = qc - 8; cs = cs < 0 ? 0 : cs; cs = cs > 48 ? 48 : cs; unsigned mk = 0u;
#pragma unroll
    for (int r = 0; r < 16; ++r) { const int kc = 32 * kh + (r & 3) + 8 * (r >> 2) + 4 * hi; mk |= ((kc >= cs) && (kc < cs + 16)) ? (1u << r) : 0u; }
    return mk;
}
__device__ __forceinline__ void na_qs(const bf16x8 (&kf)[4], const bf16x8 (&vf)[2][2], const bf16x8 (&qf)[4], const LAS float* brow, int qc, int kh, int hi, unsigned vmsel,
                                      float& m_run, float& l_run, f32x16& o0, f32x16& o1) {
    const float SCL = 0.125f * LOG2E;
    f32x16 p;
#pragma unroll
    for (int r = 0; r < 16; ++r) p[r] = 0.f;
#pragma unroll
    for (int d0 = 0; d0 < 4; ++d0) p = __builtin_amdgcn_mfma_f32_32x32x16_bf16(kf[d0], qf[d0], p, 0, 0, 0);
    unsigned vm = vmsel; asm volatile("" : "+v"(vm));
    float mx = -1e30f;
#pragma unroll
    for (int r = 0; r < 16; ++r) { const int kc = 32 * kh + (r & 3) + 8 * (r >> 2) + 4 * hi;
        int bi = kc - qc + 15; bi = bi < 0 ? 0 : bi; bi = bi > 30 ? 30 : bi;
        const float sc = p[r] * SCL + brow[bi]; p[r] = ((vm >> r) & 1u) ? sc : -1e30f; mx = fmaxf(mx, p[r]); }
    mx = xor32_max(mx);
    const float m_new = fmaxf(m_run, mx), alpha = fexp2(m_run - m_new); m_run = m_new;
    const float m_use = fmaxf(m_new, -1e20f);
    float ls = 0.f;
#pragma unroll
    for (int r = 0; r < 16; ++r) { const float e = fexp2(p[r] - m_use); p[r] = e; ls += e; }
    l_run = l_run * alpha + ls;
#pragma unroll
    for (int r = 0; r < 16; ++r) { o0[r] *= alpha; o1[r] *= alpha; }
#pragma unroll
    for (int k2 = 0; k2 < 2; ++k2) {
        u32x4 pw; pw.x = cvt_pk_bf16(p[8 * k2 + 0], p[8 * k2 + 1]); pw.y = cvt_pk_bf16(p[8 * k2 + 2], p[8 * k2 + 3]); pw.z = cvt_pk_bf16(p[8 * k2 + 4], p[8 * k2 + 5]); pw.w = cvt_pk_bf16(p[8 * k2 + 6], p[8 * k2 + 7]);
        const bf16x8 pa = __builtin_bit_cast(bf16x8, pw);
        o0 = __builtin_amdgcn_mfma_f32_32x32x16_bf16(vf[0][k2], pa, o0, 0, 0, 0);
        o1 = __builtin_amdgcn_mfma_f32_32x32x16_bf16(vf[1][k2], pa, o1, 0, 0, 0);
    }
}
__device__ __forceinline__ void na_store(bf16_t* orow, const f32x16& o0, const f32x16& o1, float l_run) {
    const float l = xor32_sum(l_run); const float inv = 1.0f / l;
#pragma unroll
    for (int rg = 0; rg < 4; ++rg) {
        u32x2 w; w.x = cvt_pk_bf16(o0[4 * rg] * inv, o0[4 * rg + 1] * inv); w.y = cvt_pk_bf16(o0[4 * rg + 2] * inv, o0[4 * rg + 3] * inv); *(u32x2*)(orow + 8 * rg) = w;
        u32x2 w2; w2.x = cvt_pk_bf16(o1[4 * rg] * inv, o1[4 * rg + 1] * inv); w2.y = cvt_pk_bf16(o1[4 * rg + 2] * inv, o1[4 * rg + 3] * inv); *(u32x2*)(orow + 32 + 8 * rg) = w2;
    }
}
__device__ __forceinline__ void na_unit(const LAS float* biasT, const bf16_t* Z, const bf16_t* VTn, bf16_t* AO, int tokbase, int S, int rr, int tid) {
    const int lane = tid & 63, h = tid >> 6, r32 = lane & 31, hi = lane >> 5;
    const int rows = S / 64; int rs = rr - 4; rs = rs < 0 ? 0 : rs; rs = rs > rows - 8 ? rows - 8 : rs;
    bf16x8 qfa[4], qfb[4];
#pragma unroll
    for (int d0 = 0; d0 < 4; ++d0) { qfa[d0] = *(const bf16x8*)(Z + (size_t)(tokbase + rr * 64 + r32) * ZP + 672 + h * 64 + 16 * d0 + 8 * hi);
                                      qfb[d0] = *(const bf16x8*)(Z + (size_t)(tokbase + rr * 64 + 32 + r32) * ZP + 672 + h * 64 + 16 * d0 + 8 * hi); }
    f32x16 oa0, oa1, ob0, ob1; float ma = -1e30f, mb = -1e30f, la = 0.f, lb = 0.f;
#pragma unroll
    for (int r = 0; r < 16; ++r) { oa0[r] = 0.f; oa1[r] = 0.f; ob0[r] = 0.f; ob1[r] = 0.f; }
    const unsigned va0 = na_vmask(r32, 0, hi), va1 = na_vmask(r32, 1, hi), vb0 = na_vmask(32 + r32, 0, hi), vb1 = na_vmask(32 + r32, 1, hi);
    const bf16_t* kbase = Z + (size_t)(tokbase + rs * 64 + r32) * ZP + 672 + 512 + h * 64 + 8 * hi;
    const bf16_t* vbase0 = VTn + (size_t)(h * 64 + r32) * TH + tokbase + rs * 64 + 4 * hi;
#define NA_LOADK(KF, IT) do { const int kr_ = (IT) >> 1, kh_ = (IT) & 1; const bf16_t* kp_ = kbase + (size_t)(kr_ * 64 + kh_ * 32) * ZP; \
        _Pragma("unroll") for (int d0 = 0; d0 < 4; ++d0) KF[d0] = *(const bf16x8*)(kp_ + 16 * d0); } while (0)
#define NA_LOADV(VF, IT) do { const int kr_ = (IT) >> 1, kh_ = (IT) & 1; const bf16_t* vp0_ = vbase0 + kr_ * 64 + kh_ * 32; const bf16_t* vp1_ = vp0_ + (size_t)32 * TH; \
        _Pragma("unroll") for (int k2 = 0; k2 < 2; ++k2) { const u32x2 lo = *(const u32x2*)(vp0_ + 16 * k2), hi2 = *(const u32x2*)(vp0_ + 16 * k2 + 8); VF[0][k2] = __builtin_bit_cast(bf16x8, ((u32x4){lo.x, lo.y, hi2.x, hi2.y})); \
            const u32x2 lo1 = *(const u32x2*)(vp1_ + 16 * k2), hi3 = *(const u32x2*)(vp1_ + 16 * k2 + 8); VF[1][k2] = __builtin_bit_cast(bf16x8, ((u32x4){lo1.x, lo1.y, hi3.x, hi3.y})); } } while (0)
    bf16x8 kf[4];
    NA_LOADK(kf, 0);
#pragma unroll 1
    for (int it = 0; it < 16; ++it) {
        const int kr = it >> 1, kh = it & 1;
        const LAS float* brow = biasT + (h * 15 + (rs + kr - rr + 7)) * 31;
        bf16x8 vf[2][2], kn[4];
        NA_LOADV(vf, it);
        const int itn = it + 1 < 16 ? it + 1 : 15;
        NA_LOADK(kn, itn);
        na_qs(kf, vf, qfa, brow, r32, kh, hi, kh ? va1 : va0, ma, la, oa0, oa1);
        na_qs(kf, vf, qfb, brow, 32 + r32, kh, hi, kh ? vb1 : vb0, mb, lb, ob0, ob1);
#pragma unroll
        for (int d0 = 0; d0 < 4; ++d0) kf[d0] = kn[d0];
    }
#undef NA_LOADK
#undef NA_LOADV
    na_store(AO + (size_t)(tokbase + rr * 64 + r32) * 1024 + 512 + h * 64 + 4 * hi, oa0, oa1, la);
    na_store(AO + (size_t)(tokbase + rr * 64 + 32 + r32) * 1024 + 512 + h * 64 + 4 * hi, ob0, ob1, lb);
}
#ifndef REP_SYNC
#define REP_SYNC 1
#endif
#ifndef REP_MLA
#define REP_MLA 1
#endif
#ifndef REP_NA
#define REP_NA 1
#endif
#ifndef REP_SCAN
#define REP_SCAN 1
#endif
#ifndef REP_UP
#define REP_UP 1
#endif
#ifndef REP_PASS
#define REP_PASS 1
#endif
#ifndef REP_GEMM
#define REP_GEMM 1
#endif
#define GSYNC() do { for (int r_ = 0; r_ < REP_SYNC; ++r_) xcd_barrier((unsigned*)(ap0->ws + WS_BAR), bst); } while (0)
constexpr int LDS_BYTES = 147456;
constexpr int NTHR = 512;
struct Args { const float* in[26]; float* out; unsigned char* ws; };


#define XB_TMO      128
#define XB_XCNT(j)  (256  + 64 * (j))
#define XB_XSUB(j)  (1280 + 64 * (j))
#define XB_XGEN(j)  (2304 + 64 * (j))
#define XB_TOP      3328
#define XB_TOPGEN   3392
#define XCD_BAR_WORDS 3456
#define XB_SPIN_CAP (1u << 22)
__device__ __forceinline__ unsigned xb_ld(unsigned* p)              { return __hip_atomic_load(p, __ATOMIC_RELAXED, __HIP_MEMORY_SCOPE_AGENT); }
__device__ __forceinline__ unsigned xb_add(unsigned* p, unsigned v) { return __hip_atomic_fetch_add(p, v, __ATOMIC_RELAXED, __HIP_MEMORY_SCOPE_AGENT); }
__device__ __forceinline__ unsigned xb_xcc_id() { return (unsigned)__builtin_amdgcn_s_getreg((3 << 11) | 20) & 0xFu; }
#define XB_SPIN(cond, bar) do { unsigned _sp = 0; while (cond) { __builtin_amdgcn_s_sleep(1); \
    if ((++_sp & 255u) == 0u) { if (xb_ld(&(bar)[XB_TMO])) break; if (_sp > XB_SPIN_CAP) { atomicAdd(&(bar)[XB_TMO], 1u); break; } } } } while (0)
__device__ __forceinline__ void xcd_barrier_complete(unsigned* bar, unsigned x, unsigned& nloc, unsigned& nx) {
    const unsigned G = gridDim.x;
    unsigned sum, cnt, mine, sp = 0u;
    for (;;) {
        sum = 0u; cnt = 0u; mine = 0u;
#pragma unroll
        for (unsigned j = 0; j < 16; ++j) { const unsigned c = xb_ld(&bar[XB_XCNT(j)]); sum += c; cnt += (c > 0u) ? 1u : 0u; mine = (j == x) ? c : mine; }
        if (sum == G) break;
        __builtin_amdgcn_s_sleep(1);
        if ((++sp & 255u) == 0u) { if (xb_ld(&bar[XB_TMO])) break; if (sp > XB_SPIN_CAP) { atomicAdd(&bar[XB_TMO], 1u); break; } }
    }
    nloc = mine > 0u ? mine : 1u; nx = cnt > 0u ? cnt : 1u;
}
__device__ __forceinline__ void xcd_barrier(unsigned* bar, volatile LAS unsigned* st) {
    asm volatile("s_waitcnt vmcnt(0)" ::: "memory");
    __syncthreads();
    if (threadIdx.x == 0) {
        __builtin_amdgcn_s_waitcnt(0);
        const unsigned x = xb_xcc_id();
        unsigned nloc = st[0], nx = st[1];
        if (nloc == 0u) { xcd_barrier_complete(bar, x, nloc, nx); st[0] = nloc; st[1] = nx; }
        const unsigned old = xb_add(&bar[XB_XSUB(x)], 1u);
        const unsigned gen = old / nloc;
        if (old + 1u == (gen + 1u) * nloc) {
            __builtin_amdgcn_fence(__ATOMIC_RELEASE, "agent");
            asm volatile("s_waitcnt vmcnt(0)" ::: "memory");
            const unsigned og = xb_add(&bar[XB_TOP], 1u);
            const unsigned tg = og / nx;
            if (og + 1u == (tg + 1u) * nx) xb_add(&bar[XB_TOPGEN], 1u);
            else XB_SPIN(xb_ld(&bar[XB_TOPGEN]) == tg, bar);
            __builtin_amdgcn_fence(__ATOMIC_ACQUIRE, "agent");
            xb_add(&bar[XB_XGEN(x)], 1u);
            asm volatile("s_waitcnt vmcnt(0)" ::: "memory");
        } else {
            XB_SPIN(xb_ld(&bar[XB_XGEN(x)]) == gen, bar);
            __builtin_amdgcn_fence(__ATOMIC_ACQUIRE, "agent");
            asm volatile("s_waitcnt vmcnt(0)" ::: "memory");
        }
    }
    __syncthreads();
}

__device__ __forceinline__ void lru_ab(float ga, float gx, float gab, float gxb, float spl  , float xb, float& a, float& b) {
    const float r = sigmoidf_(ga + gab), ii = sigmoidf_(gx + gxb);
    const float la2 = (-8.0f * LOG2E) * r * spl;
    a = fexp2(la2);
    const float om = 1.0f - a * a;
    b = __builtin_amdgcn_sqrtf(om) * (ii * xb);
}

__global__ void __launch_bounds__(NTHR, 2) mk_fwd(Args a) {
    extern __shared__ __attribute__((aligned(16))) unsigned char lds_raw[];
    LAS unsigned char* lds = (LAS unsigned char*)lds_raw;
    cg::grid_group grid = cg::this_grid();
    volatile LAS unsigned* bst = (volatile LAS unsigned*)(lds + LDS_BYTES - 64);
    if (threadIdx.x == 0) { bst[0] = 0u; bst[1] = 0u; }
    typedef const __attribute__((address_space(4))) Args* ArgP;
    ArgP ap0 = (ArgP)__builtin_amdgcn_kernarg_segment_ptr();
#define PH_BEGIN ArgP ap = ap0; asm volatile("" : "+s"(ap)); unsigned char* ws = ap->ws; (void)ws; int tid_ = threadIdx.x; asm volatile("" : "+v"(tid_)); const int tid = tid_, lane = tid & 63, wave = tid >> 6; int G_ = gridDim.x, bid_ = blockIdx.x; asm volatile("" : "+s"(G_), "+s"(bid_)); const int G = G_, bid = bid_; const int gw = bid * 8 + wave, NGW = G * 8; const int gt = bid * NTHR + tid, NGT = G * NTHR; (void)lane; (void)gw; (void)NGW; (void)gt; (void)NGT;
#define IN(k) (ap->in[k])
#define rsq ((float*)(ws + WS_RSQ))
#define rskv ((float*)(ws + WS_RSKV))
#define rope ((float2*)(ws + WS_ROPE))
#define AGG ((float2*)(ws + WS_AGG))
#define CARRY ((float*)(ws + WS_CARRY))
#define YB ((bf16_t*)(ws + WS_YB))
#define W_INATT ((bf16_t*)(ws + WS_W_INATT))
#define W_UQ ((bf16_t*)(ws + WS_W_UQ))
#define W_UKV ((bf16_t*)(ws + WS_W_UKV))
#define W_OUTATT ((bf16_t*)(ws + WS_W_OUTATT))
#define W_INREC ((bf16_t*)(ws + WS_W_INREC))
#define W_GATES ((bf16_t*)(ws + WS_W_GATES))
#define W_OUTREC ((bf16_t*)(ws + WS_W_OUTREC))
#define W_UP ((bf16_t*)(ws + WS_W_UP))
#define W_DOWN ((bf16_t*)(ws + WS_W_DOWN))
#define XN ((bf16_t*)(ws + WS_XN))
#define Zb ((bf16_t*)(ws + WS_Z))
#define Qb ((bf16_t*)(ws + WS_Q))
#define KN ((bf16_t*)(ws + WS_KN))
#define VTM ((bf16_t*)(ws + WS_VTM))
#define VTN ((bf16_t*)(ws + WS_VTN))
#define KPE ((bf16_t*)(ws + WS_KPE))
#define ACT ((bf16_t*)(ws + WS_ACT))
#define GATE ((bf16_t*)(ws + WS_GATE))
#define XB ((bf16_t*)(ws + WS_XB))
#define XBR ((bf16_t*)(ws + WS_XBR))
#define GQ ((bf16_t*)(ws + WS_GQ))
#define AO XN
#define Fb XN
#define YR XN
#define M0 Zb
#define M1 XBR
#define XIN (IN(half))
#define XST (ap->out + (size_t)half * TH * DM)
    { PH_BEGIN
    {
        LAS float* scr = (LAS float*)(lds + wave * 16384);
        constexpr int I_INATT = 16 * 69, I_UQ = 6 * 24, I_UKV = 4 * 32, I_SQ = 16 * 32, I_INREC = 16 * 64, I_UP = 16 * 256, I_DOWN = 64 * 32, I_GATE = 32 * 8;
        constexpr int NITEMS = I_INATT + I_UQ + I_UKV + 2 * I_SQ + I_INREC + 2 * I_UP + 2 * I_DOWN + I_GATE;
        for (int rep_ = 0; rep_ < REP_PASS; ++rep_)
        for (int it = gw; it < NITEMS; it += NGW) {
            int r = it;
            if (r < I_INATT) { transpose_item(IN(6), 1024, 2208, W_INATT, 0, nullptr, scr, r, lane); continue; } r -= I_INATT;
            if (r < I_UQ) { transpose_item(IN(8), 384, 768, W_UQ, 0, IN(7), scr, r, lane); continue; } r -= I_UQ;
            if (r < I_UKV) { transpose_item(IN(10), 256, 1024, W_UKV, 0, IN(9), scr, r, lane); continue; } r -= I_UKV;
            if (r < I_SQ) { transpose_item(IN(12), 1024, 1024, W_OUTATT, 0, nullptr, scr, r, lane); continue; } r -= I_SQ;
            if (r < I_SQ) { transpose_item(IN(21), 1024, 1024, W_OUTREC, 0, nullptr, scr, r, lane); continue; } r -= I_SQ;
            if (r < I_INREC) { transpose_item(IN(13), 1024, 2048, W_INREC, 0, nullptr, scr, r, lane); continue; } r -= I_INREC;
            if (r < 2 * I_UP) { const int li = r / I_UP; transpose_item(IN(22) + (size_t)li * 1024 * 8192, 1024, 8192, W_UP + (size_t)li * 8192 * 1024, 0, nullptr, scr, r % I_UP, lane); continue; } r -= 2 * I_UP;
            if (r < 2 * I_DOWN) { const int li = r / I_DOWN; transpose_item(IN(25) + (size_t)li * 4096 * 1024, 4096, 1024, W_DOWN + (size_t)li * 1024 * 4096, 0, nullptr, scr, r % I_DOWN, lane); continue; } r -= 2 * I_DOWN;
            { const int mat = r / 8, sub = r % 8; const int type = mat >> 4, e = (mat >> 3) & 1, n = mat & 7;
              transpose_item(IN(type ? 18 : 16) + (size_t)(e * 8 + n) * 128 * 128, 128, 128, W_GATES, n * 512 + (type * 2 + e) * 128, nullptr, scr, sub, lane); }
        }
        if (bid == 0) for (int i = tid; i < XCD_BAR_WORDS; i += NTHR) ((unsigned*)(ws + WS_BAR))[i] = 0u;
        for (int i = gt; i < 8 * 64 * 64; i += NGT) ((unsigned*)(ws + WS_CNT))[i] = 0u;
        for (int i = gt; i < 96 * 1024 / 8; i += NGT) ((u32x4*)(W_INATT + (size_t)2208 * 1024))[i] = (u32x4){0, 0, 0, 0};
        for (int m = gw; m < TH; m += NGW) xn_row(IN(0) + (size_t)m * DM, IN(2), XN + (size_t)m * DM, lane);
        for (int i = gt; i < 4096 * 16; i += NGT) { const int pos = i >> 4, j = i & 15;
            const double inv = exp2(-(double)j * (13.287712379549449 / 16.0));
            const double rev = (double)pos * inv * 0.15915494309189535; const float fr = (float)(rev - floor(rev));
            rope[i] = make_float2(__builtin_amdgcn_cosf(fr), __builtin_amdgcn_sinf(fr)); }
    }

    }
    grid.sync();
    if (threadIdx.x == 0) (void)xb_add((unsigned*)(ap0->ws + WS_BAR) + XB_XCNT(xb_xcc_id()), 1u);
    for (int half = 0; half < 2; ++half) {
        const int S = half ? 4096 : 2048, nseq = TH / S;
        if (half == 1 && gridDim.x != 256) {
                { PH_BEGIN
        for (int m = gw; m < TH; m += NGW) xn_row(XIN + (size_t)m * DM, IN(2), XN + (size_t)m * DM, lane);
        }
        GSYNC();
        }
        { PH_BEGIN
        { pg8::Gemm g = pg8::make_gemm(XN, DM, W_INATT, DM, DM); pg8::StaticOrder so; so.init(TH / 256, ZP / 256, G, bid);
          EpiZ E{Zb, VTN, (float*)(ws + WS_SQP), nullptr, KPE, rope, S - 1};
#ifndef NO_G1
for (int rep_ = 0; rep_ < REP_GEMM; ++rep_) pg8::gemm_phase<EpiZ>(lds, g, so, E);
#endif
 }
        }
        GSYNC();
        { PH_BEGIN
        { pg8::Gemm g = pg8::make_gemm(Zb, ZP, W_UQ, 384, 384); pg8::StaticOrder so; so.init(TH / 256, 3, G, bid);
          EpiQ E{Qb, (const float*)(ws + WS_SQP), rope, S - 1};
#ifndef NO_G2
for (int rep_ = 0; rep_ < REP_GEMM; ++rep_) pg8::gemm_phase<EpiQ>(lds, g, so, E);
#endif
 }
        { pg8::Gemm g = pg8::make_gemm(Zb + 384, ZP, W_UKV, 256, 256); pg8::StaticOrder so; so.init(TH / 256, 4, G, bid);
          EpiKV E{KN, VTM, (const float*)(ws + WS_SQP)};
#ifndef NO_G3
for (int rep_ = 0; rep_ < REP_GEMM; ++rep_) pg8::gemm_phase<EpiKV>(lds, g, so, E);
#endif
 }
        }
        GSYNC();
        { PH_BEGIN
        {
            LAS float* biasT = (LAS float*)(lds + 98304);
            for (int i = tid; i < 8 * 15 * 31; i += NTHR) biasT[i] = IN(11)[i] * LOG2E;
            __syncthreads();
            const int nqb = S / 512, nunits = nseq * 8 * nqb;
            const int vb = (G % 8 == 0) ? (bid % 8) * (G / 8) + bid / 8 : bid;
#ifdef DELAY_P4A
        { const unsigned long long t0_ = __builtin_amdgcn_s_memrealtime(); while (__builtin_amdgcn_s_memrealtime() - t0_ < 40000ull) __builtin_amdgcn_s_sleep(32); }
#endif
#ifndef NO_MLA
            for (int rep_ = 0; rep_ < REP_MLA; ++rep_) {
#ifdef REP_MLA_SYNC
            if (rep_ > 0) GSYNC();
#endif
#ifdef REP_DELAY
            if (rep_ > 0) { const unsigned long long t0_ = __builtin_amdgcn_s_memrealtime(); while (__builtin_amdgcn_s_memrealtime() - t0_ < 40000ull) __builtin_amdgcn_s_sleep(32); continue; }
#endif
            for (int u = vb; u < nunits; u += G) { const int qb = u % nqb, h = (u / nqb) & 7, s = u / (nqb * 8);
                mla_unit(lds, Qb, KN, KPE, VTM, AO, s * S, S, h, qb, tid); }
            }
#endif
#ifdef MLA_TWICE
            for (int u = vb; u < nunits; u += G) { const int qb = u % nqb, h = (u / nqb) & 7, s = u / (nqb * 8);
                mla_unit(lds, Qb, KN, KPE, VTM, AO, s * S, S, h, qb, tid); }
#endif
            const int rows = S / 64, nna = nseq * rows;
#ifdef DELAY_P4B
        { const unsigned long long t0_ = __builtin_amdgcn_s_memrealtime(); while (__builtin_amdgcn_s_memrealtime() - t0_ < 40000ull) __builtin_amdgcn_s_sleep(32); }
#endif
#ifdef RELOAD_BIAS
            __syncthreads();
            for (int i = tid; i < 8 * 15 * 31; i += NTHR) biasT[i] = IN(11)[i] * LOG2E;
            __syncthreads();
#endif
#ifndef NO_NA
            for (int rep_ = 0; rep_ < REP_NA; ++rep_)
            for (int u = vb; u < nna; u += G) na_unit(biasT, Zb, VTN, AO, (u / rows) * S, S, u % rows, tid);
#endif
        }
        }
        GSYNC();
        { PH_BEGIN
        { pg8::Gemm g = pg8::make_gemm(AO, DM, W_OUTATT, DM, DM); pg8::StaticOrder so; so.init(TH / 256, 4, G, bid);
          EpiBf16 E{M0, DM, 0, 0};
#ifndef NO_G4
for (int rep_ = 0; rep_ < REP_GEMM; ++rep_) pg8::gemm_phase<EpiBf16>(lds, g, so, E);
#endif
 }
        }
        GSYNC();
        { PH_BEGIN
        for (int m = gw; m < TH; m += NGW) res_row(M0 + (size_t)m * DM, XIN + (size_t)m * DM, XST + (size_t)m * DM, IN(3), IN(4), XN + (size_t)m * DM, lane);
        }
        GSYNC();

        for (int li = 0; li < 2; ++li) {
            if (li == 1) {
                { PH_BEGIN
                { pg8::Gemm g = pg8::make_gemm(XN, DM, W_INREC, DM, DM); pg8::StaticOrder so; so.init(TH / 256, 8, G, bid);
                  EpiBf16 E{GATE, DM, 1024, (size_t)(WS_XBR - WS_GATE) / 2};
#ifndef NO_G5
for (int rep_ = 0; rep_ < REP_GEMM; ++rep_) pg8::gemm_phase<EpiBf16>(lds, g, so, E);
#endif
 }
                }
                GSYNC();
                { PH_BEGIN
                for (int rep_ = 0; rep_ < REP_PASS; ++rep_)
                for (int i = gt; i < TH * 128; i += NGT) { const int t = i >> 7, c8 = (i & 127) * 8; const int pos = t & (S - 1);
                    float accv[8];
#pragma unroll
                    for (int j = 0; j < 8; ++j) accv[j] = IN(15)[c8 + j];
#pragma unroll
                    for (int k = 0; k < 4; ++k) { const int p2 = pos + k - 1; if (p2 < 0 || p2 >= S) continue;
                        const u32x4 w = *(const u32x4*)(XBR + (size_t)(t + k - 1) * DM + c8); const float* cwk = IN(14) + k * 1024 + c8;
                        accv[0] += cwk[0] * bflo(w.x); accv[1] += cwk[1] * bfhi(w.x); accv[2] += cwk[2] * bflo(w.y); accv[3] += cwk[3] * bfhi(w.y);
                        accv[4] += cwk[4] * bflo(w.z); accv[5] += cwk[5] * bfhi(w.z); accv[6] += cwk[6] * bflo(w.w); accv[7] += cwk[7] * bfhi(w.w); }
                    u32x4 o; o.x = cvt_pk_bf16(accv[0], accv[1]); o.y = cvt_pk_bf16(accv[2], accv[3]); o.z = cvt_pk_bf16(accv[4], accv[5]); o.w = cvt_pk_bf16(accv[6], accv[7]);
                    *(u32x4*)(XB + (size_t)t * DM + c8) = o; }
                }
                GSYNC();
                for (int qt = 0; qt < 2; ++qt) {
                    const int t0 = qt * TQ;
                    { PH_BEGIN
                    { pg8::Gemm g = pg8::make_gemm(XB + (size_t)t0 * DM, DM, W_GATES, 128, 128); g.a_pn_shift = 1; g.a_pn_step = 256;
                      pg8::StaticOrder so; so.init(TQ / 256, 16, G, bid);
                      EpiBf16 E{GQ, 4096, 0, 0};
#ifndef NO_G6
for (int rep_ = 0; rep_ < REP_GEMM; ++rep_) pg8::gemm_phase<EpiBf16>(lds, g, so, E);
#endif
 }
                    }
                    GSYNC();
                    { PH_BEGIN
                    for (int rep_ = 0; rep_ < REP_SCAN; ++rep_)
                    for (int i = gt; i < 256 * 2 * 512; i += NGT) { const int cp = i & 511, e = (i >> 9) & 1, c = i >> 10; const int ch = 2 * cp, n = ch >> 7, d = ch & 127;
                        const float2 gab = *(const float2*)(IN(17) + e * 1024 + ch), gxb = *(const float2*)(IN(19) + e * 1024 + ch), lam = *(const float2*)(IN(20) + e * 1024 + ch);
                        const float spl0 = log1pf(expf(-lam.x)), spl1 = log1pf(expf(-lam.y));
                        float A0 = 1.f, B0 = 0.f, A1 = 1.f, B1 = 0.f;
                        const bf16_t* gq0 = GQ + (size_t)(c * 32) * 4096 + n * 512 + e * 128 + d; const bf16_t* xb0 = XB + (size_t)(t0 + c * 32) * DM + ch;
#pragma unroll 16
                        for (int s = 0; s < 32; ++s) { const int tl = e ? 31 - s : s;
                            const unsigned ga2 = *(const unsigned*)(gq0 + (size_t)tl * 4096), gx2 = *(const unsigned*)(gq0 + (size_t)tl * 4096 + 256), xb2 = *(const unsigned*)(xb0 + (size_t)tl * DM);
                            float av, bv; lru_ab(bflo(ga2), bflo(gx2), gab.x, gxb.x, spl0, bflo(xb2), av, bv); A0 *= av; B0 = av * B0 + bv;
                            lru_ab(bfhi(ga2), bfhi(gx2), gab.y, gxb.y, spl1, bfhi(xb2), av, bv); A1 *= av; B1 = av * B1 + bv; }
                        *(f32x4*)(AGG + (size_t)(c * 2 + e) * 1024 + ch) = (f32x4){A0, B0, A1, B1}; }
                    }
                    GSYNC();
                    { PH_BEGIN
                    { const int cps = S / 32, nsq = TQ / S;
                      for (int rep_ = 0; rep_ < REP_SCAN; ++rep_)
                      for (int i = gt; i < nsq * 2 * 1024; i += NGT) { const int ch = i & 1023, e = (i >> 10) & 1, sq = i >> 11;
                          float hcar = 0.f;
#pragma unroll 16
                          for (int k = 0; k < cps; ++k) { const int c = sq * cps + (e ? cps - 1 - k : k); const int idx = (c * 2 + e) * 1024 + ch;
                              CARRY[idx] = hcar; const float2 ab = AGG[idx]; hcar = ab.x * hcar + ab.y; } } }
                    }
                    GSYNC();
                    { PH_BEGIN
#ifndef NO_R6
                    for (int rep_ = 0; rep_ < REP_SCAN; ++rep_)
                    for (int i = gt; i < 256 * 512; i += NGT) { const int cp = i & 511, c = i >> 9; const int ch = 2 * cp, n = ch >> 7, d = ch & 127;
                        const float2 lam0 = *(const float2*)(IN(20) + ch), lam1 = *(const float2*)(IN(20) + 1024 + ch);
                        const float2 gab0 = *(const float2*)(IN(17) + ch), gab1 = *(const float2*)(IN(17) + 1024 + ch), gxb0 = *(const float2*)(IN(19) + ch), gxb1 = *(const float2*)(IN(19) + 1024 + ch);
                        const bf16_t* gq0 = GQ + (size_t)(c * 32) * 4096 + n * 512 + d; const bf16_t* xb0 = XB + (size_t)(t0 + c * 32) * DM + ch;
                        bf16_t* yr0 = YR + (size_t)(t0 + c * 32) * DM + ch; const bf16_t* gt0 = GATE + (size_t)(t0 + c * 32) * DM + ch;
                        unsigned hfw[32];
                        { const float spl0 = log1pf(expf(-lam0.x)), spl1 = log1pf(expf(-lam0.y));
                          const float2 hc2 = *(const float2*)(CARRY + (size_t)(c * 2 + 0) * 1024 + ch); float h0 = hc2.x, h1 = hc2.y;
#pragma unroll
                          for (int s = 0; s < 32; ++s) {
                            const unsigned ga2 = *(const unsigned*)(gq0 + (size_t)s * 4096), gx2 = *(const unsigned*)(gq0 + (size_t)s * 4096 + 256), xb2 = *(const unsigned*)(xb0 + (size_t)s * DM);
                            float av, bv; lru_ab(bflo(ga2), bflo(gx2), gab0.x, gxb0.x, spl0, bflo(xb2), av, bv); h0 = av * h0 + bv;
                            lru_ab(bfhi(ga2), bfhi(gx2), gab0.y, gxb0.y, spl1, bfhi(xb2), av, bv); h1 = av * h1 + bv;
                            hfw[s] = cvt_pk_bf16(h0, h1); } }
                        { const float spl0 = log1pf(expf(-lam1.x)), spl1 = log1pf(expf(-lam1.y));
                          const float2 hc2 = *(const float2*)(CARRY + (size_t)(c * 2 + 1) * 1024 + ch); float h0 = hc2.x, h1 = hc2.y;
#pragma unroll
                          for (int s = 31; s >= 0; --s) {
                            const unsigned ga2 = *(const unsigned*)(gq0 + (size_t)s * 4096 + 128), gx2 = *(const unsigned*)(gq0 + (size_t)s * 4096 + 384), xb2 = *(const unsigned*)(xb0 + (size_t)s * DM);
                            float av, bv; lru_ab(bflo(ga2), bflo(gx2), gab1.x, gxb1.x, spl0, bflo(xb2), av, bv); h0 = av * h0 + bv;
                            lru_ab(bfhi(ga2), bfhi(gx2), gab1.y, gxb1.y, spl1, bfhi(xb2), av, bv); h1 = av * h1 + bv;
                            const unsigned g2 = *(const unsigned*)(gt0 + (size_t)s * DM), f2 = hfw[s];
                            *(unsigned*)(yr0 + (size_t)s * DM) = cvt_pk_bf16((bflo(f2) + h0) * gelu_tanh(bflo(g2)), (bfhi(f2) + h1) * gelu_tanh(bfhi(g2))); } }
                    }
#endif
                    }
                    GSYNC();
                }
                { PH_BEGIN
                { pg8::Gemm g = pg8::make_gemm(YR, DM, W_OUTREC, DM, DM); pg8::StaticOrder so; so.init(TH / 256, 4, G, bid);
                  EpiBf16 E{M1, DM, 0, 0};
#ifndef NO_G7
for (int rep_ = 0; rep_ < REP_GEMM; ++rep_) pg8::gemm_phase<EpiBf16>(lds, g, so, E);
#endif
 }
                }
                GSYNC();
                { PH_BEGIN
                for (int m = gw; m < TH; m += NGW) res_row(M1 + (size_t)m * DM, XST + (size_t)m * DM, XST + (size_t)m * DM, IN(3) + 1024, IN(4) + 1024, XN + (size_t)m * DM, lane);
                }
                GSYNC();
            }
            { PH_BEGIN
            { pg8::Gemm g = pg8::make_gemm(XN, DM, W_UP + (size_t)li * 8192 * 1024, DM, DM);
              g.a_seg = 1; g.hA = (size_t)4 * DM * 2; g.tB = (size_t)128 * DM * 2; g.hB = (size_t)4096 * DM * 2;
              pg8::StaticOrder so; so.init(TH / 256, 32, G, bid);
#ifndef NO_UP
              EpiUp E{ACT, YB, IN(23) + (size_t)li * 3 * 8192, IN(24) + (size_t)li * 8192}; for (int rep_ = 0; rep_ < REP_UP; ++rep_) pg8::gemm_phase<EpiUp>(lds, g, so, E);
#endif
 }
            }
            GSYNC();
            { PH_BEGIN
            for (int rep_ = 0; rep_ < REP_PASS; ++rep_)
            for (int b = bid; b < 256; b += G) { const int seg = b >> 1, which = b & 1; const int t = seg * 128 + (which ? 127 : 0); const int pos = t & (S - 1);
                const float* cw = IN(23) + (size_t)li * 3 * 8192; const float* cb = IN(24) + (size_t)li * 8192;
                const bool hasp = which ? true : (pos != 0), hasn = which ? (pos != S - 1) : true;
                const bf16_t* yp = which ? YB + ((size_t)seg * 4 + 2) * 8192 : YB + ((size_t)(seg - 1) * 4 + 3) * 8192;
                const bf16_t* yc = YB + ((size_t)seg * 4 + (which ? 3 : 0)) * 8192;
                const bf16_t* yn = which ? YB + ((size_t)(seg + 1) * 4 + 0) * 8192 : YB + ((size_t)seg * 4 + 1) * 8192;
                for (int c = tid; c < 4096; c += NTHR) {
                    float u2[2];
#pragma unroll
                    for (int bj = 0; bj < 2; ++bj) { const int ch = bj * 4096 + c;
                        float r = cw[8192 + ch] * bf2f(yc[ch]) + cb[ch];
                        if (hasp) r += cw[ch] * bf2f(yp[ch]);
                        if (hasn) r += cw[2 * 8192 + ch] * bf2f(yn[ch]);
                        u2[bj] = r; }
                    ACT[(size_t)t * DFF + c] = f2bf(gelu_tanh(u2[0]) * u2[1]); } }
            }
            GSYNC();
            if (gridDim.x == 256) {
                { PH_BEGIN
                { pg8::Gemm g = pg8::make_gemm(ACT, DFF, W_DOWN + (size_t)li * 1024 * 4096, DFF, DFF); pg8::StaticOrder so; so.init(TH / 256, 4, G, bid);
                  const int use = half * 2 + li;
                  EpiRms E{XST, li == 0 ? XN : nullptr, IN(5) + li * 1024, IN(2) + 1024, (float*)(ws + WS_XBUF), (float*)(ws + WS_XBUF) + (size_t)TH * 4,
                           (unsigned*)(ws + WS_CNT) + (size_t)(use * 2) * 4096, (unsigned*)(ws + WS_CNT) + (size_t)(use * 2 + 1) * 4096};
                  pg8::gemm_phase<EpiRms>(lds, g, so, E); }
                if (half == 0 && li == 1)
                  { for (int m = gw; m < TH; m += NGW) xn_row(IN(1) + (size_t)m * DM, IN(2), XN + (size_t)m * DM, lane);
                  }
                }
                GSYNC();
            } else {
                { PH_BEGIN
                { pg8::Gemm g = pg8::make_gemm(ACT, DFF, W_DOWN + (size_t)li * 1024 * 4096, DFF, DFF); pg8::StaticOrder so; so.init(TH / 256, 4, G, bid);
                  EpiBf16 E{Fb, DM, 0, 0};
                  pg8::gemm_phase<EpiBf16>(lds, g, so, E); }
                }
                GSYNC();
                { PH_BEGIN
                for (int m = gw; m < TH; m += NGW) res_row(Fb + (size_t)m * DM, XST + (size_t)m * DM, XST + (size_t)m * DM, IN(5) + li * 1024, li == 0 ? IN(2) + 1024 : nullptr, XN + (size_t)m * DM, lane);
                }
                GSYNC();
            }
        }
    }
}

extern "C" void kernel_launch(void* const* d_in, const int* in_sizes, int n_in, void* d_out, int out_size, void* d_ws, size_t ws_size, hipStream_t stream) {
    static int grid = 0;
    if (grid == 0) {
        int dev = 0, cus = 0, per_cu = 0;
        (void)hipGetDevice(&dev);
        (void)hipDeviceGetAttribute(&cus, hipDeviceAttributeMultiprocessorCount, dev);
        (void)hipFuncSetAttribute((const void*)mk_fwd, hipFuncAttributeMaxDynamicSharedMemorySize, LDS_BYTES);
        (void)hipOccupancyMaxActiveBlocksPerMultiprocessor(&per_cu, (const void*)mk_fwd, NTHR, LDS_BYTES);
        if (per_cu < 1) per_cu = 1;
        grid = cus * per_cu;
        if (ws_size < WS_END || n_in != 26) { fprintf(stderr, "kernel_launch: unexpected ws_size %zu / n_in %d\n", ws_size, n_in); }
    }
    Args a{};
    for (int i = 0; i < 26; ++i) a.in[i] = (const float*)d_in[i];
    a.out = (float*)d_out; a.ws = (unsigned char*)d_ws;
    void* args[] = {&a};
    hipError_t e = hipLaunchCooperativeKernel((const void*)mk_fwd, dim3(grid), dim3(NTHR), args, LDS_BYTES, stream);
    if (e != hipSuccess) fprintf(stderr, "cooperative launch failed: %s (grid %d)\n", hipGetErrorString(e), grid);
}
```

```cpp
#include <hip/hip_runtime.h>
#include <hip/hip_cooperative_groups.h>
#include <cstdio>
#include <cstdint>
namespace cg = cooperative_groups;

#define LAS __attribute__((address_space(3)))
typedef unsigned short bf16_t;
typedef short bf16x8 __attribute__((ext_vector_type(8)));
typedef short s16x4 __attribute__((ext_vector_type(4)));
typedef float f32x4 __attribute__((ext_vector_type(4)));
typedef float f32x16 __attribute__((ext_vector_type(16)));
typedef unsigned u32x4 __attribute__((ext_vector_type(4)));
typedef unsigned u32x2 __attribute__((ext_vector_type(2)));

__device__ __forceinline__ unsigned cvt_pk_bf16(float lo, float hi) { unsigned r; asm volatile("v_cvt_pk_bf16_f32 %0, %1, %2" : "=v"(r) : "v"(lo), "v"(hi)); return r; }
__device__ __forceinline__ float bf2f(bf16_t v) { return __uint_as_float(((unsigned)v) << 16); }
__device__ __forceinline__ float bflo(unsigned w) { return __uint_as_float(w << 16); }
__device__ __forceinline__ float bfhi(unsigned w) { return __uint_as_float(w & 0xffff0000u); }
__device__ __forceinline__ bf16_t f2bf(float f) { return (bf16_t)(cvt_pk_bf16(f, 0.f) & 0xffffu); }
__device__ __forceinline__ float fexp2(float x) { return __builtin_amdgcn_exp2f(x); }
__device__ __forceinline__ float frcp(float x) { return __builtin_amdgcn_rcpf(x); }
__device__ __forceinline__ float gelu_tanh(float x) {
    const float u = x * (1.0f + 0.044715f * x * x) * (-2.0f * 0.7978845608028654f * 1.4426950408889634f);
    return x * frcp(1.0f + fexp2(u));
}
__device__ __forceinline__ float sigmoidf_(float x) { return frcp(1.0f + fexp2(-1.4426950408889634f * x)); }
__device__ __forceinline__ float bperm_f(int src_lane, float v) { return __int_as_float(__builtin_amdgcn_ds_bpermute(src_lane << 2, __float_as_int(v))); }
#define DPP_F(V, CTRL) __int_as_float(__builtin_amdgcn_mov_dpp(__float_as_int(V), (CTRL), 0xf, 0xf, true))
__device__ __forceinline__ float wave_sum(float v, int  ) {
    v += DPP_F(v, 0xB1);
    v += DPP_F(v, 0x4E);
    v += DPP_F(v, 0x141);
    v += DPP_F(v, 0x140);
    const int iv = __float_as_int(v);
    return (__int_as_float(__builtin_amdgcn_readlane(iv, 0)) + __int_as_float(__builtin_amdgcn_readlane(iv, 16))) + (__int_as_float(__builtin_amdgcn_readlane(iv, 32)) + __int_as_float(__builtin_amdgcn_readlane(iv, 48)));
}
__device__ __forceinline__ float xor32_max(float v) { auto rr = __builtin_amdgcn_permlane32_swap(__float_as_uint(v), __float_as_uint(v), false, false); return fmaxf(__uint_as_float(rr[0]), __uint_as_float(rr[1])); }
__device__ __forceinline__ float xor32_sum(float v) { auto rr = __builtin_amdgcn_permlane32_swap(__float_as_uint(v), __float_as_uint(v), false, false); return __uint_as_float(rr[0]) + __uint_as_float(rr[1]); }

namespace pg8 {
constexpr int BM = 256, BK = 64, HALF = 128, HTB = HALF * BK * 2, STAGE_BYTES = 8 * HTB, NXCD = 8, WGM = 8;
__host__ __device__ __forceinline__ int lds_byte(int r, int c) { const int st = (r >> 4) * 2 + (c >> 5), rr = r & 15, cc = c & 31, ob = rr * 64 + cc * 2; return st * 1024 + (ob ^ (((ob >> 9) & 1) << 5)); }
__host__ __device__ __forceinline__ void stage_rc(int b, int& R, int& C) { const int st = b / 1024, sb = b % 1024, swz = sb ^ (((sb >> 9) & 1) << 5); R = (st >> 1) * 16 + swz / 64; C = (st & 1) * 32 + (swz % 64) / 2; }
__host__ __device__ __forceinline__ int perm32(int rho) { const int n = rho >> 4, i = rho & 15; return 8 * (i >> 2) + 4 * n + (i & 3); }

struct Unit { int pm, pn; };
struct Gemm { const bf16_t* A; const bf16_t* Bt; int lda, ldb, K; size_t tA, hA, tB, hB; int a_seg; int a_pn_shift; size_t a_pn_step; };
__device__ __forceinline__ Gemm make_gemm(const bf16_t* A, int lda, const bf16_t* Bt, int ldb, int K) {
    Gemm g; g.A = A; g.Bt = Bt; g.lda = lda; g.ldb = ldb; g.K = K; g.tA = (size_t)256 * lda * 2; g.hA = (size_t)128 * lda * 2; g.tB = (size_t)256 * ldb * 2; g.hB = (size_t)128 * ldb * 2;
    g.a_seg = 0; g.a_pn_shift = 0; g.a_pn_step = 0; return g;
}

struct StaticOrder {
    int nM, nN, nwg, G, c;
    __device__ __forceinline__ void init(int nM_, int nN_, int G_, int c_) { nM = nM_; nN = nN_; nwg = nM * nN; G = G_; c = c_; }
    __device__ __forceinline__ bool next(int i, Unit& u) const {
        const long L = (long)i * G + c; if (L >= nwg) return false;
        int wgid = (int)L; { const int q = nwg / NXCD, r = nwg % NXCD, xcd = wgid % NXCD, off = wgid / NXCD; wgid = (xcd < r ? xcd * (q + 1) : r * (q + 1) + (xcd - r) * q) + off; }
        const int nig = WGM * nN, gid = wgid / nig, fm = gid * WGM, gsz = (nM - fm) < WGM ? (nM - fm) : WGM;
        u.pm = fm + ((wgid % nig) % gsz); u.pn = (wgid % nig) / gsz; return true;
    }
};

template <class Epi>
__device__ __forceinline__ void gemm_phase(LAS unsigned char* lds, const Gemm g, const StaticOrder& S, const Epi& E) {
    constexpr bool SP2 = true, ALIGN_EPI = true;
    int tid_ = threadIdx.x; asm volatile("" : "+v"(tid_));
    const int tid = tid_, wid = __builtin_amdgcn_readfirstlane(tid >> 6), lane = tid & 63, wr = wid >> 2, wc = wid & 3, fr = lane & 15, fq = lane >> 4;
    int K_ = g.K; asm volatile("" : "+s"(K_)); const int K = K_, nt = K / BK;
    unsigned voffA[2], voffB[2];
#pragma unroll
    for (int i = 0; i < 2; ++i) { int R, C; stage_rc(tid * 16 + i * 8192, R, C); const int Rb = Epi::PERM ? ((R & ~31) + perm32(R & 31)) : R;
        const int Ra = g.a_seg ? (128 * (R >> 6) + 8 * (R & 15) + ((R >> 4) & 3)) : R;
        voffA[i] = (unsigned)(Ra * g.lda + C) * 2u; voffB[i] = (unsigned)(Rb * g.ldb + C) * 2u; }
    const size_t kstep = (size_t)(BK * 2);
    const size_t hstepA = g.hA, hstepB = g.hB;
    const unsigned ldsw = (unsigned)wid * 1024u;
    const int aoff = lds_byte(wr * 64 + fr, fq * 8), boff = lds_byte(wc * 32 + fr, fq * 8);
#define PG8_SA(b, h) (((b) * 2 + (h)) * HTB)
#define PG8_SB(b, h) ((4 + (b) * 2 + (h)) * HTB)
#define PG8_STAGE(bufoff, gbase, voff) do { _Pragma("unroll") for (int _i = 0; _i < 2; ++_i) \
        __builtin_amdgcn_global_load_lds((const unsigned*)((const char*)(gbase) + (voff)[_i]), (LAS unsigned*)(lds + (bufoff) + ldsw + _i * 8192), 16, 0, 0); } while (0)
#define PG8_LDA(dst, b, h) do { _Pragma("unroll") for (int m = 0; m < 4; ++m) _Pragma("unroll") for (int k = 0; k < 2; ++k) dst[m][k] = *(const LAS bf16x8*)(lds + PG8_SA(b, h) + aoff + m * 2048 + k * 1024); } while (0)
#define PG8_LDB(dst, b, h) do { _Pragma("unroll") for (int n = 0; n < 2; ++n) _Pragma("unroll") for (int k = 0; k < 2; ++k) dst[n][k] = *(const LAS bf16x8*)(lds + PG8_SB(b, h) + boff + n * 2048 + k * 1024); } while (0)
#define PG8_MMA(ai, bj, At, Bt) do { __builtin_amdgcn_s_setprio(1); _Pragma("unroll") for (int m = 0; m < 4; ++m) _Pragma("unroll") for (int n = 0; n < 2; ++n) _Pragma("unroll") for (int k = 0; k < 2; ++k) \
        acc[ai][bj][m][n] = __builtin_amdgcn_mfma_f32_16x16x32_bf16(Bt[n][k], At[m][k], acc[ai][bj][m][n], 0, 0, 0); __builtin_amdgcn_s_setprio(0); } while (0)
#define PG8_WAIT_V(n) asm volatile("s_waitcnt vmcnt(" #n ")" ::: "memory")
#define PG8_WAIT_L(n) asm volatile("s_waitcnt lgkmcnt(" #n ")" ::: "memory")
#define PG8_BAR __builtin_amdgcn_s_barrier()
#define PG8_SCHED __builtin_amdgcn_sched_barrier(0)
#define PG8_APTR(u) ((const char*)g.A + (size_t)(u).pm * g.tA + (size_t)((u).pn >> g.a_pn_shift) * g.a_pn_step)
#define PG8_BPTR(u) ((const char*)g.Bt + (size_t)(u).pn * g.tB)
    Unit cur, nxt; int ui = 0;
    if (!S.next(0, cur)) return;
    f32x4 acc[2][2][4][2];
#pragma unroll
    for (int a = 0; a < 2; ++a)
#pragma unroll
        for (int b = 0; b < 2; ++b)
#pragma unroll
            for (int m = 0; m < 4; ++m)
#pragma unroll
                for (int n = 0; n < 2; ++n) acc[a][b][m][n] = (f32x4){0.f, 0.f, 0.f, 0.f};
    bf16x8 At[4][2], B0[2][2], B1[2][2];
    const char* cA = PG8_APTR(cur); const char* cB = PG8_BPTR(cur);
    {
        PG8_STAGE(PG8_SB(0, 0), cB, voffB); PG8_STAGE(PG8_SB(0, 1), cB + hstepB, voffB); PG8_STAGE(PG8_SA(0, 0), cA, voffA); PG8_STAGE(PG8_SA(0, 1), cA + hstepA, voffA);
        if (wr == 1) PG8_BAR;
        PG8_WAIT_V(2); PG8_BAR;
        PG8_STAGE(PG8_SB(1, 0), cB + kstep, voffB); PG8_STAGE(PG8_SA(1, 0), cA + kstep, voffA); PG8_STAGE(PG8_SB(1, 1), cB + hstepB + kstep, voffB);
        PG8_WAIT_V(6); PG8_BAR;
    }
    for (;;) {
        const bool has_next = S.next(ui + 1, nxt);
        const char* nA = has_next ? PG8_APTR(nxt) : cA; const char* nB = has_next ? PG8_BPTR(nxt) : cB;
        for (int t = 0; t < nt; t += 2) {
            const bool last = (t == nt - 2);
            const char* a1 = cA + (size_t)(t + 1) * kstep;
            const char* a2 = last ? nA : cA + (size_t)(t + 2) * kstep; const char* b2 = last ? nB : cB + (size_t)(t + 2) * kstep;
            const char* a3 = a2 + kstep; const char* b3 = b2 + kstep;
            PG8_LDB(B0, 0, 0); PG8_LDB(B1, 0, 1); PG8_SCHED; PG8_LDA(At, 0, 0); PG8_STAGE(PG8_SA(1, 1), a1 + hstepA, voffA);
            PG8_WAIT_V(8); PG8_WAIT_L(0); PG8_BAR; PG8_MMA(0, 0, At, B0); PG8_MMA(0, 1, At, B1); PG8_BAR; PG8_SCHED;
            PG8_LDA(At, 0, 1); PG8_STAGE(PG8_SB(0, 0), b2, voffB); PG8_STAGE(PG8_SB(0, 1), b2 + hstepB, voffB); PG8_STAGE(PG8_SA(0, 0), a2, voffA);
            PG8_WAIT_V(8); PG8_WAIT_L(0); PG8_BAR; PG8_MMA(1, 0, At, B0); PG8_MMA(1, 1, At, B1); PG8_BAR; PG8_SCHED;
            PG8_LDB(B0, 1, 0); PG8_LDB(B1, 1, 1); PG8_SCHED; PG8_LDA(At, 1, 0); PG8_STAGE(PG8_SA(0, 1), a2 + hstepA, voffA);
            PG8_WAIT_V(8); PG8_WAIT_L(0); PG8_BAR; PG8_MMA(0, 0, At, B0); PG8_MMA(0, 1, At, B1); PG8_BAR; PG8_SCHED;
            PG8_LDA(At, 1, 1); PG8_STAGE(PG8_SB(1, 0), b3, voffB); PG8_STAGE(PG8_SB(1, 1), b3 + hstepB, voffB); PG8_STAGE(PG8_SA(1, 0), a3, voffA);
            PG8_WAIT_V(8); PG8_WAIT_L(0); PG8_BAR; PG8_MMA(1, 0, At, B0); PG8_MMA(1, 1, At, B1); PG8_BAR; PG8_SCHED;
        }
        if constexpr (ALIGN_EPI) { if (wr == 0) PG8_BAR; }
        if constexpr (!Epi::AFTER_DRAIN) E(acc, cur, wr, wc, fr, fq);
        if (!has_next) break;
#pragma unroll
        for (int a = 0; a < 2; ++a)
#pragma unroll
            for (int b = 0; b < 2; ++b)
#pragma unroll
                for (int m = 0; m < 4; ++m)
#pragma unroll
                    for (int n = 0; n < 2; ++n) acc[a][b][m][n] = (f32x4){0.f, 0.f, 0.f, 0.f};
        cur = nxt; cA = nA; cB = nB; ++ui;
        if constexpr (ALIGN_EPI) { if (wr == 1) PG8_BAR; }
    }
    PG8_WAIT_V(0);
    if constexpr (!ALIGN_EPI) { if (wr == 0) PG8_BAR; }
    PG8_BAR;
    if constexpr (Epi::AFTER_DRAIN) E.fused(acc, cur, wr, wc, fr, fq, lds, wid, lane);
#undef PG8_SA
#undef PG8_SB
#undef PG8_STAGE
#undef PG8_LDA
#undef PG8_LDB
#undef PG8_MMA
#undef PG8_WAIT_V
#undef PG8_WAIT_L
#undef PG8_BAR
#undef PG8_SCHED
#undef PG8_APTR
#undef PG8_BPTR
}
}
constexpr int TH = 16384;
constexpr int DM = 1024, ZP = 2304, DFF = 4096, TQ = 8192;
constexpr size_t MiB = 1u << 20;
constexpr size_t WS_RSQ = 0, WS_RSKV = 64 * 1024, WS_ROPE = 128 * 1024;
constexpr size_t WS_AGG = 5 * MiB;
constexpr size_t WS_CARRY = 9 * MiB;
constexpr size_t WS_XBUF = 1 * MiB;
constexpr size_t WS_SQP = 1 * MiB + 512 * 1024;
constexpr size_t WS_CNT = 3 * MiB;
constexpr size_t WS_BAR = 4 * MiB;
constexpr size_t WS_YB = 5 * MiB;
constexpr size_t WS_W_INATT = 13 * MiB;
constexpr size_t WS_W_UQ = WS_W_INATT + (size_t)2304 * 1024 * 2;
constexpr size_t WS_W_UKV = WS_W_UQ + (size_t)768 * 384 * 2;
constexpr size_t WS_W_OUTATT = WS_W_UKV + (size_t)1024 * 256 * 2;
constexpr size_t WS_W_INREC = WS_W_OUTATT + 2 * MiB;
constexpr size_t WS_W_GATES = WS_W_INREC + 4 * MiB;
constexpr size_t WS_W_OUTREC = WS_W_GATES + 1 * MiB;
constexpr size_t WS_W_UP = WS_W_OUTREC + 2 * MiB;
constexpr size_t WS_W_DOWN = WS_W_UP + 32 * MiB;
constexpr size_t WS_W_END = WS_W_DOWN + 16 * MiB;
static_assert(WS_W_END <= 76 * MiB, "weights");
constexpr size_t WS_XN = 76 * MiB;
constexpr size_t WS_BIG = 108 * MiB;
constexpr size_t WS_Z = WS_BIG;
constexpr size_t WS_Q = WS_Z + 72 * MiB;
constexpr size_t WS_KN = WS_Q + 24 * MiB;
constexpr size_t WS_VTM = WS_KN + 16 * MiB;
constexpr size_t WS_VTN = WS_VTM + 16 * MiB;
constexpr size_t WS_KPE = WS_VTN + 16 * MiB;
static_assert(WS_KPE + 1 * MiB <= 256 * MiB, "L0 overlay");
constexpr size_t WS_ACT = WS_BIG;
constexpr size_t WS_GATE = WS_BIG;
constexpr size_t WS_XB = WS_BIG + 32 * MiB;
constexpr size_t WS_XBR = WS_BIG + 64 * MiB;
constexpr size_t WS_GQ = WS_XBR;
constexpr size_t WS_END = 256 * MiB;

using pg8::Unit;

struct EpiBf16 {
    static constexpr bool PERM = true, AFTER_DRAIN = false;
    bf16_t* O; int ldc; int split_cols; size_t split_stride;
    __device__ __forceinline__ void operator()(f32x4 (&acc)[2][2][4][2], const Unit& u, int wr, int wc, int fr, int fq) const {
        const int row0 = u.pm * 256 + wr * 64 + fr; int colt = u.pn * 256; bf16_t* base = O;
        if (split_cols) { const int t = colt / split_cols; base += (size_t)t * split_stride; colt -= t * split_cols; }
        const int col0 = colt + wc * 32 + 8 * fq;
#pragma unroll
        for (int ai = 0; ai < 2; ++ai)
#pragma unroll
            for (int m = 0; m < 4; ++m) { bf16_t* rowp = base + (size_t)(row0 + ai * 128 + m * 16) * ldc + col0;
#pragma unroll
                for (int bj = 0; bj < 2; ++bj) { const f32x4 v0 = acc[ai][bj][m][0], v1 = acc[ai][bj][m][1];
                    u32x4 w; w.x = cvt_pk_bf16(v0[0], v0[1]); w.y = cvt_pk_bf16(v0[2], v0[3]); w.z = cvt_pk_bf16(v1[0], v1[1]); w.w = cvt_pk_bf16(v1[2], v1[3]);
                    *(u32x4*)(rowp + bj * 128) = w; } }
    }
};

struct EpiZ {
    static constexpr bool PERM = true, AFTER_DRAIN = false;
    bf16_t* Z; bf16_t* VTn; float* SQ; float* SKV; bf16_t* KPE; const float2* rope; int smask;
    __device__ __forceinline__ void operator()(f32x4 (&acc)[2][2][4][2], const Unit& u, int wr, int wc, int fr, int fq) const {
        const int lane = fq * 16 + fr;
        const int row0 = u.pm * 256 + wr * 64 + fr; const int col0 = u.pn * 256 + wc * 32 + 8 * fq;
#pragma unroll
        for (int ai = 0; ai < 2; ++ai)
#pragma unroll
            for (int m = 0; m < 4; ++m) { const int row = row0 + ai * 128 + m * 16; bf16_t* rowp = Z + (size_t)row * ZP + col0;
#pragma unroll
                for (int bj = 0; bj < 2; ++bj) { const f32x4 v0 = acc[ai][bj][m][0], v1 = acc[ai][bj][m][1];
                    u32x4 w; w.x = cvt_pk_bf16(v0[0], v0[1]); w.y = cvt_pk_bf16(v0[2], v0[3]); w.z = cvt_pk_bf16(v1[0], v1[1]); w.w = cvt_pk_bf16(v1[2], v1[3]);
                    *(u32x4*)(rowp + bj * 128) = w;
                    const int c = col0 + bj * 128; const int g32 = (u.pn * 256 + bj * 128 + wc * 32) >> 5;
                    if (g32 < 20) {
                        float s = (v0[0] * v0[0] + v0[1] * v0[1]) + (v0[2] * v0[2] + v0[3] * v0[3]) + ((v1[0] * v1[0] + v1[1] * v1[1]) + (v1[2] * v1[2] + v1[3] * v1[3]));
                        s += bperm_f(lane ^ 16, s); s += bperm_f(lane ^ 32, s);
                        if (fq == 0) SQ[(size_t)row * 20 + g32] = s;
                    } else if (g32 == 20) {
                        const float2* rp = rope + (size_t)(row & smask) * 16 + 8 * (fq & 1);
                        float o[8];
#pragma unroll
                        for (int k = 0; k < 8; ++k) { const float mine = k < 4 ? v0[k] : v1[k - 4]; const float other = bperm_f(lane ^ 32, mine); const float2 cs = rp[k];
                            o[k] = fq < 2 ? mine * cs.x - other * cs.y : mine * cs.x + other * cs.y; }
                        u32x4 wk; wk.x = cvt_pk_bf16(o[0], o[1]); wk.y = cvt_pk_bf16(o[2], o[3]); wk.z = cvt_pk_bf16(o[4], o[5]); wk.w = cvt_pk_bf16(o[6], o[7]);
                        *(u32x4*)(KPE + (size_t)row * 32 + 8 * fq) = wk;
                    }
                    if (c >= 1696 && c < 2208) { bf16_t* vt = VTn + (size_t)(c - 1696) * TH + row;
                        vt[0] = (bf16_t)(w.x & 0xffffu); vt[TH] = (bf16_t)(w.x >> 16); vt[2 * TH] = (bf16_t)(w.y & 0xffffu); vt[3 * TH] = (bf16_t)(w.y >> 16);
                        vt[4 * TH] = (bf16_t)(w.z & 0xffffu); vt[5 * TH] = (bf16_t)(w.z >> 16); vt[6 * TH] = (bf16_t)(w.w & 0xffffu); vt[7 * TH] = (bf16_t)(w.w >> 16); } } }
    }
};

struct EpiQ {
    static constexpr bool PERM = false, AFTER_DRAIN = false;
    bf16_t* Q; const float* rsq; const float2* rope; int smask;
    __device__ __forceinline__ void operator()(f32x4 (&acc)[2][2][4][2], const Unit& u, int wr, int wc, int fr, int fq) const {
        const float SC = 0.10206207261596577f * 1.4426950408889634f;
        const int row0 = u.pm * 256 + wr * 64 + fr;
#pragma unroll
        for (int ai = 0; ai < 2; ++ai)
#pragma unroll
            for (int m = 0; m < 4; ++m) { const int row = row0 + ai * 128 + m * 16; float ssq = 0.f;
#pragma unroll
                for (int k = 0; k < 12; ++k) ssq += rsq[(size_t)row * 20 + k];
                const float rs = SC / sqrtf(ssq * (1.f / 384.f) + 1e-6f); const int pos = row & smask;
#pragma unroll
                for (int bj = 0; bj < 2; ++bj) { const int cg = u.pn * 256 + bj * 128 + wc * 32;
                    f32x4 v0 = acc[ai][bj][m][0] * rs, v1 = acc[ai][bj][m][1] * rs;
                    if ((cg % 96) == 64) {
                        const float2* rp = rope + (size_t)pos * 16 + 4 * fq;
#pragma unroll
                        for (int i = 0; i < 4; ++i) { const float2 cs = rp[i]; const float x1 = v0[i], x2 = v1[i]; v0[i] = x1 * cs.x - x2 * cs.y; v1[i] = x2 * cs.x + x1 * cs.y; }
                    }
                    bf16_t* p = Q + (size_t)row * 768 + cg + 4 * fq;
                    u32x2 w0; w0.x = cvt_pk_bf16(v0[0], v0[1]); w0.y = cvt_pk_bf16(v0[2], v0[3]); *(u32x2*)p = w0;
                    u32x2 w1; w1.x = cvt_pk_bf16(v1[0], v1[1]); w1.y = cvt_pk_bf16(v1[2], v1[3]); *(u32x2*)(p + 16) = w1; } }
    }
};

struct EpiKV {
    static constexpr bool PERM = true, AFTER_DRAIN = false;
    bf16_t* KN; bf16_t* VTm; const float* rskv;
    __device__ __forceinline__ void operator()(f32x4 (&acc)[2][2][4][2], const Unit& u, int wr, int wc, int fr, int fq) const {
        const int row0 = u.pm * 256 + wr * 64 + fr;
#pragma unroll
        for (int ai = 0; ai < 2; ++ai)
#pragma unroll
            for (int m = 0; m < 4; ++m) { const int row = row0 + ai * 128 + m * 16; float ssq = 0.f;
#pragma unroll
                for (int k = 12; k < 20; ++k) ssq += rskv[(size_t)row * 20 + k];
                const float rs = 1.0f / sqrtf(ssq * (1.f / 256.f) + 1e-6f);
#pragma unroll
                for (int bj = 0; bj < 2; ++bj) { const int c = u.pn * 256 + bj * 128 + wc * 32 + 8 * fq;
                    const f32x4 v0 = acc[ai][bj][m][0] * rs, v1 = acc[ai][bj][m][1] * rs;
                    u32x4 w; w.x = cvt_pk_bf16(v0[0], v0[1]); w.y = cvt_pk_bf16(v0[2], v0[3]); w.z = cvt_pk_bf16(v1[0], v1[1]); w.w = cvt_pk_bf16(v1[2], v1[3]);
                    const int h = c >> 7, j = c & 127;
                    if (j < 64) { *(u32x4*)(KN + (size_t)row * 512 + h * 64 + j) = w; }
                    else { bf16_t* vt = VTm + (size_t)(h * 64 + j - 64) * TH + row;
                        vt[0] = (bf16_t)(w.x & 0xffffu); vt[TH] = (bf16_t)(w.x >> 16); vt[2 * TH] = (bf16_t)(w.y & 0xffffu); vt[3 * TH] = (bf16_t)(w.y >> 16);
                        vt[4 * TH] = (bf16_t)(w.z & 0xffffu); vt[5 * TH] = (bf16_t)(w.z >> 16); vt[6 * TH] = (bf16_t)(w.w & 0xffffu); vt[7 * TH] = (bf16_t)(w.w >> 16); } } }
    }
};

struct EpiUp {
    static constexpr bool PERM = true, AFTER_DRAIN = false;
    bf16_t* ACT; bf16_t* YB; const float* cw; const float* cb;
    __device__ __forceinline__ void operator()(f32x4 (&acc)[2][2][4][2], const Unit& u, int wr, int wc, int fr_, int fq_) const {
        int fr = fr_, fq = fq_; asm volatile("" : "+v"(fr), "+v"(fq));
        const int lane = fq * 16 + fr;
        const int tok0 = u.pm * 256 + wr * 128 + 8 * fr;
        const int ch0 = u.pn * 128 + wc * 32 + 8 * fq;
        const int seg = u.pm * 2 + wr;
        if (fr == 0 || fr == 15) {
#pragma unroll
            for (int k = 0; k < 2; ++k) {
                const int slot = fr == 0 ? k : 2 + k;
                bf16_t* yb = YB + ((size_t)seg * 4 + slot) * 8192 + ch0;
#pragma unroll
                for (int bj = 0; bj < 2; ++bj) { const f32x4 v0 = fr == 0 ? acc[0][bj][k][0] : acc[1][bj][2 + k][0], v1 = fr == 0 ? acc[0][bj][k][1] : acc[1][bj][2 + k][1];
                    u32x4 w; w.x = cvt_pk_bf16(v0[0], v0[1]); w.y = cvt_pk_bf16(v0[2], v0[3]); w.z = cvt_pk_bf16(v1[0], v1[1]); w.w = cvt_pk_bf16(v1[2], v1[3]);
                    *(u32x4*)(yb + bj * 4096) = w; }
            }
        }
        const int src_up = (lane & ~15) | ((fr - 1) & 15), src_dn = (lane & ~15) | ((fr + 1) & 15);
#pragma unroll
        for (int n = 0; n < 2; ++n)
#pragma unroll
            for (int i = 0; i < 4; ++i) {
                float ug[8], uv[8];
#pragma unroll
                for (int bj = 0; bj < 2; ++bj) {
                    const int ch = bj * 4096 + ch0 + 4 * n + i;
                    const float w0 = cw[ch], w1 = cw[8192 + ch], w2 = cw[2 * 8192 + ch], b = cb[ch];
                    const float prev7 = bperm_f(src_up, acc[1][bj][3][n][i]);
                    const float next0 = bperm_f(src_dn, acc[0][bj][0][n][i]);
#pragma unroll
                    for (int q = 0; q < 8; ++q) {
                        const float v = acc[q >> 2][bj][q & 3][n][i];
                        const float up = q > 0 ? acc[(q - 1) >> 2][bj][(q - 1) & 3][n][i] : prev7;
                        const float dn = q < 7 ? acc[(q + 1) >> 2][bj][(q + 1) & 3][n][i] : next0;
                        const float r = w0 * up + w1 * v + w2 * dn + b;
                        if (bj == 0) ug[q] = r; else uv[q] = r;
                    }
                }
#pragma unroll
                for (int q = 0; q < 8; ++q) acc[q >> 2][0][q & 3][n][i] = gelu_tanh(ug[q]) * uv[q];
            }
#pragma unroll
        for (int ai = 0; ai < 2; ++ai)
#pragma unroll
            for (int m = 0; m < 4; ++m) { const f32x4 v0 = acc[ai][0][m][0], v1 = acc[ai][0][m][1];
                u32x4 w; w.x = cvt_pk_bf16(v0[0], v0[1]); w.y = cvt_pk_bf16(v0[2], v0[3]); w.z = cvt_pk_bf16(v1[0], v1[1]); w.w = cvt_pk_bf16(v1[2], v1[3]);
                *(u32x4*)(ACT + (size_t)(tok0 + 4 * ai + m) * DFF + ch0) = w; }
    }
};

struct EpiRms {
    static constexpr bool PERM = false, AFTER_DRAIN = true;
    float* x; bf16_t* xn; const float* gpost; const float* gnext; float* xbuf1; float* xbuf2; unsigned* cnt1; unsigned* cnt2;
    __device__ __forceinline__ void operator()(f32x4 (&)[2][2][4][2], const Unit&, int, int, int, int) const {}
    __device__ __forceinline__ void stats(const f32x4 (&v)[2][2][4][2], const Unit& u, int wr, int wc, int fr, int fq, LAS unsigned char* lds, int wid, int lane, float* xbuf, unsigned* cnt) const {
        LAS float* P = (LAS float*)lds; LAS float* Sx = (LAS float*)(lds + 4096);
#pragma unroll
        for (int ai = 0; ai < 2; ++ai)
#pragma unroll
            for (int m = 0; m < 4; ++m) { float s = 0.f;
#pragma unroll
                for (int bj = 0; bj < 2; ++bj)
#pragma unroll
                    for (int n = 0; n < 2; ++n) { const f32x4 t = v[ai][bj][m][n]; s += (t[0] * t[0] + t[1] * t[1]) + (t[2] * t[2] + t[3] * t[3]); }
                s += bperm_f(lane ^ 16, s); s += bperm_f(lane ^ 32, s);
                if (fq == 0) P[(ai * 128 + wr * 64 + m * 16 + fr) * 4 + wc] = s; }
        asm volatile("s_waitcnt lgkmcnt(0)" ::: "memory"); __builtin_amdgcn_s_barrier(); asm volatile("" ::: "memory");
        const int row = wid * 32 + (lane & 31);
        if (lane < 32) { const float t = (P[row * 4 + 0] + P[row * 4 + 1]) + (P[row * 4 + 2] + P[row * 4 + 3]);
            __hip_atomic_store(xbuf + (size_t)(u.pm * 256 + row) * 4 + u.pn, t, __ATOMIC_RELAXED, __HIP_MEMORY_SCOPE_AGENT); }
        asm volatile("s_waitcnt vmcnt(0)" ::: "memory");
        if (lane == 0) __hip_atomic_fetch_add(cnt + 64 * u.pm, 1u, __ATOMIC_RELAXED, __HIP_MEMORY_SCOPE_AGENT);
        if (wid == 0) { unsigned sp = 0;
            while ((unsigned)__builtin_amdgcn_readfirstlane(__hip_atomic_load(cnt + 64 * u.pm, __ATOMIC_RELAXED, __HIP_MEMORY_SCOPE_AGENT)) < 32u) { __builtin_amdgcn_s_sleep(2); if (++sp > (1u << 22)) break; }
            __builtin_amdgcn_fence(__ATOMIC_ACQUIRE, "agent"); }
        asm volatile("s_waitcnt vmcnt(0) lgkmcnt(0)" ::: "memory"); __builtin_amdgcn_s_barrier(); asm volatile("" ::: "memory");
        if (lane < 32) { const float* slot = xbuf + (size_t)(u.pm * 256 + row) * 4; float t = 0.f;
#pragma unroll
            for (int k = 0; k < 4; ++k) t += __hip_atomic_load(slot + k, __ATOMIC_RELAXED, __HIP_MEMORY_SCOPE_AGENT);
            Sx[row] = 1.0f / sqrtf(t * (1.f / 1024.f) + 1e-6f); }
        asm volatile("s_waitcnt lgkmcnt(0)" ::: "memory"); __builtin_amdgcn_s_barrier(); asm volatile("" ::: "memory");
    }
    __device__ __forceinline__ void fused(f32x4 (&acc)[2][2][4][2], const Unit& u, int wr, int wc, int fr, int fq, LAS unsigned char* lds, int wid, int lane) const {
        const LAS float* Sx = (const LAS float*)(lds + 4096);
        const int col0 = u.pn * 256 + wc * 32 + 4 * fq;
        stats(acc, u, wr, wc, fr, fq, lds, wid, lane, xbuf1, cnt1);
#pragma unroll
        for (int ai = 0; ai < 2; ++ai)
#pragma unroll
            for (int m = 0; m < 4; ++m) { const int r = ai * 128 + wr * 64 + m * 16 + fr; const float rs = Sx[r]; float* xr = x + (size_t)(u.pm * 256 + r) * DM + col0;
#pragma unroll
                for (int bj = 0; bj < 2; ++bj)
#pragma unroll
                    for (int n = 0; n < 2; ++n) { const f32x4 g = *(const f32x4*)(gpost + col0 + bj * 128 + n * 16); const f32x4 bs = *(const f32x4*)(xr + bj * 128 + n * 16);
                        const f32x4 o = bs + acc[ai][bj][m][n] * rs * g; acc[ai][bj][m][n] = o; *(f32x4*)(xr + bj * 128 + n * 16) = o; }
                if (m & 1) asm volatile("" ::: "memory"); }
        if (xn) {
            stats(acc, u, wr, wc, fr, fq, lds, wid, lane, xbuf2, cnt2);
#pragma unroll
            for (int ai = 0; ai < 2; ++ai)
#pragma unroll
                for (int m = 0; m < 4; ++m) { const int r = ai * 128 + wr * 64 + m * 16 + fr; const float rs = Sx[r]; bf16_t* xr = xn + (size_t)(u.pm * 256 + r) * DM + col0;
#pragma unroll
                    for (int bj = 0; bj < 2; ++bj)
#pragma unroll
                        for (int n = 0; n < 2; ++n) { const f32x4 g = *(const f32x4*)(gnext + col0 + bj * 128 + n * 16); const f32x4 o = acc[ai][bj][m][n] * rs * g;
                            u32x2 w; w.x = cvt_pk_bf16(o[0], o[1]); w.y = cvt_pk_bf16(o[2], o[3]); *(u32x2*)(xr + bj * 128 + n * 16) = w; } }
        }
    }
};
constexpr float EPS = 1e-6f;
constexpr float LOG2E = 1.4426950408889634f;

__device__ __forceinline__ void transpose_item(const float* W, int K, int N, bf16_t* WT, int row_off, const float* kscale, LAS float* scr, int item, int lane) {
    const int nblk = N / 32, kb = item / nblk, nb = item % nblk, k0 = 64 * kb, n0 = 32 * nb;
#pragma unroll 8
    for (int i = 0; i < 32; ++i) { const int kk = 2 * i + (lane >> 5); float v = W[(size_t)(k0 + kk) * N + n0 + (lane & 31)]; if (kscale) v *= kscale[k0 + kk]; scr[kk * 33 + (lane & 31)] = v; }
    asm volatile("s_waitcnt lgkmcnt(0)" ::: "memory");
    const int c = lane & 7;
#pragma unroll
    for (int j = 0; j < 4; ++j) { const int n = (lane >> 3) + 8 * j; const LAS float* s = scr + (8 * c) * 33 + n;
        u32x4 o; o.x = cvt_pk_bf16(s[0 * 33], s[1 * 33]); o.y = cvt_pk_bf16(s[2 * 33], s[3 * 33]); o.z = cvt_pk_bf16(s[4 * 33], s[5 * 33]); o.w = cvt_pk_bf16(s[6 * 33], s[7 * 33]);
        *(u32x4*)(WT + (size_t)(row_off + n0 + n) * K + k0 + 8 * c) = o; }
    asm volatile("s_waitcnt lgkmcnt(0)" ::: "memory");
}

__device__ __forceinline__ void xn_row(const float* xrow, const float* gain, bf16_t* orow, int lane) {
    const f32x4* xr = (const f32x4*)xrow + lane; const f32x4* gr = (const f32x4*)gain + lane;
    f32x4 v[4]; float s = 0.f;
#pragma unroll
    for (int j = 0; j < 4; ++j) { v[j] = xr[64 * j]; s += (v[j].x * v[j].x + v[j].y * v[j].y) + (v[j].z * v[j].z + v[j].w * v[j].w); }
    const float rs = 1.0f / sqrtf(wave_sum(s, lane) * (1.f / DM) + EPS);
    u32x2* o8 = (u32x2*)orow + lane;
#pragma unroll
    for (int j = 0; j < 4; ++j) { const f32x4 g = gr[64 * j]; u32x2 w; w.x = cvt_pk_bf16(v[j].x * rs * g.x, v[j].y * rs * g.y); w.y = cvt_pk_bf16(v[j].z * rs * g.z, v[j].w * rs * g.w); o8[64 * j] = w; }
}

__device__ __forceinline__ void res_row(const bf16_t* mrow, const float* xi, float* xo, const float* gpost, const float* gnext, bf16_t* xnrow, int lane) {
    const u32x2* mr = (const u32x2*)mrow + lane; const f32x4* xr = (const f32x4*)xi + lane; const f32x4* gp = (const f32x4*)gpost + lane;
    f32x4 mv[4]; float s = 0.f;
#pragma unroll
    for (int j = 0; j < 4; ++j) { const u32x2 w = mr[64 * j]; mv[j] = (f32x4){bflo(w.x), bfhi(w.x), bflo(w.y), bfhi(w.y)}; s += (mv[j].x * mv[j].x + mv[j].y * mv[j].y) + (mv[j].z * mv[j].z + mv[j].w * mv[j].w); }
    const float rs = 1.0f / sqrtf(wave_sum(s, lane) * (1.f / DM) + EPS);
    f32x4 x[4]; float s2 = 0.f;
#pragma unroll
    for (int j = 0; j < 4; ++j) { const f32x4 g = gp[64 * j]; x[j] = xr[64 * j] + mv[j] * rs * g; s2 += (x[j].x * x[j].x + x[j].y * x[j].y) + (x[j].z * x[j].z + x[j].w * x[j].w); }
    f32x4* xw = (f32x4*)xo + lane;
#pragma unroll
    for (int j = 0; j < 4; ++j) xw[64 * j] = x[j];
    if (gnext) {
        const float rs2 = 1.0f / sqrtf(wave_sum(s2, lane) * (1.f / DM) + EPS);
        const f32x4* gn = (const f32x4*)gnext + lane; u32x2* o8 = (u32x2*)xnrow + lane;
#pragma unroll
        for (int j = 0; j < 4; ++j) { const f32x4 g = gn[64 * j]; u32x2 w; w.x = cvt_pk_bf16(x[j].x * rs2 * g.x, x[j].y * rs2 * g.y); w.y = cvt_pk_bf16(x[j].z * rs2 * g.z, x[j].w * rs2 * g.w); o8[64 * j] = w; }
    }
}

#define MLA_PACK(P, B) ((u32x4){cvt_pk_bf16(P[B], P[B + 1]), cvt_pk_bf16(P[B + 2], P[B + 3]), cvt_pk_bf16(P[B + 4], P[B + 5]), cvt_pk_bf16(P[B + 6], P[B + 7])})
__device__ __forceinline__ void mla_softmax(f32x16& p0, f32x16& p1, float& m_run, float& l_run, f32x16& o0, f32x16& o1) {
    float mx = fmaxf(p0[0], p1[0]);
#pragma unroll
    for (int r = 1; r < 16; ++r) mx = fmaxf(mx, fmaxf(p0[r], p1[r]));
    mx = xor32_max(mx);
    const float m_new = fmaxf(m_run, mx), alpha = fexp2(m_run - m_new); m_run = m_new;
    p0 = p0 - m_new; p1 = p1 - m_new;
#pragma unroll
    for (int r = 0; r < 16; ++r) { p0[r] = fexp2(p0[r]); p1[r] = fexp2(p1[r]); }
    const f32x16 ps = p0 + p1;
    const float ls = ((ps[0] + ps[1]) + (ps[2] + ps[3])) + ((ps[4] + ps[5]) + (ps[6] + ps[7])) + (((ps[8] + ps[9]) + (ps[10] + ps[11])) + ((ps[12] + ps[13]) + (ps[14] + ps[15])));
    l_run = l_run * alpha + ls;
    o0 = o0 * alpha; o1 = o1 * alpha;
}
__device__ __forceinline__ void mla_store(bf16_t* orow, const f32x16& o0, const f32x16& o1, float l_run) {
    const float inv = 1.0f / xor32_sum(l_run);
#pragma unroll
    for (int rg = 0; rg < 4; ++rg) {
        u32x2 w; w.x = cvt_pk_bf16(o0[4 * rg] * inv, o0[4 * rg + 1] * inv); w.y = cvt_pk_bf16(o0[4 * rg + 2] * inv, o0[4 * rg + 3] * inv); *(u32x2*)(orow + 8 * rg) = w;
        u32x2 w2; w2.x = cvt_pk_bf16(o1[4 * rg] * inv, o1[4 * rg + 1] * inv); w2.y = cvt_pk_bf16(o1[4 * rg + 2] * inv, o1[4 * rg + 3] * inv); *(u32x2*)(orow + 32 + 8 * rg) = w2;
    }
}
__device__ __forceinline__ void mla_unit(LAS unsigned char* lds, const bf16_t* Q, const bf16_t* KN, const bf16_t* KPE, const bf16_t* VT, bf16_t* AO, int tokbase, int S, int h, int qb, int tid) {
    constexpr int KBYTES = 12288, BUF = 20480;
    const int lane = tid & 63, wid = __builtin_amdgcn_readfirstlane(tid >> 6), r32 = lane & 31, hi = lane >> 5;
    const bf16_t* ks0 = KN + (size_t)(tokbase + lane) * 512 + h * 64 + 8 * wid;
    const bf16_t* ks1 = KPE + (size_t)(tokbase + lane) * 32 + 8 * (wid & 3);
    const bf16_t* vs = VT + (size_t)(h * 64 + lane) * TH + tokbase + 8 * wid;
#define MLA_DMA(T, B) do { LAS unsigned char* sb_ = lds + (B) * BUF; \
        __builtin_amdgcn_global_load_lds((const unsigned*)(ks0 + (size_t)(T) * (64 * 512)), (LAS unsigned*)(sb_ + wid * 1024), 16, 0, 0); \
        if (wid < 4) __builtin_amdgcn_global_load_lds((const unsigned*)(ks1 + (size_t)(T) * (64 * 32)), (LAS unsigned*)(sb_ + (8 + wid) * 1024), 16, 0, 0); \
        __builtin_amdgcn_global_load_lds((const unsigned*)(vs + (size_t)(T) * 64), (LAS unsigned*)(sb_ + KBYTES + wid * 1024), 16, 0, 0); } while (0)
#define MLA_WAITBAR_KEEP() do { if (wid < 4) asm volatile("s_waitcnt vmcnt(3)" ::: "memory"); else asm volatile("s_waitcnt vmcnt(2)" ::: "memory"); \
        asm volatile("s_waitcnt lgkmcnt(0)" ::: "memory"); __builtin_amdgcn_s_barrier(); asm volatile("" ::: "memory"); } while (0)
#define MLA_WAITBAR_ALL() do { asm volatile("s_waitcnt vmcnt(0) lgkmcnt(0)" ::: "memory"); __builtin_amdgcn_s_barrier(); asm volatile("" ::: "memory"); } while (0)
    const int NT = S / 64;
    const int qtokA = tokbase + 512 * qb + 64 * wid + r32, qtokB = qtokA + 32;
    bf16x8 qa[6], qbv[6];
#pragma unroll
    for (int d0 = 0; d0 < 6; ++d0) { qa[d0] = *(const bf16x8*)(Q + (size_t)qtokA * 768 + h * 96 + 16 * d0 + 8 * hi); qbv[d0] = *(const bf16x8*)(Q + (size_t)qtokB * 768 + h * 96 + 16 * d0 + 8 * hi); }
    asm volatile("s_waitcnt vmcnt(0)" ::: "memory");
    MLA_DMA(0, 0); MLA_DMA(1, 1);
    MLA_WAITBAR_ALL();
    f32x16 oa0, oa1, ob0, ob1;
#pragma unroll
    for (int r = 0; r < 16; ++r) { oa0[r] = 0.f; oa1[r] = 0.f; ob0[r] = 0.f; ob1[r] = 0.f; }
    float ma = -1e30f, la = 0.f, mb = -1e30f, lb = 0.f;
    for (int t = 0; t < NT; ++t) {
        if (t + 2 < NT) MLA_DMA(t + 2, (t + 2) & 3);
        const LAS unsigned char* kb = lds + (t & 3) * BUF; const LAS unsigned char* vb = kb + KBYTES;
        f32x16 pa0, pa1, pb0, pb1;
#pragma unroll
        for (int r = 0; r < 16; ++r) { pa0[r] = 0.f; pa1[r] = 0.f; pb0[r] = 0.f; pb1[r] = 0.f; }
#pragma unroll
        for (int d0 = 0; d0 < 6; ++d0) {
            const bf16x8 a0 = *(const LAS bf16x8*)(kb + (2 * d0 + hi) * 1024 + r32 * 16);
            const bf16x8 a1 = *(const LAS bf16x8*)(kb + (2 * d0 + hi) * 1024 + (32 + r32) * 16);
            pa0 = __builtin_amdgcn_mfma_f32_32x32x16_bf16(a0, qa[d0], pa0, 0, 0, 0);
            pa1 = __builtin_amdgcn_mfma_f32_32x32x16_bf16(a1, qa[d0], pa1, 0, 0, 0);
            pb0 = __builtin_amdgcn_mfma_f32_32x32x16_bf16(a0, qbv[d0], pb0, 0, 0, 0);
            pb1 = __builtin_amdgcn_mfma_f32_32x32x16_bf16(a1, qbv[d0], pb1, 0, 0, 0);
        }
        mla_softmax(pa0, pa1, ma, la, oa0, oa1);
        mla_softmax(pb0, pb1, mb, lb, ob0, ob1);
#pragma unroll
        for (int ks = 0; ks < 4; ++ks) {
            const u32x4 pwa = ks == 0 ? MLA_PACK(pa0, 0) : ks == 1 ? MLA_PACK(pa0, 8) : ks == 2 ? MLA_PACK(pa1, 0) : MLA_PACK(pa1, 8);
            const u32x4 pwb = ks == 0 ? MLA_PACK(pb0, 0) : ks == 1 ? MLA_PACK(pb0, 8) : ks == 2 ? MLA_PACK(pb1, 0) : MLA_PACK(pb1, 8);
            const bf16x8 paa = __builtin_bit_cast(bf16x8, pwa), pab = __builtin_bit_cast(bf16x8, pwb);
            const LAS unsigned char* vp = vb + (2 * ks) * 1024 + r32 * 16 + 8 * hi;
            const u32x2 a_lo = *(const LAS u32x2*)(vp), a_hi = *(const LAS u32x2*)(vp + 1024);
            const u32x2 b_lo = *(const LAS u32x2*)(vp + 512), b_hi = *(const LAS u32x2*)(vp + 1024 + 512);
            const bf16x8 vf0 = __builtin_bit_cast(bf16x8, ((u32x4){a_lo.x, a_lo.y, a_hi.x, a_hi.y}));
            const bf16x8 vf1 = __builtin_bit_cast(bf16x8, ((u32x4){b_lo.x, b_lo.y, b_hi.x, b_hi.y}));
            oa0 = __builtin_amdgcn_mfma_f32_32x32x16_bf16(vf0, paa, oa0, 0, 0, 0);
            oa1 = __builtin_amdgcn_mfma_f32_32x32x16_bf16(vf1, paa, oa1, 0, 0, 0);
            ob0 = __builtin_amdgcn_mfma_f32_32x32x16_bf16(vf0, pab, ob0, 0, 0, 0);
            ob1 = __builtin_amdgcn_mfma_f32_32x32x16_bf16(vf1, pab, ob1, 0, 0, 0);
        }
        if (t & 1) MLA_WAITBAR_ALL();
    }
#undef MLA_DMA
#undef MLA_WAITBAR_KEEP
#undef MLA_WAITBAR_ALL
    mla_store(AO + (size_t)qtokA * 1024 + h * 64 + 4 * hi, oa0, oa1, la);
    mla_store(AO + (size_t)qtokB * 1024 + h * 64 + 4 * hi, ob0, ob1, lb);
}

__device__ __forceinline__ unsigned na_vmask(int qc, int kh, int hi) {
    int cs = qc - 8; cs = cs < 0 ? 0 : cs; cs = cs > 48 ? 48 : cs; unsigned mk = 0u;
#pragma unroll
    for (int r = 0; r < 16; ++r) { const int kc = 32 * kh + (r & 3) + 8 * (r >> 2) + 4 * hi; mk |= ((kc >= cs) && (kc < cs + 16)) ? (1u << r) : 0u; }
    return mk;
}
__device__ __forceinline__ void na_qs(const bf16x8 (&kf)[4], const bf16x8 (&vf)[2][2], const bf16x8 (&qf)[4], const LAS float* brow, int qc, int kh, int hi, unsigned vmsel,
                                      float& m_run, float& l_run, f32x16& o0, f32x16& o1) {
    const float SCL = 0.125f * LOG2E;
    f32x16 p;
#pragma unroll
    for (int r = 0; r < 16; ++r) p[r] = 0.f;
#pragma unroll
    for (int d0 = 0; d0 < 4; ++d0) p = __builtin_amdgcn_mfma_f32_32x32x16_bf16(kf[d0], qf[d0], p, 0, 0, 0);
    unsigned vm = vmsel; asm volatile("" : "+v"(vm));
    float mx = -1e30f;
#pragma unroll
    for (int r = 0; r < 16; ++r) { const int kc = 32 * kh + (r & 3) + 8 * (r >> 2) + 4 * hi;
        int bi = kc - qc + 15; bi = bi < 0 ? 0 : bi; bi = bi > 30 ? 30 : bi;
        const float sc = p[r] * SCL + brow[bi]; p[r] = ((vm >> r) & 1u) ? sc : -1e30f; mx = fmaxf(mx, p[r]); }
    mx = xor32_max(mx);
    const float m_new = fmaxf(m_run, mx), alpha = fexp2(m_run - m_new); m_run = m_new;
    const float m_use = fmaxf(m_new, -1e20f);
    float ls = 0.f;
#pragma unroll
    for (int r = 0; r < 16; ++r) { const float e = fexp2(p[r] - m_use); p[r] = e; ls += e; }
    l_run = l_run * alpha + ls;
#pragma unroll
    for (int r = 0; r < 16; ++r) { o0[r] *= alpha; o1[r] *= alpha; }
#pragma unroll
    for (int k2 = 0; k2 < 2; ++k2) {
        u32x4 pw; pw.x = cvt_pk_bf16(p[8 * k2 + 0], p[8 * k2 + 1]); pw.y = cvt_pk_bf16(p[8 * k2 + 2], p[8 * k2 + 3]); pw.z = cvt_pk_bf16(p[8 * k2 + 4], p[8 * k2 + 5]); pw.w = cvt_pk_bf16(p[8 * k2 + 6], p[8 * k2 + 7]);
        const bf16x8 pa = __builtin_bit_cast(bf16x8, pw);
        o0 = __builtin_amdgcn_mfma_f32_32x32x16_bf16(vf[0][k2], pa, o0, 0, 0, 0);
        o1 = __builtin_amdgcn_mfma_f32_32x32x16_bf16(vf[1][k2], pa, o1, 0, 0, 0);
    }
}
__device__ __forceinline__ void na_store(bf16_t* orow, const f32x16& o0, const f32x16& o1, float l_run) {
    const float l = xor32_sum(l_run); const float inv = 1.0f / l;
#pragma unroll
    for (int rg = 0; rg < 4; ++rg) {
        u32x2 w; w.x = cvt_pk_bf16(o0[4 * rg] * inv, o0[4 * rg + 1] * inv); w.y = cvt_pk_bf16(o0[4 * rg + 2] * inv, o0[4 * rg + 3] * inv); *(u32x2*)(orow + 8 * rg) = w;
        u32x2 w2; w2.x = cvt_pk_bf16(o1[4 * rg] * inv, o1[4 * rg + 1] * inv); w2.y = cvt_pk_bf16(o1[4 * rg + 2] * inv, o1[4 * rg + 3] * inv); *(u32x2*)(orow + 32 + 8 * rg) = w2;
    }
}
__device__ __forceinline__ void na_unit(const LAS float* biasT, const bf16_t* Z, const bf16_t* VTn, bf16_t* AO, int tokbase, int S, int rr, int tid) {
    const int lane = tid & 63, h = tid >> 6, r32 = lane & 31, hi = lane >> 5;
    const int rows = S / 64; int rs = rr - 4; rs = rs < 0 ? 0 : rs; rs = rs > rows - 8 ? rows - 8 : rs;
    bf16x8 qfa[4], qfb[4];
#pragma unroll
    for (int d0 = 0; d0 < 4; ++d0) { qfa[d0] = *(const bf16x8*)(Z + (size_t)(tokbase + rr * 64 + r32) * ZP + 672 + h * 64 + 16 * d0 + 8 * hi);
                                      qfb[d0] = *(const bf16x8*)(Z + (size_t)(tokbase + rr * 64 + 32 + r32) * ZP + 672 + h * 64 + 16 * d0 + 8 * hi); }
    f32x16 oa0, oa1, ob0, ob1; float ma = -1e30f, mb = -1e30f, la = 0.f, lb = 0.f;
#pragma unroll
    for (int r = 0; r < 16; ++r) { oa0[r] = 0.f; oa1[r] = 0.f; ob0[r] = 0.f; ob1[r] = 0.f; }
    const unsigned va0 = na_vmask(r32, 0, hi), va1 = na_vmask(r32, 1, hi), vb0 = na_vmask(32 + r32, 0, hi), vb1 = na_vmask(32 + r32, 1, hi);
    const bf16_t* kbase = Z + (size_t)(tokbase + rs * 64 + r32) * ZP + 672 + 512 + h * 64 + 8 * hi;
    const bf16_t* vbase0 = VTn + (size_t)(h * 64 + r32) * TH + tokbase + rs * 64 + 4 * hi;
#define NA_LOADK(KF, IT) do { const int kr_ = (IT) >> 1, kh_ = (IT) & 1; const bf16_t* kp_ = kbase + (size_t)(kr_ * 64 + kh_ * 32) * ZP; \
        _Pragma("unroll") for (int d0 = 0; d0 < 4; ++d0) KF[d0] = *(const bf16x8*)(kp_ + 16 * d0); } while (0)
#define NA_LOADV(VF, IT) do { const int kr_ = (IT) >> 1, kh_ = (IT) & 1; const bf16_t* vp0_ = vbase0 + kr_ * 64 + kh_ * 32; const bf16_t* vp1_ = vp0_ + (size_t)32 * TH; \
        _Pragma("unroll") for (int k2 = 0; k2 < 2; ++k2) { const u32x2 lo = *(const u32x2*)(vp0_ + 16 * k2), hi2 = *(const u32x2*)(vp0_ + 16 * k2 + 8); VF[0][k2] = __builtin_bit_cast(bf16x8, ((u32x4){lo.x, lo.y, hi2.x, hi2.y})); \
            const u32x2 lo1 = *(const u32x2*)(vp1_ + 16 * k2), hi3 = *(const u32x2*)(vp1_ + 16 * k2 + 8); VF[1][k2] = __builtin_bit_cast(bf16x8, ((u32x4){lo1.x, lo1.y, hi3.x, hi3.y})); } } while (0)
    bf16x8 kf[4];
    NA_LOADK(kf, 0);
#pragma unroll 1
    for (int it = 0; it < 16; ++it) {
        const int kr = it >> 1, kh = it & 1;
        const LAS float* brow = biasT + (h * 15 + (rs + kr - rr + 7)) * 31;
        bf16x8 vf[2][2], kn[4];
        NA_LOADV(vf, it);
        const int itn = it + 1 < 16 ? it + 1 : 15;
        NA_LOADK(kn, itn);
        na_qs(kf, vf, qfa, brow, r32, kh, hi, kh ? va1 : va0, ma, la, oa0, oa1);
        na_qs(kf, vf, qfb, brow, 32 + r32, kh, hi, kh ? vb1 : vb0, mb, lb, ob0, ob1);
#pragma unroll
        for (int d0 = 0; d0 < 4; ++d0) kf[d0] = kn[d0];
    }
#undef NA_LOADK
#undef NA_LOADV
    na_store(AO + (size_t)(tokbase + rr * 64 + r32) * 1024 + 512 + h * 64 + 4 * hi, oa0, oa1, la);
    na_store(AO + (size_t)(tokbase + rr * 64 + 32 + r32) * 1024 + 512 + h * 64 + 4 * hi, ob0, ob1, lb);
}
#ifndef REP_SYNC
#define REP_SYNC 1
#endif
#ifndef REP_MLA
#define REP_MLA 1
#endif
#ifndef REP_NA
#define REP_NA 1
#endif
#ifndef REP_SCAN
#define REP_SCAN 1
#endif
#ifndef REP_UP
#define REP_UP 1
#endif
#ifndef REP_PASS
#define REP_PASS 1
#endif
#ifndef REP_GEMM
#define REP_GEMM 1
#endif
#define GSYNC() do { for (int r_ = 0; r_ < REP_SYNC; ++r_) xcd_barrier((unsigned*)(ap0->ws + WS_BAR), bst); } while (0)
constexpr int LDS_BYTES = 147456;
constexpr int NTHR = 512;
struct Args { const float* in[26]; float* out; unsigned char* ws; };


#define XB_TMO      128
#define XB_XCNT(j)  (256  + 64 * (j))
#define XB_XSUB(j)  (1280 + 64 * (j))
#define XB_XGEN(j)  (2304 + 64 * (j))
#define XB_TOP      3328
#define XB_TOPGEN   3392
#define XCD_BAR_WORDS 3456
#define XB_SPIN_CAP (1u << 22)
__device__ __forceinline__ unsigned xb_ld(unsigned* p)              { return __hip_atomic_load(p, __ATOMIC_RELAXED, __HIP_MEMORY_SCOPE_AGENT); }
__device__ __forceinline__ unsigned xb_add(unsigned* p, unsigned v) { return __hip_atomic_fetch_add(p, v, __ATOMIC_RELAXED, __HIP_MEMORY_SCOPE_AGENT); }
__device__ __forceinline__ unsigned xb_xcc_id() { return (unsigned)__builtin_amdgcn_s_getreg((3 << 11) | 20) & 0xFu; }
#define XB_SPIN(cond, bar) do { unsigned _sp = 0; while (cond) { __builtin_amdgcn_s_sleep(1); \
    if ((++_sp & 255u) == 0u) { if (xb_ld(&(bar)[XB_TMO])) break; if (_sp > XB_SPIN_CAP) { atomicAdd(&(bar)[XB_TMO], 1u); break; } } } } while (0)
__device__ __forceinline__ void xcd_barrier_complete(unsigned* bar, unsigned x, unsigned& nloc, unsigned& nx) {
    const unsigned G = gridDim.x;
    unsigned sum, cnt, mine, sp = 0u;
    for (;;) {
        sum = 0u; cnt = 0u; mine = 0u;
#pragma unroll
        for (unsigned j = 0; j < 16; ++j) { const unsigned c = xb_ld(&bar[XB_XCNT(j)]); sum += c; cnt += (c > 0u) ? 1u : 0u; mine = (j == x) ? c : mine; }
        if (sum == G) break;
        __builtin_amdgcn_s_sleep(1);
        if ((++sp & 255u) == 0u) { if (xb_ld(&bar[XB_TMO])) break; if (sp > XB_SPIN_CAP) { atomicAdd(&bar[XB_TMO], 1u); break; } }
    }
    nloc = mine > 0u ? mine : 1u; nx = cnt > 0u ? cnt : 1u;
}
__device__ __forceinline__ void xcd_barrier(unsigned* bar, volatile LAS unsigned* st) {
    asm volatile("s_waitcnt vmcnt(0)" ::: "memory");
    __syncthreads();
    if (threadIdx.x == 0) {
        __builtin_amdgcn_s_waitcnt(0);
        const unsigned x = xb_xcc_id();
        unsigned nloc = st[0], nx = st[1];
        if (nloc == 0u) { xcd_barrier_complete(bar, x, nloc, nx); st[0] = nloc; st[1] = nx; }
        const unsigned old = xb_add(&bar[XB_XSUB(x)], 1u);
        const unsigned gen = old / nloc;
        if (old + 1u == (gen + 1u) * nloc) {
            __builtin_amdgcn_fence(__ATOMIC_RELEASE, "agent");
            asm volatile("s_waitcnt vmcnt(0)" ::: "memory");
            const unsigned og = xb_add(&bar[XB_TOP], 1u);
            const unsigned tg = og / nx;
            if (og + 1u == (tg + 1u) * nx) xb_add(&bar[XB_TOPGEN], 1u);
            else XB_SPIN(xb_ld(&bar[XB_TOPGEN]) == tg, bar);
            __builtin_amdgcn_fence(__ATOMIC_ACQUIRE, "agent");
            xb_add(&bar[XB_XGEN(x)], 1u);
            asm volatile("s_waitcnt vmcnt(0)" ::: "memory");
        } else {
            XB_SPIN(xb_ld(&bar[XB_XGEN(x)]) == gen, bar);
            __builtin_amdgcn_fence(__ATOMIC_ACQUIRE, "agent");
            asm volatile("s_waitcnt vmcnt(0)" ::: "memory");
        }
    }
    __syncthreads();
}

__device__ __forceinline__ void lru_ab(float ga, float gx, float gab, float gxb, float spl  , float xb, float& a, float& b) {
    const float r = sigmoidf_(ga + gab), ii = sigmoidf_(gx + gxb);
    const float la2 = (-8.0f * LOG2E) * r * spl;
    a = fexp2(la2);
    const float om = 1.0f - a * a;
    b = __builtin_amdgcn_sqrtf(om) * (ii * xb);
}

__global__ void __launch_bounds__(NTHR, 2) mk_fwd(Args a) {
    extern __shared__ __attribute__((aligned(16))) unsigned char lds_raw[];
    LAS unsigned char* lds = (LAS unsigned char*)lds_raw;
    cg::grid_group grid = cg::this_grid();
    volatile LAS unsigned* bst = (volatile LAS unsigned*)(lds + LDS_BYTES - 64);
    if (threadIdx.x == 0) { bst[0] = 0u; bst[1] = 0u; }
    typedef const __attribute__((address_space(4))) Args* ArgP;
    ArgP ap0 = (ArgP)__builtin_amdgcn_kernarg_segment_ptr();
#define PH_BEGIN ArgP ap = ap0; asm volatile("" : "+s"(ap)); unsigned char* ws = ap->ws; (void)ws; int tid_ = threadIdx.x; asm volatile("" : "+v"(tid_)); const int tid = tid_, lane = tid & 63, wave = tid >> 6; int G_ = gridDim.x, bid_ = blockIdx.x; asm volatile("" : "+s"(G_), "+s"(bid_)); const int G = G_, bid = bid_; const int gw = bid * 8 + wave, NGW = G * 8; const int gt = bid * NTHR + tid, NGT = G * NTHR; (void)lane; (void)gw; (void)NGW; (void)gt; (void)NGT;
#define IN(k) (ap->in[k])
#define rsq ((float*)(ws + WS_RSQ))
#define rskv ((float*)(ws + WS_RSKV))
#define rope ((float2*)(ws + WS_ROPE))
#define AGG ((float2*)(ws + WS_AGG))
#define CARRY ((float*)(ws + WS_CARRY))
#define YB ((bf16_t*)(ws + WS_YB))
#define W_INATT ((bf16_t*)(ws + WS_W_INATT))
#define W_UQ ((bf16_t*)(ws + WS_W_UQ))
#define W_UKV ((bf16_t*)(ws + WS_W_UKV))
#define W_OUTATT ((bf16_t*)(ws + WS_W_OUTATT))
#define W_INREC ((bf16_t*)(ws + WS_W_INREC))
#define W_GATES ((bf16_t*)(ws + WS_W_GATES))
#define W_OUTREC ((bf16_t*)(ws + WS_W_OUTREC))
#define W_UP ((bf16_t*)(ws + WS_W_UP))
#define W_DOWN ((bf16_t*)(ws + WS_W_DOWN))
#define XN ((bf16_t*)(ws + WS_XN))
#define Zb ((bf16_t*)(ws + WS_Z))
#define Qb ((bf16_t*)(ws + WS_Q))
#define KN ((bf16_t*)(ws + WS_KN))
#define VTM ((bf16_t*)(ws + WS_VTM))
#define VTN ((bf16_t*)(ws + WS_VTN))
#define KPE ((bf16_t*)(ws + WS_KPE))
#define ACT ((bf16_t*)(ws + WS_ACT))
#define GATE ((bf16_t*)(ws + WS_GATE))
#define XB ((bf16_t*)(ws + WS_XB))
#define XBR ((bf16_t*)(ws + WS_XBR))
#define GQ ((bf16_t*)(ws + WS_GQ))
#define AO XN
#define Fb XN
#define YR XN
#define M0 Zb
#define M1 XBR
#define XIN (IN(half))
#define XST (ap->out + (size_t)half * TH * DM)
    { PH_BEGIN
    {
        LAS float* scr = (LAS float*)(lds + wave * 16384);
        constexpr int I_INATT = 16 * 69, I_UQ = 6 * 24, I_UKV = 4 * 32, I_SQ = 16 * 32, I_INREC = 16 * 64, I_UP = 16 * 256, I_DOWN = 64 * 32, I_GATE = 32 * 8;
        constexpr int NITEMS = I_INATT + I_UQ + I_UKV + 2 * I_SQ + I_INREC + 2 * I_UP + 2 * I_DOWN + I_GATE;
        for (int rep_ = 0; rep_ < REP_PASS; ++rep_)
        for (int it = gw; it < NITEMS; it += NGW) {
            int r = it;
            if (r < I_INATT) { transpose_item(IN(6), 1024, 2208, W_INATT, 0, nullptr, scr, r, lane); continue; } r -= I_INATT;
            if (r < I_UQ) { transpose_item(IN(8), 384, 768, W_UQ, 0, IN(7), scr, r, lane); continue; } r -= I_UQ;
            if (r < I_UKV) { transpose_item(IN(10), 256, 1024, W_UKV, 0, IN(9), scr, r, lane); continue; } r -= I_UKV;
            if (r < I_SQ) { transpose_item(IN(12), 1024, 1024, W_OUTATT, 0, nullptr, scr, r, lane); continue; } r -= I_SQ;
            if (r < I_SQ) { transpose_item(IN(21), 1024, 1024, W_OUTREC, 0, nullptr, scr, r, lane); continue; } r -= I_SQ;
            if (r < I_INREC) { transpose_item(IN(13), 1024, 2048, W_INREC, 0, nullptr, scr, r, lane); continue; } r -= I_INREC;
            if (r < 2 * I_UP) { const int li = r / I_UP; transpose_item(IN(22) + (size_t)li * 1024 * 8192, 1024, 8192, W_UP + (size_t)li * 8192 * 1024, 0, nullptr, scr, r % I_UP, lane); continue; } r -= 2 * I_UP;
            if (r < 2 * I_DOWN) { const int li = r / I_DOWN; transpose_item(IN(25) + (size_t)li * 4096 * 1024, 4096, 1024, W_DOWN + (size_t)li * 1024 * 4096, 0, nullptr, scr, r % I_DOWN, lane); continue; } r -= 2 * I_DOWN;
            { const int mat = r / 8, sub = r % 8; const int type = mat >> 4, e = (mat >> 3) & 1, n = mat & 7;
              transpose_item(IN(type ? 18 : 16) + (size_t)(e * 8 + n) * 128 * 128, 128, 128, W_GATES, n * 512 + (type * 2 + e) * 128, nullptr, scr, sub, lane); }
        }
        if (bid == 0) for (int i = tid; i < XCD_BAR_WORDS; i += NTHR) ((unsigned*)(ws + WS_BAR))[i] = 0u;
        for (int i = gt; i < 8 * 64 * 64; i += NGT) ((unsigned*)(ws + WS_CNT))[i] = 0u;
        for (int i = gt; i < 96 * 1024 / 8; i += NGT) ((u32x4*)(W_INATT + (size_t)2208 * 1024))[i] = (u32x4){0, 0, 0, 0};
        for (int m = gw; m < TH; m += NGW) xn_row(IN(0) + (size_t)m * DM, IN(2), XN + (size_t)m * DM, lane);
        for (int i = gt; i < 4096 * 16; i += NGT) { const int pos = i >> 4, j = i & 15;
            const double inv = exp2(-(double)j * (13.287712379549449 / 16.0));
            const double rev = (double)pos * inv * 0.15915494309189535; const float fr = (float)(rev - floor(rev));
            rope[i] = make_float2(__builtin_amdgcn_cosf(fr), __builtin_amdgcn_sinf(fr)); }
    }

    }
    grid.sync();
    if (threadIdx.x == 0) (void)xb_add((unsigned*)(ap0->ws + WS_BAR) + XB_XCNT(xb_xcc_id()), 1u);
    for (int half = 0; half < 2; ++half) {
        const int S = half ? 4096 : 2048, nseq = TH / S;
        if (half == 1 && gridDim.x != 256) {
                { PH_BEGIN
        for (int m = gw; m < TH; m += NGW) xn_row(XIN + (size_t)m * DM, IN(2), XN + (size_t)m * DM, lane);
        }
        GSYNC();
        }
        { PH_BEGIN
        { pg8::Gemm g = pg8::make_gemm(XN, DM, W_INATT, DM, DM); pg8::StaticOrder so; so.init(TH / 256, ZP / 256, G, bid);
          EpiZ E{Zb, VTN, (float*)(ws + WS_SQP), nullptr, KPE, rope, S - 1};
#ifndef NO_G1
for (int rep_ = 0; rep_ < REP_GEMM; ++rep_) pg8::gemm_phase<EpiZ>(lds, g, so, E);
#endif
 }
        }
        GSYNC();
        { PH_BEGIN
        { pg8::Gemm g = pg8::make_gemm(Zb, ZP, W_UQ, 384, 384); pg8::StaticOrder so; so.init(TH / 256, 3, G, bid);
          EpiQ E{Qb, (const float*)(ws + WS_SQP), rope, S - 1};
#ifndef NO_G2
for (int rep_ = 0; rep_ < REP_GEMM; ++rep_) pg8::gemm_phase<EpiQ>(lds, g, so, E);
#endif
 }
        { pg8::Gemm g = pg8::make_gemm(Zb + 384, ZP, W_UKV, 256, 256); pg8::StaticOrder so; so.init(TH / 256, 4, G, bid);
          EpiKV E{KN, VTM, (const float*)(ws + WS_SQP)};
#ifndef NO_G3
for (int rep_ = 0; rep_ < REP_GEMM; ++rep_) pg8::gemm_phase<EpiKV>(lds, g, so, E);
#endif
 }
        }
        GSYNC();
        { PH_BEGIN
        {
            LAS float* biasT = (LAS float*)(lds + 98304);
            for (int i = tid; i < 8 * 15 * 31; i += NTHR) biasT[i] = IN(11)[i] * LOG2E;
            __syncthreads();
            const int nqb = S / 512, nunits = nseq * 8 * nqb;
            const int vb = (G % 8 == 0) ? (bid % 8) * (G / 8) + bid / 8 : bid;
#ifdef DELAY_P4A
        { const unsigned long long t0_ = __builtin_amdgcn_s_memrealtime(); while (__builtin_amdgcn_s_memrealtime() - t0_ < 40000ull) __builtin_amdgcn_s_sleep(32); }
#endif
#ifndef NO_MLA
            for (int rep_ = 0; rep_ < REP_MLA; ++rep_) {
#ifdef REP_MLA_SYNC
            if (rep_ > 0) GSYNC();
#endif
#ifdef REP_DELAY
            if (rep_ > 0) { const unsigned long long t0_ = __builtin_amdgcn_s_memrealtime(); while (__builtin_amdgcn_s_memrealtime() - t0_ < 40000ull) __builtin_amdgcn_s_sleep(32); continue; }
#endif
            for (int u = vb; u < nunits; u += G) { const int qb = u % nqb, h = (u / nqb) & 7, s = u / (nqb * 8);
                mla_unit(lds, Qb, KN, KPE, VTM, AO, s * S, S, h, qb, tid); }
            }
#endif
#ifdef MLA_TWICE
            for (int u = vb; u < nunits; u += G) { const int qb = u % nqb, h = (u / nqb) & 7, s = u / (nqb * 8);
                mla_unit(lds, Qb, KN, KPE, VTM, AO, s * S, S, h, qb, tid); }
#endif
            const int rows = S / 64, nna = nseq * rows;
#ifdef DELAY_P4B
        { const unsigned long long t0_ = __builtin_amdgcn_s_memrealtime(); while (__builtin_amdgcn_s_memrealtime() - t0_ < 40000ull) __builtin_amdgcn_s_sleep(32); }
#endif
#ifdef RELOAD_BIAS
            __syncthreads();
            for (int i = tid; i < 8 * 15 * 31; i += NTHR) biasT[i] = IN(11)[i] * LOG2E;
            __syncthreads();
#endif
#ifndef NO_NA
            for (int rep_ = 0; rep_ < REP_NA; ++rep_)
            for (int u = vb; u < nna; u += G) na_unit(biasT, Zb, VTN, AO, (u / rows) * S, S, u % rows, tid);
#endif
        }
        }
        GSYNC();
        { PH_BEGIN
        { pg8::Gemm g = pg8::make_gemm(AO, DM, W_OUTATT, DM, DM); pg8::StaticOrder so; so.init(TH / 256, 4, G, bid);
          EpiBf16 E{M0, DM, 0, 0};
#ifndef NO_G4
for (int rep_ = 0; rep_ < REP_GEMM; ++rep_) pg8::gemm_phase<EpiBf16>(lds, g, so, E);
#endif
 }
        }
        GSYNC();
        { PH_BEGIN
        for (int m = gw; m < TH; m += NGW) res_row(M0 + (size_t)m * DM, XIN + (size_t)m * DM, XST + (size_t)m * DM, IN(3), IN(4), XN + (size_t)m * DM, lane);
        }
        GSYNC();

        for (int li = 0; li < 2; ++li) {
            if (li == 1) {
                { PH_BEGIN
                { pg8::Gemm g = pg8::make_gemm(XN, DM, W_INREC, DM, DM); pg8::StaticOrder so; so.init(TH / 256, 8, G, bid);
                  EpiBf16 E{GATE, DM, 1024, (size_t)(WS_XBR - WS_GATE) / 2};
#ifndef NO_G5
for (int rep_ = 0; rep_ < REP_GEMM; ++rep_) pg8::gemm_phase<EpiBf16>(lds, g, so, E);
#endif
 }
                }
                GSYNC();
                { PH_BEGIN
                for (int rep_ = 0; rep_ < REP_PASS; ++rep_)
                for (int i = gt; i < TH * 128; i += NGT) { const int t = i >> 7, c8 = (i & 127) * 8; const int pos = t & (S - 1);
                    float accv[8];
#pragma unroll
                    for (int j = 0; j < 8; ++j) accv[j] = IN(15)[c8 + j];
#pragma unroll
                    for (int k = 0; k < 4; ++k) { const int p2 = pos + k - 1; if (p2 < 0 || p2 >= S) continue;
                        const u32x4 w = *(const u32x4*)(XBR + (size_t)(t + k - 1) * DM + c8); const float* cwk = IN(14) + k * 1024 + c8;
                        accv[0] += cwk[0] * bflo(w.x); accv[1] += cwk[1] * bfhi(w.x); accv[2] += cwk[2] * bflo(w.y); accv[3] += cwk[3] * bfhi(w.y);
                        accv[4] += cwk[4] * bflo(w.z); accv[5] += cwk[5] * bfhi(w.z); accv[6] += cwk[6] * bflo(w.w); accv[7] += cwk[7] * bfhi(w.w); }
                    u32x4 o; o.x = cvt_pk_bf16(accv[0], accv[1]); o.y = cvt_pk_bf16(accv[2], accv[3]); o.z = cvt_pk_bf16(accv[4], accv[5]); o.w = cvt_pk_bf16(accv[6], accv[7]);
                    *(u32x4*)(XB + (size_t)t * DM + c8) = o; }
                }
                GSYNC();
                for (int qt = 0; qt < 2; ++qt) {
                    const int t0 = qt * TQ;
                    { PH_BEGIN
                    { pg8::Gemm g = pg8::make_gemm(XB + (size_t)t0 * DM, DM, W_GATES, 128, 128); g.a_pn_shift = 1; g.a_pn_step = 256;
                      pg8::StaticOrder so; so.init(TQ / 256, 16, G, bid);
                      EpiBf16 E{GQ, 4096, 0, 0};
#ifndef NO_G6
for (int rep_ = 0; rep_ < REP_GEMM; ++rep_) pg8::gemm_phase<EpiBf16>(lds, g, so, E);
#endif
 }
                    }
                    GSYNC();
                    { PH_BEGIN
                    for (int rep_ = 0; rep_ < REP_SCAN; ++rep_)
                    for (int i = gt; i < 256 * 2 * 512; i += NGT) { const int cp = i & 511, e = (i >> 9) & 1, c = i >> 10; const int ch = 2 * cp, n = ch >> 7, d = ch & 127;
                        const float2 gab = *(const float2*)(IN(17) + e * 1024 + ch), gxb = *(const float2*)(IN(19) + e * 1024 + ch), lam = *(const float2*)(IN(20) + e * 1024 + ch);
                        const float spl0 = log1pf(expf(-lam.x)), spl1 = log1pf(expf(-lam.y));
                        float A0 = 1.f, B0 = 0.f, A1 = 1.f, B1 = 0.f;
                        const bf16_t* gq0 = GQ + (size_t)(c * 32) * 4096 + n * 512 + e * 128 + d; const bf16_t* xb0 = XB + (size_t)(t0 + c * 32) * DM + ch;
#pragma unroll 16
                        for (int s = 0; s < 32; ++s) { const int tl = e ? 31 - s : s;
                            const unsigned ga2 = *(const unsigned*)(gq0 + (size_t)tl * 4096), gx2 = *(const unsigned*)(gq0 + (size_t)tl * 4096 + 256), xb2 = *(const unsigned*)(xb0 + (size_t)tl * DM);
                            float av, bv; lru_ab(bflo(ga2), bflo(gx2), gab.x, gxb.x, spl0, bflo(xb2), av, bv); A0 *= av; B0 = av * B0 + bv;
                            lru_ab(bfhi(ga2), bfhi(gx2), gab.y, gxb.y, spl1, bfhi(xb2), av, bv); A1 *= av; B1 = av * B1 + bv; }
                        *(f32x4*)(AGG + (size_t)(c * 2 + e) * 1024 + ch) = (f32x4){A0, B0, A1, B1}; }
                    }
                    GSYNC();
                    { PH_BEGIN
                    { const int cps = S / 32, nsq = TQ / S;
                      for (int rep_ = 0; rep_ < REP_SCAN; ++rep_)
                      for (int i = gt; i < nsq * 2 * 1024; i += NGT) { const int ch = i & 1023, e = (i >> 10) & 1, sq = i >> 11;
                          float hcar = 0.f;
#pragma unroll 16
                          for (int k = 0; k < cps; ++k) { const int c = sq * cps + (e ? cps - 1 - k : k); const int idx = (c * 2 + e) * 1024 + ch;
                              CARRY[idx] = hcar; const float2 ab = AGG[idx]; hcar = ab.x * hcar + ab.y; } } }
                    }
                    GSYNC();
                    { PH_BEGIN
#ifndef NO_R6
                    for (int rep_ = 0; rep_ < REP_SCAN; ++rep_)
                    for (int i = gt; i < 256 * 512; i += NGT) { const int cp = i & 511, c = i >> 9; const int ch = 2 * cp, n = ch >> 7, d = ch & 127;
                        const float2 lam0 = *(const float2*)(IN(20) + ch), lam1 = *(const float2*)(IN(20) + 1024 + ch);
                        const float2 gab0 = *(const float2*)(IN(17) + ch), gab1 = *(const float2*)(IN(17) + 1024 + ch), gxb0 = *(const float2*)(IN(19) + ch), gxb1 = *(const float2*)(IN(19) + 1024 + ch);
                        const bf16_t* gq0 = GQ + (size_t)(c * 32) * 4096 + n * 512 + d; const bf16_t* xb0 = XB + (size_t)(t0 + c * 32) * DM + ch;
                        bf16_t* yr0 = YR + (size_t)(t0 + c * 32) * DM + ch; const bf16_t* gt0 = GATE + (size_t)(t0 + c * 32) * DM + ch;
                        unsigned hfw[32];
                        { const float spl0 = log1pf(expf(-lam0.x)), spl1 = log1pf(expf(-lam0.y));
                          const float2 hc2 = *(const float2*)(CARRY + (size_t)(c * 2 + 0) * 1024 + ch); float h0 = hc2.x, h1 = hc2.y;
#pragma unroll
                          for (int s = 0; s < 32; ++s) {
                            const unsigned ga2 = *(const unsigned*)(gq0 + (size_t)s * 4096), gx2 = *(const unsigned*)(gq0 + (size_t)s * 4096 + 256), xb2 = *(const unsigned*)(xb0 + (size_t)s * DM);
                            float av, bv; lru_ab(bflo(ga2), bflo(gx2), gab0.x, gxb0.x, spl0, bflo(xb2), av, bv); h0 = av * h0 + bv;
                            lru_ab(bfhi(ga2), bfhi(gx2), gab0.y, gxb0.y, spl1, bfhi(xb2), av, bv); h1 = av * h1 + bv;
                            hfw[s] = cvt_pk_bf16(h0, h1); } }
                        { const float spl0 = log1pf(expf(-lam1.x)), spl1 = log1pf(expf(-lam1.y));
                          const float2 hc2 = *(const float2*)(CARRY + (size_t)(c * 2 + 1) * 1024 + ch); float h0 = hc2.x, h1 = hc2.y;
#pragma unroll
                          for (int s = 31; s >= 0; --s) {
                            const unsigned ga2 = *(const unsigned*)(gq0 + (size_t)s * 4096 + 128), gx2 = *(const unsigned*)(gq0 + (size_t)s * 4096 + 384), xb2 = *(const unsigned*)(xb0 + (size_t)s * DM);
                            float av, bv; lru_ab(bflo(ga2), bflo(gx2), gab1.x, gxb1.x, spl0, bflo(xb2), av, bv); h0 = av * h0 + bv;
                            lru_ab(bfhi(ga2), bfhi(gx2), gab1.y, gxb1.y, spl1, bfhi(xb2), av, bv); h1 = av * h1 + bv;
                            const unsigned g2 = *(const unsigned*)(gt0 + (size_t)s * DM), f2 = hfw[s];
                            *(unsigned*)(yr0 + (size_t)s * DM) = cvt_pk_bf16((bflo(f2) + h0) * gelu_tanh(bflo(g2)), (bfhi(f2) + h1) * gelu_tanh(bfhi(g2))); } }
                    }
#endif
                    }
                    GSYNC();
                }
                { PH_BEGIN
                { pg8::Gemm g = pg8::make_gemm(YR, DM, W_OUTREC, DM, DM); pg8::StaticOrder so; so.init(TH / 256, 4, G, bid);
                  EpiBf16 E{M1, DM, 0, 0};
#ifndef NO_G7
for (int rep_ = 0; rep_ < REP_GEMM; ++rep_) pg8::gemm_phase<EpiBf16>(lds, g, so, E);
#endif
 }
                }
                GSYNC();
                { PH_BEGIN
                for (int m = gw; m < TH; m += NGW) res_row(M1 + (size_t)m * DM, XST + (size_t)m * DM, XST + (size_t)m * DM, IN(3) + 1024, IN(4) + 1024, XN + (size_t)m * DM, lane);
                }
                GSYNC();
            }
            { PH_BEGIN
            { pg8::Gemm g = pg8::make_gemm(XN, DM, W_UP + (size_t)li * 8192 * 1024, DM, DM);
              g.a_seg = 1; g.hA = (size_t)4 * DM * 2; g.tB = (size_t)128 * DM * 2; g.hB = (size_t)4096 * DM * 2;
              pg8::StaticOrder so; so.init(TH / 256, 32, G, bid);
#ifndef NO_UP
              EpiUp E{ACT, YB, IN(23) + (size_t)li * 3 * 8192, IN(24) + (size_t)li * 8192}; for (int rep_ = 0; rep_ < REP_UP; ++rep_) pg8::gemm_phase<EpiUp>(lds, g, so, E);
#endif
 }
            }
            GSYNC();
            { PH_BEGIN
            for (int rep_ = 0; rep_ < REP_PASS; ++rep_)
            for (int b = bid; b < 256; b += G) { const int seg = b >> 1, which = b & 1; const int t = seg * 128 + (which ? 127 : 0); const int pos = t & (S - 1);
                const float* cw = IN(23) + (size_t)li * 3 * 8192; const float* cb = IN(24) + (size_t)li * 8192;
                const bool hasp = which ? true : (pos != 0), hasn = which ? (pos != S - 1) : true;
                const bf16_t* yp = which ? YB + ((size_t)seg * 4 + 2) * 8192 : YB + ((size_t)(seg - 1) * 4 + 3) * 8192;
                const bf16_t* yc = YB + ((size_t)seg * 4 + (which ? 3 : 0)) * 8192;
                const bf16_t* yn = which ? YB + ((size_t)(seg + 1) * 4 + 0) * 8192 : YB + ((size_t)seg * 4 + 1) * 8192;
                for (int c = tid; c < 4096; c += NTHR) {
                    float u2[2];
#pragma unroll
                    for (int bj = 0; bj < 2; ++bj) { const int ch = bj * 4096 + c;
                        float r = cw[8192 + ch] * bf2f(yc[ch]) + cb[ch];
                        if (hasp) r += cw[ch] * bf2f(yp[ch]);
                        if (hasn) r += cw[2 * 8192 + ch] * bf2f(yn[ch]);
                        u2[bj] = r; }
                    ACT[(size_t)t * DFF + c] = f2bf(gelu_tanh(u2[0]) * u2[1]); } }
            }
            GSYNC();
            if (gridDim.x == 256) {
                { PH_BEGIN
                { pg8::Gemm g = pg8::make_gemm(ACT, DFF, W_DOWN + (size_t)li * 1024 * 4096, DFF, DFF); pg8::StaticOrder so; so.init(TH / 256, 4, G, bid);
                  const int use = half * 2 + li;
                  EpiRms E{XST, li == 0 ? XN : nullptr, IN(5) + li * 1024, IN(2) + 1024, (float*)(ws + WS_XBUF), (float*)(ws + WS_XBUF) + (size_t)TH * 4,
                           (unsigned*)(ws + WS_CNT) + (size_t)(use * 2) * 4096, (unsigned*)(ws + WS_CNT) + (size_t)(use * 2 + 1) * 4096};
                  pg8::gemm_phase<EpiRms>(lds, g, so, E); }
                if (half == 0 && li == 1)
                  { for (int m = gw; m < TH; m += NGW) xn_row(IN(1) + (size_t)m * DM, IN(2), XN + (size_t)m * DM, lane);
                  }
                }
                GSYNC();
            } else {
                { PH_BEGIN
                { pg8::Gemm g = pg8::make_gemm(ACT, DFF, W_DOWN + (size_t)li * 1024 * 4096, DFF, DFF); pg8::StaticOrder so; so.init(TH / 256, 4, G, bid);
                  EpiBf16 E{Fb, DM, 0, 0};
                  pg8::gemm_phase<EpiBf16>(lds, g, so, E); }
                }
                GSYNC();
                { PH_BEGIN
                for (int m = gw; m < TH; m += NGW) res_row(Fb + (size_t)m * DM, XST + (size_t)m * DM, XST + (size_t)m * DM, IN(5) + li * 1024, li == 0 ? IN(2) + 1024 : nullptr, XN + (size_t)m * DM, lane);
                }
                GSYNC();
            }
        }
    }
}

extern "C" void kernel_launch(void* const* d_in, const int* in_sizes, int n_in, void* d_out, int out_size, void* d_ws, size_t ws_size, hipStream_t stream) {
    static int grid = 0;
    if (grid == 0) {
        int dev = 0, cus = 0, per_cu = 0;
        (void)hipGetDevice(&dev);
        (void)hipDeviceGetAttribute(&cus, hipDeviceAttributeMultiprocessorCount, dev);
        (void)hipFuncSetAttribute((const void*)mk_fwd, hipFuncAttributeMaxDynamicSharedMemorySize, LDS_BYTES);
        (void)hipOccupancyMaxActiveBlocksPerMultiprocessor(&per_cu, (const void*)mk_fwd, NTHR, LDS_BYTES);
        if (per_cu < 1) per_cu = 1;
        grid = cus * per_cu;
        if (ws_size < WS_END || n_in != 26) { fprintf(stderr, "kernel_launch: unexpected ws_size %zu / n_in %d\n", ws_size, n_in); }
    }
    Args a{};
    for (int i = 0; i < 26; ++i) a.in[i] = (const float*)d_in[i];
    a.out = (float*)d_out; a.ws = (unsigned char*)d_ws;
    void* args[] = {&a};
    hipError_t e = hipLaunchCooperativeKernel((const void*)mk_fwd, dim3(grid), dim3(NTHR), args, LDS_BYTES, stream);
    if (e != hipSuccess) fprintf(stderr, "cooperative launch failed: %s (grid %d)\n", hipGetErrorString(e), grid);
}
```

```cpp
#include <hip/hip_runtime.h>
#include <hip/hip_cooperative_groups.h>
#include <cstdio>
#include <cstdint>
namespace cg = cooperative_groups;

#define LAS __attribute__((address_space(3)))
typedef unsigned short bf16_t;
typedef short bf16x8 __attribute__((ext_vector_type(8)));
typedef short s16x4 __attribute__((ext_vector_type(4)));
typedef float f32x4 __attribute__((ext_vector_type(4)));
typedef float f32x16 __attribute__((ext_vector_type(16)));
typedef unsigned u32x4 __attribute__((ext_vector_type(4)));
typedef unsigned u32x2 __attribute__((ext_vector_type(2)));

__device__ __forceinline__ unsigned cvt_pk_bf16(float lo, float hi) { unsigned r; asm volatile("v_cvt_pk_bf16_f32 %0, %1, %2" : "=v"(r) : "v"(lo), "v"(hi)); return r; }
__device__ __forceinline__ float bf2f(bf16_t v) { return __uint_as_float(((unsigned)v) << 16); }
__device__ __forceinline__ float bflo(unsigned w) { return __uint_as_float(w << 16); }
__device__ __forceinline__ float bfhi(unsigned w) { return __uint_as_float(w & 0xffff0000u); }
__device__ __forceinline__ bf16_t f2bf(float f) { return (bf16_t)(cvt_pk_bf16(f, 0.f) & 0xffffu); }
__device__ __forceinline__ float fexp2(float x) { return __builtin_amdgcn_exp2f(x); }
__device__ __forceinline__ float frcp(float x) { return __builtin_amdgcn_rcpf(x); }
__device__ __forceinline__ float gelu_tanh(float x) {
    const float u = x * (1.0f + 0.044715f * x * x) * (-2.0f * 0.7978845608028654f * 1.4426950408889634f);
    return x * frcp(1.0f + fexp2(u));
}
__device__ __forceinline__ float sigmoidf_(float x) { return frcp(1.0f + fexp2(-1.4426950408889634f * x)); }
__device__ __forceinline__ float bperm_f(int src_lane, float v) { return __int_as_float(__builtin_amdgcn_ds_bpermute(src_lane << 2, __float_as_int(v))); }
#define DPP_F(V, CTRL) __int_as_float(__builtin_amdgcn_mov_dpp(__float_as_int(V), (CTRL), 0xf, 0xf, true))
__device__ __forceinline__ float wave_sum(float v, int  ) {
    v += DPP_F(v, 0xB1);
    v += DPP_F(v, 0x4E);
    v += DPP_F(v, 0x141);
    v += DPP_F(v, 0x140);
    const int iv = __float_as_int(v);
    return (__int_as_float(__builtin_amdgcn_readlane(iv, 0)) + __int_as_float(__builtin_amdgcn_readlane(iv, 16))) + (__int_as_float(__builtin_amdgcn_readlane(iv, 32)) + __int_as_float(__builtin_amdgcn_readlane(iv, 48)));
}
__device__ __forceinline__ float xor32_max(float v) { auto rr = __builtin_amdgcn_permlane32_swap(__float_as_uint(v), __float_as_uint(v), false, false); return fmaxf(__uint_as_float(rr[0]), __uint_as_float(rr[1])); }
__device__ __forceinline__ float xor32_sum(float v) { auto rr = __builtin_amdgcn_permlane32_swap(__float_as_uint(v), __float_as_uint(v), false, false); return __uint_as_float(rr[0]) + __uint_as_float(rr[1]); }

__device__ __forceinline__ void lru_ab(float ga, float gx, float gab, float gxb, float spl  , float xb, float& a, float& b) {
    const float r = sigmoidf_(ga + gab), ii = sigmoidf_(gx + gxb);
    const float la2 = (-8.0f * 1.4426950408889634f) * r * spl;
    a = fexp2(la2);
    const float om = 1.0f - a * a;
    b = __builtin_amdgcn_sqrtf(om) * (ii * xb);
}


namespace pg8 {
constexpr int BM = 256, BK = 64, HALF = 128, HTB = HALF * BK * 2, STAGE_BYTES = 8 * HTB, NXCD = 8, WGM = 8;
__host__ __device__ __forceinline__ int lds_byte(int r, int c) { const int st = (r >> 4) * 2 + (c >> 5), rr = r & 15, cc = c & 31, ob = rr * 64 + cc * 2; return st * 1024 + (ob ^ (((ob >> 9) & 1) << 5)); }
__host__ __device__ __forceinline__ void stage_rc(int b, int& R, int& C) { const int st = b / 1024, sb = b % 1024, swz = sb ^ (((sb >> 9) & 1) << 5); R = (st >> 1) * 16 + swz / 64; C = (st & 1) * 32 + (swz % 64) / 2; }
__host__ __device__ __forceinline__ int perm32(int rho) { const int n = rho >> 4, i = rho & 15; return 8 * (i >> 2) + 4 * n + (i & 3); }

struct Unit { int pm, pn; };
struct Gemm { const bf16_t* A; const bf16_t* Bt; int lda, ldb, K; size_t tA, hA, tB, hB; int a_seg; int a_pn_shift; size_t a_pn_step; };
__device__ __forceinline__ Gemm make_gemm(const bf16_t* A, int lda, const bf16_t* Bt, int ldb, int K) {
    Gemm g; g.A = A; g.Bt = Bt; g.lda = lda; g.ldb = ldb; g.K = K; g.tA = (size_t)256 * lda * 2; g.hA = (size_t)128 * lda * 2; g.tB = (size_t)256 * ldb * 2; g.hB = (size_t)128 * ldb * 2;
    g.a_seg = 0; g.a_pn_shift = 0; g.a_pn_step = 0; return g;
}

struct StaticOrder {
    int nM, nN, nwg, G, c;
    __device__ __forceinline__ void init(int nM_, int nN_, int G_, int c_) { nM = nM_; nN = nN_; nwg = nM * nN; G = G_; c = c_; }
    __device__ __forceinline__ bool next(int i, Unit& u) const {
        const long L = (long)i * G + c; if (L >= nwg) return false;
        int wgid = (int)L; { const int q = nwg / NXCD, r = nwg % NXCD, xcd = wgid % NXCD, off = wgid / NXCD; wgid = (xcd < r ? xcd * (q + 1) : r * (q + 1) + (xcd - r) * q) + off; }
        const int nig = WGM * nN, gid = wgid / nig, fm = gid * WGM, gsz = (nM - fm) < WGM ? (nM - fm) : WGM;
        u.pm = fm + ((wgid % nig) % gsz); u.pn = (wgid % nig) / gsz; return true;
    }
};

template <class Epi>
__device__ __forceinline__ void gemm_phase(LAS unsigned char* lds, const Gemm g, const StaticOrder& S, const Epi& E) {
    constexpr bool SP2 = true, ALIGN_EPI = true;
    int tid_ = threadIdx.x; asm volatile("" : "+v"(tid_));
    const int tid = tid_, wid = __builtin_amdgcn_readfirstlane(tid >> 6), lane = tid & 63, wr = wid >> 2, wc = wid & 3, fr = lane & 15, fq = lane >> 4;
    int K_ = g.K; asm volatile("" : "+s"(K_)); const int K = K_, nt = K / BK;
    unsigned voffA[2], voffB[2];
#pragma unroll
    for (int i = 0; i < 2; ++i) { int R, C; stage_rc(tid * 16 + i * 8192, R, C); const int Rb = Epi::PERM ? ((R & ~31) + perm32(R & 31)) : R;
        const int Ra = g.a_seg ? (128 * (R >> 6) + 8 * (R & 15) + ((R >> 4) & 3)) : R;
        voffA[i] = (unsigned)(Ra * g.lda + C) * 2u; voffB[i] = (unsigned)(Rb * g.ldb + C) * 2u; }
    const size_t kstep = (size_t)(BK * 2);
    const size_t hstepA = g.hA, hstepB = g.hB;
    const unsigned ldsw = (unsigned)wid * 1024u;
    const int aoff = lds_byte(wr * 64 + fr, fq * 8), boff = lds_byte(wc * 32 + fr, fq * 8);
#define PG8_SA(b, h) (((b) * 2 + (h)) * HTB)
#define PG8_SB(b, h) ((4 + (b) * 2 + (h)) * HTB)
#define PG8_STAGE(bufoff, gbase, voff) do { _Pragma("unroll") for (int _i = 0; _i < 2; ++_i) \
        __builtin_amdgcn_global_load_lds((const unsigned*)((const char*)(gbase) + (voff)[_i]), (LAS unsigned*)(lds + (bufoff) + ldsw + _i * 8192), 16, 0, 0); } while (0)
#define PG8_LDA(dst, b, h) do { _Pragma("unroll") for (int m = 0; m < 4; ++m) _Pragma("unroll") for (int k = 0; k < 2; ++k) dst[m][k] = *(const LAS bf16x8*)(lds + PG8_SA(b, h) + aoff + m * 2048 + k * 1024); } while (0)
#define PG8_LDB(dst, b, h) do { _Pragma("unroll") for (int n = 0; n < 2; ++n) _Pragma("unroll") for (int k = 0; k < 2; ++k) dst[n][k] = *(const LAS bf16x8*)(lds + PG8_SB(b, h) + boff + n * 2048 + k * 1024); } while (0)
#define PG8_MMA(ai, bj, At, Bt) do { __builtin_amdgcn_s_setprio(1); _Pragma("unroll") for (int m = 0; m < 4; ++m) _Pragma("unroll") for (int n = 0; n < 2; ++n) _Pragma("unroll") for (int k = 0; k < 2; ++k) \
        acc[ai][bj][m][n] = __builtin_amdgcn_mfma_f32_16x16x32_bf16(Bt[n][k], At[m][k], acc[ai][bj][m][n], 0, 0, 0); __builtin_amdgcn_s_setprio(0); } while (0)
#define PG8_WAIT_V(n) asm volatile("s_waitcnt vmcnt(" #n ")" ::: "memory")
#define PG8_WAIT_L(n) asm volatile("s_waitcnt lgkmcnt(" #n ")" ::: "memory")
#define PG8_BAR __builtin_amdgcn_s_barrier()
#define PG8_SCHED __builtin_amdgcn_sched_barrier(0)
#define PG8_APTR(u) ((const char*)g.A + (size_t)(u).pm * g.tA + (size_t)((u).pn >> g.a_pn_shift) * g.a_pn_step)
#define PG8_BPTR(u) ((const char*)g.Bt + (size_t)(u).pn * g.tB)
    Unit cur, nxt; int ui = 0;
    if (!S.next(0, cur)) return;
    f32x4 acc[2][2][4][2];
#pragma unroll
    for (int a = 0; a < 2; ++a)
#pragma unroll
        for (int b = 0; b < 2; ++b)
#pragma unroll
            for (int m = 0; m < 4; ++m)
#pragma unroll
                for (int n = 0; n < 2; ++n) acc[a][b][m][n] = (f32x4){0.f, 0.f, 0.f, 0.f};
    bf16x8 At[4][2], B0[2][2], B1[2][2];
    const char* cA = PG8_APTR(cur); const char* cB = PG8_BPTR(cur);
    {
        PG8_STAGE(PG8_SB(0, 0), cB, voffB); PG8_STAGE(PG8_SB(0, 1), cB + hstepB, voffB); PG8_STAGE(PG8_SA(0, 0), cA, voffA); PG8_STAGE(PG8_SA(0, 1), cA + hstepA, voffA);
        if (wr == 1) PG8_BAR;
        PG8_WAIT_V(2); PG8_BAR;
        PG8_STAGE(PG8_SB(1, 0), cB + kstep, voffB); PG8_STAGE(PG8_SA(1, 0), cA + kstep, voffA); PG8_STAGE(PG8_SB(1, 1), cB + hstepB + kstep, voffB);
        PG8_WAIT_V(6); PG8_BAR;
    }
    for (;;) {
        const bool has_next = S.next(ui + 1, nxt);
        const char* nA = has_next ? PG8_APTR(nxt) : cA; const char* nB = has_next ? PG8_BPTR(nxt) : cB;
        for (int t = 0; t < nt; t += 2) {
            const bool last = (t == nt - 2);
            const char* a1 = cA + (size_t)(t + 1) * kstep;
            const char* a2 = last ? nA : cA + (size_t)(t + 2) * kstep; const char* b2 = last ? nB : cB + (size_t)(t + 2) * kstep;
            const char* a3 = a2 + kstep; const char* b3 = b2 + kstep;
            PG8_LDB(B0, 0, 0); PG8_LDB(B1, 0, 1); PG8_SCHED; PG8_LDA(At, 0, 0); PG8_STAGE(PG8_SA(1, 1), a1 + hstepA, voffA);
            PG8_WAIT_V(8); PG8_WAIT_L(0); PG8_BAR; PG8_MMA(0, 0, At, B0); PG8_MMA(0, 1, At, B1); PG8_BAR; PG8_SCHED;
            PG8_LDA(At, 0, 1); PG8_STAGE(PG8_SB(0, 0), b2, voffB); PG8_STAGE(PG8_SB(0, 1), b2 + hstepB, voffB); PG8_STAGE(PG8_SA(0, 0), a2, voffA);
            PG8_WAIT_V(8); PG8_WAIT_L(0); PG8_BAR; PG8_MMA(1, 0, At, B0); PG8_MMA(1, 1, At, B1); PG8_BAR; PG8_SCHED;
            PG8_LDB(B0, 1, 0); PG8_LDB(B1, 1, 1); PG8_SCHED; PG8_LDA(At, 1, 0); PG8_STAGE(PG8_SA(0, 1), a2 + hstepA, voffA);
            PG8_WAIT_V(8); PG8_WAIT_L(0); PG8_BAR; PG8_MMA(0, 0, At, B0); PG8_MMA(0, 1, At, B1); PG8_BAR; PG8_SCHED;
            PG8_LDA(At, 1, 1); PG8_STAGE(PG8_SB(1, 0), b3, voffB); PG8_STAGE(PG8_SB(1, 1), b3 + hstepB, voffB); PG8_STAGE(PG8_SA(1, 0), a3, voffA);
            PG8_WAIT_V(8); PG8_WAIT_L(0); PG8_BAR; PG8_MMA(1, 0, At, B0); PG8_MMA(1, 1, At, B1); PG8_BAR; PG8_SCHED;
        }
        if constexpr (ALIGN_EPI) { if (wr == 0) PG8_BAR; }
        if constexpr (!Epi::AFTER_DRAIN) E(acc, cur, wr, wc, fr, fq);
        if (!has_next) break;
#pragma unroll
        for (int a = 0; a < 2; ++a)
#pragma unroll
            for (int b = 0; b < 2; ++b)
#pragma unroll
                for (int m = 0; m < 4; ++m)
#pragma unroll
                    for (int n = 0; n < 2; ++n) acc[a][b][m][n] = (f32x4){0.f, 0.f, 0.f, 0.f};
        cur = nxt; cA = nA; cB = nB; ++ui;
        if constexpr (ALIGN_EPI) { if (wr == 1) PG8_BAR; }
    }
    PG8_WAIT_V(0);
    if constexpr (!ALIGN_EPI) { if (wr == 0) PG8_BAR; }
    PG8_BAR;
    if constexpr (Epi::AFTER_DRAIN) E.fused(acc, cur, wr, wc, fr, fq, lds, wid, lane);
#undef PG8_SA
#undef PG8_SB
#undef PG8_STAGE
#undef PG8_LDA
#undef PG8_LDB
#undef PG8_MMA
#undef PG8_WAIT_V
#undef PG8_WAIT_L
#undef PG8_BAR
#undef PG8_SCHED
#undef PG8_APTR
#undef PG8_BPTR
}
}
constexpr int TH = 16384;
constexpr int DM = 1024, ZP = 2304, DFF = 4096, TQ = 8192;
constexpr size_t MiB = 1u << 20;
constexpr size_t WS_RSQ = 0, WS_RSKV = 64 * 1024, WS_ROPE = 128 * 1024;
constexpr size_t WS_AGG = 5 * MiB;
constexpr size_t WS_CARRY = 9 * MiB;
constexpr size_t WS_XBUF = 1 * MiB;
constexpr size_t WS_SQP = 1 * MiB + 512 * 1024;
constexpr size_t WS_CNT = 3 * MiB;
constexpr size_t WS_BAR = 4 * MiB;
constexpr size_t WS_YB = 5 * MiB;
constexpr size_t WS_W_INATT = 13 * MiB;
constexpr size_t WS_W_UQ = WS_W_INATT + (size_t)2304 * 1024 * 2;
constexpr size_t WS_W_UKV = WS_W_UQ + (size_t)768 * 384 * 2;
constexpr size_t WS_W_OUTATT = WS_W_UKV + (size_t)1024 * 256 * 2;
constexpr size_t WS_W_INREC = WS_W_OUTATT + 2 * MiB;
constexpr size_t WS_W_GATES = WS_W_INREC + 4 * MiB;
constexpr size_t WS_W_OUTREC = WS_W_GATES + 1 * MiB;
constexpr size_t WS_W_UP = WS_W_OUTREC + 2 * MiB;
constexpr size_t WS_W_DOWN = WS_W_UP + 32 * MiB;
constexpr size_t WS_W_END = WS_W_DOWN + 16 * MiB;
static_assert(WS_W_END <= 76 * MiB, "weights");
constexpr size_t WS_XN = 76 * MiB;
constexpr size_t WS_BIG = 108 * MiB;
constexpr size_t WS_Z = WS_BIG;
constexpr size_t WS_Q = WS_Z + 72 * MiB;
constexpr size_t WS_KN = WS_Q + 24 * MiB;
constexpr size_t WS_VTM = WS_KN + 16 * MiB;
constexpr size_t WS_VTN = WS_VTM + 16 * MiB;
constexpr size_t WS_KPE = WS_VTN + 16 * MiB;
static_assert(WS_KPE + 1 * MiB <= 256 * MiB, "L0 overlay");
constexpr size_t WS_ACT = WS_BIG;
constexpr size_t WS_GATE = WS_BIG;
constexpr size_t WS_XB = WS_BIG + 32 * MiB;
constexpr size_t WS_XBR = WS_BIG + 64 * MiB;
constexpr size_t WS_GQ = WS_XBR;
constexpr size_t WS_END = 256 * MiB;

using pg8::Unit;

struct EpiBf16 {
    static constexpr bool PERM = true, AFTER_DRAIN = false;
    bf16_t* O; int ldc; int split_cols; size_t split_stride;
    __device__ __forceinline__ void operator()(f32x4 (&acc)[2][2][4][2], const Unit& u, int wr, int wc, int fr, int fq) const {
        const int row0 = u.pm * 256 + wr * 64 + fr; int colt = u.pn * 256; bf16_t* base = O;
        if (split_cols) { const int t = colt / split_cols; base += (size_t)t * split_stride; colt -= t * split_cols; }
        const int col0 = colt + wc * 32 + 8 * fq;
#pragma unroll
        for (int ai = 0; ai < 2; ++ai)
#pragma unroll
            for (int m = 0; m < 4; ++m) { bf16_t* rowp = base + (size_t)(row0 + ai * 128 + m * 16) * ldc + col0;
#pragma unroll
                for (int bj = 0; bj < 2; ++bj) { const f32x4 v0 = acc[ai][bj][m][0], v1 = acc[ai][bj][m][1];
                    u32x4 w; w.x = cvt_pk_bf16(v0[0], v0[1]); w.y = cvt_pk_bf16(v0[2], v0[3]); w.z = cvt_pk_bf16(v1[0], v1[1]); w.w = cvt_pk_bf16(v1[2], v1[3]);
                    *(u32x4*)(rowp + bj * 128) = w; } }
    }
};

struct EpiZ {
    static constexpr bool PERM = true, AFTER_DRAIN = false;
    bf16_t* Z; bf16_t* VTn; float* SQ; float* SKV; bf16_t* KPE; const float2* rope; int smask;
    __device__ __forceinline__ void operator()(f32x4 (&acc)[2][2][4][2], const Unit& u, int wr, int wc, int fr, int fq) const {
        const int lane = fq * 16 + fr;
        const int row0 = u.pm * 256 + wr * 64 + fr; const int col0 = u.pn * 256 + wc * 32 + 8 * fq;
#pragma unroll
        for (int ai = 0; ai < 2; ++ai)
#pragma unroll
            for (int m = 0; m < 4; ++m) { const int row = row0 + ai * 128 + m * 16; bf16_t* rowp = Z + (size_t)row * ZP + col0;
#pragma unroll
                for (int bj = 0; bj < 2; ++bj) { const f32x4 v0 = acc[ai][bj][m][0], v1 = acc[ai][bj][m][1];
                    u32x4 w; w.x = cvt_pk_bf16(v0[0], v0[1]); w.y = cvt_pk_bf16(v0[2], v0[3]); w.z = cvt_pk_bf16(v1[0], v1[1]); w.w = cvt_pk_bf16(v1[2], v1[3]);
                    *(u32x4*)(rowp + bj * 128) = w;
                    const int c = col0 + bj * 128; const int g32 = (u.pn * 256 + bj * 128 + wc * 32) >> 5;
                    if (g32 < 20) {
                        float s = (v0[0] * v0[0] + v0[1] * v0[1]) + (v0[2] * v0[2] + v0[3] * v0[3]) + ((v1[0] * v1[0] + v1[1] * v1[1]) + (v1[2] * v1[2] + v1[3] * v1[3]));
                        s += bperm_f(lane ^ 16, s); s += bperm_f(lane ^ 32, s);
                        if (fq == 0) SQ[(size_t)row * 20 + g32] = s;
                    } else if (g32 == 20) {
                        const float2* rp = rope + (size_t)(row & smask) * 16 + 8 * (fq & 1);
                        float o[8];
#pragma unroll
                        for (int k = 0; k < 8; ++k) { const float mine = k < 4 ? v0[k] : v1[k - 4]; const float other = bperm_f(lane ^ 32, mine); const float2 cs = rp[k];
                            o[k] = fq < 2 ? mine * cs.x - other * cs.y : mine * cs.x + other * cs.y; }
                        u32x4 wk; wk.x = cvt_pk_bf16(o[0], o[1]); wk.y = cvt_pk_bf16(o[2], o[3]); wk.z = cvt_pk_bf16(o[4], o[5]); wk.w = cvt_pk_bf16(o[6], o[7]);
                        *(u32x4*)(KPE + (size_t)row * 32 + 8 * fq) = wk;
                    }
                    if (c >= 1696 && c < 2208) { bf16_t* vt = VTn + (size_t)(c - 1696) * TH + row;
                        vt[0] = (bf16_t)(w.x & 0xffffu); vt[TH] = (bf16_t)(w.x >> 16); vt[2 * TH] = (bf16_t)(w.y & 0xffffu); vt[3 * TH] = (bf16_t)(w.y >> 16);
                        vt[4 * TH] = (bf16_t)(w.z & 0xffffu); vt[5 * TH] = (bf16_t)(w.z >> 16); vt[6 * TH] = (bf16_t)(w.w & 0xffffu); vt[7 * TH] = (bf16_t)(w.w >> 16); } } }
    }
};

struct EpiQ {
    static constexpr bool PERM = false, AFTER_DRAIN = false;
    bf16_t* Q; const float* rsq; const float2* rope; int smask;
    __device__ __forceinline__ void operator()(f32x4 (&acc)[2][2][4][2], const Unit& u, int wr, int wc, int fr, int fq) const {
        const float SC = 0.10206207261596577f * 1.4426950408889634f;
        const int row0 = u.pm * 256 + wr * 64 + fr;
#pragma unroll
        for (int ai = 0; ai < 2; ++ai)
#pragma unroll
            for (int m = 0; m < 4; ++m) { const int row = row0 + ai * 128 + m * 16; float ssq = 0.f;
#pragma unroll
                for (int k = 0; k < 12; ++k) ssq += rsq[(size_t)row * 20 + k];
                const float rs = SC / sqrtf(ssq * (1.f / 384.f) + 1e-6f); const int pos = row & smask;
#pragma unroll
                for (int bj = 0; bj < 2; ++bj) { const int cg = u.pn * 256 + bj * 128 + wc * 32;
                    f32x4 v0 = acc[ai][bj][m][0] * rs, v1 = acc[ai][bj][m][1] * rs;
                    if ((cg % 96) == 64) {
                        const float2* rp = rope + (size_t)pos * 16 + 4 * fq;
#pragma unroll
                        for (int i = 0; i < 4; ++i) { const float2 cs = rp[i]; const float x1 = v0[i], x2 = v1[i]; v0[i] = x1 * cs.x - x2 * cs.y; v1[i] = x2 * cs.x + x1 * cs.y; }
                    }
                    bf16_t* p = Q + (size_t)row * 768 + cg + 4 * fq;
                    u32x2 w0; w0.x = cvt_pk_bf16(v0[0], v0[1]); w0.y = cvt_pk_bf16(v0[2], v0[3]); *(u32x2*)p = w0;
                    u32x2 w1; w1.x = cvt_pk_bf16(v1[0], v1[1]); w1.y = cvt_pk_bf16(v1[2], v1[3]); *(u32x2*)(p + 16) = w1; } }
    }
};

struct EpiKV {
    static constexpr bool PERM = true, AFTER_DRAIN = false;
    bf16_t* KN; bf16_t* VTm; const float* rskv;
    __device__ __forceinline__ void operator()(f32x4 (&acc)[2][2][4][2], const Unit& u, int wr, int wc, int fr, int fq) const {
        const int row0 = u.pm * 256 + wr * 64 + fr;
#pragma unroll
        for (int ai = 0; ai < 2; ++ai)
#pragma unroll
            for (int m = 0; m < 4; ++m) { const int row = row0 + ai * 128 + m * 16; float ssq = 0.f;
#pragma unroll
                for (int k = 12; k < 20; ++k) ssq += rskv[(size_t)row * 20 + k];
                const float rs = 1.0f / sqrtf(ssq * (1.f / 256.f) + 1e-6f);
#pragma unroll
                for (int bj = 0; bj < 2; ++bj) { const int c = u.pn * 256 + bj * 128 + wc * 32 + 8 * fq;
                    const f32x4 v0 = acc[ai][bj][m][0] * rs, v1 = acc[ai][bj][m][1] * rs;
                    u32x4 w; w.x = cvt_pk_bf16(v0[0], v0[1]); w.y = cvt_pk_bf16(v0[2], v0[3]); w.z = cvt_pk_bf16(v1[0], v1[1]); w.w = cvt_pk_bf16(v1[2], v1[3]);
                    const int h = c >> 7, j = c & 127;
                    if (j < 64) { *(u32x4*)(KN + (size_t)row * 512 + h * 64 + j) = w; }
                    else { bf16_t* vt = VTm + (size_t)(h * 64 + j - 64) * TH + row;
                        vt[0] = (bf16_t)(w.x & 0xffffu); vt[TH] = (bf16_t)(w.x >> 16); vt[2 * TH] = (bf16_t)(w.y & 0xffffu); vt[3 * TH] = (bf16_t)(w.y >> 16);
                        vt[4 * TH] = (bf16_t)(w.z & 0xffffu); vt[5 * TH] = (bf16_t)(w.z >> 16); vt[6 * TH] = (bf16_t)(w.w & 0xffffu); vt[7 * TH] = (bf16_t)(w.w >> 16); } } }
    }
};

struct EpiUp {
    static constexpr bool PERM = true, AFTER_DRAIN = false;
    bf16_t* ACT; bf16_t* YB; const float* cw; const float* cb;
    __device__ __forceinline__ void operator()(f32x4 (&acc)[2][2][4][2], const Unit& u, int wr, int wc, int fr_, int fq_) const {
        int fr = fr_, fq = fq_; asm volatile("" : "+v"(fr), "+v"(fq));
        const int lane = fq * 16 + fr;
        const int tok0 = u.pm * 256 + wr * 128 + 8 * fr;
        const int ch0 = u.pn * 128 + wc * 32 + 8 * fq;
        const int seg = u.pm * 2 + wr;
        if (fr == 0 || fr == 15) {
#pragma unroll
            for (int k = 0; k < 2; ++k) {
                const int slot = fr == 0 ? k : 2 + k;
                bf16_t* yb = YB + ((size_t)seg * 4 + slot) * 8192 + ch0;
#pragma unroll
                for (int bj = 0; bj < 2; ++bj) { const f32x4 v0 = fr == 0 ? acc[0][bj][k][0] : acc[1][bj][2 + k][0], v1 = fr == 0 ? acc[0][bj][k][1] : acc[1][bj][2 + k][1];
                    u32x4 w; w.x = cvt_pk_bf16(v0[0], v0[1]); w.y = cvt_pk_bf16(v0[2], v0[3]); w.z = cvt_pk_bf16(v1[0], v1[1]); w.w = cvt_pk_bf16(v1[2], v1[3]);
                    *(u32x4*)(yb + bj * 4096) = w; }
            }
        }
        const int src_up = (lane & ~15) | ((fr - 1) & 15), src_dn = (lane & ~15) | ((fr + 1) & 15);
#pragma unroll
        for (int n = 0; n < 2; ++n)
#pragma unroll
            for (int i = 0; i < 4; ++i) {
                float ug[8], uv[8];
#pragma unroll
                for (int bj = 0; bj < 2; ++bj) {
                    const int ch = bj * 4096 + ch0 + 4 * n + i;
                    const float w0 = cw[ch], w1 = cw[8192 + ch], w2 = cw[2 * 8192 + ch], b = cb[ch];
                    const float prev7 = bperm_f(src_up, acc[1][bj][3][n][i]);
                    const float next0 = bperm_f(src_dn, acc[0][bj][0][n][i]);
#pragma unroll
                    for (int q = 0; q < 8; ++q) {
                        const float v = acc[q >> 2][bj][q & 3][n][i];
                        const float up = q > 0 ? acc[(q - 1) >> 2][bj][(q - 1) & 3][n][i] : prev7;
                        const float dn = q < 7 ? acc[(q + 1) >> 2][bj][(q + 1) & 3][n][i] : next0;
                        const float r = w0 * up + w1 * v + w2 * dn + b;
                        if (bj == 0) ug[q] = r; else uv[q] = r;
                    }
                }
#pragma unroll
                for (int q = 0; q < 8; ++q) acc[q >> 2][0][q & 3][n][i] = gelu_tanh(ug[q]) * uv[q];
            }
#pragma unroll
        for (int ai = 0; ai < 2; ++ai)
#pragma unroll
            for (int m = 0; m < 4; ++m) { const f32x4 v0 = acc[ai][0][m][0], v1 = acc[ai][0][m][1];
                u32x4 w; w.x = cvt_pk_bf16(v0[0], v0[1]); w.y = cvt_pk_bf16(v0[2], v0[3]); w.z = cvt_pk_bf16(v1[0], v1[1]); w.w = cvt_pk_bf16(v1[2], v1[3]);
                *(u32x4*)(ACT + (size_t)(tok0 + 4 * ai + m) * DFF + ch0) = w; }
    }
};

struct EpiGates {
    static constexpr bool PERM = true, AFTER_DRAIN = false;
    bf16_t* G; const bf16_t* XBq; float2* AGGp; const float* gab_; const float* gxb_; const float* lam_;
    __device__ __forceinline__ void operator()(f32x4 (&acc)[2][2][4][2], const Unit& u, int wr, int wc, int fr_, int fq_) const {
        int fr = fr_, fq = fq_; asm volatile("" : "+v"(fr), "+v"(fq));
        const int lane = fq * 16 + fr;
        const int nblk = u.pn >> 1, e = u.pn & 1;
        const int tl0 = u.pm * 256 + wr * 128 + 8 * fr;
        const int d0 = wc * 32 + 8 * fq, ch0 = nblk * 128 + d0;
        unsigned gaw[8][4], gxw[8][4];
#pragma unroll
        for (int ai = 0; ai < 2; ++ai)
#pragma unroll
            for (int m = 0; m < 4; ++m) { const int q = 4 * ai + m; bf16_t* rowp = G + (size_t)(tl0 + q) * 4096 + u.pn * 256 + d0;
#pragma unroll
                for (int bj = 0; bj < 2; ++bj) { const f32x4 v0 = acc[ai][bj][m][0], v1 = acc[ai][bj][m][1];
                    u32x4 w; w.x = cvt_pk_bf16(v0[0], v0[1]); w.y = cvt_pk_bf16(v0[2], v0[3]); w.z = cvt_pk_bf16(v1[0], v1[1]); w.w = cvt_pk_bf16(v1[2], v1[3]);
                    *(u32x4*)(rowp + bj * 128) = w;
                    if (bj == 0) { gaw[q][0] = w.x; gaw[q][1] = w.y; gaw[q][2] = w.z; gaw[q][3] = w.w; } else { gxw[q][0] = w.x; gxw[q][1] = w.y; gxw[q][2] = w.z; gxw[q][3] = w.w; } } }
        u32x4 xbw[8];
#pragma unroll
        for (int q = 0; q < 8; ++q) xbw[q] = *(const u32x4*)(XBq + (size_t)(tl0 + q) * DM + ch0);
        float Aagg[8], Bagg[8];
#pragma unroll
        for (int k2 = 0; k2 < 4; ++k2) {
            const float2 gab = *(const float2*)(gab_ + e * 1024 + ch0 + 2 * k2), gxb = *(const float2*)(gxb_ + e * 1024 + ch0 + 2 * k2), lam = *(const float2*)(lam_ + e * 1024 + ch0 + 2 * k2);
            const float spl0 = log1pf(expf(-lam.x)), spl1 = log1pf(expf(-lam.y));
            float A0 = 1.f, B0 = 0.f, A1 = 1.f, B1 = 0.f;
#pragma unroll
            for (int s = 0; s < 8; ++s) { const int q = e ? 7 - s : s;
                const unsigned ga2 = e ? gaw[7 - s][k2] : gaw[s][k2], gx2 = e ? gxw[7 - s][k2] : gxw[s][k2];
                const unsigned xb2 = e ? (k2 == 0 ? xbw[7 - s].x : k2 == 1 ? xbw[7 - s].y : k2 == 2 ? xbw[7 - s].z : xbw[7 - s].w) : (k2 == 0 ? xbw[s].x : k2 == 1 ? xbw[s].y : k2 == 2 ? xbw[s].z : xbw[s].w); (void)q;
                float av, bv; lru_ab(bflo(ga2), bflo(gx2), gab.x, gxb.x, spl0, bflo(xb2), av, bv); A0 *= av; B0 = av * B0 + bv;
                lru_ab(bfhi(ga2), bfhi(gx2), gab.y, gxb.y, spl1, bfhi(xb2), av, bv); A1 *= av; B1 = av * B1 + bv; }
            Aagg[2 * k2] = A0; Bagg[2 * k2] = B0; Aagg[2 * k2 + 1] = A1; Bagg[2 * k2 + 1] = B1;
        }
#pragma unroll
        for (int bit = 1; bit <= 2; bit <<= 1) {
            const bool me_first = e ? ((fr & bit) != 0) : ((fr & bit) == 0);
#pragma unroll
            for (int k = 0; k < 8; ++k) { const float Ao = bperm_f(lane ^ bit, Aagg[k]), Bo = bperm_f(lane ^ bit, Bagg[k]);
                const float An = Ao * Aagg[k], Bn = me_first ? Ao * Bagg[k] + Bo : Aagg[k] * Bo + Bagg[k];
                Aagg[k] = An; Bagg[k] = Bn; }
        }
        if ((fr & 3) == 0) { const int c = (tl0 >> 5);
            float2* dst = AGGp + (size_t)(c * 2 + e) * 1024 + ch0;
#pragma unroll
            for (int k = 0; k < 8; k += 2) *(f32x4*)(dst + k) = (f32x4){Aagg[k], Bagg[k], Aagg[k + 1], Bagg[k + 1]}; }
    }
};

struct EpiRms {
    static constexpr bool PERM = false, AFTER_DRAIN = true;
    float* x; bf16_t* xn; const float* gpost; const float* gnext; float* xbuf1; float* xbuf2; unsigned* cnt1; unsigned* cnt2;
    __device__ __forceinline__ void operator()(f32x4 (&)[2][2][4][2], const Unit&, int, int, int, int) const {}
    __device__ __forceinline__ void stats(const f32x4 (&v)[2][2][4][2], const Unit& u, int wr, int wc, int fr, int fq, LAS unsigned char* lds, int wid, int lane, float* xbuf, unsigned* cnt) const {
        LAS float* P = (LAS float*)lds; LAS float* Sx = (LAS float*)(lds + 4096);
#pragma unroll
        for (int ai = 0; ai < 2; ++ai)
#pragma unroll
            for (int m = 0; m < 4; ++m) { float s = 0.f;
#pragma unroll
                for (int bj = 0; bj < 2; ++bj)
#pragma unroll
                    for (int n = 0; n < 2; ++n) { const f32x4 t = v[ai][bj][m][n]; s += (t[0] * t[0] + t[1] * t[1]) + (t[2] * t[2] + t[3] * t[3]); }
                s += bperm_f(lane ^ 16, s); s += bperm_f(lane ^ 32, s);
                if (fq == 0) P[(ai * 128 + wr * 64 + m * 16 + fr) * 4 + wc] = s; }
        asm volatile("s_waitcnt lgkmcnt(0)" ::: "memory"); __builtin_amdgcn_s_barrier(); asm volatile("" ::: "memory");
        const int row = wid * 32 + (lane & 31);
        if (lane < 32) { const float t = (P[row * 4 + 0] + P[row * 4 + 1]) + (P[row * 4 + 2] + P[row * 4 + 3]);
            __hip_atomic_store(xbuf + (size_t)(u.pm * 256 + row) * 4 + u.pn, t, __ATOMIC_RELAXED, __HIP_MEMORY_SCOPE_AGENT); }
        asm volatile("s_waitcnt vmcnt(0)" ::: "memory");
        if (lane == 0) __hip_atomic_fetch_add(cnt + 64 * u.pm, 1u, __ATOMIC_RELAXED, __HIP_MEMORY_SCOPE_AGENT);
        if (wid == 0) { unsigned sp = 0;
            while ((unsigned)__builtin_amdgcn_readfirstlane(__hip_atomic_load(cnt + 64 * u.pm, __ATOMIC_RELAXED, __HIP_MEMORY_SCOPE_AGENT)) < 32u) { __builtin_amdgcn_s_sleep(2); if (++sp > (1u << 22)) break; }
            __builtin_amdgcn_fence(__ATOMIC_ACQUIRE, "agent"); }
        asm volatile("s_waitcnt vmcnt(0) lgkmcnt(0)" ::: "memory"); __builtin_amdgcn_s_barrier(); asm volatile("" ::: "memory");
        if (lane < 32) { const float* slot = xbuf + (size_t)(u.pm * 256 + row) * 4; float t = 0.f;
#pragma unroll
            for (int k = 0; k < 4; ++k) t += __hip_atomic_load(slot + k, __ATOMIC_RELAXED, __HIP_MEMORY_SCOPE_AGENT);
            Sx[row] = 1.0f / sqrtf(t * (1.f / 1024.f) + 1e-6f); }
        asm volatile("s_waitcnt lgkmcnt(0)" ::: "memory"); __builtin_amdgcn_s_barrier(); asm volatile("" ::: "memory");
    }
    __device__ __forceinline__ void fused(f32x4 (&acc)[2][2][4][2], const Unit& u, int wr, int wc, int fr, int fq, LAS unsigned char* lds, int wid, int lane) const {
        const LAS float* Sx = (const LAS float*)(lds + 4096);
        const int col0 = u.pn * 256 + wc * 32 + 4 * fq;
        stats(acc, u, wr, wc, fr, fq, lds, wid, lane, xbuf1, cnt1);
#pragma unroll
        for (int ai = 0; ai < 2; ++ai)
#pragma unroll
            for (int m = 0; m < 4; ++m) { const int r = ai * 128 + wr * 64 + m * 16 + fr; const float rs = Sx[r]; float* xr = x + (size_t)(u.pm * 256 + r) * DM + col0;
#pragma unroll
                for (int bj = 0; bj < 2; ++bj)
#pragma unroll
                    for (int n = 0; n < 2; ++n) { const f32x4 g = *(const f32x4*)(gpost + col0 + bj * 128 + n * 16); const f32x4 bs = *(const f32x4*)(xr + bj * 128 + n * 16);
                        const f32x4 o = bs + acc[ai][bj][m][n] * rs * g; acc[ai][bj][m][n] = o; *(f32x4*)(xr + bj * 128 + n * 16) = o; }
                if (m & 1) asm volatile("" ::: "memory"); }
        if (xn) {
            stats(acc, u, wr, wc, fr, fq, lds, wid, lane, xbuf2, cnt2);
#pragma unroll
            for (int ai = 0; ai < 2; ++ai)
#pragma unroll
                for (int m = 0; m < 4; ++m) { const int r = ai * 128 + wr * 64 + m * 16 + fr; const float rs = Sx[r]; bf16_t* xr = xn + (size_t)(u.pm * 256 + r) * DM + col0;
#pragma unroll
                    for (int bj = 0; bj < 2; ++bj)
#pragma unroll
                        for (int n = 0; n < 2; ++n) { const f32x4 g = *(const f32x4*)(gnext + col0 + bj * 128 + n * 16); const f32x4 o = acc[ai][bj][m][n] * rs * g;
                            u32x2 w; w.x = cvt_pk_bf16(o[0], o[1]); w.y = cvt_pk_bf16(o[2], o[3]); *(u32x2*)(xr + bj * 128 + n * 16) = w; } }
        }
    }
};
constexpr float EPS = 1e-6f;
constexpr float LOG2E = 1.4426950408889634f;

__device__ __forceinline__ void transpose_item(const float* W, int K, int N, bf16_t* WT, int row_off, const float* kscale, LAS float* scr, int item, int lane) {
    const int nblk = N / 32, kb = item / nblk, nb = item % nblk, k0 = 64 * kb, n0 = 32 * nb;
#pragma unroll 8
    for (int i = 0; i < 32; ++i) { const int kk = 2 * i + (lane >> 5); float v = W[(size_t)(k0 + kk) * N + n0 + (lane & 31)]; if (kscale) v *= kscale[k0 + kk]; scr[kk * 33 + (lane & 31)] = v; }
    asm volatile("s_waitcnt lgkmcnt(0)" ::: "memory");
    const int c = lane & 7;
#pragma unroll
    for (int j = 0; j < 4; ++j) { const int n = (lane >> 3) + 8 * j; const LAS float* s = scr + (8 * c) * 33 + n;
        u32x4 o; o.x = cvt_pk_bf16(s[0 * 33], s[1 * 33]); o.y = cvt_pk_bf16(s[2 * 33], s[3 * 33]); o.z = cvt_pk_bf16(s[4 * 33], s[5 * 33]); o.w = cvt_pk_bf16(s[6 * 33], s[7 * 33]);
        *(u32x4*)(WT + (size_t)(row_off + n0 + n) * K + k0 + 8 * c) = o; }
    asm volatile("s_waitcnt lgkmcnt(0)" ::: "memory");
}

__device__ __forceinline__ void xn_row(const float* xrow, const float* gain, bf16_t* orow, int lane) {
    const f32x4* xr = (const f32x4*)xrow + lane; const f32x4* gr = (const f32x4*)gain + lane;
    f32x4 v[4]; float s = 0.f;
#pragma unroll
    for (int j = 0; j < 4; ++j) { v[j] = xr[64 * j]; s += (v[j].x * v[j].x + v[j].y * v[j].y) + (v[j].z * v[j].z + v[j].w * v[j].w); }
    const float rs = 1.0f / sqrtf(wave_sum(s, lane) * (1.f / DM) + EPS);
    u32x2* o8 = (u32x2*)orow + lane;
#pragma unroll
    for (int j = 0; j < 4; ++j) { const f32x4 g = gr[64 * j]; u32x2 w; w.x = cvt_pk_bf16(v[j].x * rs * g.x, v[j].y * rs * g.y); w.y = cvt_pk_bf16(v[j].z * rs * g.z, v[j].w * rs * g.w); o8[64 * j] = w; }
}

__device__ __forceinline__ void res_row(const bf16_t* mrow, const float* xi, float* xo, const float* gpost, const float* gnext, bf16_t* xnrow, int lane) {
    const u32x2* mr = (const u32x2*)mrow + lane; const f32x4* xr = (const f32x4*)xi + lane; const f32x4* gp = (const f32x4*)gpost + lane;
    f32x4 mv[4]; float s = 0.f;
#pragma unroll
    for (int j = 0; j < 4; ++j) { const u32x2 w = mr[64 * j]; mv[j] = (f32x4){bflo(w.x), bfhi(w.x), bflo(w.y), bfhi(w.y)}; s += (mv[j].x * mv[j].x + mv[j].y * mv[j].y) + (mv[j].z * mv[j].z + mv[j].w * mv[j].w); }
    const float rs = 1.0f / sqrtf(wave_sum(s, lane) * (1.f / DM) + EPS);
    f32x4 x[4]; float s2 = 0.f;
#pragma unroll
    for (int j = 0; j < 4; ++j) { const f32x4 g = gp[64 * j]; x[j] = xr[64 * j] + mv[j] * rs * g; s2 += (x[j].x * x[j].x + x[j].y * x[j].y) + (x[j].z * x[j].z + x[j].w * x[j].w); }
    f32x4* xw = (f32x4*)xo + lane;
#pragma unroll
    for (int j = 0; j < 4; ++j) xw[64 * j] = x[j];
    if (gnext) {
        const float rs2 = 1.0f / sqrtf(wave_sum(s2, lane) * (1.f / DM) + EPS);
        const f32x4* gn = (const f32x4*)gnext + lane; u32x2* o8 = (u32x2*)xnrow + lane;
#pragma unroll
        for (int j = 0; j < 4; ++j) { const f32x4 g = gn[64 * j]; u32x2 w; w.x = cvt_pk_bf16(x[j].x * rs2 * g.x, x[j].y * rs2 * g.y); w.y = cvt_pk_bf16(x[j].z * rs2 * g.z, x[j].w * rs2 * g.w); o8[64 * j] = w; }
    }
}

#define MLA_PACK(P, B) ((u32x4){cvt_pk_bf16(P[B], P[B + 1]), cvt_pk_bf16(P[B + 2], P[B + 3]), cvt_pk_bf16(P[B + 4], P[B + 5]), cvt_pk_bf16(P[B + 6], P[B + 7])})
__device__ __forceinline__ void mla_softmax(f32x16& p0, f32x16& p1, float& m_run, float& l_run, f32x16& o0, f32x16& o1) {
    float mx = fmaxf(p0[0], p1[0]);
#pragma unroll
    for (int r = 1; r < 16; ++r) mx = fmaxf(mx, fmaxf(p0[r], p1[r]));
    mx = xor32_max(mx);
    const float m_new = fmaxf(m_run, mx), alpha = fexp2(m_run - m_new); m_run = m_new;
    p0 = p0 - m_new; p1 = p1 - m_new;
#pragma unroll
    for (int r = 0; r < 16; ++r) { p0[r] = fexp2(p0[r]); p1[r] = fexp2(p1[r]); }
    const f32x16 ps = p0 + p1;
    const float ls = ((ps[0] + ps[1]) + (ps[2] + ps[3])) + ((ps[4] + ps[5]) + (ps[6] + ps[7])) + (((ps[8] + ps[9]) + (ps[10] + ps[11])) + ((ps[12] + ps[13]) + (ps[14] + ps[15])));
    l_run = l_run * alpha + ls;
    o0 = o0 * alpha; o1 = o1 * alpha;
}
__device__ __forceinline__ void mla_store(bf16_t* orow, const f32x16& o0, const f32x16& o1, float l_run) {
    const float inv = 1.0f / xor32_sum(l_run);
#pragma unroll
    for (int rg = 0; rg < 4; ++rg) {
        u32x2 w; w.x = cvt_pk_bf16(o0[4 * rg] * inv, o0[4 * rg + 1] * inv); w.y = cvt_pk_bf16(o0[4 * rg + 2] * inv, o0[4 * rg + 3] * inv); *(u32x2*)(orow + 8 * rg) = w;
        u32x2 w2; w2.x = cvt_pk_bf16(o1[4 * rg] * inv, o1[4 * rg + 1] * inv); w2.y = cvt_pk_bf16(o1[4 * rg + 2] * inv, o1[4 * rg + 3] * inv); *(u32x2*)(orow + 32 + 8 * rg) = w2;
    }
}
__device__ __forceinline__ void mla_unit(LAS unsigned char* lds, const bf16_t* Q, const bf16_t* KN, const bf16_t* KPE, const bf16_t* VT, bf16_t* AO, int tokbase, int S, int h, int qb, int tid) {
    constexpr int KBYTES = 12288, BUF = 20480;
    const int lane = tid & 63, wid = __builtin_amdgcn_readfirstlane(tid >> 6), r32 = lane & 31, hi = lane >> 5;
    const bf16_t* ks0 = KN + (size_t)(tokbase + lane) * 512 + h * 64 + 8 * wid;
    const bf16_t* ks1 = KPE + (size_t)(tokbase + lane) * 32 + 8 * (wid & 3);
    const bf16_t* vs = VT + (size_t)(h * 64 + lane) * TH + tokbase + 8 * wid;
#define MLA_DMA(T, B) do { LAS unsigned char* sb_ = lds + (B) * BUF; \
        __builtin_amdgcn_global_load_lds((const unsigned*)(ks0 + (size_t)(T) * (64 * 512)), (LAS unsigned*)(sb_ + wid * 1024), 16, 0, 0); \
        if (wid < 4) __builtin_amdgcn_global_load_lds((const unsigned*)(ks1 + (size_t)(T) * (64 * 32)), (LAS unsigned*)(sb_ + (8 + wid) * 1024), 16, 0, 0); \
        __builtin_amdgcn_global_load_lds((const unsigned*)(vs + (size_t)(T) * 64), (LAS unsigned*)(sb_ + KBYTES + wid * 1024), 16, 0, 0); } while (0)
#define MLA_WAITBAR_KEEP() do { if (wid < 4) asm volatile("s_waitcnt vmcnt(3)" ::: "memory"); else asm volatile("s_waitcnt vmcnt(2)" ::: "memory"); \
        asm volatile("s_waitcnt lgkmcnt(0)" ::: "memory"); __builtin_amdgcn_s_barrier(); asm volatile("" ::: "memory"); } while (0)
#define MLA_WAITBAR_ALL() do { asm volatile("s_waitcnt vmcnt(0) lgkmcnt(0)" ::: "memory"); __builtin_amdgcn_s_barrier(); asm volatile("" ::: "memory"); } while (0)
    const int NT = S / 64;
    const int qtokA = tokbase + 512 * qb + 64 * wid + r32, qtokB = qtokA + 32;
    bf16x8 qa[6], qbv[6];
#pragma unroll
    for (int d0 = 0; d0 < 6; ++d0) { qa[d0] = *(const bf16x8*)(Q + (size_t)qtokA * 768 + h * 96 + 16 * d0 + 8 * hi); qbv[d0] = *(const bf16x8*)(Q + (size_t)qtokB * 768 + h * 96 + 16 * d0 + 8 * hi); }
    asm volatile("s_waitcnt vmcnt(0)" ::: "memory");
    MLA_DMA(0, 0); MLA_DMA(1, 1);
    MLA_WAITBAR_ALL();
    f32x16 oa0, oa1, ob0, ob1;
#pragma unroll
    for (int r = 0; r < 16; ++r) { oa0[r] = 0.f; oa1[r] = 0.f; ob0[r] = 0.f; ob1[r] = 0.f; }
    float ma = -1e30f, la = 0.f, mb = -1e30f, lb = 0.f;
    for (int t = 0; t < NT; ++t) {
        if (t + 2 < NT) MLA_DMA(t + 2, (t + 2) & 3);
        const LAS unsigned char* kb = lds + (t & 3) * BUF; const LAS unsigned char* vb = kb + KBYTES;
        f32x16 pa0, pa1, pb0, pb1;
#pragma unroll
        for (int r = 0; r < 16; ++r) { pa0[r] = 0.f; pa1[r] = 0.f; pb0[r] = 0.f; pb1[r] = 0.f; }
#pragma unroll
        for (int d0 = 0; d0 < 6; ++d0) {
            const bf16x8 a0 = *(const LAS bf16x8*)(kb + (2 * d0 + hi) * 1024 + r32 * 16);
            const bf16x8 a1 = *(const LAS bf16x8*)(kb + (2 * d0 + hi) * 1024 + (32 + r32) * 16);
            pa0 = __builtin_amdgcn_mfma_f32_32x32x16_bf16(a0, qa[d0], pa0, 0, 0, 0);
            pa1 = __builtin_amdgcn_mfma_f32_32x32x16_bf16(a1, qa[d0], pa1, 0, 0, 0);
            pb0 = __builtin_amdgcn_mfma_f32_32x32x16_bf16(a0, qbv[d0], pb0, 0, 0, 0);
            pb1 = __builtin_amdgcn_mfma_f32_32x32x16_bf16(a1, qbv[d0], pb1, 0, 0, 0);
        }
        mla_softmax(pa0, pa1, ma, la, oa0, oa1);
        mla_softmax(pb0, pb1, mb, lb, ob0, ob1);
#pragma unroll
        for (int ks = 0; ks < 4; ++ks) {
            const u32x4 pwa = ks == 0 ? MLA_PACK(pa0, 0) : ks == 1 ? MLA_PACK(pa0, 8) : ks == 2 ? MLA_PACK(pa1, 0) : MLA_PACK(pa1, 8);
            const u32x4 pwb = ks == 0 ? MLA_PACK(pb0, 0) : ks == 1 ? MLA_PACK(pb0, 8) : ks == 2 ? MLA_PACK(pb1, 0) : MLA_PACK(pb1, 8);
            const bf16x8 paa = __builtin_bit_cast(bf16x8, pwa), pab = __builtin_bit_cast(bf16x8, pwb);
            const LAS unsigned char* vp = vb + (2 * ks) * 1024 + r32 * 16 + 8 * hi;
            const u32x2 a_lo = *(const LAS u32x2*)(vp), a_hi = *(const LAS u32x2*)(vp + 1024);
            const u32x2 b_lo = *(const LAS u32x2*)(vp + 512), b_hi = *(const LAS u32x2*)(vp + 1024 + 512);
            const bf16x8 vf0 = __builtin_bit_cast(bf16x8, ((u32x4){a_lo.x, a_lo.y, a_hi.x, a_hi.y}));
            const bf16x8 vf1 = __builtin_bit_cast(bf16x8, ((u32x4){b_lo.x, b_lo.y, b_hi.x, b_hi.y}));
            oa0 = __builtin_amdgcn_mfma_f32_32x32x16_bf16(vf0, paa, oa0, 0, 0, 0);
            oa1 = __builtin_amdgcn_mfma_f32_32x32x16_bf16(vf1, paa, oa1, 0, 0, 0);
            ob0 = __builtin_amdgcn_mfma_f32_32x32x16_bf16(vf0, pab, ob0, 0, 0, 0);
            ob1 = __builtin_amdgcn_mfma_f32_32x32x16_bf16(vf1, pab, ob1, 0, 0, 0);
        }
        if (t & 1) MLA_WAITBAR_ALL();
    }
#undef MLA_DMA
#undef MLA_WAITBAR_KEEP
#undef MLA_WAITBAR_ALL
    mla_store(AO + (size_t)qtokA * 1024 + h * 64 + 4 * hi, oa0, oa1, la);
    mla_store(AO + (size_t)qtokB * 1024 + h * 64 + 4 * hi, ob0, ob1, lb);
}

__device__ __forceinline__ unsigned na_vmask(int qc, int kh, int hi) {
    int cs = qc - 8; cs = cs < 0 ? 0 : cs; cs = cs > 48 ? 48 : cs; unsigned mk = 0u;
#pragma unroll
    for (int r = 0; r < 16; ++r) { const int kc = 32 * kh + (r & 3) + 8 * (r >> 2) + 4 * hi; mk |= ((kc >= cs) && (kc < cs + 16)) ? (1u << r) : 0u; }
    return mk;
}
__device__ __forceinline__ void na_qs(const bf16x8 (&kf)[4], const bf16x8 (&vf)[2][2], const bf16x8 (&qf)[4], const LAS float* brow, int qc, int kh, int hi, unsigned vmsel,
                                      float& m_run, float& l_run, f32x16& o0, f32x16& o1) {
    const float SCL = 0.125f * LOG2E;
    f32x16 p;
#pragma unroll
    for (int r = 0; r < 16; ++r) p[r] = 0.f;
#pragma unroll
    for (int d0 = 0; d0 < 4; ++d0) p = __builtin_amdgcn_mfma_f32_32x32x16_bf16(kf[d0], qf[d0], p, 0, 0, 0);
    unsigned vm = vmsel; asm volatile("" : "+v"(vm));
    float mx = -1e30f;
#pragma unroll
    for (int r = 0; r < 16; ++r) { const int kc = 32 * kh + (r & 3) + 8 * (r >> 2) + 4 * hi;
        int bi = kc - qc + 15; bi = bi < 0 ? 0 : bi; bi = bi > 30 ? 30 : bi;
        const float sc = p[r] * SCL + brow[bi]; p[r] = ((vm >> r) & 1u) ? sc : -1e30f; mx = fmaxf(mx, p[r]); }
    mx = xor32_max(mx);
    const float m_new = fmaxf(m_run, mx), alpha = fexp2(m_run - m_new); m_run = m_new;
    const float m_use = fmaxf(m_new, -1e20f);
    float ls = 0.f;
#pragma unroll
    for (int r = 0; r < 16; ++r) { const float e = fexp2(p[r] - m_use); p[r] = e; ls += e; }
    l_run = l_run * alpha + ls;
#pragma unroll
    for (int r = 0; r < 16; ++r) { o0[r] *= alpha; o1[r] *= alpha; }
#pragma unroll
    for (int k2 = 0; k2 < 2; ++k2) {
        u32x4 pw; pw.x = cvt_pk_bf16(p[8 * k2 + 0], p[8 * k2 + 1]); pw.y = cvt_pk_bf16(p[8 * k2 + 2], p[8 * k2 + 3]); pw.z = cvt_pk_bf16(p[8 * k2 + 4], p[8 * k2 + 5]); pw.w = cvt_pk_bf16(p[8 * k2 + 6], p[8 * k2 + 7]);
        const bf16x8 pa = __builtin_bit_cast(bf16x8, pw);
        o0 = __builtin_amdgcn_mfma_f32_32x32x16_bf16(vf[0][k2], pa, o0, 0, 0, 0);
        o1 = __builtin_amdgcn_mfma_f32_32x32x16_bf16(vf[1][k2], pa, o1, 0, 0, 0);
    }
}
__device__ __forceinline__ void na_store(bf16_t* orow, const f32x16& o0, const f32x16& o1, float l_run) {
    const float l = xor32_sum(l_run); const float inv = 1.0f / l;
#pragma unroll
    for (int rg = 0; rg < 4; ++rg) {
        u32x2 w; w.x = cvt_pk_bf16(o0[4 * rg] * inv, o0[4 * rg + 1] * inv); w.y = cvt_pk_bf16(o0[4 * rg + 2] * inv, o0[4 * rg + 3] * inv); *(u32x2*)(orow + 8 * rg) = w;
        u32x2 w2; w2.x = cvt_pk_bf16(o1[4 * rg] * inv, o1[4 * rg + 1] * inv); w2.y = cvt_pk_bf16(o1[4 * rg + 2] * inv, o1[4 * rg + 3] * inv); *(u32x2*)(orow + 32 + 8 * rg) = w2;
    }
}
__device__ __forceinline__ void na_unit(const LAS float* biasT, const bf16_t* Z, const bf16_t* VTn, bf16_t* AO, int tokbase, int S, int rr, int tid) {
    const int lane = tid & 63, h = tid >> 6, r32 = lane & 31, hi = lane >> 5;
    const int rows = S / 64; int rs = rr - 4; rs = rs < 0 ? 0 : rs; rs = rs > rows - 8 ? rows - 8 : rs;
    bf16x8 qfa[4], qfb[4];
#pragma unroll
    for (int d0 = 0; d0 < 4; ++d0) { qfa[d0] = *(const bf16x8*)(Z + (size_t)(tokbase + rr * 64 + r32) * ZP + 672 + h * 64 + 16 * d0 + 8 * hi);
                                      qfb[d0] = *(const bf16x8*)(Z + (size_t)(tokbase + rr * 64 + 32 + r32) * ZP + 672 + h * 64 + 16 * d0 + 8 * hi); }
    f32x16 oa0, oa1, ob0, ob1; float ma = -1e30f, mb = -1e30f, la = 0.f, lb = 0.f;
#pragma unroll
    for (int r = 0; r < 16; ++r) { oa0[r] = 0.f; oa1[r] = 0.f; ob0[r] = 0.f; ob1[r] = 0.f; }
    const unsigned va0 = na_vmask(r32, 0, hi), va1 = na_vmask(r32, 1, hi), vb0 = na_vmask(32 + r32, 0, hi), vb1 = na_vmask(32 + r32, 1, hi);
    const bf16_t* kbase = Z + (size_t)(tokbase + rs * 64 + r32) * ZP + 672 + 512 + h * 64 + 8 * hi;
    const bf16_t* vbase0 = VTn + (size_t)(h * 64 + r32) * TH + tokbase + rs * 64 + 4 * hi;
#define NA_LOADK(KF, IT) do { const int kr_ = (IT) >> 1, kh_ = (IT) & 1; const bf16_t* kp_ = kbase + (size_t)(kr_ * 64 + kh_ * 32) * ZP; \
        _Pragma("unroll") for (int d0 = 0; d0 < 4; ++d0) KF[d0] = *(const bf16x8*)(kp_ + 16 * d0); } while (0)
#define NA_LOADV(VF, IT) do { const int kr_ = (IT) >> 1, kh_ = (IT) & 1; const bf16_t* vp0_ = vbase0 + kr_ * 64 + kh_ * 32; const bf16_t* vp1_ = vp0_ + (size_t)32 * TH; \
        _Pragma("unroll") for (int k2 = 0; k2 < 2; ++k2) { const u32x2 lo = *(const u32x2*)(vp0_ + 16 * k2), hi2 = *(const u32x2*)(vp0_ + 16 * k2 + 8); VF[0][k2] = __builtin_bit_cast(bf16x8, ((u32x4){lo.x, lo.y, hi2.x, hi2.y})); \
            const u32x2 lo1 = *(const u32x2*)(vp1_ + 16 * k2), hi3 = *(const u32x2*)(vp1_ + 16 * k2 + 8); VF[1][k2] = __builtin_bit_cast(bf16x8, ((u32x4){lo1.x, lo1.y, hi3.x, hi3.y})); } } while (0)
    bf16x8 kf[4];
    NA_LOADK(kf, 0);
#pragma unroll 1
    for (int it = 0; it < 16; ++it) {
        const int kr = it >> 1, kh = it & 1;
        const LAS float* brow = biasT + (h * 15 + (rs + kr - rr + 7)) * 31;
        bf16x8 vf[2][2], kn[4];
        NA_LOADV(vf, it);
        const int itn = it + 1 < 16 ? it + 1 : 15;
        NA_LOADK(kn, itn);
        na_qs(kf, vf, qfa, brow, r32, kh, hi, kh ? va1 : va0, ma, la, oa0, oa1);
        na_qs(kf, vf, qfb, brow, 32 + r32, kh, hi, kh ? vb1 : vb0, mb, lb, ob0, ob1);
#pragma unroll
        for (int d0 = 0; d0 < 4; ++d0) kf[d0] = kn[d0];
    }
#undef NA_LOADK
#undef NA_LOADV
    na_store(AO + (size_t)(tokbase + rr * 64 + r32) * 1024 + 512 + h * 64 + 4 * hi, oa0, oa1, la);
    na_store(AO + (size_t)(tokbase + rr * 64 + 32 + r32) * 1024 + 512 + h * 64 + 4 * hi, ob0, ob1, lb);
}
#ifndef REP_SYNC
#define REP_SYNC 1
#endif
#ifndef REP_MLA
#define REP_MLA 1
#endif
#ifndef REP_NA
#define REP_NA 1
#endif
#ifndef REP_SCAN
#define REP_SCAN 1
#endif
#ifndef REP_UP
#define REP_UP 1
#endif
#ifndef REP_PASS
#define REP_PASS 1
#endif
#ifndef REP_GEMM
#define REP_GEMM 1
#endif
#define GSYNC() do { for (int r_ = 0; r_ < REP_SYNC; ++r_) xcd_barrier((unsigned*)(ap0->ws + WS_BAR), bst); } while (0)
constexpr int LDS_BYTES = 147456;
constexpr int NTHR = 512;
struct Args { const float* in[26]; float* out; unsigned char* ws; };


#define XB_TMO      128
#define XB_XCNT(j)  (256  + 64 * (j))
#define XB_XSUB(j)  (1280 + 64 * (j))
#define XB_XGEN(j)  (2304 + 64 * (j))
#define XB_TOP      3328
#define XB_TOPGEN   3392
#define XCD_BAR_WORDS 3456
#define XB_SPIN_CAP (1u << 22)
__device__ __forceinline__ unsigned xb_ld(unsigned* p)              { return __hip_atomic_load(p, __ATOMIC_RELAXED, __HIP_MEMORY_SCOPE_AGENT); }
__device__ __forceinline__ unsigned xb_add(unsigned* p, unsigned v) { return __hip_atomic_fetch_add(p, v, __ATOMIC_RELAXED, __HIP_MEMORY_SCOPE_AGENT); }
__device__ __forceinline__ unsigned xb_xcc_id() { return (unsigned)__builtin_amdgcn_s_getreg((3 << 11) | 20) & 0xFu; }
#define XB_SPIN(cond, bar) do { unsigned _sp = 0; while (cond) { __builtin_amdgcn_s_sleep(1); \
    if ((++_sp & 255u) == 0u) { if (xb_ld(&(bar)[XB_TMO])) break; if (_sp > XB_SPIN_CAP) { atomicAdd(&(bar)[XB_TMO], 1u); break; } } } } while (0)
__device__ __forceinline__ void xcd_barrier_complete(unsigned* bar, unsigned x, unsigned& nloc, unsigned& nx) {
    const unsigned G = gridDim.x;
    unsigned sum, cnt, mine, sp = 0u;
    for (;;) {
        sum = 0u; cnt = 0u; mine = 0u;
#pragma unroll
        for (unsigned j = 0; j < 16; ++j) { const unsigned c = xb_ld(&bar[XB_XCNT(j)]); sum += c; cnt += (c > 0u) ? 1u : 0u; mine = (j == x) ? c : mine; }
        if (sum == G) break;
        __builtin_amdgcn_s_sleep(1);
        if ((++sp & 255u) == 0u) { if (xb_ld(&bar[XB_TMO])) break; if (sp > XB_SPIN_CAP) { atomicAdd(&bar[XB_TMO], 1u); break; } }
    }
    nloc = mine > 0u ? mine : 1u; nx = cnt > 0u ? cnt : 1u;
}
__device__ __forceinline__ void xcd_barrier(unsigned* bar, volatile LAS unsigned* st) {
    asm volatile("s_waitcnt vmcnt(0)" ::: "memory");
    __syncthreads();
    if (threadIdx.x == 0) {
        __builtin_amdgcn_s_waitcnt(0);
        const unsigned x = xb_xcc_id();
        unsigned nloc = st[0], nx = st[1];
        if (nloc == 0u) { xcd_barrier_complete(bar, x, nloc, nx); st[0] = nloc; st[1] = nx; }
        const unsigned old = xb_add(&bar[XB_XSUB(x)], 1u);
        const unsigned gen = old / nloc;
        if (old + 1u == (gen + 1u) * nloc) {
            __builtin_amdgcn_fence(__ATOMIC_RELEASE, "agent");
            asm volatile("s_waitcnt vmcnt(0)" ::: "memory");
            const unsigned og = xb_add(&bar[XB_TOP], 1u);
            const unsigned tg = og / nx;
            if (og + 1u == (tg + 1u) * nx) xb_add(&bar[XB_TOPGEN], 1u);
            else XB_SPIN(xb_ld(&bar[XB_TOPGEN]) == tg, bar);
            __builtin_amdgcn_fence(__ATOMIC_ACQUIRE, "agent");
            xb_add(&bar[XB_XGEN(x)], 1u);
            asm volatile("s_waitcnt vmcnt(0)" ::: "memory");
        } else {
            XB_SPIN(xb_ld(&bar[XB_XGEN(x)]) == gen, bar);
            __builtin_amdgcn_fence(__ATOMIC_ACQUIRE, "agent");
            asm volatile("s_waitcnt vmcnt(0)" ::: "memory");
        }
    }
    __syncthreads();
}

__global__ void __launch_bounds__(NTHR, 2) mk_fwd(Args a) {
    extern __shared__ __attribute__((aligned(16))) unsigned char lds_raw[];
    LAS unsigned char* lds = (LAS unsigned char*)lds_raw;
    cg::grid_group grid = cg::this_grid();
    volatile LAS unsigned* bst = (volatile LAS unsigned*)(lds + LDS_BYTES - 64);
    if (threadIdx.x == 0) { bst[0] = 0u; bst[1] = 0u; }
    typedef const __attribute__((address_space(4))) Args* ArgP;
    ArgP ap0 = (ArgP)__builtin_amdgcn_kernarg_segment_ptr();
#define PH_BEGIN ArgP ap = ap0; asm volatile("" : "+s"(ap)); unsigned char* ws = ap->ws; (void)ws; int tid_ = threadIdx.x; asm volatile("" : "+v"(tid_)); const int tid = tid_, lane = tid & 63, wave = tid >> 6; int G_ = gridDim.x, bid_ = blockIdx.x; asm volatile("" : "+s"(G_), "+s"(bid_)); const int G = G_, bid = bid_; const int gw = bid * 8 + wave, NGW = G * 8; const int gt = bid * NTHR + tid, NGT = G * NTHR; (void)lane; (void)gw; (void)NGW; (void)gt; (void)NGT;
#define IN(k) (ap->in[k])
#define rsq ((float*)(ws + WS_RSQ))
#define rskv ((float*)(ws + WS_RSKV))
#define rope ((float2*)(ws + WS_ROPE))
#define AGG ((float2*)(ws + WS_AGG))
#define CARRY ((float*)(ws + WS_CARRY))
#define YB ((bf16_t*)(ws + WS_YB))
#define W_INATT ((bf16_t*)(ws + WS_W_INATT))
#define W_UQ ((bf16_t*)(ws + WS_W_UQ))
#define W_UKV ((bf16_t*)(ws + WS_W_UKV))
#define W_OUTATT ((bf16_t*)(ws + WS_W_OUTATT))
#define W_INREC ((bf16_t*)(ws + WS_W_INREC))
#define W_GATES ((bf16_t*)(ws + WS_W_GATES))
#define W_OUTREC ((bf16_t*)(ws + WS_W_OUTREC))
#define W_UP ((bf16_t*)(ws + WS_W_UP))
#define W_DOWN ((bf16_t*)(ws + WS_W_DOWN))
#define XN ((bf16_t*)(ws + WS_XN))
#define Zb ((bf16_t*)(ws + WS_Z))
#define Qb ((bf16_t*)(ws + WS_Q))
#define KN ((bf16_t*)(ws + WS_KN))
#define VTM ((bf16_t*)(ws + WS_VTM))
#define VTN ((bf16_t*)(ws + WS_VTN))
#define KPE ((bf16_t*)(ws + WS_KPE))
#define ACT ((bf16_t*)(ws + WS_ACT))
#define GATE ((bf16_t*)(ws + WS_GATE))
#define XB ((bf16_t*)(ws + WS_XB))
#define XBR ((bf16_t*)(ws + WS_XBR))
#define GQ ((bf16_t*)(ws + WS_GQ))
#define AO XN
#define Fb XN
#define YR XN
#define M0 Zb
#define M1 XBR
#define XIN (IN(half))
#define XST (ap->out + (size_t)half * TH * DM)
    { PH_BEGIN
    {
        LAS float* scr = (LAS float*)(lds + wave * 16384);
        constexpr int I_INATT = 16 * 69, I_UQ = 6 * 24, I_UKV = 4 * 32, I_SQ = 16 * 32, I_INREC = 16 * 64, I_UP = 16 * 256, I_DOWN = 64 * 32, I_GATE = 32 * 8;
        constexpr int NITEMS = I_INATT + I_UQ + I_UKV + 2 * I_SQ + I_INREC + 2 * I_UP + 2 * I_DOWN + I_GATE;
        for (int rep_ = 0; rep_ < REP_PASS; ++rep_)
        for (int it = gw; it < NITEMS; it += NGW) {
            int r = it;
            if (r < I_INATT) { transpose_item(IN(6), 1024, 2208, W_INATT, 0, nullptr, scr, r, lane); continue; } r -= I_INATT;
            if (r < I_UQ) { transpose_item(IN(8), 384, 768, W_UQ, 0, IN(7), scr, r, lane); continue; } r -= I_UQ;
            if (r < I_UKV) { transpose_item(IN(10), 256, 1024, W_UKV, 0, IN(9), scr, r, lane); continue; } r -= I_UKV;
            if (r < I_SQ) { transpose_item(IN(12), 1024, 1024, W_OUTATT, 0, nullptr, scr, r, lane); continue; } r -= I_SQ;
            if (r < I_SQ) { transpose_item(IN(21), 1024, 1024, W_OUTREC, 0, nullptr, scr, r, lane); continue; } r -= I_SQ;
            if (r < I_INREC) { transpose_item(IN(13), 1024, 2048, W_INREC, 0, nullptr, scr, r, lane); continue; } r -= I_INREC;
            if (r < 2 * I_UP) { const int li = r / I_UP; transpose_item(IN(22) + (size_t)li * 1024 * 8192, 1024, 8192, W_UP + (size_t)li * 8192 * 1024, 0, nullptr, scr, r % I_UP, lane); continue; } r -= 2 * I_UP;
            if (r < 2 * I_DOWN) { const int li = r / I_DOWN; transpose_item(IN(25) + (size_t)li * 4096 * 1024, 4096, 1024, W_DOWN + (size_t)li * 1024 * 4096, 0, nullptr, scr, r % I_DOWN, lane); continue; } r -= 2 * I_DOWN;
            { const int mat = r / 8, sub = r % 8; const int type = mat >> 4, e = (mat >> 3) & 1, n = mat & 7;
              transpose_item(IN(type ? 18 : 16) + (size_t)(e * 8 + n) * 128 * 128, 128, 128, W_GATES, n * 512 + e * 256 + type * 128, nullptr, scr, sub, lane); }
        }
        if (bid == 0) for (int i = tid; i < XCD_BAR_WORDS; i += NTHR) ((unsigned*)(ws + WS_BAR))[i] = 0u;
        for (int i = gt; i < 8 * 64 * 64; i += NGT) ((unsigned*)(ws + WS_CNT))[i] = 0u;
        for (int i = gt; i < 96 * 1024 / 8; i += NGT) ((u32x4*)(W_INATT + (size_t)2208 * 1024))[i] = (u32x4){0, 0, 0, 0};
        for (int m = gw; m < TH; m += NGW) xn_row(IN(0) + (size_t)m * DM, IN(2), XN + (size_t)m * DM, lane);
        for (int i = gt; i < 4096 * 16; i += NGT) { const int pos = i >> 4, j = i & 15;
            const double inv = exp2(-(double)j * (13.287712379549449 / 16.0));
            const double rev = (double)pos * inv * 0.15915494309189535; const float fr = (float)(rev - floor(rev));
            rope[i] = make_float2(__builtin_amdgcn_cosf(fr), __builtin_amdgcn_sinf(fr)); }
    }

    }
    grid.sync();
    if (threadIdx.x == 0) (void)xb_add((unsigned*)(ap0->ws + WS_BAR) + XB_XCNT(xb_xcc_id()), 1u);
    for (int half = 0; half < 2; ++half) {
        const int S = half ? 4096 : 2048, nseq = TH / S;
        if (half == 1 && gridDim.x != 256) {
                { PH_BEGIN
        for (int m = gw; m < TH; m += NGW) xn_row(XIN + (size_t)m * DM, IN(2), XN + (size_t)m * DM, lane);
        }
        GSYNC();
        }
        { PH_BEGIN
        { pg8::Gemm g = pg8::make_gemm(XN, DM, W_INATT, DM, DM); pg8::StaticOrder so; so.init(TH / 256, ZP / 256, G, bid);
          EpiZ E{Zb, VTN, (float*)(ws + WS_SQP), nullptr, KPE, rope, S - 1};
#ifndef NO_G1
for (int rep_ = 0; rep_ < REP_GEMM; ++rep_) pg8::gemm_phase<EpiZ>(lds, g, so, E);
#endif
 }
        }
        GSYNC();
        { PH_BEGIN
        { pg8::Gemm g = pg8::make_gemm(Zb, ZP, W_UQ, 384, 384); pg8::StaticOrder so; so.init(TH / 256, 3, G, bid);
          EpiQ E{Qb, (const float*)(ws + WS_SQP), rope, S - 1};
#ifndef NO_G2
for (int rep_ = 0; rep_ < REP_GEMM; ++rep_) pg8::gemm_phase<EpiQ>(lds, g, so, E);
#endif
 }
        { pg8::Gemm g = pg8::make_gemm(Zb + 384, ZP, W_UKV, 256, 256); pg8::StaticOrder so; so.init(TH / 256, 4, G, bid);
          EpiKV E{KN, VTM, (const float*)(ws + WS_SQP)};
#ifndef NO_G3
for (int rep_ = 0; rep_ < REP_GEMM; ++rep_) pg8::gemm_phase<EpiKV>(lds, g, so, E);
#endif
 }
        }
        GSYNC();
        { PH_BEGIN
        {
            LAS float* biasT = (LAS float*)(lds + 98304);
            for (int i = tid; i < 8 * 15 * 31; i += NTHR) biasT[i] = IN(11)[i] * LOG2E;
            __syncthreads();
            const int nqb = S / 512, nunits = nseq * 8 * nqb;
            const int vb = (G % 8 == 0) ? (bid % 8) * (G / 8) + bid / 8 : bid;
#ifdef DELAY_P4A
        { const unsigned long long t0_ = __builtin_amdgcn_s_memrealtime(); while (__builtin_amdgcn_s_memrealtime() - t0_ < 40000ull) __builtin_amdgcn_s_sleep(32); }
#endif
#ifndef NO_MLA
            for (int rep_ = 0; rep_ < REP_MLA; ++rep_) {
#ifdef REP_MLA_SYNC
            if (rep_ > 0) GSYNC();
#endif
#ifdef REP_DELAY
            if (rep_ > 0) { const unsigned long long t0_ = __builtin_amdgcn_s_memrealtime(); while (__builtin_amdgcn_s_memrealtime() - t0_ < 40000ull) __builtin_amdgcn_s_sleep(32); continue; }
#endif
            for (int u = vb; u < nunits; u += G) { const int qb = u % nqb, h = (u / nqb) & 7, s = u / (nqb * 8);
                mla_unit(lds, Qb, KN, KPE, VTM, AO, s * S, S, h, qb, tid); }
            }
#endif
#ifdef MLA_TWICE
            for (int u = vb; u < nunits; u += G) { const int qb = u % nqb, h = (u / nqb) & 7, s = u / (nqb * 8);
                mla_unit(lds, Qb, KN, KPE, VTM, AO, s * S, S, h, qb, tid); }
#endif
            const int rows = S / 64, nna = nseq * rows;
#ifdef DELAY_P4B
        { const unsigned long long t0_ = __builtin_amdgcn_s_memrealtime(); while (__builtin_amdgcn_s_memrealtime() - t0_ < 40000ull) __builtin_amdgcn_s_sleep(32); }
#endif
#ifdef RELOAD_BIAS
            __syncthreads();
            for (int i = tid; i < 8 * 15 * 31; i += NTHR) biasT[i] = IN(11)[i] * LOG2E;
            __syncthreads();
#endif
#ifndef NO_NA
            for (int rep_ = 0; rep_ < REP_NA; ++rep_)
            for (int u = vb; u < nna; u += G) na_unit(biasT, Zb, VTN, AO, (u / rows) * S, S, u % rows, tid);
#endif
        }
        }
        GSYNC();
        { PH_BEGIN
        { pg8::Gemm g = pg8::make_gemm(AO, DM, W_OUTATT, DM, DM); pg8::StaticOrder so; so.init(TH / 256, 4, G, bid);
          EpiBf16 E{M0, DM, 0, 0};
#ifndef NO_G4
for (int rep_ = 0; rep_ < REP_GEMM; ++rep_) pg8::gemm_phase<EpiBf16>(lds, g, so, E);
#endif
 }
        }
        GSYNC();
        { PH_BEGIN
        for (int m = gw; m < TH; m += NGW) res_row(M0 + (size_t)m * DM, XIN + (size_t)m * DM, XST + (size_t)m * DM, IN(3), IN(4), XN + (size_t)m * DM, lane);
        }
        GSYNC();

        for (int li = 0; li < 2; ++li) {
            if (li == 1) {
                { PH_BEGIN
                { pg8::Gemm g = pg8::make_gemm(XN, DM, W_INREC, DM, DM); pg8::StaticOrder so; so.init(TH / 256, 8, G, bid);
                  EpiBf16 E{GATE, DM, 1024, (size_t)(WS_XBR - WS_GATE) / 2};
#ifndef NO_G5
for (int rep_ = 0; rep_ < REP_GEMM; ++rep_) pg8::gemm_phase<EpiBf16>(lds, g, so, E);
#endif
 }
                }
                GSYNC();
                { PH_BEGIN
                for (int rep_ = 0; rep_ < REP_PASS; ++rep_)
                for (int i = gt; i < TH * 128; i += NGT) { const int t = i >> 7, c8 = (i & 127) * 8; const int pos = t & (S - 1);
                    float accv[8];
#pragma unroll
                    for (int j = 0; j < 8; ++j) accv[j] = IN(15)[c8 + j];
#pragma unroll
                    for (int k = 0; k < 4; ++k) { const int p2 = pos + k - 1; if (p2 < 0 || p2 >= S) continue;
                        const u32x4 w = *(const u32x4*)(XBR + (size_t)(t + k - 1) * DM + c8); const float* cwk = IN(14) + k * 1024 + c8;
                        accv[0] += cwk[0] * bflo(w.x); accv[1] += cwk[1] * bfhi(w.x); accv[2] += cwk[2] * bflo(w.y); accv[3] += cwk[3] * bfhi(w.y);
                        accv[4] += cwk[4] * bflo(w.z); accv[5] += cwk[5] * bfhi(w.z); accv[6] += cwk[6] * bflo(w.w); accv[7] += cwk[7] * bfhi(w.w); }
                    u32x4 o; o.x = cvt_pk_bf16(accv[0], accv[1]); o.y = cvt_pk_bf16(accv[2], accv[3]); o.z = cvt_pk_bf16(accv[4], accv[5]); o.w = cvt_pk_bf16(accv[6], accv[7]);
                    *(u32x4*)(XB + (size_t)t * DM + c8) = o; }
                }
                GSYNC();
                for (int qt = 0; qt < 2; ++qt) {
                    const int t0 = qt * TQ;
                    { PH_BEGIN
                    { pg8::Gemm g = pg8::make_gemm(XB + (size_t)t0 * DM, DM, W_GATES, 128, 128); g.a_pn_shift = 1; g.a_pn_step = 256; g.a_seg = 1; g.hA = (size_t)4 * DM * 2;
                      pg8::StaticOrder so; so.init(TQ / 256, 16, G, bid);
                      EpiGates E{GQ, XB + (size_t)t0 * DM, AGG, IN(17), IN(19), IN(20)};
                      pg8::gemm_phase<EpiGates>(lds, g, so, E);
 }
                    }
                    GSYNC();
                    { PH_BEGIN
                    { const int cps = S / 32, nsq = TQ / S;
                      for (int rep_ = 0; rep_ < REP_SCAN; ++rep_)
                      for (int i = gt; i < nsq * 2 * 1024; i += NGT) { const int ch = i & 1023, e = (i >> 10) & 1, sq = i >> 11;
                          float hcar = 0.f;
#pragma unroll 16
                          for (int k = 0; k < cps; ++k) { const int c = sq * cps + (e ? cps - 1 - k : k); const int idx = (c * 2 + e) * 1024 + ch;
                              CARRY[idx] = hcar; const float2 ab = AGG[idx]; hcar = ab.x * hcar + ab.y; } } }
                    }
                    GSYNC();
                    { PH_BEGIN
#ifndef NO_R6
                    for (int rep_ = 0; rep_ < REP_SCAN; ++rep_)
                    for (int i = gt; i < 256 * 512; i += NGT) { const int cp = i & 511, c = i >> 9; const int ch = 2 * cp, n = ch >> 7, d = ch & 127;
                        const float2 lam0 = *(const float2*)(IN(20) + ch), lam1 = *(const float2*)(IN(20) + 1024 + ch);
                        const float2 gab0 = *(const float2*)(IN(17) + ch), gab1 = *(const float2*)(IN(17) + 1024 + ch), gxb0 = *(const float2*)(IN(19) + ch), gxb1 = *(const float2*)(IN(19) + 1024 + ch);
                        const bf16_t* gq0 = GQ + (size_t)(c * 32) * 4096 + n * 512 + d; const bf16_t* xb0 = XB + (size_t)(t0 + c * 32) * DM + ch;
                        bf16_t* yr0 = YR + (size_t)(t0 + c * 32) * DM + ch; const bf16_t* gt0 = GATE + (size_t)(t0 + c * 32) * DM + ch;
                        unsigned hfw[32];
                        { const float spl0 = log1pf(expf(-lam0.x)), spl1 = log1pf(expf(-lam0.y));
                          const float2 hc2 = *(const float2*)(CARRY + (size_t)(c * 2 + 0) * 1024 + ch); float h0 = hc2.x, h1 = hc2.y;
#pragma unroll
                          for (int s = 0; s < 32; ++s) {
                            const unsigned ga2 = *(const unsigned*)(gq0 + (size_t)s * 4096), gx2 = *(const unsigned*)(gq0 + (size_t)s * 4096 + 128), xb2 = *(const unsigned*)(xb0 + (size_t)s * DM);
                            float av, bv; lru_ab(bflo(ga2), bflo(gx2), gab0.x, gxb0.x, spl0, bflo(xb2), av, bv); h0 = av * h0 + bv;
                            lru_ab(bfhi(ga2), bfhi(gx2), gab0.y, gxb0.y, spl1, bfhi(xb2), av, bv); h1 = av * h1 + bv;
                            hfw[s] = cvt_pk_bf16(h0, h1); } }
                        { const float spl0 = log1pf(expf(-lam1.x)), spl1 = log1pf(expf(-lam1.y));
                          const float2 hc2 = *(const float2*)(CARRY + (size_t)(c * 2 + 1) * 1024 + ch); float h0 = hc2.x, h1 = hc2.y;
#pragma unroll
                          for (int s = 31; s >= 0; --s) {
                            const unsigned ga2 = *(const unsigned*)(gq0 + (size_t)s * 4096 + 256), gx2 = *(const unsigned*)(gq0 + (size_t)s * 4096 + 384), xb2 = *(const unsigned*)(xb0 + (size_t)s * DM);
                            float av, bv; lru_ab(bflo(ga2), bflo(gx2), gab1.x, gxb1.x, spl0, bflo(xb2), av, bv); h0 = av * h0 + bv;
                            lru_ab(bfhi(ga2), bfhi(gx2), gab1.y, gxb1.y, spl1, bfhi(xb2), av, bv); h1 = av * h1 + bv;
                            const unsigned g2 = *(const unsigned*)(gt0 + (size_t)s * DM), f2 = hfw[s];
                            *(unsigned*)(yr0 + (size_t)s * DM) = cvt_pk_bf16((bflo(f2) + h0) * gelu_tanh(bflo(g2)), (bfhi(f2) + h1) * gelu_tanh(bfhi(g2))); } }
                    }
#endif
                    }
                    GSYNC();
                }
                { PH_BEGIN
                { pg8::Gemm g = pg8::make_gemm(YR, DM, W_OUTREC, DM, DM); pg8::StaticOrder so; so.init(TH / 256, 4, G, bid);
                  EpiBf16 E{M1, DM, 0, 0};
#ifndef NO_G7
for (int rep_ = 0; rep_ < REP_GEMM; ++rep_) pg8::gemm_phase<EpiBf16>(lds, g, so, E);
#endif
 }
                }
                GSYNC();
                { PH_BEGIN
                for (int m = gw; m < TH; m += NGW) res_row(M1 + (size_t)m * DM, XST + (size_t)m * DM, XST + (size_t)m * DM, IN(3) + 1024, IN(4) + 1024, XN + (size_t)m * DM, lane);
                }
                GSYNC();
            }
            { PH_BEGIN
            { pg8::Gemm g = pg8::make_gemm(XN, DM, W_UP + (size_t)li * 8192 * 1024, DM, DM);
              g.a_seg = 1; g.hA = (size_t)4 * DM * 2; g.tB = (size_t)128 * DM * 2; g.hB = (size_t)4096 * DM * 2;
              pg8::StaticOrder so; so.init(TH / 256, 32, G, bid);
#ifndef NO_UP
              EpiUp E{ACT, YB, IN(23) + (size_t)li * 3 * 8192, IN(24) + (size_t)li * 8192}; for (int rep_ = 0; rep_ < REP_UP; ++rep_) pg8::gemm_phase<EpiUp>(lds, g, so, E);
#endif
 }
            }
            GSYNC();
            { PH_BEGIN
            for (int rep_ = 0; rep_ < REP_PASS; ++rep_)
            for (int b = bid; b < 256; b += G) { const int seg = b >> 1, which = b & 1; const int t = seg * 128 + (which ? 127 : 0); const int pos = t & (S - 1);
                const float* cw = IN(23) + (size_t)li * 3 * 8192; const float* cb = IN(24) + (size_t)li * 8192;
                const bool hasp = which ? true : (pos != 0), hasn = which ? (pos != S - 1) : true;
                const bf16_t* yp = which ? YB + ((size_t)seg * 4 + 2) * 8192 : YB + ((size_t)(seg - 1) * 4 + 3) * 8192;
                const bf16_t* yc = YB + ((size_t)seg * 4 + (which ? 3 : 0)) * 8192;
                const bf16_t* yn = which ? YB + ((size_t)(seg + 1) * 4 + 0) * 8192 : YB + ((size_t)seg * 4 + 1) * 8192;
                for (int c = tid; c < 4096; c += NTHR) {
                    float u2[2];
#pragma unroll
                    for (int bj = 0; bj < 2; ++bj) { const int ch = bj * 4096 + c;
                        float r = cw[8192 + ch] * bf2f(yc[ch]) + cb[ch];
                        if (hasp) r += cw[ch] * bf2f(yp[ch]);
                        if (hasn) r += cw[2 * 8192 + ch] * bf2f(yn[ch]);
                        u2[bj] = r; }
                    ACT[(size_t)t * DFF + c] = f2bf(gelu_tanh(u2[0]) * u2[1]); } }
            }
            GSYNC();
            if (gridDim.x == 256) {
                { PH_BEGIN
                { pg8::Gemm g = pg8::make_gemm(ACT, DFF, W_DOWN + (size_t)li * 1024 * 4096, DFF, DFF); pg8::StaticOrder so; so.init(TH / 256, 4, G, bid);
                  const int use = half * 2 + li;
                  EpiRms E{XST, li == 0 ? XN : nullptr, IN(5) + li * 1024, IN(2) + 1024, (float*)(ws + WS_XBUF), (float*)(ws + WS_XBUF) + (size_t)TH * 4,
                           (unsigned*)(ws + WS_CNT) + (size_t)(use * 2) * 4096, (unsigned*)(ws + WS_CNT) + (size_t)(use * 2 + 1) * 4096};
                  pg8::gemm_phase<EpiRms>(lds, g, so, E); }
                if (half == 0 && li == 1)
                  { for (int m = gw; m < TH; m += NGW) xn_row(IN(1) + (size_t)m * DM, IN(2), XN + (size_t)m * DM, lane);
                  }
                }
                GSYNC();
            } else {
                { PH_BEGIN
                { pg8::Gemm g = pg8::make_gemm(ACT, DFF, W_DOWN + (size_t)li * 1024 * 4096, DFF, DFF); pg8::StaticOrder so; so.init(TH / 256, 4, G, bid);
                  EpiBf16 E{Fb, DM, 0, 0};
                  pg8::gemm_phase<EpiBf16>(lds, g, so, E); }
                }
                GSYNC();
                { PH_BEGIN
                for (int m = gw; m < TH; m += NGW) res_row(Fb + (size_t)m * DM, XST + (size_t)m * DM, XST + (size_t)m * DM, IN(5) + li * 1024, li == 0 ? IN(2) + 1024 : nullptr, XN + (size_t)m * DM, lane);
                }
                GSYNC();
            }
        }
    }
}

extern "C" void kernel_launch(void* const* d_in, const int* in_sizes, int n_in, void* d_out, int out_size, void* d_ws, size_t ws_size, hipStream_t stream) {
    static int grid = 0;
    if (grid == 0) {
        int dev = 0, cus = 0, per_cu = 0;
        (void)hipGetDevice(&dev);
        (void)hipDeviceGetAttribute(&cus, hipDeviceAttributeMultiprocessorCount, dev);
        (void)hipFuncSetAttribute((const void*)mk_fwd, hipFuncAttributeMaxDynamicSharedMemorySize, LDS_BYTES);
        (void)hipOccupancyMaxActiveBlocksPerMultiprocessor(&per_cu, (const void*)mk_fwd, NTHR, LDS_BYTES);
        if (per_cu < 1) per_cu = 1;
        grid = cus * per_cu;
        if (ws_size < WS_END || n_in != 26) { fprintf(stderr, "kernel_launch: unexpected ws_size %zu / n_in %d\n", ws_size, n_in); }
    }
    Args a{};
    for (int i = 0; i < 26; ++i) a.in[i] = (const float*)d_in[i];
    a.out = (float*)d_out; a.ws = (unsigned char*)d_ws;
    void* args[] = {&a};
    hipError_t e = hipLaunchCooperativeKernel((const void*)mk_fwd, dim3(grid), dim3(NTHR), args, LDS_BYTES, stream);
    if (e != hipSuccess) fprintf(stderr, "cooperative launch failed: %s (grid %d)\n", hipGetErrorString(e), grid);
}
```

```cpp
#include <hip/hip_runtime.h>
#include <hip/hip_cooperative_groups.h>
#include <cstdio>
#include <cstdint>
namespace cg = cooperative_groups;

#define LAS __attribute__((address_space(3)))
typedef unsigned short bf16_t;
typedef short bf16x8 __attribute__((ext_vector_type(8)));
typedef short s16x4 __attribute__((ext_vector_type(4)));
typedef float f32x4 __attribute__((ext_vector_type(4)));
typedef float f32x16 __attribute__((ext_vector_type(16)));
typedef unsigned u32x4 __attribute__((ext_vector_type(4)));
typedef unsigned u32x2 __attribute__((ext_vector_type(2)));

__device__ __forceinline__ unsigned cvt_pk_bf16(float lo, float hi) { unsigned r; asm volatile("v_cvt_pk_bf16_f32 %0, %1, %2" : "=v"(r) : "v"(lo), "v"(hi)); return r; }
__device__ __forceinline__ float bf2f(bf16_t v) { return __uint_as_float(((unsigned)v) << 16); }
__device__ __forceinline__ float bflo(unsigned w) { return __uint_as_float(w << 16); }
__device__ __forceinline__ float bfhi(unsigned w) { return __uint_as_float(w & 0xffff0000u); }
__device__ __forceinline__ bf16_t f2bf(float f) { return (bf16_t)(cvt_pk_bf16(f, 0.f) & 0xffffu); }
__device__ __forceinline__ float fexp2(float x) { return __builtin_amdgcn_exp2f(x); }
__device__ __forceinline__ float frcp(float x) { return __builtin_amdgcn_rcpf(x); }
__device__ __forceinline__ float gelu_tanh(float x) {
    const float u = x * (1.0f + 0.044715f * x * x) * (-2.0f * 0.7978845608028654f * 1.4426950408889634f);
    return x * frcp(1.0f + fexp2(u));
}
__device__ __forceinline__ float sigmoidf_(float x) { return frcp(1.0f + fexp2(-1.4426950408889634f * x)); }
__device__ __forceinline__ float bperm_f(int src_lane, float v) { return __int_as_float(__builtin_amdgcn_ds_bpermute(src_lane << 2, __float_as_int(v))); }
#define DPP_F(V, CTRL) __int_as_float(__builtin_amdgcn_mov_dpp(__float_as_int(V), (CTRL), 0xf, 0xf, true))
__device__ __forceinline__ float wave_sum(float v, int  ) {
    v += DPP_F(v, 0xB1);
    v += DPP_F(v, 0x4E);
    v += DPP_F(v, 0x141);
    v += DPP_F(v, 0x140);
    const int iv = __float_as_int(v);
    return (__int_as_float(__builtin_amdgcn_readlane(iv, 0)) + __int_as_float(__builtin_amdgcn_readlane(iv, 16))) + (__int_as_float(__builtin_amdgcn_readlane(iv, 32)) + __int_as_float(__builtin_amdgcn_readlane(iv, 48)));
}
__device__ __forceinline__ float xor32_max(float v) { auto rr = __builtin_amdgcn_permlane32_swap(__float_as_uint(v), __float_as_uint(v), false, false); return fmaxf(__uint_as_float(rr[0]), __uint_as_float(rr[1])); }
__device__ __forceinline__ float xor32_sum(float v) { auto rr = __builtin_amdgcn_permlane32_swap(__float_as_uint(v), __float_as_uint(v), false, false); return __uint_as_float(rr[0]) + __uint_as_float(rr[1]); }

__device__ __forceinline__ void lru_ab(float ga, float gx, float gab, float gxb, float spl  , float xb, float& a, float& b) {
    const float r = sigmoidf_(ga + gab), ii = sigmoidf_(gx + gxb);
    const float la2 = (-8.0f * 1.4426950408889634f) * r * spl;
    a = fexp2(la2);
    const float om = 1.0f - a * a;
    b = __builtin_amdgcn_sqrtf(om) * (ii * xb);
}


__device__ __forceinline__ void lru_lb(float ga, float gx, float gab, float gxb, float spl, float xb, float& la2, float& b) {
    const float r = sigmoidf_(ga + gab), ii = sigmoidf_(gx + gxb);
    la2 = (-8.0f * 1.4426950408889634f) * r * spl;
    const float a = fexp2(la2); const float om = 1.0f - a * a;
    b = __builtin_amdgcn_sqrtf(om) * (ii * xb);
}

namespace pg8 {
constexpr int BM = 256, BK = 64, HALF = 128, HTB = HALF * BK * 2, STAGE_BYTES = 8 * HTB, NXCD = 8, WGM = 8;
__host__ __device__ __forceinline__ int lds_byte(int r, int c) { const int st = (r >> 4) * 2 + (c >> 5), rr = r & 15, cc = c & 31, ob = rr * 64 + cc * 2; return st * 1024 + (ob ^ (((ob >> 9) & 1) << 5)); }
__host__ __device__ __forceinline__ void stage_rc(int b, int& R, int& C) { const int st = b / 1024, sb = b % 1024, swz = sb ^ (((sb >> 9) & 1) << 5); R = (st >> 1) * 16 + swz / 64; C = (st & 1) * 32 + (swz % 64) / 2; }
__host__ __device__ __forceinline__ int perm32(int rho) { const int n = rho >> 4, i = rho & 15; return 8 * (i >> 2) + 4 * n + (i & 3); }

struct Unit { int pm, pn; };
struct Gemm { const bf16_t* A; const bf16_t* Bt; int lda, ldb, K; size_t tA, hA, tB, hB; int a_seg; int a_pn_shift; size_t a_pn_step; };
__device__ __forceinline__ Gemm make_gemm(const bf16_t* A, int lda, const bf16_t* Bt, int ldb, int K) {
    Gemm g; g.A = A; g.Bt = Bt; g.lda = lda; g.ldb = ldb; g.K = K; g.tA = (size_t)256 * lda * 2; g.hA = (size_t)128 * lda * 2; g.tB = (size_t)256 * ldb * 2; g.hB = (size_t)128 * ldb * 2;
    g.a_seg = 0; g.a_pn_shift = 0; g.a_pn_step = 0; return g;
}

struct StaticOrder {
    int nM, nN, nwg, G, c;
    __device__ __forceinline__ void init(int nM_, int nN_, int G_, int c_) { nM = nM_; nN = nN_; nwg = nM * nN; G = G_; c = c_; }
    __device__ __forceinline__ bool next(int i, Unit& u) const {
        const long L = (long)i * G + c; if (L >= nwg) return false;
        int wgid = (int)L; { const int q = nwg / NXCD, r = nwg % NXCD, xcd = wgid % NXCD, off = wgid / NXCD; wgid = (xcd < r ? xcd * (q + 1) : r * (q + 1) + (xcd - r) * q) + off; }
        const int nig = WGM * nN, gid = wgid / nig, fm = gid * WGM, gsz = (nM - fm) < WGM ? (nM - fm) : WGM;
        u.pm = fm + ((wgid % nig) % gsz); u.pn = (wgid % nig) / gsz; return true;
    }
};

template <class Epi>
__device__ __forceinline__ void gemm_phase(LAS unsigned char* lds, const Gemm g, const StaticOrder& S, const Epi& E) {
    constexpr bool SP2 = true, ALIGN_EPI = true;
    int tid_ = threadIdx.x; asm volatile("" : "+v"(tid_));
    const int tid = tid_, wid = __builtin_amdgcn_readfirstlane(tid >> 6), lane = tid & 63, wr = wid >> 2, wc = wid & 3, fr = lane & 15, fq = lane >> 4;
    int K_ = g.K; asm volatile("" : "+s"(K_)); const int K = K_, nt = K / BK;
    unsigned voffA[2], voffB[2];
#pragma unroll
    for (int i = 0; i < 2; ++i) { int R, C; stage_rc(tid * 16 + i * 8192, R, C); const int Rb = Epi::PERM ? ((R & ~31) + perm32(R & 31)) : R;
        const int Ra = g.a_seg ? (128 * (R >> 6) + 8 * (R & 15) + ((R >> 4) & 3)) : R;
        voffA[i] = (unsigned)(Ra * g.lda + C) * 2u; voffB[i] = (unsigned)(Rb * g.ldb + C) * 2u; }
    const size_t kstep = (size_t)(BK * 2);
    const size_t hstepA = g.hA, hstepB = g.hB;
    const unsigned ldsw = (unsigned)wid * 1024u;
    const int aoff = lds_byte(wr * 64 + fr, fq * 8), boff = lds_byte(wc * 32 + fr, fq * 8);
#define PG8_SA(b, h) (((b) * 2 + (h)) * HTB)
#define PG8_SB(b, h) ((4 + (b) * 2 + (h)) * HTB)
#define PG8_STAGE(bufoff, gbase, voff) do { _Pragma("unroll") for (int _i = 0; _i < 2; ++_i) \
        __builtin_amdgcn_global_load_lds((const unsigned*)((const char*)(gbase) + (voff)[_i]), (LAS unsigned*)(lds + (bufoff) + ldsw + _i * 8192), 16, 0, 0); } while (0)
#define PG8_LDA(dst, b, h) do { _Pragma("unroll") for (int m = 0; m < 4; ++m) _Pragma("unroll") for (int k = 0; k < 2; ++k) dst[m][k] = *(const LAS bf16x8*)(lds + PG8_SA(b, h) + aoff + m * 2048 + k * 1024); } while (0)
#define PG8_LDB(dst, b, h) do { _Pragma("unroll") for (int n = 0; n < 2; ++n) _Pragma("unroll") for (int k = 0; k < 2; ++k) dst[n][k] = *(const LAS bf16x8*)(lds + PG8_SB(b, h) + boff + n * 2048 + k * 1024); } while (0)
#define PG8_MMA(ai, bj, At, Bt) do { __builtin_amdgcn_s_setprio(1); _Pragma("unroll") for (int m = 0; m < 4; ++m) _Pragma("unroll") for (int n = 0; n < 2; ++n) _Pragma("unroll") for (int k = 0; k < 2; ++k) \
        acc[ai][bj][m][n] = __builtin_amdgcn_mfma_f32_16x16x32_bf16(Bt[n][k], At[m][k], acc[ai][bj][m][n], 0, 0, 0); __builtin_amdgcn_s_setprio(0); } while (0)
#define PG8_WAIT_V(n) asm volatile("s_waitcnt vmcnt(" #n ")" ::: "memory")
#define PG8_WAIT_L(n) asm volatile("s_waitcnt lgkmcnt(" #n ")" ::: "memory")
#define PG8_BAR __builtin_amdgcn_s_barrier()
#define PG8_SCHED __builtin_amdgcn_sched_barrier(0)
#define PG8_APTR(u) ((const char*)g.A + (size_t)(u).pm * g.tA + (size_t)((u).pn >> g.a_pn_shift) * g.a_pn_step)
#define PG8_BPTR(u) ((const char*)g.Bt + (size_t)(u).pn * g.tB)
    Unit cur, nxt; int ui = 0;
    if (!S.next(0, cur)) return;
    f32x4 acc[2][2][4][2];
#pragma unroll
    for (int a = 0; a < 2; ++a)
#pragma unroll
        for (int b = 0; b < 2; ++b)
#pragma unroll
            for (int m = 0; m < 4; ++m)
#pragma unroll
                for (int n = 0; n < 2; ++n) acc[a][b][m][n] = (f32x4){0.f, 0.f, 0.f, 0.f};
    bf16x8 At[4][2], B0[2][2], B1[2][2];
    const char* cA = PG8_APTR(cur); const char* cB = PG8_BPTR(cur);
    {
        PG8_STAGE(PG8_SB(0, 0), cB, voffB); PG8_STAGE(PG8_SB(0, 1), cB + hstepB, voffB); PG8_STAGE(PG8_SA(0, 0), cA, voffA); PG8_STAGE(PG8_SA(0, 1), cA + hstepA, voffA);
        if (wr == 1) PG8_BAR;
        PG8_WAIT_V(2); PG8_BAR;
        PG8_STAGE(PG8_SB(1, 0), cB + kstep, voffB); PG8_STAGE(PG8_SA(1, 0), cA + kstep, voffA); PG8_STAGE(PG8_SB(1, 1), cB + hstepB + kstep, voffB);
        PG8_WAIT_V(6); PG8_BAR;
    }
    for (;;) {
        const bool has_next = S.next(ui + 1, nxt);
        const char* nA = has_next ? PG8_APTR(nxt) : cA; const char* nB = has_next ? PG8_BPTR(nxt) : cB;
        for (int t = 0; t < nt; t += 2) {
            const bool last = (t == nt - 2);
            const char* a1 = cA + (size_t)(t + 1) * kstep;
            const char* a2 = last ? nA : cA + (size_t)(t + 2) * kstep; const char* b2 = last ? nB : cB + (size_t)(t + 2) * kstep;
            const char* a3 = a2 + kstep; const char* b3 = b2 + kstep;
            PG8_LDB(B0, 0, 0); PG8_LDB(B1, 0, 1); PG8_SCHED; PG8_LDA(At, 0, 0); PG8_STAGE(PG8_SA(1, 1), a1 + hstepA, voffA);
            PG8_WAIT_V(8); PG8_WAIT_L(0); PG8_BAR; PG8_MMA(0, 0, At, B0); PG8_MMA(0, 1, At, B1); PG8_BAR; PG8_SCHED;
            PG8_LDA(At, 0, 1); PG8_STAGE(PG8_SB(0, 0), b2, voffB); PG8_STAGE(PG8_SB(0, 1), b2 + hstepB, voffB); PG8_STAGE(PG8_SA(0, 0), a2, voffA);
            PG8_WAIT_V(8); PG8_WAIT_L(0); PG8_BAR; PG8_MMA(1, 0, At, B0); PG8_MMA(1, 1, At, B1); PG8_BAR; PG8_SCHED;
            PG8_LDB(B0, 1, 0); PG8_LDB(B1, 1, 1); PG8_SCHED; PG8_LDA(At, 1, 0); PG8_STAGE(PG8_SA(0, 1), a2 + hstepA, voffA);
            PG8_WAIT_V(8); PG8_WAIT_L(0); PG8_BAR; PG8_MMA(0, 0, At, B0); PG8_MMA(0, 1, At, B1); PG8_BAR; PG8_SCHED;
            PG8_LDA(At, 1, 1); PG8_STAGE(PG8_SB(1, 0), b3, voffB); PG8_STAGE(PG8_SB(1, 1), b3 + hstepB, voffB); PG8_STAGE(PG8_SA(1, 0), a3, voffA);
            PG8_WAIT_V(8); PG8_WAIT_L(0); PG8_BAR; PG8_MMA(1, 0, At, B0); PG8_MMA(1, 1, At, B1); PG8_BAR; PG8_SCHED;
        }
        if constexpr (ALIGN_EPI) { if (wr == 0) PG8_BAR; }
        if constexpr (!Epi::AFTER_DRAIN) E(acc, cur, wr, wc, fr, fq);
        if (!has_next) break;
#pragma unroll
        for (int a = 0; a < 2; ++a)
#pragma unroll
            for (int b = 0; b < 2; ++b)
#pragma unroll
                for (int m = 0; m < 4; ++m)
#pragma unroll
                    for (int n = 0; n < 2; ++n) acc[a][b][m][n] = (f32x4){0.f, 0.f, 0.f, 0.f};
        cur = nxt; cA = nA; cB = nB; ++ui;
        if constexpr (ALIGN_EPI) { if (wr == 1) PG8_BAR; }
    }
    PG8_WAIT_V(0);
    if constexpr (!ALIGN_EPI) { if (wr == 0) PG8_BAR; }
    PG8_BAR;
    if constexpr (Epi::AFTER_DRAIN) E.fused(acc, cur, wr, wc, fr, fq, lds, wid, lane);
#undef PG8_SA
#undef PG8_SB
#undef PG8_STAGE
#undef PG8_LDA
#undef PG8_LDB
#undef PG8_MMA
#undef PG8_WAIT_V
#undef PG8_WAIT_L
#undef PG8_BAR
#undef PG8_SCHED
#undef PG8_APTR
#undef PG8_BPTR
}
}
constexpr int TH = 16384;
constexpr int DM = 1024, ZP = 2304, DFF = 4096, TQ = 8192;
constexpr size_t MiB = 1u << 20;
constexpr size_t WS_RSQ = 0, WS_RSKV = 64 * 1024, WS_ROPE = 128 * 1024;
constexpr size_t WS_AGG = 5 * MiB;
constexpr size_t WS_CARRY = 9 * MiB;
constexpr size_t WS_XBUF = 1 * MiB;
constexpr size_t WS_SQP = 1 * MiB + 512 * 1024;
constexpr size_t WS_CNT = 3 * MiB;
constexpr size_t WS_BAR = 4 * MiB;
constexpr size_t WS_YB = 5 * MiB;
constexpr size_t WS_W_INATT = 13 * MiB;
constexpr size_t WS_W_UQ = WS_W_INATT + (size_t)2304 * 1024 * 2;
constexpr size_t WS_W_UKV = WS_W_UQ + (size_t)768 * 384 * 2;
constexpr size_t WS_W_OUTATT = WS_W_UKV + (size_t)1024 * 256 * 2;
constexpr size_t WS_W_INREC = WS_W_OUTATT + 2 * MiB;
constexpr size_t WS_W_GATES = WS_W_INREC + 4 * MiB;
constexpr size_t WS_W_OUTREC = WS_W_GATES + 1 * MiB;
constexpr size_t WS_W_UP = WS_W_OUTREC + 2 * MiB;
constexpr size_t WS_W_DOWN = WS_W_UP + 32 * MiB;
constexpr size_t WS_W_END = WS_W_DOWN + 16 * MiB;
static_assert(WS_W_END <= 76 * MiB, "weights");
constexpr size_t WS_XN = 76 * MiB;
constexpr size_t WS_BIG = 108 * MiB;
constexpr size_t WS_Z = WS_BIG;
constexpr size_t WS_Q = WS_Z + 72 * MiB;
constexpr size_t WS_KN = WS_Q + 24 * MiB;
constexpr size_t WS_VTM = WS_KN + 16 * MiB;
constexpr size_t WS_VTN = WS_VTM + 16 * MiB;
constexpr size_t WS_KPE = WS_VTN + 16 * MiB;
static_assert(WS_KPE + 1 * MiB <= 256 * MiB, "L0 overlay");
constexpr size_t WS_ACT = WS_BIG;
constexpr size_t WS_GATE = WS_BIG;
constexpr size_t WS_XB = WS_BIG + 32 * MiB;
constexpr size_t WS_XBR = WS_BIG + 64 * MiB;
constexpr size_t WS_GQ = WS_XBR;
constexpr size_t WS_END = 256 * MiB;

using pg8::Unit;

struct EpiBf16 {
    static constexpr bool PERM = true, AFTER_DRAIN = false;
    bf16_t* O; int ldc; int split_cols; size_t split_stride;
    __device__ __forceinline__ void operator()(f32x4 (&acc)[2][2][4][2], const Unit& u, int wr, int wc, int fr, int fq) const {
        const int row0 = u.pm * 256 + wr * 64 + fr; int colt = u.pn * 256; bf16_t* base = O;
        if (split_cols) { const int t = colt / split_cols; base += (size_t)t * split_stride; colt -= t * split_cols; }
        const int col0 = colt + wc * 32 + 8 * fq;
#pragma unroll
        for (int ai = 0; ai < 2; ++ai)
#pragma unroll
            for (int m = 0; m < 4; ++m) { bf16_t* rowp = base + (size_t)(row0 + ai * 128 + m * 16) * ldc + col0;
#pragma unroll
                for (int bj = 0; bj < 2; ++bj) { const f32x4 v0 = acc[ai][bj][m][0], v1 = acc[ai][bj][m][1];
                    u32x4 w; w.x = cvt_pk_bf16(v0[0], v0[1]); w.y = cvt_pk_bf16(v0[2], v0[3]); w.z = cvt_pk_bf16(v1[0], v1[1]); w.w = cvt_pk_bf16(v1[2], v1[3]);
                    *(u32x4*)(rowp + bj * 128) = w; } }
    }
};

struct EpiZ {
    static constexpr bool PERM = true, AFTER_DRAIN = false;
    bf16_t* Z; bf16_t* VTn; float* SQ; float* SKV; bf16_t* KPE; const float2* rope; int smask;
    __device__ __forceinline__ void operator()(f32x4 (&acc)[2][2][4][2], const Unit& u, int wr, int wc, int fr, int fq) const {
        const int lane = fq * 16 + fr;
        const int row0 = u.pm * 256 + wr * 64 + fr; const int col0 = u.pn * 256 + wc * 32 + 8 * fq;
#pragma unroll
        for (int ai = 0; ai < 2; ++ai)
#pragma unroll
            for (int m = 0; m < 4; ++m) { const int row = row0 + ai * 128 + m * 16; bf16_t* rowp = Z + (size_t)row * ZP + col0;
#pragma unroll
                for (int bj = 0; bj < 2; ++bj) { const f32x4 v0 = acc[ai][bj][m][0], v1 = acc[ai][bj][m][1];
                    u32x4 w; w.x = cvt_pk_bf16(v0[0], v0[1]); w.y = cvt_pk_bf16(v0[2], v0[3]); w.z = cvt_pk_bf16(v1[0], v1[1]); w.w = cvt_pk_bf16(v1[2], v1[3]);
                    *(u32x4*)(rowp + bj * 128) = w;
                    const int c = col0 + bj * 128; const int g32 = (u.pn * 256 + bj * 128 + wc * 32) >> 5;
                    if (g32 < 20) {
                        float s = (v0[0] * v0[0] + v0[1] * v0[1]) + (v0[2] * v0[2] + v0[3] * v0[3]) + ((v1[0] * v1[0] + v1[1] * v1[1]) + (v1[2] * v1[2] + v1[3] * v1[3]));
                        s += bperm_f(lane ^ 16, s); s += bperm_f(lane ^ 32, s);
                        if (fq == 0) SQ[(size_t)row * 20 + g32] = s;
                    } else if (g32 == 20) {
                        const float2* rp = rope + (size_t)(row & smask) * 16 + 8 * (fq & 1);
                        float o[8];
#pragma unroll
                        for (int k = 0; k < 8; ++k) { const float mine = k < 4 ? v0[k] : v1[k - 4]; const float other = bperm_f(lane ^ 32, mine); const float2 cs = rp[k];
                            o[k] = fq < 2 ? mine * cs.x - other * cs.y : mine * cs.x + other * cs.y; }
                        u32x4 wk; wk.x = cvt_pk_bf16(o[0], o[1]); wk.y = cvt_pk_bf16(o[2], o[3]); wk.z = cvt_pk_bf16(o[4], o[5]); wk.w = cvt_pk_bf16(o[6], o[7]);
                        *(u32x4*)(KPE + (size_t)row * 32 + 8 * fq) = wk;
                    }
                    if (c >= 1696 && c < 2208) { bf16_t* vt = VTn + (size_t)(c - 1696) * TH + row;
                        vt[0] = (bf16_t)(w.x & 0xffffu); vt[TH] = (bf16_t)(w.x >> 16); vt[2 * TH] = (bf16_t)(w.y & 0xffffu); vt[3 * TH] = (bf16_t)(w.y >> 16);
                        vt[4 * TH] = (bf16_t)(w.z & 0xffffu); vt[5 * TH] = (bf16_t)(w.z >> 16); vt[6 * TH] = (bf16_t)(w.w & 0xffffu); vt[7 * TH] = (bf16_t)(w.w >> 16); } } }
    }
};

struct EpiQ {
    static constexpr bool PERM = false, AFTER_DRAIN = false;
    bf16_t* Q; const float* rsq; const float2* rope; int smask;
    __device__ __forceinline__ void operator()(f32x4 (&acc)[2][2][4][2], const Unit& u, int wr, int wc, int fr, int fq) const {
        const float SC = 0.10206207261596577f * 1.4426950408889634f;
        const int row0 = u.pm * 256 + wr * 64 + fr;
#pragma unroll
        for (int ai = 0; ai < 2; ++ai)
#pragma unroll
            for (int m = 0; m < 4; ++m) { const int row = row0 + ai * 128 + m * 16; float ssq = 0.f;
#pragma unroll
                for (int k = 0; k < 12; ++k) ssq += rsq[(size_t)row * 20 + k];
                const float rs = SC / sqrtf(ssq * (1.f / 384.f) + 1e-6f); const int pos = row & smask;
#pragma unroll
                for (int bj = 0; bj < 2; ++bj) { const int cg = u.pn * 256 + bj * 128 + wc * 32;
                    f32x4 v0 = acc[ai][bj][m][0] * rs, v1 = acc[ai][bj][m][1] * rs;
                    if ((cg % 96) == 64) {
                        const float2* rp = rope + (size_t)pos * 16 + 4 * fq;
#pragma unroll
                        for (int i = 0; i < 4; ++i) { const float2 cs = rp[i]; const float x1 = v0[i], x2 = v1[i]; v0[i] = x1 * cs.x - x2 * cs.y; v1[i] = x2 * cs.x + x1 * cs.y; }
                    }
                    bf16_t* p = Q + (size_t)row * 768 + cg + 4 * fq;
                    u32x2 w0; w0.x = cvt_pk_bf16(v0[0], v0[1]); w0.y = cvt_pk_bf16(v0[2], v0[3]); *(u32x2*)p = w0;
                    u32x2 w1; w1.x = cvt_pk_bf16(v1[0], v1[1]); w1.y = cvt_pk_bf16(v1[2], v1[3]); *(u32x2*)(p + 16) = w1; } }
    }
};

struct EpiKV {
    static constexpr bool PERM = true, AFTER_DRAIN = false;
    bf16_t* KN; bf16_t* VTm; const float* rskv;
    __device__ __forceinline__ void operator()(f32x4 (&acc)[2][2][4][2], const Unit& u, int wr, int wc, int fr, int fq) const {
        const int row0 = u.pm * 256 + wr * 64 + fr;
#pragma unroll
        for (int ai = 0; ai < 2; ++ai)
#pragma unroll
            for (int m = 0; m < 4; ++m) { const int row = row0 + ai * 128 + m * 16; float ssq = 0.f;
#pragma unroll
                for (int k = 12; k < 20; ++k) ssq += rskv[(size_t)row * 20 + k];
                const float rs = 1.0f / sqrtf(ssq * (1.f / 256.f) + 1e-6f);
#pragma unroll
                for (int bj = 0; bj < 2; ++bj) { const int c = u.pn * 256 + bj * 128 + wc * 32 + 8 * fq;
                    const f32x4 v0 = acc[ai][bj][m][0] * rs, v1 = acc[ai][bj][m][1] * rs;
                    u32x4 w; w.x = cvt_pk_bf16(v0[0], v0[1]); w.y = cvt_pk_bf16(v0[2], v0[3]); w.z = cvt_pk_bf16(v1[0], v1[1]); w.w = cvt_pk_bf16(v1[2], v1[3]);
                    const int h = c >> 7, j = c & 127;
                    if (j < 64) { *(u32x4*)(KN + (size_t)row * 512 + h * 64 + j) = w; }
                    else { bf16_t* vt = VTm + (size_t)(h * 64 + j - 64) * TH + row;
                        vt[0] = (bf16_t)(w.x & 0xffffu); vt[TH] = (bf16_t)(w.x >> 16); vt[2 * TH] = (bf16_t)(w.y & 0xffffu); vt[3 * TH] = (bf16_t)(w.y >> 16);
                        vt[4 * TH] = (bf16_t)(w.z & 0xffffu); vt[5 * TH] = (bf16_t)(w.z >> 16); vt[6 * TH] = (bf16_t)(w.w & 0xffffu); vt[7 * TH] = (bf16_t)(w.w >> 16); } } }
    }
};

struct EpiUp {
    static constexpr bool PERM = true, AFTER_DRAIN = false;
    bf16_t* ACT; bf16_t* YB; const float* cw; const float* cb;
    __device__ __forceinline__ void operator()(f32x4 (&acc)[2][2][4][2], const Unit& u, int wr, int wc, int fr_, int fq_) const {
        int fr = fr_, fq = fq_; asm volatile("" : "+v"(fr), "+v"(fq));
        const int lane = fq * 16 + fr;
        const int tok0 = u.pm * 256 + wr * 128 + 8 * fr;
        const int ch0 = u.pn * 128 + wc * 32 + 8 * fq;
        const int seg = u.pm * 2 + wr;
        if (fr == 0 || fr == 15) {
#pragma unroll
            for (int k = 0; k < 2; ++k) {
                const int slot = fr == 0 ? k : 2 + k;
                bf16_t* yb = YB + ((size_t)seg * 4 + slot) * 8192 + ch0;
#pragma unroll
                for (int bj = 0; bj < 2; ++bj) { const f32x4 v0 = fr == 0 ? acc[0][bj][k][0] : acc[1][bj][2 + k][0], v1 = fr == 0 ? acc[0][bj][k][1] : acc[1][bj][2 + k][1];
                    u32x4 w; w.x = cvt_pk_bf16(v0[0], v0[1]); w.y = cvt_pk_bf16(v0[2], v0[3]); w.z = cvt_pk_bf16(v1[0], v1[1]); w.w = cvt_pk_bf16(v1[2], v1[3]);
                    *(u32x4*)(yb + bj * 4096) = w; }
            }
        }
        const int src_up = (lane & ~15) | ((fr - 1) & 15), src_dn = (lane & ~15) | ((fr + 1) & 15);
#pragma unroll
        for (int n = 0; n < 2; ++n)
#pragma unroll
            for (int i = 0; i < 4; ++i) {
                float ug[8], uv[8];
#pragma unroll
                for (int bj = 0; bj < 2; ++bj) {
                    const int ch = bj * 4096 + ch0 + 4 * n + i;
                    const float w0 = cw[ch], w1 = cw[8192 + ch], w2 = cw[2 * 8192 + ch], b = cb[ch];
                    const float prev7 = bperm_f(src_up, acc[1][bj][3][n][i]);
                    const float next0 = bperm_f(src_dn, acc[0][bj][0][n][i]);
#pragma unroll
                    for (int q = 0; q < 8; ++q) {
                        const float v = acc[q >> 2][bj][q & 3][n][i];
                        const float up = q > 0 ? acc[(q - 1) >> 2][bj][(q - 1) & 3][n][i] : prev7;
                        const float dn = q < 7 ? acc[(q + 1) >> 2][bj][(q + 1) & 3][n][i] : next0;
                        const float r = w0 * up + w1 * v + w2 * dn + b;
                        if (bj == 0) ug[q] = r; else uv[q] = r;
                    }
                }
#pragma unroll
                for (int q = 0; q < 8; ++q) acc[q >> 2][0][q & 3][n][i] = gelu_tanh(ug[q]) * uv[q];
            }
#pragma unroll
        for (int ai = 0; ai < 2; ++ai)
#pragma unroll
            for (int m = 0; m < 4; ++m) { const f32x4 v0 = acc[ai][0][m][0], v1 = acc[ai][0][m][1];
                u32x4 w; w.x = cvt_pk_bf16(v0[0], v0[1]); w.y = cvt_pk_bf16(v0[2], v0[3]); w.z = cvt_pk_bf16(v1[0], v1[1]); w.w = cvt_pk_bf16(v1[2], v1[3]);
                *(u32x4*)(ACT + (size_t)(tok0 + 4 * ai + m) * DFF + ch0) = w; }
    }
};

struct EpiGates {
    static constexpr bool PERM = true, AFTER_DRAIN = false;
    bf16_t* G; const bf16_t* XBq; float2* AGGp; const float* gab_; const float* gxb_; const float* lam_;
    __device__ __forceinline__ void operator()(f32x4 (&acc)[2][2][4][2], const Unit& u, int wr, int wc, int fr_, int fq_) const {
        int fr = fr_, fq = fq_; asm volatile("" : "+v"(fr), "+v"(fq));
        const int lane = fq * 16 + fr;
        const int nblk = u.pn >> 1, e = u.pn & 1;
        const int tl0 = u.pm * 256 + wr * 128 + 8 * fr;
        const int d0 = wc * 32 + 8 * fq, ch0 = nblk * 128 + d0;
        u32x4 xbw[8];
#pragma unroll
        for (int q = 0; q < 8; ++q) xbw[q] = *(const u32x4*)(XBq + (size_t)(tl0 + q) * DM + ch0);
        unsigned law[8][4], bw[8][4];
#pragma unroll
        for (int k2 = 0; k2 < 4; ++k2) {
            const float2 gab = *(const float2*)(gab_ + e * 1024 + ch0 + 2 * k2), gxb = *(const float2*)(gxb_ + e * 1024 + ch0 + 2 * k2), lam = *(const float2*)(lam_ + e * 1024 + ch0 + 2 * k2);
            const float spl0 = log1pf(expf(-lam.x)), spl1 = log1pf(expf(-lam.y));
#pragma unroll
            for (int q = 0; q < 8; ++q) {
                const unsigned xb2 = k2 == 0 ? xbw[q].x : k2 == 1 ? xbw[q].y : k2 == 2 ? xbw[q].z : xbw[q].w;
                float l0, b0, l1, b1;
                lru_lb(acc[q >> 2][0][q & 3][k2 >> 1][2 * (k2 & 1)], acc[q >> 2][1][q & 3][k2 >> 1][2 * (k2 & 1)], gab.x, gxb.x, spl0, bflo(xb2), l0, b0);
                lru_lb(acc[q >> 2][0][q & 3][k2 >> 1][2 * (k2 & 1) + 1], acc[q >> 2][1][q & 3][k2 >> 1][2 * (k2 & 1) + 1], gab.y, gxb.y, spl1, bfhi(xb2), l1, b1);
                law[q][k2] = cvt_pk_bf16(l0, l1); bw[q][k2] = cvt_pk_bf16(b0, b1); }
        }
#pragma unroll
        for (int q = 0; q < 8; ++q) { bf16_t* rowp = G + (size_t)(tl0 + q) * 4096 + u.pn * 256 + d0;
            *(u32x4*)(rowp) = (u32x4){law[q][0], law[q][1], law[q][2], law[q][3]}; *(u32x4*)(rowp + 128) = (u32x4){bw[q][0], bw[q][1], bw[q][2], bw[q][3]}; }
        float Aagg[8], Bagg[8];
#pragma unroll
        for (int k2 = 0; k2 < 4; ++k2) {
            float A0 = 1.f, B0 = 0.f, A1 = 1.f, B1 = 0.f;
#pragma unroll
            for (int s = 0; s < 8; ++s) {
                const unsigned l2 = e ? law[7 - s][k2] : law[s][k2], b2 = e ? bw[7 - s][k2] : bw[s][k2];
                const float a0 = fexp2(bflo(l2)), a1 = fexp2(bfhi(l2));
                A0 *= a0; B0 = a0 * B0 + bflo(b2); A1 *= a1; B1 = a1 * B1 + bfhi(b2); }
            Aagg[2 * k2] = A0; Bagg[2 * k2] = B0; Aagg[2 * k2 + 1] = A1; Bagg[2 * k2 + 1] = B1;
        }
#pragma unroll
        for (int bit = 1; bit <= 2; bit <<= 1) {
            const bool me_first = e ? ((fr & bit) != 0) : ((fr & bit) == 0);
#pragma unroll
            for (int k = 0; k < 8; ++k) { const float Ao = bperm_f(lane ^ bit, Aagg[k]), Bo = bperm_f(lane ^ bit, Bagg[k]);
                const float An = Ao * Aagg[k], Bn = me_first ? Ao * Bagg[k] + Bo : Aagg[k] * Bo + Bagg[k];
                Aagg[k] = An; Bagg[k] = Bn; }
        }
        if ((fr & 3) == 0) { const int c = (tl0 >> 5);
            float2* dst = AGGp + (size_t)(c * 2 + e) * 1024 + ch0;
#pragma unroll
            for (int k = 0; k < 8; k += 2) *(f32x4*)(dst + k) = (f32x4){Aagg[k], Bagg[k], Aagg[k + 1], Bagg[k + 1]}; }
    }
};

struct EpiRms {
    static constexpr bool PERM = false, AFTER_DRAIN = true;
    float* x; bf16_t* xn; const float* gpost; const float* gnext; float* xbuf1; float* xbuf2; unsigned* cnt1; unsigned* cnt2;
    __device__ __forceinline__ void operator()(f32x4 (&)[2][2][4][2], const Unit&, int, int, int, int) const {}
    __device__ __forceinline__ void stats(const f32x4 (&v)[2][2][4][2], const Unit& u, int wr, int wc, int fr, int fq, LAS unsigned char* lds, int wid, int lane, float* xbuf, unsigned* cnt) const {
        LAS float* P = (LAS float*)lds; LAS float* Sx = (LAS float*)(lds + 4096);
#pragma unroll
        for (int ai = 0; ai < 2; ++ai)
#pragma unroll
            for (int m = 0; m < 4; ++m) { float s = 0.f;
#pragma unroll
                for (int bj = 0; bj < 2; ++bj)
#pragma unroll
                    for (int n = 0; n < 2; ++n) { const f32x4 t = v[ai][bj][m][n]; s += (t[0] * t[0] + t[1] * t[1]) + (t[2] * t[2] + t[3] * t[3]); }
                s += bperm_f(lane ^ 16, s); s += bperm_f(lane ^ 32, s);
                if (fq == 0) P[(ai * 128 + wr * 64 + m * 16 + fr) * 4 + wc] = s; }
        asm volatile("s_waitcnt lgkmcnt(0)" ::: "memory"); __builtin_amdgcn_s_barrier(); asm volatile("" ::: "memory");
        const int row = wid * 32 + (lane & 31);
        if (lane < 32) { const float t = (P[row * 4 + 0] + P[row * 4 + 1]) + (P[row * 4 + 2] + P[row * 4 + 3]);
            __hip_atomic_store(xbuf + (size_t)(u.pm * 256 + row) * 4 + u.pn, t, __ATOMIC_RELAXED, __HIP_MEMORY_SCOPE_AGENT); }
        asm volatile("s_waitcnt vmcnt(0)" ::: "memory");
        if (lane == 0) __hip_atomic_fetch_add(cnt + 64 * u.pm, 1u, __ATOMIC_RELAXED, __HIP_MEMORY_SCOPE_AGENT);
        if (wid == 0) { unsigned sp = 0;
            while ((unsigned)__builtin_amdgcn_readfirstlane(__hip_atomic_load(cnt + 64 * u.pm, __ATOMIC_RELAXED, __HIP_MEMORY_SCOPE_AGENT)) < 32u) { __builtin_amdgcn_s_sleep(2); if (++sp > (1u << 22)) break; }
            __builtin_amdgcn_fence(__ATOMIC_ACQUIRE, "agent"); }
        asm volatile("s_waitcnt vmcnt(0) lgkmcnt(0)" ::: "memory"); __builtin_amdgcn_s_barrier(); asm volatile("" ::: "memory");
        if (lane < 32) { const float* slot = xbuf + (size_t)(u.pm * 256 + row) * 4; float t = 0.f;
#pragma unroll
            for (int k = 0; k < 4; ++k) t += __hip_atomic_load(slot + k, __ATOMIC_RELAXED, __HIP_MEMORY_SCOPE_AGENT);
            Sx[row] = 1.0f / sqrtf(t * (1.f / 1024.f) + 1e-6f); }
        asm volatile("s_waitcnt lgkmcnt(0)" ::: "memory"); __builtin_amdgcn_s_barrier(); asm volatile("" ::: "memory");
    }
    __device__ __forceinline__ void fused(f32x4 (&acc)[2][2][4][2], const Unit& u, int wr, int wc, int fr, int fq, LAS unsigned char* lds, int wid, int lane) const {
        const LAS float* Sx = (const LAS float*)(lds + 4096);
        const int col0 = u.pn * 256 + wc * 32 + 4 * fq;
        stats(acc, u, wr, wc, fr, fq, lds, wid, lane, xbuf1, cnt1);
#pragma unroll
        for (int ai = 0; ai < 2; ++ai)
#pragma unroll
            for (int m = 0; m < 4; ++m) { const int r = ai * 128 + wr * 64 + m * 16 + fr; const float rs = Sx[r]; float* xr = x + (size_t)(u.pm * 256 + r) * DM + col0;
#pragma unroll
                for (int bj = 0; bj < 2; ++bj)
#pragma unroll
                    for (int n = 0; n < 2; ++n) { const f32x4 g = *(const f32x4*)(gpost + col0 + bj * 128 + n * 16); const f32x4 bs = *(const f32x4*)(xr + bj * 128 + n * 16);
                        const f32x4 o = bs + acc[ai][bj][m][n] * rs * g; acc[ai][bj][m][n] = o; *(f32x4*)(xr + bj * 128 + n * 16) = o; }
                if (m & 1) asm volatile("" ::: "memory"); }
        if (xn) {
            stats(acc, u, wr, wc, fr, fq, lds, wid, lane, xbuf2, cnt2);
#pragma unroll
            for (int ai = 0; ai < 2; ++ai)
#pragma unroll
                for (int m = 0; m < 4; ++m) { const int r = ai * 128 + wr * 64 + m * 16 + fr; const float rs = Sx[r]; bf16_t* xr = xn + (size_t)(u.pm * 256 + r) * DM + col0;
#pragma unroll
                    for (int bj = 0; bj < 2; ++bj)
#pragma unroll
                        for (int n = 0; n < 2; ++n) { const f32x4 g = *(const f32x4*)(gnext + col0 + bj * 128 + n * 16); const f32x4 o = acc[ai][bj][m][n] * rs * g;
                            u32x2 w; w.x = cvt_pk_bf16(o[0], o[1]); w.y = cvt_pk_bf16(o[2], o[3]); *(u32x2*)(xr + bj * 128 + n * 16) = w; } }
        }
    }
};
constexpr float EPS = 1e-6f;
constexpr float LOG2E = 1.4426950408889634f;

__device__ __forceinline__ void transpose_item(const float* W, int K, int N, bf16_t* WT, int row_off, const float* kscale, LAS float* scr, int item, int lane) {
    const int nblk = N / 32, kb = item / nblk, nb = item % nblk, k0 = 64 * kb, n0 = 32 * nb;
#pragma unroll 8
    for (int i = 0; i < 32; ++i) { const int kk = 2 * i + (lane >> 5); float v = W[(size_t)(k0 + kk) * N + n0 + (lane & 31)]; if (kscale) v *= kscale[k0 + kk]; scr[kk * 33 + (lane & 31)] = v; }
    asm volatile("s_waitcnt lgkmcnt(0)" ::: "memory");
    const int c = lane & 7;
#pragma unroll
    for (int j = 0; j < 4; ++j) { const int n = (lane >> 3) + 8 * j; const LAS float* s = scr + (8 * c) * 33 + n;
        u32x4 o; o.x = cvt_pk_bf16(s[0 * 33], s[1 * 33]); o.y = cvt_pk_bf16(s[2 * 33], s[3 * 33]); o.z = cvt_pk_bf16(s[4 * 33], s[5 * 33]); o.w = cvt_pk_bf16(s[6 * 33], s[7 * 33]);
        *(u32x4*)(WT + (size_t)(row_off + n0 + n) * K + k0 + 8 * c) = o; }
    asm volatile("s_waitcnt lgkmcnt(0)" ::: "memory");
}

__device__ __forceinline__ void xn_row(const float* xrow, const float* gain, bf16_t* orow, int lane) {
    const f32x4* xr = (const f32x4*)xrow + lane; const f32x4* gr = (const f32x4*)gain + lane;
    f32x4 v[4]; float s = 0.f;
#pragma unroll
    for (int j = 0; j < 4; ++j) { v[j] = xr[64 * j]; s += (v[j].x * v[j].x + v[j].y * v[j].y) + (v[j].z * v[j].z + v[j].w * v[j].w); }
    const float rs = 1.0f / sqrtf(wave_sum(s, lane) * (1.f / DM) + EPS);
    u32x2* o8 = (u32x2*)orow + lane;
#pragma unroll
    for (int j = 0; j < 4; ++j) { const f32x4 g = gr[64 * j]; u32x2 w; w.x = cvt_pk_bf16(v[j].x * rs * g.x, v[j].y * rs * g.y); w.y = cvt_pk_bf16(v[j].z * rs * g.z, v[j].w * rs * g.w); o8[64 * j] = w; }
}

__device__ __forceinline__ void res_row(const bf16_t* mrow, const float* xi, float* xo, const float* gpost, const float* gnext, bf16_t* xnrow, int lane) {
    const u32x2* mr = (const u32x2*)mrow + lane; const f32x4* xr = (const f32x4*)xi + lane; const f32x4* gp = (const f32x4*)gpost + lane;
    f32x4 mv[4]; float s = 0.f;
#pragma unroll
    for (int j = 0; j < 4; ++j) { const u32x2 w = mr[64 * j]; mv[j] = (f32x4){bflo(w.x), bfhi(w.x), bflo(w.y), bfhi(w.y)}; s += (mv[j].x * mv[j].x + mv[j].y * mv[j].y) + (mv[j].z * mv[j].z + mv[j].w * mv[j].w); }
    const float rs = 1.0f / sqrtf(wave_sum(s, lane) * (1.f / DM) + EPS);
    f32x4 x[4]; float s2 = 0.f;
#pragma unroll
    for (int j = 0; j < 4; ++j) { const f32x4 g = gp[64 * j]; x[j] = xr[64 * j] + mv[j] * rs * g; s2 += (x[j].x * x[j].x + x[j].y * x[j].y) + (x[j].z * x[j].z + x[j].w * x[j].w); }
    f32x4* xw = (f32x4*)xo + lane;
#pragma unroll
    for (int j = 0; j < 4; ++j) xw[64 * j] = x[j];
    if (gnext) {
        const float rs2 = 1.0f / sqrtf(wave_sum(s2, lane) * (1.f / DM) + EPS);
        const f32x4* gn = (const f32x4*)gnext + lane; u32x2* o8 = (u32x2*)xnrow + lane;
#pragma unroll
        for (int j = 0; j < 4; ++j) { const f32x4 g = gn[64 * j]; u32x2 w; w.x = cvt_pk_bf16(x[j].x * rs2 * g.x, x[j].y * rs2 * g.y); w.y = cvt_pk_bf16(x[j].z * rs2 * g.z, x[j].w * rs2 * g.w); o8[64 * j] = w; }
    }
}

#define MLA_PACK(P, B) ((u32x4){cvt_pk_bf16(P[B], P[B + 1]), cvt_pk_bf16(P[B + 2], P[B + 3]), cvt_pk_bf16(P[B + 4], P[B + 5]), cvt_pk_bf16(P[B + 6], P[B + 7])})
__device__ __forceinline__ void mla_softmax(f32x16& p0, f32x16& p1, float& m_run, float& l_run, f32x16& o0, f32x16& o1) {
    float mx = fmaxf(p0[0], p1[0]);
#pragma unroll
    for (int r = 1; r < 16; ++r) mx = fmaxf(mx, fmaxf(p0[r], p1[r]));
    mx = xor32_max(mx);
    const float m_new = fmaxf(m_run, mx), alpha = fexp2(m_run - m_new); m_run = m_new;
    p0 = p0 - m_new; p1 = p1 - m_new;
#pragma unroll
    for (int r = 0; r < 16; ++r) { p0[r] = fexp2(p0[r]); p1[r] = fexp2(p1[r]); }
    const f32x16 ps = p0 + p1;
    const float ls = ((ps[0] + ps[1]) + (ps[2] + ps[3])) + ((ps[4] + ps[5]) + (ps[6] + ps[7])) + (((ps[8] + ps[9]) + (ps[10] + ps[11])) + ((ps[12] + ps[13]) + (ps[14] + ps[15])));
    l_run = l_run * alpha + ls;
    o0 = o0 * alpha; o1 = o1 * alpha;
}
__device__ __forceinline__ void mla_store(bf16_t* orow, const f32x16& o0, const f32x16& o1, float l_run) {
    const float inv = 1.0f / xor32_sum(l_run);
#pragma unroll
    for (int rg = 0; rg < 4; ++rg) {
        u32x2 w; w.x = cvt_pk_bf16(o0[4 * rg] * inv, o0[4 * rg + 1] * inv); w.y = cvt_pk_bf16(o0[4 * rg + 2] * inv, o0[4 * rg + 3] * inv); *(u32x2*)(orow + 8 * rg) = w;
        u32x2 w2; w2.x = cvt_pk_bf16(o1[4 * rg] * inv, o1[4 * rg + 1] * inv); w2.y = cvt_pk_bf16(o1[4 * rg + 2] * inv, o1[4 * rg + 3] * inv); *(u32x2*)(orow + 32 + 8 * rg) = w2;
    }
}
__device__ __forceinline__ void mla_unit(LAS unsigned char* lds, const bf16_t* Q, const bf16_t* KN, const bf16_t* KPE, const bf16_t* VT, bf16_t* AO, int tokbase, int S, int h, int qb, int tid) {
    constexpr int KBYTES = 12288, BUF = 20480;
    const int lane = tid & 63, wid = __builtin_amdgcn_readfirstlane(tid >> 6), r32 = lane & 31, hi = lane >> 5;
    const bf16_t* ks0 = KN + (size_t)(tokbase + lane) * 512 + h * 64 + 8 * wid;
    const bf16_t* ks1 = KPE + (size_t)(tokbase + lane) * 32 + 8 * (wid & 3);
    const bf16_t* vs = VT + (size_t)(h * 64 + lane) * TH + tokbase + 8 * wid;
#define MLA_DMA(T, B) do { LAS unsigned char* sb_ = lds + (B) * BUF; \
        __builtin_amdgcn_global_load_lds((const unsigned*)(ks0 + (size_t)(T) * (64 * 512)), (LAS unsigned*)(sb_ + wid * 1024), 16, 0, 0); \
        if (wid < 4) __builtin_amdgcn_global_load_lds((const unsigned*)(ks1 + (size_t)(T) * (64 * 32)), (LAS unsigned*)(sb_ + (8 + wid) * 1024), 16, 0, 0); \
        __builtin_amdgcn_global_load_lds((const unsigned*)(vs + (size_t)(T) * 64), (LAS unsigned*)(sb_ + KBYTES + wid * 1024), 16, 0, 0); } while (0)
#define MLA_WAITBAR_KEEP() do { if (wid < 4) asm volatile("s_waitcnt vmcnt(3)" ::: "memory"); else asm volatile("s_waitcnt vmcnt(2)" ::: "memory"); \
        asm volatile("s_waitcnt lgkmcnt(0)" ::: "memory"); __builtin_amdgcn_s_barrier(); asm volatile("" ::: "memory"); } while (0)
#define MLA_WAITBAR_ALL() do { asm volatile("s_waitcnt vmcnt(0) lgkmcnt(0)" ::: "memory"); __builtin_amdgcn_s_barrier(); asm volatile("" ::: "memory"); } while (0)
    const int NT = S / 64;
    const int qtokA = tokbase + 512 * qb + 64 * wid + r32, qtokB = qtokA + 32;
    bf16x8 qa[6], qbv[6];
#pragma unroll
    for (int d0 = 0; d0 < 6; ++d0) { qa[d0] = *(const bf16x8*)(Q + (size_t)qtokA * 768 + h * 96 + 16 * d0 + 8 * hi); qbv[d0] = *(const bf16x8*)(Q + (size_t)qtokB * 768 + h * 96 + 16 * d0 + 8 * hi); }
    asm volatile("s_waitcnt vmcnt(0)" ::: "memory");
    MLA_DMA(0, 0); MLA_DMA(1, 1);
    MLA_WAITBAR_ALL();
    f32x16 oa0, oa1, ob0, ob1;
#pragma unroll
    for (int r = 0; r < 16; ++r) { oa0[r] = 0.f; oa1[r] = 0.f; ob0[r] = 0.f; ob1[r] = 0.f; }
    float ma = -1e30f, la = 0.f, mb = -1e30f, lb = 0.f;
    for (int t = 0; t < NT; ++t) {
        if (t + 2 < NT) MLA_DMA(t + 2, (t + 2) & 3);
        const LAS unsigned char* kb = lds + (t & 3) * BUF; const LAS unsigned char* vb = kb + KBYTES;
        f32x16 pa0, pa1, pb0, pb1;
#pragma unroll
        for (int r = 0; r < 16; ++r) { pa0[r] = 0.f; pa1[r] = 0.f; pb0[r] = 0.f; pb1[r] = 0.f; }
#pragma unroll
        for (int d0 = 0; d0 < 6; ++d0) {
            const bf16x8 a0 = *(const LAS bf16x8*)(kb + (2 * d0 + hi) * 1024 + r32 * 16);
            const bf16x8 a1 = *(const LAS bf16x8*)(kb + (2 * d0 + hi) * 1024 + (32 + r32) * 16);
            pa0 = __builtin_amdgcn_mfma_f32_32x32x16_bf16(a0, qa[d0], pa0, 0, 0, 0);
            pa1 = __builtin_amdgcn_mfma_f32_32x32x16_bf16(a1, qa[d0], pa1, 0, 0, 0);
            pb0 = __builtin_amdgcn_mfma_f32_32x32x16_bf16(a0, qbv[d0], pb0, 0, 0, 0);
            pb1 = __builtin_amdgcn_mfma_f32_32x32x16_bf16(a1, qbv[d0], pb1, 0, 0, 0);
        }
        mla_softmax(pa0, pa1, ma, la, oa0, oa1);
        mla_softmax(pb0, pb1, mb, lb, ob0, ob1);
#pragma unroll
        for (int ks = 0; ks < 4; ++ks) {
            const u32x4 pwa = ks == 0 ? MLA_PACK(pa0, 0) : ks == 1 ? MLA_PACK(pa0, 8) : ks == 2 ? MLA_PACK(pa1, 0) : MLA_PACK(pa1, 8);
            const u32x4 pwb = ks == 0 ? MLA_PACK(pb0, 0) : ks == 1 ? MLA_PACK(pb0, 8) : ks == 2 ? MLA_PACK(pb1, 0) : MLA_PACK(pb1, 8);
            const bf16x8 paa = __builtin_bit_cast(bf16x8, pwa), pab = __builtin_bit_cast(bf16x8, pwb);
            const LAS unsigned char* vp = vb + (2 * ks) * 1024 + r32 * 16 + 8 * hi;
            const u32x2 a_lo = *(const LAS u32x2*)(vp), a_hi = *(const LAS u32x2*)(vp + 1024);
            const u32x2 b_lo = *(const LAS u32x2*)(vp + 512), b_hi = *(const LAS u32x2*)(vp + 1024 + 512);
            const bf16x8 vf0 = __builtin_bit_cast(bf16x8, ((u32x4){a_lo.x, a_lo.y, a_hi.x, a_hi.y}));
            const bf16x8 vf1 = __builtin_bit_cast(bf16x8, ((u32x4){b_lo.x, b_lo.y, b_hi.x, b_hi.y}));
            oa0 = __builtin_amdgcn_mfma_f32_32x32x16_bf16(vf0, paa, oa0, 0, 0, 0);
            oa1 = __builtin_amdgcn_mfma_f32_32x32x16_bf16(vf1, paa, oa1, 0, 0, 0);
            ob0 = __builtin_amdgcn_mfma_f32_32x32x16_bf16(vf0, pab, ob0, 0, 0, 0);
            ob1 = __builtin_amdgcn_mfma_f32_32x32x16_bf16(vf1, pab, ob1, 0, 0, 0);
        }
        if (t & 1) MLA_WAITBAR_ALL();
    }
#undef MLA_DMA
#undef MLA_WAITBAR_KEEP
#undef MLA_WAITBAR_ALL
    mla_store(AO + (size_t)qtokA * 1024 + h * 64 + 4 * hi, oa0, oa1, la);
    mla_store(AO + (size_t)qtokB * 1024 + h * 64 + 4 * hi, ob0, ob1, lb);
}

__device__ __forceinline__ unsigned na_vmask(int qc, int kh, int hi) {
    int cs = qc - 8; cs = cs < 0 ? 0 : cs; cs = cs > 48 ? 48 : cs; unsigned mk = 0u;
#pragma unroll
    for (int r = 0; r < 16; ++r) { const int kc = 32 * kh + (r & 3) + 8 * (r >> 2) + 4 * hi; mk |= ((kc >= cs) && (kc < cs + 16)) ? (1u << r) : 0u; }
    return mk;
}
__device__ __forceinline__ void na_qs(const bf16x8 (&kf)[4], const bf16x8 (&vf)[2][2], const bf16x8 (&qf)[4], const LAS float* brow, int qc, int kh, int hi, unsigned vmsel,
                                      float& m_run, float& l_run, f32x16& o0, f32x16& o1) {
    const float SCL = 0.125f * LOG2E;
    f32x16 p;
#pragma unroll
    for (int r = 0; r < 16; ++r) p[r] = 0.f;
#pragma unroll
    for (int d0 = 0; d0 < 4; ++d0) p = __builtin_amdgcn_mfma_f32_32x32x16_bf16(kf[d0], qf[d0], p, 0, 0, 0);
    unsigned vm = vmsel; asm volatile("" : "+v"(vm));
    float mx = -1e30f;
#pragma unroll
    for (int r = 0; r < 16; ++r) { const int kc = 32 * kh + (r & 3) + 8 * (r >> 2) + 4 * hi;
        int bi = kc - qc + 15; bi = bi < 0 ? 0 : bi; bi = bi > 30 ? 30 : bi;
        const float sc = p[r] * SCL + brow[bi]; p[r] = ((vm >> r) & 1u) ? sc : -1e30f; mx = fmaxf(mx, p[r]); }
    mx = xor32_max(mx);
    const float m_new = fmaxf(m_run, mx), alpha = fexp2(m_run - m_new); m_run = m_new;
    const float m_use = fmaxf(m_new, -1e20f);
    float ls = 0.f;
#pragma unroll
    for (int r = 0; r < 16; ++r) { const float e = fexp2(p[r] - m_use); p[r] = e; ls += e; }
    l_run = l_run * alpha + ls;
#pragma unroll
    for (int r = 0; r < 16; ++r) { o0[r] *= alpha; o1[r] *= alpha; }
#pragma unroll
    for (int k2 = 0; k2 < 2; ++k2) {
        u32x4 pw; pw.x = cvt_pk_bf16(p[8 * k2 + 0], p[8 * k2 + 1]); pw.y = cvt_pk_bf16(p[8 * k2 + 2], p[8 * k2 + 3]); pw.z = cvt_pk_bf16(p[8 * k2 + 4], p[8 * k2 + 5]); pw.w = cvt_pk_bf16(p[8 * k2 + 6], p[8 * k2 + 7]);
        const bf16x8 pa = __builtin_bit_cast(bf16x8, pw);
        o0 = __builtin_amdgcn_mfma_f32_32x32x16_bf16(vf[0][k2], pa, o0, 0, 0, 0);
        o1 = __builtin_amdgcn_mfma_f32_32x32x16_bf16(vf[1][k2], pa, o1, 0, 0, 0);
    }
}
__device__ __forceinline__ void na_store(bf16_t* orow, const f32x16& o0, const f32x16& o1, float l_run) {
    const float l = xor32_sum(l_run); const float inv = 1.0f / l;
#pragma unroll
    for (int rg = 0; rg < 4; ++rg) {
        u32x2 w; w.x = cvt_pk_bf16(o0[4 * rg] * inv, o0[4 * rg + 1] * inv); w.y = cvt_pk_bf16(o0[4 * rg + 2] * inv, o0[4 * rg + 3] * inv); *(u32x2*)(orow + 8 * rg) = w;
        u32x2 w2; w2.x = cvt_pk_bf16(o1[4 * rg] * inv, o1[4 * rg + 1] * inv); w2.y = cvt_pk_bf16(o1[4 * rg + 2] * inv, o1[4 * rg + 3] * inv); *(u32x2*)(orow + 32 + 8 * rg) = w2;
    }
}
__device__ __forceinline__ void na_unit(const LAS float* biasT, const bf16_t* Z, const bf16_t* VTn, bf16_t* AO, int tokbase, int S, int rr, int tid) {
    const int lane = tid & 63, h = tid >> 6, r32 = lane & 31, hi = lane >> 5;
    const int rows = S / 64; int rs = rr - 4; rs = rs < 0 ? 0 : rs; rs = rs > rows - 8 ? rows - 8 : rs;
    bf16x8 qfa[4], qfb[4];
#pragma unroll
    for (int d0 = 0; d0 < 4; ++d0) { qfa[d0] = *(const bf16x8*)(Z + (size_t)(tokbase + rr * 64 + r32) * ZP + 672 + h * 64 + 16 * d0 + 8 * hi);
                                      qfb[d0] = *(const bf16x8*)(Z + (size_t)(tokbase + rr * 64 + 32 + r32) * ZP + 672 + h * 64 + 16 * d0 + 8 * hi); }
    f32x16 oa0, oa1, ob0, ob1; float ma = -1e30f, mb = -1e30f, la = 0.f, lb = 0.f;
#pragma unroll
    for (int r = 0; r < 16; ++r) { oa0[r] = 0.f; oa1[r] = 0.f; ob0[r] = 0.f; ob1[r] = 0.f; }
    const unsigned va0 = na_vmask(r32, 0, hi), va1 = na_vmask(r32, 1, hi), vb0 = na_vmask(32 + r32, 0, hi), vb1 = na_vmask(32 + r32, 1, hi);
    const bf16_t* kbase = Z + (size_t)(tokbase + rs * 64 + r32) * ZP + 672 + 512 + h * 64 + 8 * hi;
    const bf16_t* vbase0 = VTn + (size_t)(h * 64 + r32) * TH + tokbase + rs * 64 + 4 * hi;
#define NA_LOADK(KF, IT) do { const int kr_ = (IT) >> 1, kh_ = (IT) & 1; const bf16_t* kp_ = kbase + (size_t)(kr_ * 64 + kh_ * 32) * ZP; \
        _Pragma("unroll") for (int d0 = 0; d0 < 4; ++d0) KF[d0] = *(const bf16x8*)(kp_ + 16 * d0); } while (0)
#define NA_LOADV(VF, IT) do { const int kr_ = (IT) >> 1, kh_ = (IT) & 1; const bf16_t* vp0_ = vbase0 + kr_ * 64 + kh_ * 32; const bf16_t* vp1_ = vp0_ + (size_t)32 * TH; \
        _Pragma("unroll") for (int k2 = 0; k2 < 2; ++k2) { const u32x2 lo = *(const u32x2*)(vp0_ + 16 * k2), hi2 = *(const u32x2*)(vp0_ + 16 * k2 + 8); VF[0][k2] = __builtin_bit_cast(bf16x8, ((u32x4){lo.x, lo.y, hi2.x, hi2.y})); \
            const u32x2 lo1 = *(const u32x2*)(vp1_ + 16 * k2), hi3 = *(const u32x2*)(vp1_ + 16 * k2 + 8); VF[1][k2] = __builtin_bit_cast(bf16x8, ((u32x4){lo1.x, lo1.y, hi3.x, hi3.y})); } } while (0)
    bf16x8 kf[4];
    NA_LOADK(kf, 0);
#pragma unroll 1
    for (int it = 0; it < 16; ++it) {
        const int kr = it >> 1, kh = it & 1;
        const LAS float* brow = biasT + (h * 15 + (rs + kr - rr + 7)) * 31;
        bf16x8 vf[2][2], kn[4];
        NA_LOADV(vf, it);
        const int itn = it + 1 < 16 ? it + 1 : 15;
        NA_LOADK(kn, itn);
        na_qs(kf, vf, qfa, brow, r32, kh, hi, kh ? va1 : va0, ma, la, oa0, oa1);
        na_qs(kf, vf, qfb, brow, 32 + r32, kh, hi, kh ? vb1 : vb0, mb, lb, ob0, ob1);
#pragma unroll
        for (int d0 = 0; d0 < 4; ++d0) kf[d0] = kn[d0];
    }
#undef NA_LOADK
#undef NA_LOADV
    na_store(AO + (size_t)(tokbase + rr * 64 + r32) * 1024 + 512 + h * 64 + 4 * hi, oa0, oa1, la);
    na_store(AO + (size_t)(tokbase + rr * 64 + 32 + r32) * 1024 + 512 + h * 64 + 4 * hi, ob0, ob1, lb);
}
#ifndef REP_SYNC
#define REP_SYNC 1
#endif
#ifndef REP_MLA
#define REP_MLA 1
#endif
#ifndef REP_NA
#define REP_NA 1
#endif
#ifndef REP_SCAN
#define REP_SCAN 1
#endif
#ifndef REP_UP
#define REP_UP 1
#endif
#ifndef REP_PASS
#define REP_PASS 1
#endif
#ifndef REP_GEMM
#define REP_GEMM 1
#endif
#define GSYNC() do { for (int r_ = 0; r_ < REP_SYNC; ++r_) xcd_barrier((unsigned*)(ap0->ws + WS_BAR), bst); } while (0)
constexpr int LDS_BYTES = 147456;
constexpr int NTHR = 512;
struct Args { const float* in[26]; float* out; unsigned char* ws; };


#define XB_TMO      128
#define XB_XCNT(j)  (256  + 64 * (j))
#define XB_XSUB(j)  (1280 + 64 * (j))
#define XB_XGEN(j)  (2304 + 64 * (j))
#define XB_TOP      3328
#define XB_TOPGEN   3392
#define XCD_BAR_WORDS 3456
#define XB_SPIN_CAP (1u << 22)
__device__ __forceinline__ unsigned xb_ld(unsigned* p)              { return __hip_atomic_load(p, __ATOMIC_RELAXED, __HIP_MEMORY_SCOPE_AGENT); }
__device__ __forceinline__ unsigned xb_add(unsigned* p, unsigned v) { return __hip_atomic_fetch_add(p, v, __ATOMIC_RELAXED, __HIP_MEMORY_SCOPE_AGENT); }
__device__ __forceinline__ unsigned xb_xcc_id() { return (unsigned)__builtin_amdgcn_s_getreg((3 << 11) | 20) & 0xFu; }
#define XB_SPIN(cond, bar) do { unsigned _sp = 0; while (cond) { __builtin_amdgcn_s_sleep(1); \
    if ((++_sp & 255u) == 0u) { if (xb_ld(&(bar)[XB_TMO])) break; if (_sp > XB_SPIN_CAP) { atomicAdd(&(bar)[XB_TMO], 1u); break; } } } } while (0)
__device__ __forceinline__ void xcd_barrier_complete(unsigned* bar, unsigned x, unsigned& nloc, unsigned& nx) {
    const unsigned G = gridDim.x;
    unsigned sum, cnt, mine, sp = 0u;
    for (;;) {
        sum = 0u; cnt = 0u; mine = 0u;
#pragma unroll
        for (unsigned j = 0; j < 16; ++j) { const unsigned c = xb_ld(&bar[XB_XCNT(j)]); sum += c; cnt += (c > 0u) ? 1u : 0u; mine = (j == x) ? c : mine; }
        if (sum == G) break;
        __builtin_amdgcn_s_sleep(1);
        if ((++sp & 255u) == 0u) { if (xb_ld(&bar[XB_TMO])) break; if (sp > XB_SPIN_CAP) { atomicAdd(&bar[XB_TMO], 1u); break; } }
    }
    nloc = mine > 0u ? mine : 1u; nx = cnt > 0u ? cnt : 1u;
}
__device__ __forceinline__ void xcd_barrier(unsigned* bar, volatile LAS unsigned* st) {
    asm volatile("s_waitcnt vmcnt(0)" ::: "memory");
    __syncthreads();
    if (threadIdx.x == 0) {
        __builtin_amdgcn_s_waitcnt(0);
        const unsigned x = xb_xcc_id();
        unsigned nloc = st[0], nx = st[1];
        if (nloc == 0u) { xcd_barrier_complete(bar, x, nloc, nx); st[0] = nloc; st[1] = nx; }
        const unsigned old = xb_add(&bar[XB_XSUB(x)], 1u);
        const unsigned gen = old / nloc;
        if (old + 1u == (gen + 1u) * nloc) {
            __builtin_amdgcn_fence(__ATOMIC_RELEASE, "agent");
            asm volatile("s_waitcnt vmcnt(0)" ::: "memory");
            const unsigned og = xb_add(&bar[XB_TOP], 1u);
            const unsigned tg = og / nx;
            if (og + 1u == (tg + 1u) * nx) xb_add(&bar[XB_TOPGEN], 1u);
            else XB_SPIN(xb_ld(&bar[XB_TOPGEN]) == tg, bar);
            __builtin_amdgcn_fence(__ATOMIC_ACQUIRE, "agent");
            xb_add(&bar[XB_XGEN(x)], 1u);
            asm volatile("s_waitcnt vmcnt(0)" ::: "memory");
        } else {
            XB_SPIN(xb_ld(&bar[XB_XGEN(x)]) == gen, bar);
            __builtin_amdgcn_fence(__ATOMIC_ACQUIRE, "agent");
            asm volatile("s_waitcnt vmcnt(0)" ::: "memory");
        }
    }
    __syncthreads();
}

__global__ void __launch_bounds__(NTHR, 2) mk_fwd(Args a) {
    extern __shared__ __attribute__((aligned(16))) unsigned char lds_raw[];
    LAS unsigned char* lds = (LAS unsigned char*)lds_raw;
    cg::grid_group grid = cg::this_grid();
    volatile LAS unsigned* bst = (volatile LAS unsigned*)(lds + LDS_BYTES - 64);
    if (threadIdx.x == 0) { bst[0] = 0u; bst[1] = 0u; }
    typedef const __attribute__((address_space(4))) Args* ArgP;
    ArgP ap0 = (ArgP)__builtin_amdgcn_kernarg_segment_ptr();
#define PH_BEGIN ArgP ap = ap0; asm volatile("" : "+s"(ap)); unsigned char* ws = ap->ws; (void)ws; int tid_ = threadIdx.x; asm volatile("" : "+v"(tid_)); const int tid = tid_, lane = tid & 63, wave = tid >> 6; int G_ = gridDim.x, bid_ = blockIdx.x; asm volatile("" : "+s"(G_), "+s"(bid_)); const int G = G_, bid = bid_; const int gw = bid * 8 + wave, NGW = G * 8; const int gt = bid * NTHR + tid, NGT = G * NTHR; (void)lane; (void)gw; (void)NGW; (void)gt; (void)NGT;
#define IN(k) (ap->in[k])
#define rsq ((float*)(ws + WS_RSQ))
#define rskv ((float*)(ws + WS_RSKV))
#define rope ((float2*)(ws + WS_ROPE))
#define AGG ((float2*)(ws + WS_AGG))
#define CARRY ((float*)(ws + WS_CARRY))
#define YB ((bf16_t*)(ws + WS_YB))
#define W_INATT ((bf16_t*)(ws + WS_W_INATT))
#define W_UQ ((bf16_t*)(ws + WS_W_UQ))
#define W_UKV ((bf16_t*)(ws + WS_W_UKV))
#define W_OUTATT ((bf16_t*)(ws + WS_W_OUTATT))
#define W_INREC ((bf16_t*)(ws + WS_W_INREC))
#define W_GATES ((bf16_t*)(ws + WS_W_GATES))
#define W_OUTREC ((bf16_t*)(ws + WS_W_OUTREC))
#define W_UP ((bf16_t*)(ws + WS_W_UP))
#define W_DOWN ((bf16_t*)(ws + WS_W_DOWN))
#define XN ((bf16_t*)(ws + WS_XN))
#define Zb ((bf16_t*)(ws + WS_Z))
#define Qb ((bf16_t*)(ws + WS_Q))
#define KN ((bf16_t*)(ws + WS_KN))
#define VTM ((bf16_t*)(ws + WS_VTM))
#define VTN ((bf16_t*)(ws + WS_VTN))
#define KPE ((bf16_t*)(ws + WS_KPE))
#define ACT ((bf16_t*)(ws + WS_ACT))
#define GATE ((bf16_t*)(ws + WS_GATE))
#define XB ((bf16_t*)(ws + WS_XB))
#define XBR ((bf16_t*)(ws + WS_XBR))
#define GQ ((bf16_t*)(ws + WS_GQ))
#define AO XN
#define Fb XN
#define YR XN
#define M0 Zb
#define M1 XBR
#define XIN (IN(half))
#define XST (ap->out + (size_t)half * TH * DM)
    { PH_BEGIN
    {
        LAS float* scr = (LAS float*)(lds + wave * 16384);
        constexpr int I_INATT = 16 * 69, I_UQ = 6 * 24, I_UKV = 4 * 32, I_SQ = 16 * 32, I_INREC = 16 * 64, I_UP = 16 * 256, I_DOWN = 64 * 32, I_GATE = 32 * 8;
        constexpr int NITEMS = I_INATT + I_UQ + I_UKV + 2 * I_SQ + I_INREC + 2 * I_UP + 2 * I_DOWN + I_GATE;
        for (int rep_ = 0; rep_ < REP_PASS; ++rep_)
        for (int it = gw; it < NITEMS; it += NGW) {
            int r = it;
            if (r < I_INATT) { transpose_item(IN(6), 1024, 2208, W_INATT, 0, nullptr, scr, r, lane); continue; } r -= I_INATT;
            if (r < I_UQ) { transpose_item(IN(8), 384, 768, W_UQ, 0, IN(7), scr, r, lane); continue; } r -= I_UQ;
            if (r < I_UKV) { transpose_item(IN(10), 256, 1024, W_UKV, 0, IN(9), scr, r, lane); continue; } r -= I_UKV;
            if (r < I_SQ) { transpose_item(IN(12), 1024, 1024, W_OUTATT, 0, nullptr, scr, r, lane); continue; } r -= I_SQ;
            if (r < I_SQ) { transpose_item(IN(21), 1024, 1024, W_OUTREC, 0, nullptr, scr, r, lane); continue; } r -= I_SQ;
            if (r < I_INREC) { transpose_item(IN(13), 1024, 2048, W_INREC, 0, nullptr, scr, r, lane); continue; } r -= I_INREC;
            if (r < 2 * I_UP) { const int li = r / I_UP; transpose_item(IN(22) + (size_t)li * 1024 * 8192, 1024, 8192, W_UP + (size_t)li * 8192 * 1024, 0, nullptr, scr, r % I_UP, lane); continue; } r -= 2 * I_UP;
            if (r < 2 * I_DOWN) { const int li = r / I_DOWN; transpose_item(IN(25) + (size_t)li * 4096 * 1024, 4096, 1024, W_DOWN + (size_t)li * 1024 * 4096, 0, nullptr, scr, r % I_DOWN, lane); continue; } r -= 2 * I_DOWN;
            { const int mat = r / 8, sub = r % 8; const int type = mat >> 4, e = (mat >> 3) & 1, n = mat & 7;
              transpose_item(IN(type ? 18 : 16) + (size_t)(e * 8 + n) * 128 * 128, 128, 128, W_GATES, n * 512 + e * 256 + type * 128, nullptr, scr, sub, lane); }
        }
        if (bid == 0) for (int i = tid; i < XCD_BAR_WORDS; i += NTHR) ((unsigned*)(ws + WS_BAR))[i] = 0u;
        for (int i = gt; i < 8 * 64 * 64; i += NGT) ((unsigned*)(ws + WS_CNT))[i] = 0u;
        for (int i = gt; i < 96 * 1024 / 8; i += NGT) ((u32x4*)(W_INATT + (size_t)2208 * 1024))[i] = (u32x4){0, 0, 0, 0};
        for (int m = gw; m < TH; m += NGW) xn_row(IN(0) + (size_t)m * DM, IN(2), XN + (size_t)m * DM, lane);
        for (int i = gt; i < 4096 * 16; i += NGT) { const int pos = i >> 4, j = i & 15;
            const double inv = exp2(-(double)j * (13.287712379549449 / 16.0));
            const double rev = (double)pos * inv * 0.15915494309189535; const float fr = (float)(rev - floor(rev));
            rope[i] = make_float2(__builtin_amdgcn_cosf(fr), __builtin_amdgcn_sinf(fr)); }
    }

    }
    grid.sync();
    if (threadIdx.x == 0) (void)xb_add((unsigned*)(ap0->ws + WS_BAR) + XB_XCNT(xb_xcc_id()), 1u);
    for (int half = 0; half < 2; ++half) {
        const int S = half ? 4096 : 2048, nseq = TH / S;
        if (half == 1 && gridDim.x != 256) {
                { PH_BEGIN
        for (int m = gw; m < TH; m += NGW) xn_row(XIN + (size_t)m * DM, IN(2), XN + (size_t)m * DM, lane);
        }
        GSYNC();
        }
        { PH_BEGIN
        { pg8::Gemm g = pg8::make_gemm(XN, DM, W_INATT, DM, DM); pg8::StaticOrder so; so.init(TH / 256, ZP / 256, G, bid);
          EpiZ E{Zb, VTN, (float*)(ws + WS_SQP), nullptr, KPE, rope, S - 1};
#ifndef NO_G1
for (int rep_ = 0; rep_ < REP_GEMM; ++rep_) pg8::gemm_phase<EpiZ>(lds, g, so, E);
#endif
 }
        }
        GSYNC();
        { PH_BEGIN
        { pg8::Gemm g = pg8::make_gemm(Zb, ZP, W_UQ, 384, 384); pg8::StaticOrder so; so.init(TH / 256, 3, G, bid);
          EpiQ E{Qb, (const float*)(ws + WS_SQP), rope, S - 1};
#ifndef NO_G2
for (int rep_ = 0; rep_ < REP_GEMM; ++rep_) pg8::gemm_phase<EpiQ>(lds, g, so, E);
#endif
 }
        { pg8::Gemm g = pg8::make_gemm(Zb + 384, ZP, W_UKV, 256, 256); pg8::StaticOrder so; so.init(TH / 256, 4, G, bid);
          EpiKV E{KN, VTM, (const float*)(ws + WS_SQP)};
#ifndef NO_G3
for (int rep_ = 0; rep_ < REP_GEMM; ++rep_) pg8::gemm_phase<EpiKV>(lds, g, so, E);
#endif
 }
        }
        GSYNC();
        { PH_BEGIN
        {
            LAS float* biasT = (LAS float*)(lds + 98304);
            for (int i = tid; i < 8 * 15 * 31; i += NTHR) biasT[i] = IN(11)[i] * LOG2E;
            __syncthreads();
            const int nqb = S / 512, nunits = nseq * 8 * nqb;
            const int vb = (G % 8 == 0) ? (bid % 8) * (G / 8) + bid / 8 : bid;
#ifdef DELAY_P4A
        { const unsigned long long t0_ = __builtin_amdgcn_s_memrealtime(); while (__builtin_amdgcn_s_memrealtime() - t0_ < 40000ull) __builtin_amdgcn_s_sleep(32); }
#endif
#ifndef NO_MLA
            for (int rep_ = 0; rep_ < REP_MLA; ++rep_) {
#ifdef REP_MLA_SYNC
            if (rep_ > 0) GSYNC();
#endif
#ifdef REP_DELAY
            if (rep_ > 0) { const unsigned long long t0_ = __builtin_amdgcn_s_memrealtime(); while (__builtin_amdgcn_s_memrealtime() - t0_ < 40000ull) __builtin_amdgcn_s_sleep(32); continue; }
#endif
            for (int u = vb; u < nunits; u += G) { const int qb = u % nqb, h = (u / nqb) & 7, s = u / (nqb * 8);
                mla_unit(lds, Qb, KN, KPE, VTM, AO, s * S, S, h, qb, tid); }
            }
#endif
#ifdef MLA_TWICE
            for (int u = vb; u < nunits; u += G) { const int qb = u % nqb, h = (u / nqb) & 7, s = u / (nqb * 8);
                mla_unit(lds, Qb, KN, KPE, VTM, AO, s * S, S, h, qb, tid); }
#endif
            const int rows = S / 64, nna = nseq * rows;
#ifdef DELAY_P4B
        { const unsigned long long t0_ = __builtin_amdgcn_s_memrealtime(); while (__builtin_amdgcn_s_memrealtime() - t0_ < 40000ull) __builtin_amdgcn_s_sleep(32); }
#endif
#ifdef RELOAD_BIAS
            __syncthreads();
            for (int i = tid; i < 8 * 15 * 31; i += NTHR) biasT[i] = IN(11)[i] * LOG2E;
            __syncthreads();
#endif
#ifndef NO_NA
            for (int rep_ = 0; rep_ < REP_NA; ++rep_)
            for (int u = vb; u < nna; u += G) na_unit(biasT, Zb, VTN, AO, (u / rows) * S, S, u % rows, tid);
#endif
        }
        }
        GSYNC();
        { PH_BEGIN
        { pg8::Gemm g = pg8::make_gemm(AO, DM, W_OUTATT, DM, DM); pg8::StaticOrder so; so.init(TH / 256, 4, G, bid);
          EpiBf16 E{M0, DM, 0, 0};
#ifndef NO_G4
for (int rep_ = 0; rep_ < REP_GEMM; ++rep_) pg8::gemm_phase<EpiBf16>(lds, g, so, E);
#endif
 }
        }
        GSYNC();
        { PH_BEGIN
        for (int m = gw; m < TH; m += NGW) res_row(M0 + (size_t)m * DM, XIN + (size_t)m * DM, XST + (size_t)m * DM, IN(3), IN(4), XN + (size_t)m * DM, lane);
        }
        GSYNC();

        for (int li = 0; li < 2; ++li) {
            if (li == 1) {
                { PH_BEGIN
                { pg8::Gemm g = pg8::make_gemm(XN, DM, W_INREC, DM, DM); pg8::StaticOrder so; so.init(TH / 256, 8, G, bid);
                  EpiBf16 E{GATE, DM, 1024, (size_t)(WS_XBR - WS_GATE) / 2};
#ifndef NO_G5
for (int rep_ = 0; rep_ < REP_GEMM; ++rep_) pg8::gemm_phase<EpiBf16>(lds, g, so, E);
#endif
 }
                }
                GSYNC();
                { PH_BEGIN
                for (int rep_ = 0; rep_ < REP_PASS; ++rep_)
                for (int i = gt; i < TH * 128; i += NGT) { const int t = i >> 7, c8 = (i & 127) * 8; const int pos = t & (S - 1);
                    float accv[8];
#pragma unroll
                    for (int j = 0; j < 8; ++j) accv[j] = IN(15)[c8 + j];
#pragma unroll
                    for (int k = 0; k < 4; ++k) { const int p2 = pos + k - 1; if (p2 < 0 || p2 >= S) continue;
                        const u32x4 w = *(const u32x4*)(XBR + (size_t)(t + k - 1) * DM + c8); const float* cwk = IN(14) + k * 1024 + c8;
                        accv[0] += cwk[0] * bflo(w.x); accv[1] += cwk[1] * bfhi(w.x); accv[2] += cwk[2] * bflo(w.y); accv[3] += cwk[3] * bfhi(w.y);
                        accv[4] += cwk[4] * bflo(w.z); accv[5] += cwk[5] * bfhi(w.z); accv[6] += cwk[6] * bflo(w.w); accv[7] += cwk[7] * bfhi(w.w); }
                    u32x4 o; o.x = cvt_pk_bf16(accv[0], accv[1]); o.y = cvt_pk_bf16(accv[2], accv[3]); o.z = cvt_pk_bf16(accv[4], accv[5]); o.w = cvt_pk_bf16(accv[6], accv[7]);
                    *(u32x4*)(XB + (size_t)t * DM + c8) = o; }
                }
                GSYNC();
                for (int qt = 0; qt < 2; ++qt) {
                    const int t0 = qt * TQ;
                    { PH_BEGIN
                    { pg8::Gemm g = pg8::make_gemm(XB + (size_t)t0 * DM, DM, W_GATES, 128, 128); g.a_pn_shift = 1; g.a_pn_step = 256; g.a_seg = 1; g.hA = (size_t)4 * DM * 2;
                      pg8::StaticOrder so; so.init(TQ / 256, 16, G, bid);
                      EpiGates E{GQ, XB + (size_t)t0 * DM, AGG, IN(17), IN(19), IN(20)};
                      pg8::gemm_phase<EpiGates>(lds, g, so, E);
 }
                    }
                    GSYNC();
                    { PH_BEGIN
                    { const int cps = S / 32, nsq = TQ / S;
                      for (int rep_ = 0; rep_ < REP_SCAN; ++rep_)
                      for (int i = gt; i < nsq * 2 * 1024; i += NGT) { const int ch = i & 1023, e = (i >> 10) & 1, sq = i >> 11;
                          float hcar = 0.f;
#pragma unroll 16
                          for (int k = 0; k < cps; ++k) { const int c = sq * cps + (e ? cps - 1 - k : k); const int idx = (c * 2 + e) * 1024 + ch;
                              CARRY[idx] = hcar; const float2 ab = AGG[idx]; hcar = ab.x * hcar + ab.y; } } }
                    }
                    GSYNC();
                    { PH_BEGIN
#ifndef NO_R6
                    for (int rep_ = 0; rep_ < REP_SCAN; ++rep_)
                    for (int i = gt; i < 256 * 512; i += NGT) { const int cp = i & 511, c = i >> 9; const int ch = 2 * cp, n = ch >> 7, d = ch & 127;
                        const bf16_t* gq0 = GQ + (size_t)(c * 32) * 4096 + n * 512 + d;
                        bf16_t* yr0 = YR + (size_t)(t0 + c * 32) * DM + ch; const bf16_t* gt0 = GATE + (size_t)(t0 + c * 32) * DM + ch;
                        unsigned hfw[32];
                        { const float2 hc2 = *(const float2*)(CARRY + (size_t)(c * 2 + 0) * 1024 + ch); float h0 = hc2.x, h1 = hc2.y;
#pragma unroll
                          for (int s = 0; s < 32; ++s) {
                            const unsigned l2 = *(const unsigned*)(gq0 + (size_t)s * 4096), b2 = *(const unsigned*)(gq0 + (size_t)s * 4096 + 128);
                            h0 = fexp2(bflo(l2)) * h0 + bflo(b2); h1 = fexp2(bfhi(l2)) * h1 + bfhi(b2);
                            hfw[s] = cvt_pk_bf16(h0, h1); } }
                        { const float2 hc2 = *(const float2*)(CARRY + (size_t)(c * 2 + 1) * 1024 + ch); float h0 = hc2.x, h1 = hc2.y;
#pragma unroll
                          for (int s = 31; s >= 0; --s) {
                            const unsigned l2 = *(const unsigned*)(gq0 + (size_t)s * 4096 + 256), b2 = *(const unsigned*)(gq0 + (size_t)s * 4096 + 384);
                            h0 = fexp2(bflo(l2)) * h0 + bflo(b2); h1 = fexp2(bfhi(l2)) * h1 + bfhi(b2);
                            const unsigned g2 = *(const unsigned*)(gt0 + (size_t)s * DM), f2 = hfw[s];
                            *(unsigned*)(yr0 + (size_t)s * DM) = cvt_pk_bf16((bflo(f2) + h0) * gelu_tanh(bflo(g2)), (bfhi(f2) + h1) * gelu_tanh(bfhi(g2))); } }
                    }
#endif
                    }
                    GSYNC();
                }
                { PH_BEGIN
                { pg8::Gemm g = pg8::make_gemm(YR, DM, W_OUTREC, DM, DM); pg8::StaticOrder so; so.init(TH / 256, 4, G, bid);
                  EpiBf16 E{M1, DM, 0, 0};
#ifndef NO_G7
for (int rep_ = 0; rep_ < REP_GEMM; ++rep_) pg8::gemm_phase<EpiBf16>(lds, g, so, E);
#endif
 }
                }
                GSYNC();
                { PH_BEGIN
                for (int m = gw; m < TH; m += NGW) res_row(M1 + (size_t)m * DM, XST + (size_t)m * DM, XST + (size_t)m * DM, IN(3) + 1024, IN(4) + 1024, XN + (size_t)m * DM, lane);
                }
                GSYNC();
            }
            { PH_BEGIN
            { pg8::Gemm g = pg8::make_gemm(XN, DM, W_UP + (size_t)li * 8192 * 1024, DM, DM);
              g.a_seg = 1; g.hA = (size_t)4 * DM * 2; g.tB = (size_t)128 * DM * 2; g.hB = (size_t)4096 * DM * 2;
              pg8::StaticOrder so; so.init(TH / 256, 32, G, bid);
#ifndef NO_UP
              EpiUp E{ACT, YB, IN(23) + (size_t)li * 3 * 8192, IN(24) + (size_t)li * 8192}; for (int rep_ = 0; rep_ < REP_UP; ++rep_) pg8::gemm_phase<EpiUp>(lds, g, so, E);
#endif
 }
            }
            GSYNC();
            { PH_BEGIN
            for (int rep_ = 0; rep_ < REP_PASS; ++rep_)
            for (int b = bid; b < 256; b += G) { const int seg = b >> 1, which = b & 1; const int t = seg * 128 + (which ? 127 : 0); const int pos = t & (S - 1);
                const float* cw = IN(23) + (size_t)li * 3 * 8192; const float* cb = IN(24) + (size_t)li * 8192;
                const bool hasp = which ? true : (pos != 0), hasn = which ? (pos != S - 1) : true;
                const bf16_t* yp = which ? YB + ((size_t)seg * 4 + 2) * 8192 : YB + ((size_t)(seg - 1) * 4 + 3) * 8192;
                const bf16_t* yc = YB + ((size_t)seg * 4 + (which ? 3 : 0)) * 8192;
                const bf16_t* yn = which ? YB + ((size_t)(seg + 1) * 4 + 0) * 8192 : YB + ((size_t)seg * 4 + 1) * 8192;
                for (int c = tid; c < 4096; c += NTHR) {
                    float u2[2];
#pragma unroll
                    for (int bj = 0; bj < 2; ++bj) { const int ch = bj * 4096 + c;
                        float r = cw[8192 + ch] * bf2f(yc[ch]) + cb[ch];
                        if (hasp) r += cw[ch] * bf2f(yp[ch]);
                        if (hasn) r += cw[2 * 8192 + ch] * bf2f(yn[ch]);
                        u2[bj] = r; }
                    ACT[(size_t)t * DFF + c] = f2bf(gelu_tanh(u2[0]) * u2[1]); } }
            }
            GSYNC();
            if (gridDim.x == 256) {
                { PH_BEGIN
                { pg8::Gemm g = pg8::make_gemm(ACT, DFF, W_DOWN + (size_t)li * 1024 * 4096, DFF, DFF); pg8::StaticOrder so; so.init(TH / 256, 4, G, bid);
                  const int use = half * 2 + li;
                  EpiRms E{XST, li == 0 ? XN : nullptr, IN(5) + li * 1024, IN(2) + 1024, (float*)(ws + WS_XBUF), (float*)(ws + WS_XBUF) + (size_t)TH * 4,
                           (unsigned*)(ws + WS_CNT) + (size_t)(use * 2) * 4096, (unsigned*)(ws + WS_CNT) + (size_t)(use * 2 + 1) * 4096};
                  pg8::gemm_phase<EpiRms>(lds, g, so, E); }
                if (half == 0 && li == 1)
                  { for (int m = gw; m < TH; m += NGW) xn_row(IN(1) + (size_t)m * DM, IN(2), XN + (size_t)m * DM, lane);
                  }
                }
                GSYNC();
            } else {
                { PH_BEGIN
                { pg8::Gemm g = pg8::make_gemm(ACT, DFF, W_DOWN + (size_t)li * 1024 * 4096, DFF, DFF); pg8::StaticOrder so; so.init(TH / 256, 4, G, bid);
                  EpiBf16 E{Fb, DM, 0, 0};
                  pg8::gemm_phase<EpiBf16>(lds, g, so, E); }
                }
                GSYNC();
                { PH_BEGIN
                for (int m = gw; m < TH; m += NGW) res_row(Fb + (size_t)m * DM, XST + (size_t)m * DM, XST + (size_t)m * DM, IN(5) + li * 1024, li == 0 ? IN(2) + 1024 : nullptr, XN + (size_t)m * DM, lane);
                }
                GSYNC();
            }
        }
    }
}

extern "C" void kernel_launch(void* const* d_in, const int* in_sizes, int n_in, void* d_out, int out_size, void* d_ws, size_t ws_size, hipStream_t stream) {
    static int grid = 0;
    if (grid == 0) {
        int dev = 0, cus = 0, per_cu = 0;
        (void)hipGetDevice(&dev);
        (void)hipDeviceGetAttribute(&cus, hipDeviceAttributeMultiprocessorCount, dev);
        (void)hipFuncSetAttribute((const void*)mk_fwd, hipFuncAttributeMaxDynamicSharedMemorySize, LDS_BYTES);
        (void)hipOccupancyMaxActiveBlocksPerMultiprocessor(&per_cu, (const void*)mk_fwd, NTHR, LDS_BYTES);
        if (per_cu < 1) per_cu = 1;
        grid = cus * per_cu;
        if (ws_size < WS_END || n_in != 26) { fprintf(stderr, "kernel_launch: unexpected ws_size %zu / n_in %d\n", ws_size, n_in); }
    }
    Args a{};
    for (int i = 0; i < 26; ++i) a.in[i] = (const float*)d_in[i];
    a.out = (float*)d_out; a.ws = (unsigned char*)d_ws;
    void* args[] = {&a};
    hipError_t e = hipLaunchCooperativeKernel((const void*)mk_fwd, dim3(grid), dim3(NTHR), args, LDS_BYTES, stream);
    if (e != hipSuccess) fprintf(stderr, "cooperative launch failed: %s (grid %d)\n", hipGetErrorString(e), grid);
}
```

```cpp
#include <hip/hip_runtime.h>
#include <hip/hip_cooperative_groups.h>
#include <cstdio>
#include <cstdint>
namespace cg = cooperative_groups;

#define LAS __attribute__((address_space(3)))
typedef unsigned short bf16_t;
typedef short bf16x8 __attribute__((ext_vector_type(8)));
typedef short s16x4 __attribute__((ext_vector_type(4)));
typedef float f32x4 __attribute__((ext_vector_type(4)));
typedef float f32x16 __attribute__((ext_vector_type(16)));
typedef unsigned u32x4 __attribute__((ext_vector_type(4)));
typedef unsigned u32x2 __attribute__((ext_vector_type(2)));

__device__ __forceinline__ unsigned cvt_pk_bf16(float lo, float hi) { unsigned r; asm volatile("v_cvt_pk_bf16_f32 %0, %1, %2" : "=v"(r) : "v"(lo), "v"(hi)); return r; }
__device__ __forceinline__ float bf2f(bf16_t v) { return __uint_as_float(((unsigned)v) << 16); }
__device__ __forceinline__ float bflo(unsigned w) { return __uint_as_float(w << 16); }
__device__ __forceinline__ float bfhi(unsigned w) { return __uint_as_float(w & 0xffff0000u); }
__device__ __forceinline__ bf16_t f2bf(float f) { return (bf16_t)(cvt_pk_bf16(f, 0.f) & 0xffffu); }
__device__ __forceinline__ float fexp2(float x) { return __builtin_amdgcn_exp2f(x); }
__device__ __forceinline__ float frcp(float x) { return __builtin_amdgcn_rcpf(x); }
__device__ __forceinline__ float gelu_tanh(float x) {
    const float u = x * (1.0f + 0.044715f * x * x) * (-2.0f * 0.7978845608028654f * 1.4426950408889634f);
    return x * frcp(1.0f + fexp2(u));
}
__device__ __forceinline__ float sigmoidf_(float x) { return frcp(1.0f + fexp2(-1.4426950408889634f * x)); }
__device__ __forceinline__ float bperm_f(int src_lane, float v) { return __int_as_float(__builtin_amdgcn_ds_bpermute(src_lane << 2, __float_as_int(v))); }
#define DPP_F(V, CTRL) __int_as_float(__builtin_amdgcn_mov_dpp(__float_as_int(V), (CTRL), 0xf, 0xf, true))
__device__ __forceinline__ float wave_sum(float v, int  ) {
    v += DPP_F(v, 0xB1);
    v += DPP_F(v, 0x4E);
    v += DPP_F(v, 0x141);
    v += DPP_F(v, 0x140);
    const int iv = __float_as_int(v);
    return (__int_as_float(__builtin_amdgcn_readlane(iv, 0)) + __int_as_float(__builtin_amdgcn_readlane(iv, 16))) + (__int_as_float(__builtin_amdgcn_readlane(iv, 32)) + __int_as_float(__builtin_amdgcn_readlane(iv, 48)));
}
__device__ __forceinline__ float xor32_max(float v) { auto rr = __builtin_amdgcn_permlane32_swap(__float_as_uint(v), __float_as_uint(v), false, false); return fmaxf(__uint_as_float(rr[0]), __uint_as_float(rr[1])); }
__device__ __forceinline__ float xor32_sum(float v) { auto rr = __builtin_amdgcn_permlane32_swap(__float_as_uint(v), __float_as_uint(v), false, false); return __uint_as_float(rr[0]) + __uint_as_float(rr[1]); }

__device__ __forceinline__ void lru_ab(float ga, float gx, float gab, float gxb, float spl  , float xb, float& a, float& b) {
    const float r = sigmoidf_(ga + gab), ii = sigmoidf_(gx + gxb);
    const float la2 = (-8.0f * 1.4426950408889634f) * r * spl;
    a = fexp2(la2);
    const float om = 1.0f - a * a;
    b = __builtin_amdgcn_sqrtf(om) * (ii * xb);
}


__device__ __forceinline__ void lru_lb(float ga, float gx, float gab, float gxb, float spl, float xb, float& la2, float& b) {
    const float r = sigmoidf_(ga + gab), ii = sigmoidf_(gx + gxb);
    la2 = (-8.0f * 1.4426950408889634f) * r * spl;
    const float a = fexp2(la2); const float om = 1.0f - a * a;
    b = __builtin_amdgcn_sqrtf(om) * (ii * xb);
}

namespace pg8 {
constexpr int BM = 256, BK = 64, HALF = 128, HTB = HALF * BK * 2, STAGE_BYTES = 8 * HTB, NXCD = 8, WGM = 8;
__host__ __device__ __forceinline__ int lds_byte(int r, int c) { const int st = (r >> 4) * 2 + (c >> 5), rr = r & 15, cc = c & 31, ob = rr * 64 + cc * 2; return st * 1024 + (ob ^ (((ob >> 9) & 1) << 5)); }
__host__ __device__ __forceinline__ void stage_rc(int b, int& R, int& C) { const int st = b / 1024, sb = b % 1024, swz = sb ^ (((sb >> 9) & 1) << 5); R = (st >> 1) * 16 + swz / 64; C = (st & 1) * 32 + (swz % 64) / 2; }
__host__ __device__ __forceinline__ int perm32(int rho) { const int n = rho >> 4, i = rho & 15; return 8 * (i >> 2) + 4 * n + (i & 3); }

struct Unit { int pm, pn; };
struct Gemm { const bf16_t* A; const bf16_t* Bt; int lda, ldb, K; size_t tA, hA, tB, hB; int a_seg; int a_pn_shift; size_t a_pn_step; };
__device__ __forceinline__ Gemm make_gemm(const bf16_t* A, int lda, const bf16_t* Bt, int ldb, int K) {
    Gemm g; g.A = A; g.Bt = Bt; g.lda = lda; g.ldb = ldb; g.K = K; g.tA = (size_t)256 * lda * 2; g.hA = (size_t)128 * lda * 2; g.tB = (size_t)256 * ldb * 2; g.hB = (size_t)128 * ldb * 2;
    g.a_seg = 0; g.a_pn_shift = 0; g.a_pn_step = 0; return g;
}

struct StaticOrder {
    int nM, nN, nwg, G, c;
    __device__ __forceinline__ void init(int nM_, int nN_, int G_, int c_) { nM = nM_; nN = nN_; nwg = nM * nN; G = G_; c = c_; }
    __device__ __forceinline__ bool next(int i, Unit& u) const {
        const long L = (long)i * G + c; if (L >= nwg) return false;
        int wgid = (int)L; { const int q = nwg / NXCD, r = nwg % NXCD, xcd = wgid % NXCD, off = wgid / NXCD; wgid = (xcd < r ? xcd * (q + 1) : r * (q + 1) + (xcd - r) * q) + off; }
        const int nig = WGM * nN, gid = wgid / nig, fm = gid * WGM, gsz = (nM - fm) < WGM ? (nM - fm) : WGM;
        u.pm = fm + ((wgid % nig) % gsz); u.pn = (wgid % nig) / gsz; return true;
    }
};

template <class Epi>
__device__ __forceinline__ void gemm_phase(LAS unsigned char* lds, const Gemm g, const StaticOrder& S, const Epi& E) {
    constexpr bool SP2 = true, ALIGN_EPI = true;
    int tid_ = threadIdx.x; asm volatile("" : "+v"(tid_));
    const int tid = tid_, wid = __builtin_amdgcn_readfirstlane(tid >> 6), lane = tid & 63, wr = wid >> 2, wc = wid & 3, fr = lane & 15, fq = lane >> 4;
    int K_ = g.K; asm volatile("" : "+s"(K_)); const int K = K_, nt = K / BK;
    unsigned voffA[2], voffB[2];
#pragma unroll
    for (int i = 0; i < 2; ++i) { int R, C; stage_rc(tid * 16 + i * 8192, R, C); const int Rb = Epi::PERM ? ((R & ~31) + perm32(R & 31)) : R;
        const int Ra = g.a_seg ? (128 * (R >> 6) + 8 * (R & 15) + ((R >> 4) & 3)) : R;
        voffA[i] = (unsigned)(Ra * g.lda + C) * 2u; voffB[i] = (unsigned)(Rb * g.ldb + C) * 2u; }
    const size_t kstep = (size_t)(BK * 2);
    const size_t hstepA = g.hA, hstepB = g.hB;
    const unsigned ldsw = (unsigned)wid * 1024u;
    const int aoff = lds_byte(wr * 64 + fr, fq * 8), boff = lds_byte(wc * 32 + fr, fq * 8);
#define PG8_SA(b, h) (((b) * 2 + (h)) * HTB)
#define PG8_SB(b, h) ((4 + (b) * 2 + (h)) * HTB)
#define PG8_STAGE(bufoff, gbase, voff) do { _Pragma("unroll") for (int _i = 0; _i < 2; ++_i) \
        __builtin_amdgcn_global_load_lds((const unsigned*)((const char*)(gbase) + (voff)[_i]), (LAS unsigned*)(lds + (bufoff) + ldsw + _i * 8192), 16, 0, 0); } while (0)
#define PG8_LDA(dst, b, h) do { _Pragma("unroll") for (int m = 0; m < 4; ++m) _Pragma("unroll") for (int k = 0; k < 2; ++k) dst[m][k] = *(const LAS bf16x8*)(lds + PG8_SA(b, h) + aoff + m * 2048 + k * 1024); } while (0)
#define PG8_LDB(dst, b, h) do { _Pragma("unroll") for (int n = 0; n < 2; ++n) _Pragma("unroll") for (int k = 0; k < 2; ++k) dst[n][k] = *(const LAS bf16x8*)(lds + PG8_SB(b, h) + boff + n * 2048 + k * 1024); } while (0)
#define PG8_MMA(ai, bj, At, Bt) do { __builtin_amdgcn_s_setprio(1); _Pragma("unroll") for (int m = 0; m < 4; ++m) _Pragma("unroll") for (int n = 0; n < 2; ++n) _Pragma("unroll") for (int k = 0; k < 2; ++k) \
        acc[ai][bj][m][n] = __builtin_amdgcn_mfma_f32_16x16x32_bf16(Bt[n][k], At[m][k], acc[ai][bj][m][n], 0, 0, 0); __builtin_amdgcn_s_setprio(0); } while (0)
#define PG8_WAIT_V(n) asm volatile("s_waitcnt vmcnt(" #n ")" ::: "memory")
#define PG8_WAIT_L(n) asm volatile("s_waitcnt lgkmcnt(" #n ")" ::: "memory")
#define PG8_BAR __builtin_amdgcn_s_barrier()
#define PG8_SCHED __builtin_amdgcn_sched_barrier(0)
#define PG8_APTR(u) ((const char*)g.A + (size_t)(u).pm * g.tA + (size_t)((u).pn >> g.a_pn_shift) * g.a_pn_step)
#define PG8_BPTR(u) ((const char*)g.Bt + (size_t)(u).pn * g.tB)
    Unit cur, nxt; int ui = 0;
    if (!S.next(0, cur)) return;
    f32x4 acc[2][2][4][2];
#pragma unroll
    for (int a = 0; a < 2; ++a)
#pragma unroll
        for (int b = 0; b < 2; ++b)
#pragma unroll
            for (int m = 0; m < 4; ++m)
#pragma unroll
                for (int n = 0; n < 2; ++n) acc[a][b][m][n] = (f32x4){0.f, 0.f, 0.f, 0.f};
    bf16x8 At[4][2], B0[2][2], B1[2][2];
    const char* cA = PG8_APTR(cur); const char* cB = PG8_BPTR(cur);
    {
        PG8_STAGE(PG8_SB(0, 0), cB, voffB); PG8_STAGE(PG8_SB(0, 1), cB + hstepB, voffB); PG8_STAGE(PG8_SA(0, 0), cA, voffA); PG8_STAGE(PG8_SA(0, 1), cA + hstepA, voffA);
        if (wr == 1) PG8_BAR;
        PG8_WAIT_V(2); PG8_BAR;
        PG8_STAGE(PG8_SB(1, 0), cB + kstep, voffB); PG8_STAGE(PG8_SA(1, 0), cA + kstep, voffA); PG8_STAGE(PG8_SB(1, 1), cB + hstepB + kstep, voffB);
        PG8_WAIT_V(6); PG8_BAR;
    }
    for (;;) {
        const bool has_next = S.next(ui + 1, nxt);
        const char* nA = has_next ? PG8_APTR(nxt) : cA; const char* nB = has_next ? PG8_BPTR(nxt) : cB;
        for (int t = 0; t < nt; t += 2) {
            const bool last = (t == nt - 2);
            const char* a1 = cA + (size_t)(t + 1) * kstep;
            const char* a2 = last ? nA : cA + (size_t)(t + 2) * kstep; const char* b2 = last ? nB : cB + (size_t)(t + 2) * kstep;
            const char* a3 = a2 + kstep; const char* b3 = b2 + kstep;
            PG8_LDB(B0, 0, 0); PG8_LDB(B1, 0, 1); PG8_SCHED; PG8_LDA(At, 0, 0); PG8_STAGE(PG8_SA(1, 1), a1 + hstepA, voffA);
            PG8_WAIT_V(8); PG8_WAIT_L(0); PG8_BAR; PG8_MMA(0, 0, At, B0); PG8_MMA(0, 1, At, B1); PG8_BAR; PG8_SCHED;
            PG8_LDA(At, 0, 1); PG8_STAGE(PG8_SB(0, 0), b2, voffB); PG8_STAGE(PG8_SB(0, 1), b2 + hstepB, voffB); PG8_STAGE(PG8_SA(0, 0), a2, voffA);
            PG8_WAIT_V(8); PG8_WAIT_L(0); PG8_BAR; PG8_MMA(1, 0, At, B0); PG8_MMA(1, 1, At, B1); PG8_BAR; PG8_SCHED;
            PG8_LDB(B0, 1, 0); PG8_LDB(B1, 1, 1); PG8_SCHED; PG8_LDA(At, 1, 0); PG8_STAGE(PG8_SA(0, 1), a2 + hstepA, voffA);
            PG8_WAIT_V(8); PG8_WAIT_L(0); PG8_BAR; PG8_MMA(0, 0, At, B0); PG8_MMA(0, 1, At, B1); PG8_BAR; PG8_SCHED;
            PG8_LDA(At, 1, 1); PG8_STAGE(PG8_SB(1, 0), b3, voffB); PG8_STAGE(PG8_SB(1, 1), b3 + hstepB, voffB); PG8_STAGE(PG8_SA(1, 0), a3, voffA);
            PG8_WAIT_V(8); PG8_WAIT_L(0); PG8_BAR; PG8_MMA(1, 0, At, B0); PG8_MMA(1, 1, At, B1); PG8_BAR; PG8_SCHED;
        }
        if constexpr (ALIGN_EPI) { if (wr == 0) PG8_BAR; }
        if constexpr (!Epi::AFTER_DRAIN) E(acc, cur, wr, wc, fr, fq);
        if (!has_next) break;
#pragma unroll
        for (int a = 0; a < 2; ++a)
#pragma unroll
            for (int b = 0; b < 2; ++b)
#pragma unroll
                for (int m = 0; m < 4; ++m)
#pragma unroll
                    for (int n = 0; n < 2; ++n) acc[a][b][m][n] = (f32x4){0.f, 0.f, 0.f, 0.f};
        cur = nxt; cA = nA; cB = nB; ++ui;
        if constexpr (ALIGN_EPI) { if (wr == 1) PG8_BAR; }
    }
    PG8_WAIT_V(0);
    if constexpr (!ALIGN_EPI) { if (wr == 0) PG8_BAR; }
    PG8_BAR;
    if constexpr (Epi::AFTER_DRAIN) E.fused(acc, cur, wr, wc, fr, fq, lds, wid, lane);
#undef PG8_SA
#undef PG8_SB
#undef PG8_STAGE
#undef PG8_LDA
#undef PG8_LDB
#undef PG8_MMA
#undef PG8_WAIT_V
#undef PG8_WAIT_L
#undef PG8_BAR
#undef PG8_SCHED
#undef PG8_APTR
#undef PG8_BPTR
}
}
constexpr int TH = 16384;
constexpr int DM = 1024, ZP = 2304, DFF = 4096, TQ = 8192;
constexpr size_t MiB = 1u << 20;
constexpr size_t WS_RSQ = 0, WS_RSKV = 64 * 1024, WS_ROPE = 128 * 1024;
constexpr size_t WS_AGG = 5 * MiB;
constexpr size_t WS_CARRY = 9 * MiB;
constexpr size_t WS_XBUF = 1 * MiB;
constexpr size_t WS_SQP = 1 * MiB + 512 * 1024;
constexpr size_t WS_CNT = 3 * MiB;
constexpr size_t WS_BAR = 4 * MiB;
constexpr size_t WS_YB = 5 * MiB;
constexpr size_t WS_W_INATT = 13 * MiB;
constexpr size_t WS_W_UQ = WS_W_INATT + (size_t)2304 * 1024 * 2;
constexpr size_t WS_W_UKV = WS_W_UQ + (size_t)768 * 384 * 2;
constexpr size_t WS_W_OUTATT = WS_W_UKV + (size_t)1024 * 256 * 2;
constexpr size_t WS_W_INREC = WS_W_OUTATT + 2 * MiB;
constexpr size_t WS_W_GATES = WS_W_INREC + 4 * MiB;
constexpr size_t WS_W_OUTREC = WS_W_GATES + 1 * MiB;
constexpr size_t WS_W_UP = WS_W_OUTREC + 2 * MiB;
constexpr size_t WS_W_DOWN = WS_W_UP + 32 * MiB;
constexpr size_t WS_W_END = WS_W_DOWN + 16 * MiB;
static_assert(WS_W_END <= 76 * MiB, "weights");
constexpr size_t WS_XN = 76 * MiB;
constexpr size_t WS_BIG = 108 * MiB;
constexpr size_t WS_Z = WS_BIG;
constexpr size_t WS_Q = WS_Z + 72 * MiB;
constexpr size_t WS_KN = WS_Q + 24 * MiB;
constexpr size_t WS_VTM = WS_KN + 16 * MiB;
constexpr size_t WS_VTN = WS_VTM + 16 * MiB;
constexpr size_t WS_KPE = WS_VTN + 16 * MiB;
static_assert(WS_KPE + 1 * MiB <= 256 * MiB, "L0 overlay");
constexpr size_t WS_ACT = WS_BIG;
constexpr size_t WS_GATE = WS_BIG;
constexpr size_t WS_XB = WS_BIG + 32 * MiB;
constexpr size_t WS_XBR = WS_BIG + 64 * MiB;
constexpr size_t WS_GQ = WS_XBR;
constexpr size_t WS_END = 256 * MiB;

using pg8::Unit;

struct EpiBf16 {
    static constexpr bool PERM = true, AFTER_DRAIN = false;
    bf16_t* O; int ldc; int split_cols; size_t split_stride;
    __device__ __forceinline__ void operator()(f32x4 (&acc)[2][2][4][2], const Unit& u, int wr, int wc, int fr, int fq) const {
        const int row0 = u.pm * 256 + wr * 64 + fr; int colt = u.pn * 256; bf16_t* base = O;
        if (split_cols) { const int t = colt / split_cols; base += (size_t)t * split_stride; colt -= t * split_cols; }
        const int col0 = colt + wc * 32 + 8 * fq;
#pragma unroll
        for (int ai = 0; ai < 2; ++ai)
#pragma unroll
            for (int m = 0; m < 4; ++m) { bf16_t* rowp = base + (size_t)(row0 + ai * 128 + m * 16) * ldc + col0;
#pragma unroll
                for (int bj = 0; bj < 2; ++bj) { const f32x4 v0 = acc[ai][bj][m][0], v1 = acc[ai][bj][m][1];
                    u32x4 w; w.x = cvt_pk_bf16(v0[0], v0[1]); w.y = cvt_pk_bf16(v0[2], v0[3]); w.z = cvt_pk_bf16(v1[0], v1[1]); w.w = cvt_pk_bf16(v1[2], v1[3]);
                    *(u32x4*)(rowp + bj * 128) = w; } }
    }
};

struct EpiZ {
    static constexpr bool PERM = true, AFTER_DRAIN = false;
    bf16_t* Z; bf16_t* VTn; float* SQ; float* SKV; bf16_t* KPE; const float2* rope; int smask;
    __device__ __forceinline__ void operator()(f32x4 (&acc)[2][2][4][2], const Unit& u, int wr, int wc, int fr, int fq) const {
        const int lane = fq * 16 + fr;
        const int row0 = u.pm * 256 + wr * 64 + fr; const int col0 = u.pn * 256 + wc * 32 + 8 * fq;
#pragma unroll
        for (int ai = 0; ai < 2; ++ai)
#pragma unroll
            for (int m = 0; m < 4; ++m) { const int row = row0 + ai * 128 + m * 16; bf16_t* rowp = Z + (size_t)row * ZP + col0;
#pragma unroll
                for (int bj = 0; bj < 2; ++bj) { const f32x4 v0 = acc[ai][bj][m][0], v1 = acc[ai][bj][m][1];
                    u32x4 w; w.x = cvt_pk_bf16(v0[0], v0[1]); w.y = cvt_pk_bf16(v0[2], v0[3]); w.z = cvt_pk_bf16(v1[0], v1[1]); w.w = cvt_pk_bf16(v1[2], v1[3]);
                    *(u32x4*)(rowp + bj * 128) = w;
                    const int c = col0 + bj * 128; const int g32 = (u.pn * 256 + bj * 128 + wc * 32) >> 5;
                    if (g32 < 20) {
                        float s = (v0[0] * v0[0] + v0[1] * v0[1]) + (v0[2] * v0[2] + v0[3] * v0[3]) + ((v1[0] * v1[0] + v1[1] * v1[1]) + (v1[2] * v1[2] + v1[3] * v1[3]));
                        s += bperm_f(lane ^ 16, s); s += bperm_f(lane ^ 32, s);
                        if (fq == 0) SQ[(size_t)row * 20 + g32] = s;
                    } else if (g32 == 20) {
                        const float2* rp = rope + (size_t)(row & smask) * 16 + 8 * (fq & 1);
                        float o[8];
#pragma unroll
                        for (int k = 0; k < 8; ++k) { const float mine = k < 4 ? v0[k] : v1[k - 4]; const float other = bperm_f(lane ^ 32, mine); const float2 cs = rp[k];
                            o[k] = fq < 2 ? mine * cs.x - other * cs.y : mine * cs.x + other * cs.y; }
                        u32x4 wk; wk.x = cvt_pk_bf16(o[0], o[1]); wk.y = cvt_pk_bf16(o[2], o[3]); wk.z = cvt_pk_bf16(o[4], o[5]); wk.w = cvt_pk_bf16(o[6], o[7]);
                        *(u32x4*)(KPE + (size_t)row * 32 + 8 * fq) = wk;
                    }
                    if (c >= 1696 && c < 2208) { bf16_t* vt = VTn + (size_t)(c - 1696) * TH + row;
                        vt[0] = (bf16_t)(w.x & 0xffffu); vt[TH] = (bf16_t)(w.x >> 16); vt[2 * TH] = (bf16_t)(w.y & 0xffffu); vt[3 * TH] = (bf16_t)(w.y >> 16);
                        vt[4 * TH] = (bf16_t)(w.z & 0xffffu); vt[5 * TH] = (bf16_t)(w.z >> 16); vt[6 * TH] = (bf16_t)(w.w & 0xffffu); vt[7 * TH] = (bf16_t)(w.w >> 16); } } }
    }
};

struct EpiQ {
    static constexpr bool PERM = false, AFTER_DRAIN = false;
    bf16_t* Q; const float* rsq; const float2* rope; int smask;
    __device__ __forceinline__ void operator()(f32x4 (&acc)[2][2][4][2], const Unit& u, int wr, int wc, int fr, int fq) const {
        const float SC = 0.10206207261596577f * 1.4426950408889634f;
        const int row0 = u.pm * 256 + wr * 64 + fr;
#pragma unroll
        for (int ai = 0; ai < 2; ++ai)
#pragma unroll
            for (int m = 0; m < 4; ++m) { const int row = row0 + ai * 128 + m * 16; float ssq = 0.f;
#pragma unroll
                for (int k = 0; k < 12; ++k) ssq += rsq[(size_t)row * 20 + k];
                const float rs = SC / sqrtf(ssq * (1.f / 384.f) + 1e-6f); const int pos = row & smask;
#pragma unroll
                for (int bj = 0; bj < 2; ++bj) { const int cg = u.pn * 256 + bj * 128 + wc * 32;
                    f32x4 v0 = acc[ai][bj][m][0] * rs, v1 = acc[ai][bj][m][1] * rs;
                    if ((cg % 96) == 64) {
                        const float2* rp = rope + (size_t)pos * 16 + 4 * fq;
#pragma unroll
                        for (int i = 0; i < 4; ++i) { const float2 cs = rp[i]; const float x1 = v0[i], x2 = v1[i]; v0[i] = x1 * cs.x - x2 * cs.y; v1[i] = x2 * cs.x + x1 * cs.y; }
                    }
                    bf16_t* p = Q + (size_t)row * 768 + cg + 4 * fq;
                    u32x2 w0; w0.x = cvt_pk_bf16(v0[0], v0[1]); w0.y = cvt_pk_bf16(v0[2], v0[3]); *(u32x2*)p = w0;
                    u32x2 w1; w1.x = cvt_pk_bf16(v1[0], v1[1]); w1.y = cvt_pk_bf16(v1[2], v1[3]); *(u32x2*)(p + 16) = w1; } }
    }
};

struct EpiKV {
    static constexpr bool PERM = true, AFTER_DRAIN = false;
    bf16_t* KN; bf16_t* VTm; const float* rskv;
    __device__ __forceinline__ void operator()(f32x4 (&acc)[2][2][4][2], const Unit& u, int wr, int wc, int fr, int fq) const {
        const int row0 = u.pm * 256 + wr * 64 + fr;
#pragma unroll
        for (int ai = 0; ai < 2; ++ai)
#pragma unroll
            for (int m = 0; m < 4; ++m) { const int row = row0 + ai * 128 + m * 16; float ssq = 0.f;
#pragma unroll
                for (int k = 12; k < 20; ++k) ssq += rskv[(size_t)row * 20 + k];
                const float rs = 1.0f / sqrtf(ssq * (1.f / 256.f) + 1e-6f);
#pragma unroll
                for (int bj = 0; bj < 2; ++bj) { const int c = u.pn * 256 + bj * 128 + wc * 32 + 8 * fq;
                    const f32x4 v0 = acc[ai][bj][m][0] * rs, v1 = acc[ai][bj][m][1] * rs;
                    u32x4 w; w.x = cvt_pk_bf16(v0[0], v0[1]); w.y = cvt_pk_bf16(v0[2], v0[3]); w.z = cvt_pk_bf16(v1[0], v1[1]); w.w = cvt_pk_bf16(v1[2], v1[3]);
                    const int h = c >> 7, j = c & 127;
                    if (j < 64) { *(u32x4*)(KN + (size_t)row * 512 + h * 64 + j) = w; }
                    else { bf16_t* vt = VTm + (size_t)(h * 64 + j - 64) * TH + row;
                        vt[0] = (bf16_t)(w.x & 0xffffu); vt[TH] = (bf16_t)(w.x >> 16); vt[2 * TH] = (bf16_t)(w.y & 0xffffu); vt[3 * TH] = (bf16_t)(w.y >> 16);
                        vt[4 * TH] = (bf16_t)(w.z & 0xffffu); vt[5 * TH] = (bf16_t)(w.z >> 16); vt[6 * TH] = (bf16_t)(w.w & 0xffffu); vt[7 * TH] = (bf16_t)(w.w >> 16); } } }
    }
};

struct EpiUp {
    static constexpr bool PERM = true, AFTER_DRAIN = false;
    bf16_t* ACT; bf16_t* YB; const float* cw; const float* cb;
    __device__ __forceinline__ void operator()(f32x4 (&acc)[2][2][4][2], const Unit& u, int wr, int wc, int fr_, int fq_) const {
        int fr = fr_, fq = fq_; asm volatile("" : "+v"(fr), "+v"(fq));
        const int lane = fq * 16 + fr;
        const int tok0 = u.pm * 256 + wr * 128 + 8 * fr;
        const int ch0 = u.pn * 128 + wc * 32 + 8 * fq;
        const int seg = u.pm * 2 + wr;
        if (fr == 0 || fr == 15) {
#pragma unroll
            for (int k = 0; k < 2; ++k) {
                const int slot = fr == 0 ? k : 2 + k;
                bf16_t* yb = YB + ((size_t)seg * 4 + slot) * 8192 + ch0;
#pragma unroll
                for (int bj = 0; bj < 2; ++bj) { const f32x4 v0 = fr == 0 ? acc[0][bj][k][0] : acc[1][bj][2 + k][0], v1 = fr == 0 ? acc[0][bj][k][1] : acc[1][bj][2 + k][1];
                    u32x4 w; w.x = cvt_pk_bf16(v0[0], v0[1]); w.y = cvt_pk_bf16(v0[2], v0[3]); w.z = cvt_pk_bf16(v1[0], v1[1]); w.w = cvt_pk_bf16(v1[2], v1[3]);
                    *(u32x4*)(yb + bj * 4096) = w; }
            }
        }
        const int src_up = (lane & ~15) | ((fr - 1) & 15), src_dn = (lane & ~15) | ((fr + 1) & 15);
#pragma unroll
        for (int n = 0; n < 2; ++n)
#pragma unroll
            for (int i = 0; i < 4; ++i) {
                float ug[8], uv[8];
#pragma unroll
                for (int bj = 0; bj < 2; ++bj) {
                    const int ch = bj * 4096 + ch0 + 4 * n + i;
                    const float w0 = cw[ch], w1 = cw[8192 + ch], w2 = cw[2 * 8192 + ch], b = cb[ch];
                    const float prev7 = bperm_f(src_up, acc[1][bj][3][n][i]);
                    const float next0 = bperm_f(src_dn, acc[0][bj][0][n][i]);
#pragma unroll
                    for (int q = 0; q < 8; ++q) {
                        const float v = acc[q >> 2][bj][q & 3][n][i];
                        const float up = q > 0 ? acc[(q - 1) >> 2][bj][(q - 1) & 3][n][i] : prev7;
                        const float dn = q < 7 ? acc[(q + 1) >> 2][bj][(q + 1) & 3][n][i] : next0;
                        const float r = w0 * up + w1 * v + w2 * dn + b;
                        if (bj == 0) ug[q] = r; else uv[q] = r;
                    }
                }
#pragma unroll
                for (int q = 0; q < 8; ++q) acc[q >> 2][0][q & 3][n][i] = gelu_tanh(ug[q]) * uv[q];
            }
#pragma unroll
        for (int ai = 0; ai < 2; ++ai)
#pragma unroll
            for (int m = 0; m < 4; ++m) { const f32x4 v0 = acc[ai][0][m][0], v1 = acc[ai][0][m][1];
                u32x4 w; w.x = cvt_pk_bf16(v0[0], v0[1]); w.y = cvt_pk_bf16(v0[2], v0[3]); w.z = cvt_pk_bf16(v1[0], v1[1]); w.w = cvt_pk_bf16(v1[2], v1[3]);
                *(u32x4*)(ACT + (size_t)(tok0 + 4 * ai + m) * DFF + ch0) = w; }
    }
};

struct EpiGates {
    static constexpr bool PERM = true, AFTER_DRAIN = false;
    bf16_t* G; const bf16_t* XBq; float2* AGGp; const float* gab_; const float* gxb_; const float* lam_;
    __device__ __forceinline__ void operator()(f32x4 (&acc)[2][2][4][2], const Unit& u, int wr, int wc, int fr_, int fq_) const {
        int fr = fr_, fq = fq_; asm volatile("" : "+v"(fr), "+v"(fq));
        const int lane = fq * 16 + fr;
        const int nblk = u.pn >> 1, e = u.pn & 1;
        const int tl0 = u.pm * 256 + wr * 128 + 8 * fr;
        const int d0 = wc * 32 + 8 * fq, ch0 = nblk * 128 + d0;
        u32x4 xbw[8];
#pragma unroll
        for (int q = 0; q < 8; ++q) xbw[q] = *(const u32x4*)(XBq + (size_t)(tl0 + q) * DM + ch0);
        unsigned law[8][4], bw[8][4];
#pragma unroll
        for (int k2 = 0; k2 < 4; ++k2) {
            const float2 gab = *(const float2*)(gab_ + e * 1024 + ch0 + 2 * k2), gxb = *(const float2*)(gxb_ + e * 1024 + ch0 + 2 * k2), lam = *(const float2*)(lam_ + e * 1024 + ch0 + 2 * k2);
            const float spl0 = log1pf(expf(-lam.x)), spl1 = log1pf(expf(-lam.y));
#pragma unroll
            for (int q = 0; q < 8; ++q) {
                const unsigned xb2 = k2 == 0 ? xbw[q].x : k2 == 1 ? xbw[q].y : k2 == 2 ? xbw[q].z : xbw[q].w;
                float l0, b0, l1, b1;
                lru_lb(acc[q >> 2][0][q & 3][k2 >> 1][2 * (k2 & 1)], acc[q >> 2][1][q & 3][k2 >> 1][2 * (k2 & 1)], gab.x, gxb.x, spl0, bflo(xb2), l0, b0);
                lru_lb(acc[q >> 2][0][q & 3][k2 >> 1][2 * (k2 & 1) + 1], acc[q >> 2][1][q & 3][k2 >> 1][2 * (k2 & 1) + 1], gab.y, gxb.y, spl1, bfhi(xb2), l1, b1);
                law[q][k2] = cvt_pk_bf16(l0, l1); bw[q][k2] = cvt_pk_bf16(b0, b1); }
        }
#pragma unroll
        for (int q = 0; q < 8; ++q) { bf16_t* rowp = G + (size_t)(tl0 + q) * 4096 + u.pn * 256 + d0;
            *(u32x4*)(rowp) = (u32x4){law[q][0], law[q][1], law[q][2], law[q][3]}; *(u32x4*)(rowp + 128) = (u32x4){bw[q][0], bw[q][1], bw[q][2], bw[q][3]}; }
        float Aagg[8], Bagg[8];
#pragma unroll
        for (int k2 = 0; k2 < 4; ++k2) {
            float A0 = 1.f, B0 = 0.f, A1 = 1.f, B1 = 0.f;
#pragma unroll
            for (int s = 0; s < 8; ++s) {
                const unsigned l2 = e ? law[7 - s][k2] : law[s][k2], b2 = e ? bw[7 - s][k2] : bw[s][k2];
                const float a0 = fexp2(bflo(l2)), a1 = fexp2(bfhi(l2));
                A0 *= a0; B0 = a0 * B0 + bflo(b2); A1 *= a1; B1 = a1 * B1 + bfhi(b2); }
            Aagg[2 * k2] = A0; Bagg[2 * k2] = B0; Aagg[2 * k2 + 1] = A1; Bagg[2 * k2 + 1] = B1;
        }
#pragma unroll
        for (int bit = 1; bit <= 2; bit <<= 1) {
            const bool me_first = e ? ((fr & bit) != 0) : ((fr & bit) == 0);
#pragma unroll
            for (int k = 0; k < 8; ++k) { const float Ao = bperm_f(lane ^ bit, Aagg[k]), Bo = bperm_f(lane ^ bit, Bagg[k]);
                const float An = Ao * Aagg[k], Bn = me_first ? Ao * Bagg[k] + Bo : Aagg[k] * Bo + Bagg[k];
                Aagg[k] = An; Bagg[k] = Bn; }
        }
        if ((fr & 3) == 0) { const int c = (tl0 >> 5);
            float2* dst = AGGp + (size_t)(c * 2 + e) * 1024 + ch0;
#pragma unroll
            for (int k = 0; k < 8; k += 2) *(f32x4*)(dst + k) = (f32x4){Aagg[k], Bagg[k], Aagg[k + 1], Bagg[k + 1]}; }
    }
};

struct EpiRms {
    static constexpr bool PERM = false, AFTER_DRAIN = true;
    float* x; bf16_t* xn; const float* gpost; const float* gnext; float* xbuf1; float* xbuf2; unsigned* cnt1; unsigned* cnt2;
    __device__ __forceinline__ void operator()(f32x4 (&)[2][2][4][2], const Unit&, int, int, int, int) const {}
    __device__ __forceinline__ void stats(const f32x4 (&v)[2][2][4][2], const Unit& u, int wr, int wc, int fr, int fq, LAS unsigned char* lds, int wid, int lane, float* xbuf, unsigned* cnt) const {
        LAS float* P = (LAS float*)lds; LAS float* Sx = (LAS float*)(lds + 4096);
#pragma unroll
        for (int ai = 0; ai < 2; ++ai)
#pragma unroll
            for (int m = 0; m < 4; ++m) { float s = 0.f;
#pragma unroll
                for (int bj = 0; bj < 2; ++bj)
#pragma unroll
                    for (int n = 0; n < 2; ++n) { const f32x4 t = v[ai][bj][m][n]; s += (t[0] * t[0] + t[1] * t[1]) + (t[2] * t[2] + t[3] * t[3]); }
                s += bperm_f(lane ^ 16, s); s += bperm_f(lane ^ 32, s);
                if (fq == 0) P[(ai * 128 + wr * 64 + m * 16 + fr) * 4 + wc] = s; }
        asm volatile("s_waitcnt lgkmcnt(0)" ::: "memory"); __builtin_amdgcn_s_barrier(); asm volatile("" ::: "memory");
        const int row = wid * 32 + (lane & 31);
        if (lane < 32) { const float t = (P[row * 4 + 0] + P[row * 4 + 1]) + (P[row * 4 + 2] + P[row * 4 + 3]);
            __hip_atomic_store(xbuf + (size_t)(u.pm * 256 + row) * 4 + u.pn, t, __ATOMIC_RELAXED, __HIP_MEMORY_SCOPE_AGENT); }
        asm volatile("s_waitcnt vmcnt(0)" ::: "memory");
        if (lane == 0) __hip_atomic_fetch_add(cnt + 64 * u.pm, 1u, __ATOMIC_RELAXED, __HIP_MEMORY_SCOPE_AGENT);
        if (wid == 0) { unsigned sp = 0;
            while ((unsigned)__builtin_amdgcn_readfirstlane(__hip_atomic_load(cnt + 64 * u.pm, __ATOMIC_RELAXED, __HIP_MEMORY_SCOPE_AGENT)) < 32u) { __builtin_amdgcn_s_sleep(2); if (++sp > (1u << 22)) break; }
            __builtin_amdgcn_fence(__ATOMIC_ACQUIRE, "agent"); }
        asm volatile("s_waitcnt vmcnt(0) lgkmcnt(0)" ::: "memory"); __builtin_amdgcn_s_barrier(); asm volatile("" ::: "memory");
        if (lane < 32) { const float* slot = xbuf + (size_t)(u.pm * 256 + row) * 4; float t = 0.f;
#pragma unroll
            for (int k = 0; k < 4; ++k) t += __hip_atomic_load(slot + k, __ATOMIC_RELAXED, __HIP_MEMORY_SCOPE_AGENT);
            Sx[row] = 1.0f / sqrtf(t * (1.f / 1024.f) + 1e-6f); }
        asm volatile("s_waitcnt lgkmcnt(0)" ::: "memory"); __builtin_amdgcn_s_barrier(); asm volatile("" ::: "memory");
    }
    __device__ __forceinline__ void fused(f32x4 (&acc)[2][2][4][2], const Unit& u, int wr, int wc, int fr, int fq, LAS unsigned char* lds, int wid, int lane) const {
        const LAS float* Sx = (const LAS float*)(lds + 4096);
        const int col0 = u.pn * 256 + wc * 32 + 4 * fq;
        stats(acc, u, wr, wc, fr, fq, lds, wid, lane, xbuf1, cnt1);
#pragma unroll
        for (int ai = 0; ai < 2; ++ai)
#pragma unroll
            for (int m = 0; m < 4; ++m) { const int r = ai * 128 + wr * 64 + m * 16 + fr; const float rs = Sx[r]; float* xr = x + (size_t)(u.pm * 256 + r) * DM + col0;
#pragma unroll
                for (int bj = 0; bj < 2; ++bj)
#pragma unroll
                    for (int n = 0; n < 2; ++n) { const f32x4 g = *(const f32x4*)(gpost + col0 + bj * 128 + n * 16); const f32x4 bs = *(const f32x4*)(xr + bj * 128 + n * 16);
                        const f32x4 o = bs + acc[ai][bj][m][n] * rs * g; acc[ai][bj][m][n] = o; *(f32x4*)(xr + bj * 128 + n * 16) = o; }
                if (m & 1) asm volatile("" ::: "memory"); }
        if (xn) {
            stats(acc, u, wr, wc, fr, fq, lds, wid, lane, xbuf2, cnt2);
#pragma unroll
            for (int ai = 0; ai < 2; ++ai)
#pragma unroll
                for (int m = 0; m < 4; ++m) { const int r = ai * 128 + wr * 64 + m * 16 + fr; const float rs = Sx[r]; bf16_t* xr = xn + (size_t)(u.pm * 256 + r) * DM + col0;
#pragma unroll
                    for (int bj = 0; bj < 2; ++bj)
#pragma unroll
                        for (int n = 0; n < 2; ++n) { const f32x4 g = *(const f32x4*)(gnext + col0 + bj * 128 + n * 16); const f32x4 o = acc[ai][bj][m][n] * rs * g;
                            u32x2 w; w.x = cvt_pk_bf16(o[0], o[1]); w.y = cvt_pk_bf16(o[2], o[3]); *(u32x2*)(xr + bj * 128 + n * 16) = w; } }
        }
    }
};
constexpr float EPS = 1e-6f;
constexpr float LOG2E = 1.4426950408889634f;

__device__ __forceinline__ void transpose_item(const float* W, int K, int N, bf16_t* WT, int row_off, const float* kscale, LAS float* scr, int item, int lane) {
    const int nblk = N / 32, kb = item / nblk, nb = item % nblk, k0 = 64 * kb, n0 = 32 * nb;
#pragma unroll 8
    for (int i = 0; i < 32; ++i) { const int kk = 2 * i + (lane >> 5); float v = W[(size_t)(k0 + kk) * N + n0 + (lane & 31)]; if (kscale) v *= kscale[k0 + kk]; scr[kk * 33 + (lane & 31)] = v; }
    asm volatile("s_waitcnt lgkmcnt(0)" ::: "memory");
    const int c = lane & 7;
#pragma unroll
    for (int j = 0; j < 4; ++j) { const int n = (lane >> 3) + 8 * j; const LAS float* s = scr + (8 * c) * 33 + n;
        u32x4 o; o.x = cvt_pk_bf16(s[0 * 33], s[1 * 33]); o.y = cvt_pk_bf16(s[2 * 33], s[3 * 33]); o.z = cvt_pk_bf16(s[4 * 33], s[5 * 33]); o.w = cvt_pk_bf16(s[6 * 33], s[7 * 33]);
        *(u32x4*)(WT + (size_t)(row_off + n0 + n) * K + k0 + 8 * c) = o; }
    asm volatile("s_waitcnt lgkmcnt(0)" ::: "memory");
}

__device__ __forceinline__ void xn_row(const float* xrow, const float* gain, bf16_t* orow, int lane) {
    const f32x4* xr = (const f32x4*)xrow + lane; const f32x4* gr = (const f32x4*)gain + lane;
    f32x4 v[4]; float s = 0.f;
#pragma unroll
    for (int j = 0; j < 4; ++j) { v[j] = xr[64 * j]; s += (v[j].x * v[j].x + v[j].y * v[j].y) + (v[j].z * v[j].z + v[j].w * v[j].w); }
    const float rs = 1.0f / sqrtf(wave_sum(s, lane) * (1.f / DM) + EPS);
    u32x2* o8 = (u32x2*)orow + lane;
#pragma unroll
    for (int j = 0; j < 4; ++j) { const f32x4 g = gr[64 * j]; u32x2 w; w.x = cvt_pk_bf16(v[j].x * rs * g.x, v[j].y * rs * g.y); w.y = cvt_pk_bf16(v[j].z * rs * g.z, v[j].w * rs * g.w); o8[64 * j] = w; }
}

__device__ __forceinline__ void res_row(const bf16_t* mrow, const float* xi, float* xo, const float* gpost, const float* gnext, bf16_t* xnrow, int lane) {
    const u32x2* mr = (const u32x2*)mrow + lane; const f32x4* xr = (const f32x4*)xi + lane; const f32x4* gp = (const f32x4*)gpost + lane;
    f32x4 mv[4]; float s = 0.f;
#pragma unroll
    for (int j = 0; j < 4; ++j) { const u32x2 w = mr[64 * j]; mv[j] = (f32x4){bflo(w.x), bfhi(w.x), bflo(w.y), bfhi(w.y)}; s += (mv[j].x * mv[j].x + mv[j].y * mv[j].y) + (mv[j].z * mv[j].z + mv[j].w * mv[j].w); }
    const float rs = 1.0f / sqrtf(wave_sum(s, lane) * (1.f / DM) + EPS);
    f32x4 x[4]; float s2 = 0.f;
#pragma unroll
    for (int j = 0; j < 4; ++j) { const f32x4 g = gp[64 * j]; x[j] = xr[64 * j] + mv[j] * rs * g; s2 += (x[j].x * x[j].x + x[j].y * x[j].y) + (x[j].z * x[j].z + x[j].w * x[j].w); }
    f32x4* xw = (f32x4*)xo + lane;
#pragma unroll
    for (int j = 0; j < 4; ++j) xw[64 * j] = x[j];
    if (gnext) {
        const float rs2 = 1.0f / sqrtf(wave_sum(s2, lane) * (1.f / DM) + EPS);
        const f32x4* gn = (const f32x4*)gnext + lane; u32x2* o8 = (u32x2*)xnrow + lane;
#pragma unroll
        for (int j = 0; j < 4; ++j) { const f32x4 g = gn[64 * j]; u32x2 w; w.x = cvt_pk_bf16(x[j].x * rs2 * g.x, x[j].y * rs2 * g.y); w.y = cvt_pk_bf16(x[j].z * rs2 * g.z, x[j].w * rs2 * g.w); o8[64 * j] = w; }
    }
}

__device__ __forceinline__ void res_row2(const bf16_t* m0, const bf16_t* m1, const float* xi0, const float* xi1, float* xo0, float* xo1, const float* gpost, const float* gnext, bf16_t* xn0, bf16_t* xn1, int lane) {
    const u32x2* mr0 = (const u32x2*)m0 + lane; const u32x2* mr1 = (const u32x2*)m1 + lane; const f32x4* xr0 = (const f32x4*)xi0 + lane; const f32x4* xr1 = (const f32x4*)xi1 + lane; const f32x4* gp = (const f32x4*)gpost + lane;
    u32x2 w0[4], w1[4]; f32x4 xa[4], xb[4], g[4];
#pragma unroll
    for (int j = 0; j < 4; ++j) { w0[j] = mr0[64 * j]; w1[j] = mr1[64 * j]; xa[j] = xr0[64 * j]; xb[j] = xr1[64 * j]; g[j] = gp[64 * j]; }
    f32x4 ma[4], mb[4]; float s0 = 0.f, s1 = 0.f;
#pragma unroll
    for (int j = 0; j < 4; ++j) { ma[j] = (f32x4){bflo(w0[j].x), bfhi(w0[j].x), bflo(w0[j].y), bfhi(w0[j].y)}; mb[j] = (f32x4){bflo(w1[j].x), bfhi(w1[j].x), bflo(w1[j].y), bfhi(w1[j].y)};
        s0 += (ma[j].x * ma[j].x + ma[j].y * ma[j].y) + (ma[j].z * ma[j].z + ma[j].w * ma[j].w); s1 += (mb[j].x * mb[j].x + mb[j].y * mb[j].y) + (mb[j].z * mb[j].z + mb[j].w * mb[j].w); }
    const float rs0 = 1.0f / sqrtf(wave_sum(s0, lane) * (1.f / DM) + EPS), rs1 = 1.0f / sqrtf(wave_sum(s1, lane) * (1.f / DM) + EPS);
    float t0 = 0.f, t1 = 0.f;
#pragma unroll
    for (int j = 0; j < 4; ++j) { xa[j] = xa[j] + ma[j] * rs0 * g[j]; xb[j] = xb[j] + mb[j] * rs1 * g[j];
        t0 += (xa[j].x * xa[j].x + xa[j].y * xa[j].y) + (xa[j].z * xa[j].z + xa[j].w * xa[j].w); t1 += (xb[j].x * xb[j].x + xb[j].y * xb[j].y) + (xb[j].z * xb[j].z + xb[j].w * xb[j].w); }
    f32x4* xw0 = (f32x4*)xo0 + lane; f32x4* xw1 = (f32x4*)xo1 + lane;
#pragma unroll
    for (int j = 0; j < 4; ++j) { xw0[64 * j] = xa[j]; xw1[64 * j] = xb[j]; }
    if (gnext) {
        const float q0 = 1.0f / sqrtf(wave_sum(t0, lane) * (1.f / DM) + EPS), q1 = 1.0f / sqrtf(wave_sum(t1, lane) * (1.f / DM) + EPS);
        const f32x4* gn = (const f32x4*)gnext + lane; u32x2* o0 = (u32x2*)xn0 + lane; u32x2* o1 = (u32x2*)xn1 + lane;
#pragma unroll
        for (int j = 0; j < 4; ++j) { const f32x4 h = gn[64 * j];
            u32x2 a; a.x = cvt_pk_bf16(xa[j].x * q0 * h.x, xa[j].y * q0 * h.y); a.y = cvt_pk_bf16(xa[j].z * q0 * h.z, xa[j].w * q0 * h.w); o0[64 * j] = a;
            u32x2 b; b.x = cvt_pk_bf16(xb[j].x * q1 * h.x, xb[j].y * q1 * h.y); b.y = cvt_pk_bf16(xb[j].z * q1 * h.z, xb[j].w * q1 * h.w); o1[64 * j] = b; }
    }
}

#define MLA_PACK(P, B) ((u32x4){cvt_pk_bf16(P[B], P[B + 1]), cvt_pk_bf16(P[B + 2], P[B + 3]), cvt_pk_bf16(P[B + 4], P[B + 5]), cvt_pk_bf16(P[B + 6], P[B + 7])})
__device__ __forceinline__ void mla_softmax(f32x16& p0, f32x16& p1, float& m_run, float& l_run, f32x16& o0, f32x16& o1) {
    float mx = fmaxf(p0[0], p1[0]);
#pragma unroll
    for (int r = 1; r < 16; ++r) mx = fmaxf(mx, fmaxf(p0[r], p1[r]));
    mx = xor32_max(mx);
    const float m_new = fmaxf(m_run, mx), alpha = fexp2(m_run - m_new); m_run = m_new;
    p0 = p0 - m_new; p1 = p1 - m_new;
#pragma unroll
    for (int r = 0; r < 16; ++r) { p0[r] = fexp2(p0[r]); p1[r] = fexp2(p1[r]); }
    const f32x16 ps = p0 + p1;
    const float ls = ((ps[0] + ps[1]) + (ps[2] + ps[3])) + ((ps[4] + ps[5]) + (ps[6] + ps[7])) + (((ps[8] + ps[9]) + (ps[10] + ps[11])) + ((ps[12] + ps[13]) + (ps[14] + ps[15])));
    l_run = l_run * alpha + ls;
    o0 = o0 * alpha; o1 = o1 * alpha;
}
__device__ __forceinline__ void mla_store(bf16_t* orow, const f32x16& o0, const f32x16& o1, float l_run) {
    const float inv = 1.0f / xor32_sum(l_run);
#pragma unroll
    for (int rg = 0; rg < 4; ++rg) {
        u32x2 w; w.x = cvt_pk_bf16(o0[4 * rg] * inv, o0[4 * rg + 1] * inv); w.y = cvt_pk_bf16(o0[4 * rg + 2] * inv, o0[4 * rg + 3] * inv); *(u32x2*)(orow + 8 * rg) = w;
        u32x2 w2; w2.x = cvt_pk_bf16(o1[4 * rg] * inv, o1[4 * rg + 1] * inv); w2.y = cvt_pk_bf16(o1[4 * rg + 2] * inv, o1[4 * rg + 3] * inv); *(u32x2*)(orow + 32 + 8 * rg) = w2;
    }
}
__device__ __forceinline__ void mla_unit(LAS unsigned char* lds, const bf16_t* Q, const bf16_t* KN, const bf16_t* KPE, const bf16_t* VT, bf16_t* AO, int tokbase, int S, int h, int qb, int tid) {
    constexpr int KBYTES = 12288, BUF = 20480;
    const int lane = tid & 63, wid = __builtin_amdgcn_readfirstlane(tid >> 6), r32 = lane & 31, hi = lane >> 5;
    const bf16_t* ks0 = KN + (size_t)(tokbase + lane) * 512 + h * 64 + 8 * wid;
    const bf16_t* ks1 = KPE + (size_t)(tokbase + lane) * 32 + 8 * (wid & 3);
    const bf16_t* vs = VT + (size_t)(h * 64 + lane) * TH + tokbase + 8 * wid;
#define MLA_DMA(T, B) do { LAS unsigned char* sb_ = lds + (B) * BUF; \
        __builtin_amdgcn_global_load_lds((const unsigned*)(ks0 + (size_t)(T) * (64 * 512)), (LAS unsigned*)(sb_ + wid * 1024), 16, 0, 0); \
        if (wid < 4) __builtin_amdgcn_global_load_lds((const unsigned*)(ks1 + (size_t)(T) * (64 * 32)), (LAS unsigned*)(sb_ + (8 + wid) * 1024), 16, 0, 0); \
        __builtin_amdgcn_global_load_lds((const unsigned*)(vs + (size_t)(T) * 64), (LAS unsigned*)(sb_ + KBYTES + wid * 1024), 16, 0, 0); } while (0)
#define MLA_WAITBAR_KEEP() do { if (wid < 4) asm volatile("s_waitcnt vmcnt(3)" ::: "memory"); else asm volatile("s_waitcnt vmcnt(2)" ::: "memory"); \
        asm volatile("s_waitcnt lgkmcnt(0)" ::: "memory"); __builtin_amdgcn_s_barrier(); asm volatile("" ::: "memory"); } while (0)
#define MLA_WAITBAR_ALL() do { asm volatile("s_waitcnt vmcnt(0) lgkmcnt(0)" ::: "memory"); __builtin_amdgcn_s_barrier(); asm volatile("" ::: "memory"); } while (0)
    const int NT = S / 64;
    const int qtokA = tokbase + 512 * qb + 64 * wid + r32, qtokB = qtokA + 32;
    bf16x8 qa[6], qbv[6];
#pragma unroll
    for (int d0 = 0; d0 < 6; ++d0) { qa[d0] = *(const bf16x8*)(Q + (size_t)qtokA * 768 + h * 96 + 16 * d0 + 8 * hi); qbv[d0] = *(const bf16x8*)(Q + (size_t)qtokB * 768 + h * 96 + 16 * d0 + 8 * hi); }
    asm volatile("s_waitcnt vmcnt(0)" ::: "memory");
    MLA_DMA(0, 0); MLA_DMA(1, 1);
    MLA_WAITBAR_ALL();
    f32x16 oa0, oa1, ob0, ob1;
#pragma unroll
    for (int r = 0; r < 16; ++r) { oa0[r] = 0.f; oa1[r] = 0.f; ob0[r] = 0.f; ob1[r] = 0.f; }
    float ma = -1e30f, la = 0.f, mb = -1e30f, lb = 0.f;
    for (int t = 0; t < NT; ++t) {
        if (t + 2 < NT) MLA_DMA(t + 2, (t + 2) & 3);
        const LAS unsigned char* kb = lds + (t & 3) * BUF; const LAS unsigned char* vb = kb + KBYTES;
        f32x16 pa0, pa1, pb0, pb1;
#pragma unroll
        for (int r = 0; r < 16; ++r) { pa0[r] = 0.f; pa1[r] = 0.f; pb0[r] = 0.f; pb1[r] = 0.f; }
#pragma unroll
        for (int d0 = 0; d0 < 6; ++d0) {
            const bf16x8 a0 = *(const LAS bf16x8*)(kb + (2 * d0 + hi) * 1024 + r32 * 16);
            const bf16x8 a1 = *(const LAS bf16x8*)(kb + (2 * d0 + hi) * 1024 + (32 + r32) * 16);
            pa0 = __builtin_amdgcn_mfma_f32_32x32x16_bf16(a0, qa[d0], pa0, 0, 0, 0);
            pa1 = __builtin_amdgcn_mfma_f32_32x32x16_bf16(a1, qa[d0], pa1, 0, 0, 0);
            pb0 = __builtin_amdgcn_mfma_f32_32x32x16_bf16(a0, qbv[d0], pb0, 0, 0, 0);
            pb1 = __builtin_amdgcn_mfma_f32_32x32x16_bf16(a1, qbv[d0], pb1, 0, 0, 0);
        }
        mla_softmax(pa0, pa1, ma, la, oa0, oa1);
        mla_softmax(pb0, pb1, mb, lb, ob0, ob1);
#pragma unroll
        for (int ks = 0; ks < 4; ++ks) {
            const u32x4 pwa = ks == 0 ? MLA_PACK(pa0, 0) : ks == 1 ? MLA_PACK(pa0, 8) : ks == 2 ? MLA_PACK(pa1, 0) : MLA_PACK(pa1, 8);
            const u32x4 pwb = ks == 0 ? MLA_PACK(pb0, 0) : ks == 1 ? MLA_PACK(pb0, 8) : ks == 2 ? MLA_PACK(pb1, 0) : MLA_PACK(pb1, 8);
            const bf16x8 paa = __builtin_bit_cast(bf16x8, pwa), pab = __builtin_bit_cast(bf16x8, pwb);
            const LAS unsigned char* vp = vb + (2 * ks) * 1024 + r32 * 16 + 8 * hi;
            const u32x2 a_lo = *(const LAS u32x2*)(vp), a_hi = *(const LAS u32x2*)(vp + 1024);
            const u32x2 b_lo = *(const LAS u32x2*)(vp + 512), b_hi = *(const LAS u32x2*)(vp + 1024 + 512);
            const bf16x8 vf0 = __builtin_bit_cast(bf16x8, ((u32x4){a_lo.x, a_lo.y, a_hi.x, a_hi.y}));
            const bf16x8 vf1 = __builtin_bit_cast(bf16x8, ((u32x4){b_lo.x, b_lo.y, b_hi.x, b_hi.y}));
            oa0 = __builtin_amdgcn_mfma_f32_32x32x16_bf16(vf0, paa, oa0, 0, 0, 0);
            oa1 = __builtin_amdgcn_mfma_f32_32x32x16_bf16(vf1, paa, oa1, 0, 0, 0);
            ob0 = __builtin_amdgcn_mfma_f32_32x32x16_bf16(vf0, pab, ob0, 0, 0, 0);
            ob1 = __builtin_amdgcn_mfma_f32_32x32x16_bf16(vf1, pab, ob1, 0, 0, 0);
        }
        if (t & 1) MLA_WAITBAR_ALL();
    }
#undef MLA_DMA
#undef MLA_WAITBAR_KEEP
#undef MLA_WAITBAR_ALL
    mla_store(AO + (size_t)qtokA * 1024 + h * 64 + 4 * hi, oa0, oa1, la);
    mla_store(AO + (size_t)qtokB * 1024 + h * 64 + 4 * hi, ob0, ob1, lb);
}

__device__ __forceinline__ unsigned na_vmask(int qc, int kh, int hi) {
    int cs = qc - 8; cs = cs < 0 ? 0 : cs; cs = cs > 48 ? 48 : cs; unsigned mk = 0u;
#pragma unroll
    for (int r = 0; r < 16; ++r) { const int kc = 32 * kh + (r & 3) + 8 * (r >> 2) + 4 * hi; mk |= ((kc >= cs) && (kc < cs + 16)) ? (1u << r) : 0u; }
    return mk;
}
__device__ __forceinline__ void na_qs(const bf16x8 (&kf)[4], const bf16x8 (&vf)[2][2], const bf16x8 (&qf)[4], const LAS float* brow, int qc, int kh, int hi, unsigned vmsel,
                                      float& m_run, float& l_run, f32x16& o0, f32x16& o1) {
    const float SCL = 0.125f * LOG2E;
    f32x16 p;
#pragma unroll
    for (int r = 0; r < 16; ++r) p[r] = 0.f;
#pragma unroll
    for (int d0 = 0; d0 < 4; ++d0) p = __builtin_amdgcn_mfma_f32_32x32x16_bf16(kf[d0], qf[d0], p, 0, 0, 0);
    unsigned vm = vmsel; asm volatile("" : "+v"(vm));
    float mx = -1e30f;
#pragma unroll
    for (int r = 0; r < 16; ++r) { const int kc = 32 * kh + (r & 3) + 8 * (r >> 2) + 4 * hi;
        int bi = kc - qc + 15; bi = bi < 0 ? 0 : bi; bi = bi > 30 ? 30 : bi;
        const float sc = p[r] * SCL + brow[bi]; p[r] = ((vm >> r) & 1u) ? sc : -1e30f; mx = fmaxf(mx, p[r]); }
    mx = xor32_max(mx);
    const float m_new = fmaxf(m_run, mx), alpha = fexp2(m_run - m_new); m_run = m_new;
    const float m_use = fmaxf(m_new, -1e20f);
    float ls = 0.f;
#pragma unroll
    for (int r = 0; r < 16; ++r) { const float e = fexp2(p[r] - m_use); p[r] = e; ls += e; }
    l_run = l_run * alpha + ls;
#pragma unroll
    for (int r = 0; r < 16; ++r) { o0[r] *= alpha; o1[r] *= alpha; }
#pragma unroll
    for (int k2 = 0; k2 < 2; ++k2) {
        u32x4 pw; pw.x = cvt_pk_bf16(p[8 * k2 + 0], p[8 * k2 + 1]); pw.y = cvt_pk_bf16(p[8 * k2 + 2], p[8 * k2 + 3]); pw.z = cvt_pk_bf16(p[8 * k2 + 4], p[8 * k2 + 5]); pw.w = cvt_pk_bf16(p[8 * k2 + 6], p[8 * k2 + 7]);
        const bf16x8 pa = __builtin_bit_cast(bf16x8, pw);
        o0 = __builtin_amdgcn_mfma_f32_32x32x16_bf16(vf[0][k2], pa, o0, 0, 0, 0);
        o1 = __builtin_amdgcn_mfma_f32_32x32x16_bf16(vf[1][k2], pa, o1, 0, 0, 0);
    }
}
__device__ __forceinline__ void na_store(bf16_t* orow, const f32x16& o0, const f32x16& o1, float l_run) {
    const float l = xor32_sum(l_run); const float inv = 1.0f / l;
#pragma unroll
    for (int rg = 0; rg < 4; ++rg) {
        u32x2 w; w.x = cvt_pk_bf16(o0[4 * rg] * inv, o0[4 * rg + 1] * inv); w.y = cvt_pk_bf16(o0[4 * rg + 2] * inv, o0[4 * rg + 3] * inv); *(u32x2*)(orow + 8 * rg) = w;
        u32x2 w2; w2.x = cvt_pk_bf16(o1[4 * rg] * inv, o1[4 * rg + 1] * inv); w2.y = cvt_pk_bf16(o1[4 * rg + 2] * inv, o1[4 * rg + 3] * inv); *(u32x2*)(orow + 32 + 8 * rg) = w2;
    }
}
__device__ __forceinline__ void na_unit(const LAS float* biasT, const bf16_t* Z, const bf16_t* VTn, bf16_t* AO, int tokbase, int S, int rr, int tid) {
    const int lane = tid & 63, h = tid >> 6, r32 = lane & 31, hi = lane >> 5;
    const int rows = S / 64; int rs = rr - 4; rs = rs < 0 ? 0 : rs; rs = rs > rows - 8 ? rows - 8 : rs;
    bf16x8 qfa[4], qfb[4];
#pragma unroll
    for (int d0 = 0; d0 < 4; ++d0) { qfa[d0] = *(const bf16x8*)(Z + (size_t)(tokbase + rr * 64 + r32) * ZP + 672 + h * 64 + 16 * d0 + 8 * hi);
                                      qfb[d0] = *(const bf16x8*)(Z + (size_t)(tokbase + rr * 64 + 32 + r32) * ZP + 672 + h * 64 + 16 * d0 + 8 * hi); }
    f32x16 oa0, oa1, ob0, ob1; float ma = -1e30f, mb = -1e30f, la = 0.f, lb = 0.f;
#pragma unroll
    for (int r = 0; r < 16; ++r) { oa0[r] = 0.f; oa1[r] = 0.f; ob0[r] = 0.f; ob1[r] = 0.f; }
    const unsigned va0 = na_vmask(r32, 0, hi), va1 = na_vmask(r32, 1, hi), vb0 = na_vmask(32 + r32, 0, hi), vb1 = na_vmask(32 + r32, 1, hi);
    const bf16_t* kbase = Z + (size_t)(tokbase + rs * 64 + r32) * ZP + 672 + 512 + h * 64 + 8 * hi;
    const bf16_t* vbase0 = VTn + (size_t)(h * 64 + r32) * TH + tokbase + rs * 64 + 4 * hi;
#define NA_LOADK(KF, IT) do { const int kr_ = (IT) >> 1, kh_ = (IT) & 1; const bf16_t* kp_ = kbase + (size_t)(kr_ * 64 + kh_ * 32) * ZP; \
        _Pragma("unroll") for (int d0 = 0; d0 < 4; ++d0) KF[d0] = *(const bf16x8*)(kp_ + 16 * d0); } while (0)
#define NA_LOADV(VF, IT) do { const int kr_ = (IT) >> 1, kh_ = (IT) & 1; const bf16_t* vp0_ = vbase0 + kr_ * 64 + kh_ * 32; const bf16_t* vp1_ = vp0_ + (size_t)32 * TH; \
        _Pragma("unroll") for (int k2 = 0; k2 < 2; ++k2) { const u32x2 lo = *(const u32x2*)(vp0_ + 16 * k2), hi2 = *(const u32x2*)(vp0_ + 16 * k2 + 8); VF[0][k2] = __builtin_bit_cast(bf16x8, ((u32x4){lo.x, lo.y, hi2.x, hi2.y})); \
            const u32x2 lo1 = *(const u32x2*)(vp1_ + 16 * k2), hi3 = *(const u32x2*)(vp1_ + 16 * k2 + 8); VF[1][k2] = __builtin_bit_cast(bf16x8, ((u32x4){lo1.x, lo1.y, hi3.x, hi3.y})); } } while (0)
    bf16x8 kf[4];
    NA_LOADK(kf, 0);
#pragma unroll 1
    for (int it = 0; it < 16; ++it) {
        const int kr = it >> 1, kh = it & 1;
        const LAS float* brow = biasT + (h * 15 + (rs + kr - rr + 7)) * 31;
        bf16x8 vf[2][2], kn[4];
        NA_LOADV(vf, it);
        const int itn = it + 1 < 16 ? it + 1 : 15;
        NA_LOADK(kn, itn);
        na_qs(kf, vf, qfa, brow, r32, kh, hi, kh ? va1 : va0, ma, la, oa0, oa1);
        na_qs(kf, vf, qfb, brow, 32 + r32, kh, hi, kh ? vb1 : vb0, mb, lb, ob0, ob1);
#pragma unroll
        for (int d0 = 0; d0 < 4; ++d0) kf[d0] = kn[d0];
    }
#undef NA_LOADK
#undef NA_LOADV
    na_store(AO + (size_t)(tokbase + rr * 64 + r32) * 1024 + 512 + h * 64 + 4 * hi, oa0, oa1, la);
    na_store(AO + (size_t)(tokbase + rr * 64 + 32 + r32) * 1024 + 512 + h * 64 + 4 * hi, ob0, ob1, lb);
}
#ifndef REP_SYNC
#define REP_SYNC 1
#endif
#ifndef REP_MLA
#define REP_MLA 1
#endif
#ifndef REP_NA
#define REP_NA 1
#endif
#ifndef REP_SCAN
#define REP_SCAN 1
#endif
#ifndef REP_UP
#define REP_UP 1
#endif
#ifndef REP_PASS
#define REP_PASS 1
#endif
#ifndef REP_GEMM
#define REP_GEMM 1
#endif
#define GSYNC() do { for (int r_ = 0; r_ < REP_SYNC; ++r_) xcd_barrier((unsigned*)(ap0->ws + WS_BAR), bst); } while (0)
constexpr int LDS_BYTES = 147456;
constexpr int NTHR = 512;
struct Args { const float* in[26]; float* out; unsigned char* ws; };


#define XB_TMO      128
#define XB_XCNT(j)  (256  + 64 * (j))
#define XB_XSUB(j)  (1280 + 64 * (j))
#define XB_XGEN(j)  (2304 + 64 * (j))
#define XB_TOP      3328
#define XB_TOPGEN   3392
#define XCD_BAR_WORDS 3456
#define XB_SPIN_CAP (1u << 22)
__device__ __forceinline__ unsigned xb_ld(unsigned* p)              { return __hip_atomic_load(p, __ATOMIC_RELAXED, __HIP_MEMORY_SCOPE_AGENT); }
__device__ __forceinline__ unsigned xb_add(unsigned* p, unsigned v) { return __hip_atomic_fetch_add(p, v, __ATOMIC_RELAXED, __HIP_MEMORY_SCOPE_AGENT); }
__device__ __forceinline__ unsigned xb_xcc_id() { return (unsigned)__builtin_amdgcn_s_getreg((3 << 11) | 20) & 0xFu; }
#define XB_SPIN(cond, bar) do { unsigned _sp = 0; while (cond) { __builtin_amdgcn_s_sleep(1); \
    if ((++_sp & 255u) == 0u) { if (xb_ld(&(bar)[XB_TMO])) break; if (_sp > XB_SPIN_CAP) { atomicAdd(&(bar)[XB_TMO], 1u); break; } } } } while (0)
__device__ __forceinline__ void xcd_barrier_complete(unsigned* bar, unsigned x, unsigned& nloc, unsigned& nx) {
    const unsigned G = gridDim.x;
    unsigned sum, cnt, mine, sp = 0u;
    for (;;) {
        sum = 0u; cnt = 0u; mine = 0u;
#pragma unroll
        for (unsigned j = 0; j < 16; ++j) { const unsigned c = xb_ld(&bar[XB_XCNT(j)]); sum += c; cnt += (c > 0u) ? 1u : 0u; mine = (j == x) ? c : mine; }
        if (sum == G) break;
        __builtin_amdgcn_s_sleep(1);
        if ((++sp & 255u) == 0u) { if (xb_ld(&bar[XB_TMO])) break; if (sp > XB_SPIN_CAP) { atomicAdd(&bar[XB_TMO], 1u); break; } }
    }
    nloc = mine > 0u ? mine : 1u; nx = cnt > 0u ? cnt : 1u;
}
__device__ __forceinline__ void xcd_barrier(unsigned* bar, volatile LAS unsigned* st) {
    asm volatile("s_waitcnt vmcnt(0)" ::: "memory");
    __syncthreads();
    if (threadIdx.x == 0) {
        __builtin_amdgcn_s_waitcnt(0);
        const unsigned x = xb_xcc_id();
        unsigned nloc = st[0], nx = st[1];
        if (nloc == 0u) { xcd_barrier_complete(bar, x, nloc, nx); st[0] = nloc; st[1] = nx; }
        const unsigned old = xb_add(&bar[XB_XSUB(x)], 1u);
        const unsigned gen = old / nloc;
        if (old + 1u == (gen + 1u) * nloc) {
            __builtin_amdgcn_fence(__ATOMIC_RELEASE, "agent");
            asm volatile("s_waitcnt vmcnt(0)" ::: "memory");
            const unsigned og = xb_add(&bar[XB_TOP], 1u);
            const unsigned tg = og / nx;
            if (og + 1u == (tg + 1u) * nx) xb_add(&bar[XB_TOPGEN], 1u);
            else XB_SPIN(xb_ld(&bar[XB_TOPGEN]) == tg, bar);
            __builtin_amdgcn_fence(__ATOMIC_ACQUIRE, "agent");
            xb_add(&bar[XB_XGEN(x)], 1u);
            asm volatile("s_waitcnt vmcnt(0)" ::: "memory");
        } else {
            XB_SPIN(xb_ld(&bar[XB_XGEN(x)]) == gen, bar);
            __builtin_amdgcn_fence(__ATOMIC_ACQUIRE, "agent");
            asm volatile("s_waitcnt vmcnt(0)" ::: "memory");
        }
    }
    __syncthreads();
}

__global__ void __launch_bounds__(NTHR, 2) mk_fwd(Args a) {
    extern __shared__ __attribute__((aligned(16))) unsigned char lds_raw[];
    LAS unsigned char* lds = (LAS unsigned char*)lds_raw;
    cg::grid_group grid = cg::this_grid();
    volatile LAS unsigned* bst = (volatile LAS unsigned*)(lds + LDS_BYTES - 64);
    if (threadIdx.x == 0) { bst[0] = 0u; bst[1] = 0u; }
    typedef const __attribute__((address_space(4))) Args* ArgP;
    ArgP ap0 = (ArgP)__builtin_amdgcn_kernarg_segment_ptr();
#define PH_BEGIN ArgP ap = ap0; asm volatile("" : "+s"(ap)); unsigned char* ws = ap->ws; (void)ws; int tid_ = threadIdx.x; asm volatile("" : "+v"(tid_)); const int tid = tid_, lane = tid & 63, wave = tid >> 6; int G_ = gridDim.x, bid_ = blockIdx.x; asm volatile("" : "+s"(G_), "+s"(bid_)); const int G = G_, bid = bid_; const int gw = bid * 8 + wave, NGW = G * 8; const int gt = bid * NTHR + tid, NGT = G * NTHR; (void)lane; (void)gw; (void)NGW; (void)gt; (void)NGT;
#define IN(k) (ap->in[k])
#define rsq ((float*)(ws + WS_RSQ))
#define rskv ((float*)(ws + WS_RSKV))
#define rope ((float2*)(ws + WS_ROPE))
#define AGG ((float2*)(ws + WS_AGG))
#define CARRY ((float*)(ws + WS_CARRY))
#define YB ((bf16_t*)(ws + WS_YB))
#define W_INATT ((bf16_t*)(ws + WS_W_INATT))
#define W_UQ ((bf16_t*)(ws + WS_W_UQ))
#define W_UKV ((bf16_t*)(ws + WS_W_UKV))
#define W_OUTATT ((bf16_t*)(ws + WS_W_OUTATT))
#define W_INREC ((bf16_t*)(ws + WS_W_INREC))
#define W_GATES ((bf16_t*)(ws + WS_W_GATES))
#define W_OUTREC ((bf16_t*)(ws + WS_W_OUTREC))
#define W_UP ((bf16_t*)(ws + WS_W_UP))
#define W_DOWN ((bf16_t*)(ws + WS_W_DOWN))
#define XN ((bf16_t*)(ws + WS_XN))
#define Zb ((bf16_t*)(ws + WS_Z))
#define Qb ((bf16_t*)(ws + WS_Q))
#define KN ((bf16_t*)(ws + WS_KN))
#define VTM ((bf16_t*)(ws + WS_VTM))
#define VTN ((bf16_t*)(ws + WS_VTN))
#define KPE ((bf16_t*)(ws + WS_KPE))
#define ACT ((bf16_t*)(ws + WS_ACT))
#define GATE ((bf16_t*)(ws + WS_GATE))
#define XB ((bf16_t*)(ws + WS_XB))
#define XBR ((bf16_t*)(ws + WS_XBR))
#define GQ ((bf16_t*)(ws + WS_GQ))
#define AO XN
#define Fb XN
#define YR XN
#define M0 Zb
#define M1 XBR
#define XIN (IN(half))
#define XST (ap->out + (size_t)half * TH * DM)
    { PH_BEGIN
    {
        LAS float* scr = (LAS float*)(lds + wave * 16384);
        constexpr int I_INATT = 16 * 69, I_UQ = 6 * 24, I_UKV = 4 * 32, I_SQ = 16 * 32, I_INREC = 16 * 64, I_UP = 16 * 256, I_DOWN = 64 * 32, I_GATE = 32 * 8;
        constexpr int NITEMS = I_INATT + I_UQ + I_UKV + 2 * I_SQ + I_INREC + 2 * I_UP + 2 * I_DOWN + I_GATE;
        for (int rep_ = 0; rep_ < REP_PASS; ++rep_)
        for (int it = gw; it < NITEMS; it += NGW) {
            int r = it;
            if (r < I_INATT) { transpose_item(IN(6), 1024, 2208, W_INATT, 0, nullptr, scr, r, lane); continue; } r -= I_INATT;
            if (r < I_UQ) { transpose_item(IN(8), 384, 768, W_UQ, 0, IN(7), scr, r, lane); continue; } r -= I_UQ;
            if (r < I_UKV) { transpose_item(IN(10), 256, 1024, W_UKV, 0, IN(9), scr, r, lane); continue; } r -= I_UKV;
            if (r < I_SQ) { transpose_item(IN(12), 1024, 1024, W_OUTATT, 0, nullptr, scr, r, lane); continue; } r -= I_SQ;
            if (r < I_SQ) { transpose_item(IN(21), 1024, 1024, W_OUTREC, 0, nullptr, scr, r, lane); continue; } r -= I_SQ;
            if (r < I_INREC) { transpose_item(IN(13), 1024, 2048, W_INREC, 0, nullptr, scr, r, lane); continue; } r -= I_INREC;
            if (r < 2 * I_UP) { const int li = r / I_UP; transpose_item(IN(22) + (size_t)li * 1024 * 8192, 1024, 8192, W_UP + (size_t)li * 8192 * 1024, 0, nullptr, scr, r % I_UP, lane); continue; } r -= 2 * I_UP;
            if (r < 2 * I_DOWN) { const int li = r / I_DOWN; transpose_item(IN(25) + (size_t)li * 4096 * 1024, 4096, 1024, W_DOWN + (size_t)li * 1024 * 4096, 0, nullptr, scr, r % I_DOWN, lane); continue; } r -= 2 * I_DOWN;
            { const int mat = r / 8, sub = r % 8; const int type = mat >> 4, e = (mat >> 3) & 1, n = mat & 7;
              transpose_item(IN(type ? 18 : 16) + (size_t)(e * 8 + n) * 128 * 128, 128, 128, W_GATES, n * 512 + e * 256 + type * 128, nullptr, scr, sub, lane); }
        }
        if (bid == 0) for (int i = tid; i < XCD_BAR_WORDS; i += NTHR) ((unsigned*)(ws + WS_BAR))[i] = 0u;
        for (int i = gt; i < 8 * 64 * 64; i += NGT) ((unsigned*)(ws + WS_CNT))[i] = 0u;
        for (int i = gt; i < 96 * 1024 / 8; i += NGT) ((u32x4*)(W_INATT + (size_t)2208 * 1024))[i] = (u32x4){0, 0, 0, 0};
        for (int m = gw; m < TH; m += NGW) xn_row(IN(0) + (size_t)m * DM, IN(2), XN + (size_t)m * DM, lane);
        for (int i = gt; i < 4096 * 16; i += NGT) { const int pos = i >> 4, j = i & 15;
            const double inv = exp2(-(double)j * (13.287712379549449 / 16.0));
            const double rev = (double)pos * inv * 0.15915494309189535; const float fr = (float)(rev - floor(rev));
            rope[i] = make_float2(__builtin_amdgcn_cosf(fr), __builtin_amdgcn_sinf(fr)); }
    }

    }
    grid.sync();
    if (threadIdx.x == 0) (void)xb_add((unsigned*)(ap0->ws + WS_BAR) + XB_XCNT(xb_xcc_id()), 1u);
    for (int half = 0; half < 2; ++half) {
        const int S = half ? 4096 : 2048, nseq = TH / S;
        if (half == 1 && gridDim.x != 256) {
                { PH_BEGIN
        for (int m = gw; m < TH; m += NGW) xn_row(XIN + (size_t)m * DM, IN(2), XN + (size_t)m * DM, lane);
        }
        GSYNC();
        }
        { PH_BEGIN
        { pg8::Gemm g = pg8::make_gemm(XN, DM, W_INATT, DM, DM); pg8::StaticOrder so; so.init(TH / 256, ZP / 256, G, bid);
          EpiZ E{Zb, VTN, (float*)(ws + WS_SQP), nullptr, KPE, rope, S - 1};
#ifndef NO_G1
for (int rep_ = 0; rep_ < REP_GEMM; ++rep_) pg8::gemm_phase<EpiZ>(lds, g, so, E);
#endif
 }
        }
        GSYNC();
        { PH_BEGIN
        { pg8::Gemm g = pg8::make_gemm(Zb, ZP, W_UQ, 384, 384); pg8::StaticOrder so; so.init(TH / 256, 3, G, bid);
          EpiQ E{Qb, (const float*)(ws + WS_SQP), rope, S - 1};
#ifndef NO_G2
for (int rep_ = 0; rep_ < REP_GEMM; ++rep_) pg8::gemm_phase<EpiQ>(lds, g, so, E);
#endif
 }
        { pg8::Gemm g = pg8::make_gemm(Zb + 384, ZP, W_UKV, 256, 256); pg8::StaticOrder so; so.init(TH / 256, 4, G, bid);
          EpiKV E{KN, VTM, (const float*)(ws + WS_SQP)};
#ifndef NO_G3
for (int rep_ = 0; rep_ < REP_GEMM; ++rep_) pg8::gemm_phase<EpiKV>(lds, g, so, E);
#endif
 }
        }
        GSYNC();
        { PH_BEGIN
        {
            LAS float* biasT = (LAS float*)(lds + 98304);
            for (int i = tid; i < 8 * 15 * 31; i += NTHR) biasT[i] = IN(11)[i] * LOG2E;
            __syncthreads();
            const int nqb = S / 512, nunits = nseq * 8 * nqb;
            const int vb = (G % 8 == 0) ? (bid % 8) * (G / 8) + bid / 8 : bid;
#ifdef DELAY_P4A
        { const unsigned long long t0_ = __builtin_amdgcn_s_memrealtime(); while (__builtin_amdgcn_s_memrealtime() - t0_ < 40000ull) __builtin_amdgcn_s_sleep(32); }
#endif
#ifndef NO_MLA
            for (int rep_ = 0; rep_ < REP_MLA; ++rep_) {
#ifdef REP_MLA_SYNC
            if (rep_ > 0) GSYNC();
#endif
#ifdef REP_DELAY
            if (rep_ > 0) { const unsigned long long t0_ = __builtin_amdgcn_s_memrealtime(); while (__builtin_amdgcn_s_memrealtime() - t0_ < 40000ull) __builtin_amdgcn_s_sleep(32); continue; }
#endif
            for (int u = vb; u < nunits; u += G) { const int qb = u % nqb, h = (u / nqb) & 7, s = u / (nqb * 8);
                mla_unit(lds, Qb, KN, KPE, VTM, AO, s * S, S, h, qb, tid); }
            }
#endif
#ifdef MLA_TWICE
            for (int u = vb; u < nunits; u += G) { const int qb = u % nqb, h = (u / nqb) & 7, s = u / (nqb * 8);
                mla_unit(lds, Qb, KN, KPE, VTM, AO, s * S, S, h, qb, tid); }
#endif
            const int rows = S / 64, nna = nseq * rows;
#ifdef DELAY_P4B
        { const unsigned long long t0_ = __builtin_amdgcn_s_memrealtime(); while (__builtin_amdgcn_s_memrealtime() - t0_ < 40000ull) __builtin_amdgcn_s_sleep(32); }
#endif
#ifdef RELOAD_BIAS
            __syncthreads();
            for (int i = tid; i < 8 * 15 * 31; i += NTHR) biasT[i] = IN(11)[i] * LOG2E;
            __syncthreads();
#endif
#ifndef NO_NA
            for (int rep_ = 0; rep_ < REP_NA; ++rep_)
            for (int u = vb; u < nna; u += G) na_unit(biasT, Zb, VTN, AO, (u / rows) * S, S, u % rows, tid);
#endif
        }
        }
        GSYNC();
        { PH_BEGIN
        { pg8::Gemm g = pg8::make_gemm(AO, DM, W_OUTATT, DM, DM); pg8::StaticOrder so; so.init(TH / 256, 4, G, bid);
          EpiBf16 E{M0, DM, 0, 0};
#ifndef NO_G4
for (int rep_ = 0; rep_ < REP_GEMM; ++rep_) pg8::gemm_phase<EpiBf16>(lds, g, so, E);
#endif
 }
        }
        GSYNC();
        { PH_BEGIN
        for (int m = gw; m < TH; m += 2 * NGW) { const int m2 = m + NGW; if (m2 < TH) res_row2(M0 + (size_t)m * DM, M0 + (size_t)m2 * DM, XIN + (size_t)m * DM, XIN + (size_t)m2 * DM, XST + (size_t)m * DM, XST + (size_t)m2 * DM, IN(3), IN(4), XN + (size_t)m * DM, XN + (size_t)m2 * DM, lane); else res_row(M0 + (size_t)m * DM, XIN + (size_t)m * DM, XST + (size_t)m * DM, IN(3), IN(4), XN + (size_t)m * DM, lane); }
        }
        GSYNC();

        for (int li = 0; li < 2; ++li) {
            if (li == 1) {
                { PH_BEGIN
                { pg8::Gemm g = pg8::make_gemm(XN, DM, W_INREC, DM, DM); pg8::StaticOrder so; so.init(TH / 256, 8, G, bid);
                  EpiBf16 E{GATE, DM, 1024, (size_t)(WS_XBR - WS_GATE) / 2};
#ifndef NO_G5
for (int rep_ = 0; rep_ < REP_GEMM; ++rep_) pg8::gemm_phase<EpiBf16>(lds, g, so, E);
#endif
 }
                }
                GSYNC();
                { PH_BEGIN
                for (int rep_ = 0; rep_ < REP_PASS; ++rep_)
                for (int i = gt; i < TH * 128; i += NGT) { const int t = i >> 7, c8 = (i & 127) * 8; const int pos = t & (S - 1);
                    float accv[8];
#pragma unroll
                    for (int j = 0; j < 8; ++j) accv[j] = IN(15)[c8 + j];
#pragma unroll
                    for (int k = 0; k < 4; ++k) { const int p2 = pos + k - 1; if (p2 < 0 || p2 >= S) continue;
                        const u32x4 w = *(const u32x4*)(XBR + (size_t)(t + k - 1) * DM + c8); const float* cwk = IN(14) + k * 1024 + c8;
                        accv[0] += cwk[0] * bflo(w.x); accv[1] += cwk[1] * bfhi(w.x); accv[2] += cwk[2] * bflo(w.y); accv[3] += cwk[3] * bfhi(w.y);
                        accv[4] += cwk[4] * bflo(w.z); accv[5] += cwk[5] * bfhi(w.z); accv[6] += cwk[6] * bflo(w.w); accv[7] += cwk[7] * bfhi(w.w); }
                    u32x4 o; o.x = cvt_pk_bf16(accv[0], accv[1]); o.y = cvt_pk_bf16(accv[2], accv[3]); o.z = cvt_pk_bf16(accv[4], accv[5]); o.w = cvt_pk_bf16(accv[6], accv[7]);
                    *(u32x4*)(XB + (size_t)t * DM + c8) = o; }
                }
                GSYNC();
                for (int qt = 0; qt < 2; ++qt) {
                    const int t0 = qt * TQ;
                    { PH_BEGIN
                    { pg8::Gemm g = pg8::make_gemm(XB + (size_t)t0 * DM, DM, W_GATES, 128, 128); g.a_pn_shift = 1; g.a_pn_step = 256; g.a_seg = 1; g.hA = (size_t)4 * DM * 2;
                      pg8::StaticOrder so; so.init(TQ / 256, 16, G, bid);
                      EpiGates E{GQ, XB + (size_t)t0 * DM, AGG, IN(17), IN(19), IN(20)};
                      pg8::gemm_phase<EpiGates>(lds, g, so, E);
 }
                    }
                    GSYNC();
                    { PH_BEGIN
                    { const int cps = S / 32, nsq = TQ / S;
                      for (int rep_ = 0; rep_ < REP_SCAN; ++rep_)
                      for (int i = gt; i < nsq * 2 * 1024; i += NGT) { const int ch = i & 1023, e = (i >> 10) & 1, sq = i >> 11;
                          float hcar = 0.f;
#pragma unroll 16
                          for (int k = 0; k < cps; ++k) { const int c = sq * cps + (e ? cps - 1 - k : k); const int idx = (c * 2 + e) * 1024 + ch;
                              CARRY[idx] = hcar; const float2 ab = AGG[idx]; hcar = ab.x * hcar + ab.y; } } }
                    }
                    GSYNC();
                    { PH_BEGIN
#ifndef NO_R6
                    for (int rep_ = 0; rep_ < REP_SCAN; ++rep_)
                    for (int i = gt; i < 256 * 512; i += NGT) { const int cp = i & 511, c = i >> 9; const int ch = 2 * cp, n = ch >> 7, d = ch & 127;
                        const bf16_t* gq0 = GQ + (size_t)(c * 32) * 4096 + n * 512 + d;
                        bf16_t* yr0 = YR + (size_t)(t0 + c * 32) * DM + ch; const bf16_t* gt0 = GATE + (size_t)(t0 + c * 32) * DM + ch;
                        unsigned hfw[32];
                        { const float2 hc2 = *(const float2*)(CARRY + (size_t)(c * 2 + 0) * 1024 + ch); float h0 = hc2.x, h1 = hc2.y;
#pragma unroll
                          for (int s = 0; s < 32; ++s) {
                            const unsigned l2 = *(const unsigned*)(gq0 + (size_t)s * 4096), b2 = *(const unsigned*)(gq0 + (size_t)s * 4096 + 128);
                            h0 = fexp2(bflo(l2)) * h0 + bflo(b2); h1 = fexp2(bfhi(l2)) * h1 + bfhi(b2);
                            hfw[s] = cvt_pk_bf16(h0, h1); } }
                        { const float2 hc2 = *(const float2*)(CARRY + (size_t)(c * 2 + 1) * 1024 + ch); float h0 = hc2.x, h1 = hc2.y;
#pragma unroll
                          for (int s = 31; s >= 0; --s) {
                            const unsigned l2 = *(const unsigned*)(gq0 + (size_t)s * 4096 + 256), b2 = *(const unsigned*)(gq0 + (size_t)s * 4096 + 384);
                            h0 = fexp2(bflo(l2)) * h0 + bflo(b2); h1 = fexp2(bfhi(l2)) * h1 + bfhi(b2);
                            const unsigned g2 = *(const unsigned*)(gt0 + (size_t)s * DM), f2 = hfw[s];
                            *(unsigned*)(yr0 + (size_t)s * DM) = cvt_pk_bf16((bflo(f2) + h0) * gelu_tanh(bflo(g2)), (bfhi(f2) + h1) * gelu_tanh(bfhi(g2))); } }
                    }
#endif
                    }
                    GSYNC();
                }
                { PH_BEGIN
                { pg8::Gemm g = pg8::make_gemm(YR, DM, W_OUTREC, DM, DM); pg8::StaticOrder so; so.init(TH / 256, 4, G, bid);
                  EpiBf16 E{M1, DM, 0, 0};
#ifndef NO_G7
for (int rep_ = 0; rep_ < REP_GEMM; ++rep_) pg8::gemm_phase<EpiBf16>(lds, g, so, E);
#endif
 }
                }
                GSYNC();
                { PH_BEGIN
                for (int m = gw; m < TH; m += 2 * NGW) { const int m2 = m + NGW; if (m2 < TH) res_row2(M1 + (size_t)m * DM, M1 + (size_t)m2 * DM, XST + (size_t)m * DM, XST + (size_t)m2 * DM, XST + (size_t)m * DM, XST + (size_t)m2 * DM, IN(3) + 1024, IN(4) + 1024, XN + (size_t)m * DM, XN + (size_t)m2 * DM, lane); else res_row(M1 + (size_t)m * DM, XST + (size_t)m * DM, XST + (size_t)m * DM, IN(3) + 1024, IN(4) + 1024, XN + (size_t)m * DM, lane); }
                }
                GSYNC();
            }
            { PH_BEGIN
            { pg8::Gemm g = pg8::make_gemm(XN, DM, W_UP + (size_t)li * 8192 * 1024, DM, DM);
              g.a_seg = 1; g.hA = (size_t)4 * DM * 2; g.tB = (size_t)128 * DM * 2; g.hB = (size_t)4096 * DM * 2;
              pg8::StaticOrder so; so.init(TH / 256, 32, G, bid);
#ifndef NO_UP
              EpiUp E{ACT, YB, IN(23) + (size_t)li * 3 * 8192, IN(24) + (size_t)li * 8192}; for (int rep_ = 0; rep_ < REP_UP; ++rep_) pg8::gemm_phase<EpiUp>(lds, g, so, E);
#endif
 }
            }
            GSYNC();
            { PH_BEGIN
            for (int rep_ = 0; rep_ < REP_PASS; ++rep_)
            for (int b = bid; b < 256; b += G) { const int seg = b >> 1, which = b & 1; const int t = seg * 128 + (which ? 127 : 0); const int pos = t & (S - 1);
                const float* cw = IN(23) + (size_t)li * 3 * 8192; const float* cb = IN(24) + (size_t)li * 8192;
                const bool hasp = which ? true : (pos != 0), hasn = which ? (pos != S - 1) : true;
                const bf16_t* yp = which ? YB + ((size_t)seg * 4 + 2) * 8192 : YB + ((size_t)(seg - 1) * 4 + 3) * 8192;
                const bf16_t* yc = YB + ((size_t)seg * 4 + (which ? 3 : 0)) * 8192;
                const bf16_t* yn = which ? YB + ((size_t)(seg + 1) * 4 + 0) * 8192 : YB + ((size_t)seg * 4 + 1) * 8192;
                for (int c = tid; c < 4096; c += NTHR) {
                    float u2[2];
#pragma unroll
                    for (int bj = 0; bj < 2; ++bj) { const int ch = bj * 4096 + c;
                        float r = cw[8192 + ch] * bf2f(yc[ch]) + cb[ch];
                        if (hasp) r += cw[ch] * bf2f(yp[ch]);
                        if (hasn) r += cw[2 * 8192 + ch] * bf2f(yn[ch]);
                        u2[bj] = r; }
                    ACT[(size_t)t * DFF + c] = f2bf(gelu_tanh(u2[0]) * u2[1]); } }
            }
            GSYNC();
            if (gridDim.x == 256) {
                { PH_BEGIN
                { pg8::Gemm g = pg8::make_gemm(ACT, DFF, W_DOWN + (size_t)li * 1024 * 4096, DFF, DFF); pg8::StaticOrder so; so.init(TH / 256, 4, G, bid);
                  const int use = half * 2 + li;
                  EpiRms E{XST, li == 0 ? XN : nullptr, IN(5) + li * 1024, IN(2) + 1024, (float*)(ws + WS_XBUF), (float*)(ws + WS_XBUF) + (size_t)TH * 4,
                           (unsigned*)(ws + WS_CNT) + (size_t)(use * 2) * 4096, (unsigned*)(ws + WS_CNT) + (size_t)(use * 2 + 1) * 4096};
                  pg8::gemm_phase<EpiRms>(lds, g, so, E); }
                if (half == 0 && li == 1)
                  { for (int m = gw; m < TH; m += NGW) xn_row(IN(1) + (size_t)m * DM, IN(2), XN + (size_t)m * DM, lane);
                  }
                }
                GSYNC();
            } else {
                { PH_BEGIN
                { pg8::Gemm g = pg8::make_gemm(ACT, DFF, W_DOWN + (size_t)li * 1024 * 4096, DFF, DFF); pg8::StaticOrder so; so.init(TH / 256, 4, G, bid);
                  EpiBf16 E{Fb, DM, 0, 0};
                  pg8::gemm_phase<EpiBf16>(lds, g, so, E); }
                }
                GSYNC();
                { PH_BEGIN
                for (int m = gw; m < TH; m += NGW) res_row(Fb + (size_t)m * DM, XST + (size_t)m * DM, XST + (size_t)m * DM, IN(5) + li * 1024, li == 0 ? IN(2) + 1024 : nullptr, XN + (size_t)m * DM, lane);
                }
                GSYNC();
            }
        }
    }
}

extern "C" void kernel_launch(void* const* d_in, const int* in_sizes, int n_in, void* d_out, int out_size, void* d_ws, size_t ws_size, hipStream_t stream) {
    static int grid = 0;
    if (grid == 0) {
        int dev = 0, cus = 0, per_cu = 0;
        (void)hipGetDevice(&dev);
        (void)hipDeviceGetAttribute(&cus, hipDeviceAttributeMultiprocessorCount, dev);
        (void)hipFuncSetAttribute((const void*)mk_fwd, hipFuncAttributeMaxDynamicSharedMemorySize, LDS_BYTES);
        (void)hipOccupancyMaxActiveBlocksPerMultiprocessor(&per_cu, (const void*)mk_fwd, NTHR, LDS_BYTES);
        if (per_cu < 1) per_cu = 1;
        grid = cus * per_cu;
        if (ws_size < WS_END || n_in != 26) { fprintf(stderr, "kernel_launch: unexpected ws_size %zu / n_in %d\n", ws_size, n_in); }
    }
    Args a{};
    for (int i = 0; i < 26; ++i) a.in[i] = (const float*)d_in[i];
    a.out = (float*)d_out; a.ws = (unsigned char*)d_ws;
    void* args[] = {&a};
    hipError_t e = hipLaunchCooperativeKernel((const void*)mk_fwd, dim3(grid), dim3(NTHR), args, LDS_BYTES, stream);
    if (e != hipSuccess) fprintf(stderr, "cooperative launch failed: %s (grid %d)\n", hipGetErrorString(e), grid);
}
```

```cpp
#include <hip/hip_runtime.h>
#include <hip/hip_cooperative_groups.h>
#include <cstdio>
#include <cstdint>
namespace cg = cooperative_groups;

#define LAS __attribute__((address_space(3)))
typedef unsigned short bf16_t;
typedef short bf16x8 __attribute__((ext_vector_type(8)));
typedef short s16x4 __attribute__((ext_vector_type(4)));
typedef float f32x4 __attribute__((ext_vector_type(4)));
typedef float f32x16 __attribute__((ext_vector_type(16)));
typedef unsigned u32x4 __attribute__((ext_vector_type(4)));
typedef unsigned u32x2 __attribute__((ext_vector_type(2)));

__device__ __forceinline__ unsigned cvt_pk_bf16(float lo, float hi) { unsigned r; asm volatile("v_cvt_pk_bf16_f32 %0, %1, %2" : "=v"(r) : "v"(lo), "v"(hi)); return r; }
__device__ __forceinline__ float bf2f(bf16_t v) { return __uint_as_float(((unsigned)v) << 16); }
__device__ __forceinline__ float bflo(unsigned w) { return __uint_as_float(w << 16); }
__device__ __forceinline__ float bfhi(unsigned w) { return __uint_as_float(w & 0xffff0000u); }
__device__ __forceinline__ bf16_t f2bf(float f) { return (bf16_t)(cvt_pk_bf16(f, 0.f) & 0xffffu); }
__device__ __forceinline__ float fexp2(float x) { return __builtin_amdgcn_exp2f(x); }
__device__ __forceinline__ float frcp(float x) { return __builtin_amdgcn_rcpf(x); }
__device__ __forceinline__ float gelu_tanh(float x) {
    const float u = x * (1.0f + 0.044715f * x * x) * (-2.0f * 0.7978845608028654f * 1.4426950408889634f);
    return x * frcp(1.0f + fexp2(u));
}
__device__ __forceinline__ float sigmoidf_(float x) { return frcp(1.0f + fexp2(-1.4426950408889634f * x)); }
__device__ __forceinline__ float bperm_f(int src_lane, float v) { return __int_as_float(__builtin_amdgcn_ds_bpermute(src_lane << 2, __float_as_int(v))); }
#define DPP_F(V, CTRL) __int_as_float(__builtin_amdgcn_mov_dpp(__float_as_int(V), (CTRL), 0xf, 0xf, true))
__device__ __forceinline__ float wave_sum(float v, int  ) {
    v += DPP_F(v, 0xB1);
    v += DPP_F(v, 0x4E);
    v += DPP_F(v, 0x141);
    v += DPP_F(v, 0x140);
    const int iv = __float_as_int(v);
    return (__int_as_float(__builtin_amdgcn_readlane(iv, 0)) + __int_as_float(__builtin_amdgcn_readlane(iv, 16))) + (__int_as_float(__builtin_amdgcn_readlane(iv, 32)) + __int_as_float(__builtin_amdgcn_readlane(iv, 48)));
}
__device__ __forceinline__ float xor32_max(float v) { auto rr = __builtin_amdgcn_permlane32_swap(__float_as_uint(v), __float_as_uint(v), false, false); return fmaxf(__uint_as_float(rr[0]), __uint_as_float(rr[1])); }
__device__ __forceinline__ float xor32_sum(float v) { auto rr = __builtin_amdgcn_permlane32_swap(__float_as_uint(v), __float_as_uint(v), false, false); return __uint_as_float(rr[0]) + __uint_as_float(rr[1]); }

__device__ __forceinline__ void lru_ab(float ga, float gx, float gab, float gxb, float spl  , float xb, float& a, float& b) {
    const float r = sigmoidf_(ga + gab), ii = sigmoidf_(gx + gxb);
    const float la2 = (-8.0f * 1.4426950408889634f) * r * spl;
    a = fexp2(la2);
    const float om = 1.0f - a * a;
    b = __builtin_amdgcn_sqrtf(om) * (ii * xb);
}


__device__ __forceinline__ void lru_lb(float ga, float gx, float gab, float gxb, float spl, float xb, float& la2, float& b) {
    const float r = sigmoidf_(ga + gab), ii = sigmoidf_(gx + gxb);
    la2 = (-8.0f * 1.4426950408889634f) * r * spl;
    const float a = fexp2(la2); const float om = 1.0f - a * a;
    b = __builtin_amdgcn_sqrtf(om) * (ii * xb);
}

namespace pg8 {
constexpr int BM = 256, BK = 64, HALF = 128, HTB = HALF * BK * 2, STAGE_BYTES = 8 * HTB, NXCD = 8, WGM = 8;
__host__ __device__ __forceinline__ int lds_byte(int r, int c) { const int st = (r >> 4) * 2 + (c >> 5), rr = r & 15, cc = c & 31, ob = rr * 64 + cc * 2; return st * 1024 + (ob ^ (((ob >> 9) & 1) << 5)); }
__host__ __device__ __forceinline__ void stage_rc(int b, int& R, int& C) { const int st = b / 1024, sb = b % 1024, swz = sb ^ (((sb >> 9) & 1) << 5); R = (st >> 1) * 16 + swz / 64; C = (st & 1) * 32 + (swz % 64) / 2; }
__host__ __device__ __forceinline__ int perm32(int rho) { const int n = rho >> 4, i = rho & 15; return 8 * (i >> 2) + 4 * n + (i & 3); }

struct Unit { int pm, pn; };
struct Gemm { const bf16_t* A; const bf16_t* Bt; int lda, ldb, K; size_t tA, hA, tB, hB; int a_seg; int a_pn_shift; size_t a_pn_step; };
__device__ __forceinline__ Gemm make_gemm(const bf16_t* A, int lda, const bf16_t* Bt, int ldb, int K) {
    Gemm g; g.A = A; g.Bt = Bt; g.lda = lda; g.ldb = ldb; g.K = K; g.tA = (size_t)256 * lda * 2; g.hA = (size_t)128 * lda * 2; g.tB = (size_t)256 * ldb * 2; g.hB = (size_t)128 * ldb * 2;
    g.a_seg = 0; g.a_pn_shift = 0; g.a_pn_step = 0; return g;
}

struct StaticOrder {
    int nM, nN, nwg, G, c;
    __device__ __forceinline__ void init(int nM_, int nN_, int G_, int c_) { nM = nM_; nN = nN_; nwg = nM * nN; G = G_; c = c_; }
    __device__ __forceinline__ bool next(int i, Unit& u) const {
        const long L = (long)i * G + c; if (L >= nwg) return false;
        int wgid = (int)L; { const int q = nwg / NXCD, r = nwg % NXCD, xcd = wgid % NXCD, off = wgid / NXCD; wgid = (xcd < r ? xcd * (q + 1) : r * (q + 1) + (xcd - r) * q) + off; }
        const int nig = WGM * nN, gid = wgid / nig, fm = gid * WGM, gsz = (nM - fm) < WGM ? (nM - fm) : WGM;
        u.pm = fm + ((wgid % nig) % gsz); u.pn = (wgid % nig) / gsz; return true;
    }
};

template <class Epi>
__device__ __forceinline__ void gemm_phase(LAS unsigned char* lds, const Gemm g, const StaticOrder& S, const Epi& E) {
    constexpr bool SP2 = true, ALIGN_EPI = true;
    int tid_ = threadIdx.x; asm volatile("" : "+v"(tid_));
    const int tid = tid_, wid = __builtin_amdgcn_readfirstlane(tid >> 6), lane = tid & 63, wr = wid >> 2, wc = wid & 3, fr = lane & 15, fq = lane >> 4;
    int K_ = g.K; asm volatile("" : "+s"(K_)); const int K = K_, nt = K / BK;
    unsigned voffA[2], voffB[2];
#pragma unroll
    for (int i = 0; i < 2; ++i) { int R, C; stage_rc(tid * 16 + i * 8192, R, C); const int Rb = Epi::PERM ? ((R & ~31) + perm32(R & 31)) : R;
        const int Ra = g.a_seg ? (128 * (R >> 6) + 8 * (R & 15) + ((R >> 4) & 3)) : R;
        voffA[i] = (unsigned)(Ra * g.lda + C) * 2u; voffB[i] = (unsigned)(Rb * g.ldb + C) * 2u; }
    const size_t kstep = (size_t)(BK * 2);
    const size_t hstepA = g.hA, hstepB = g.hB;
    const unsigned ldsw = (unsigned)wid * 1024u;
    const int aoff = lds_byte(wr * 64 + fr, fq * 8), boff = lds_byte(wc * 32 + fr, fq * 8);
#define PG8_SA(b, h) (((b) * 2 + (h)) * HTB)
#define PG8_SB(b, h) ((4 + (b) * 2 + (h)) * HTB)
#define PG8_STAGE(bufoff, gbase, voff) do { _Pragma("unroll") for (int _i = 0; _i < 2; ++_i) \
        __builtin_amdgcn_global_load_lds((const unsigned*)((const char*)(gbase) + (voff)[_i]), (LAS unsigned*)(lds + (bufoff) + ldsw + _i * 8192), 16, 0, 0); } while (0)
#define PG8_LDA(dst, b, h) do { _Pragma("unroll") for (int m = 0; m < 4; ++m) _Pragma("unroll") for (int k = 0; k < 2; ++k) dst[m][k] = *(const LAS bf16x8*)(lds + PG8_SA(b, h) + aoff + m * 2048 + k * 1024); } while (0)
#define PG8_LDB(dst, b, h) do { _Pragma("unroll") for (int n = 0; n < 2; ++n) _Pragma("unroll") for (int k = 0; k < 2; ++k) dst[n][k] = *(const LAS bf16x8*)(lds + PG8_SB(b, h) + boff + n * 2048 + k * 1024); } while (0)
#define PG8_MMA(ai, bj, At, Bt) do { __builtin_amdgcn_s_setprio(1); _Pragma("unroll") for (int m = 0; m < 4; ++m) _Pragma("unroll") for (int n = 0; n < 2; ++n) _Pragma("unroll") for (int k = 0; k < 2; ++k) \
        acc[ai][bj][m][n] = __builtin_amdgcn_mfma_f32_16x16x32_bf16(Bt[n][k], At[m][k], acc[ai][bj][m][n], 0, 0, 0); __builtin_amdgcn_s_setprio(0); } while (0)
#define PG8_WAIT_V(n) asm volatile("s_waitcnt vmcnt(" #n ")" ::: "memory")
#define PG8_WAIT_L(n) asm volatile("s_waitcnt lgkmcnt(" #n ")" ::: "memory")
#define PG8_BAR __builtin_amdgcn_s_barrier()
#define PG8_SCHED __builtin_amdgcn_sched_barrier(0)
#define PG8_APTR(u) ((const char*)g.A + (size_t)(u).pm * g.tA + (size_t)((u).pn >> g.a_pn_shift) * g.a_pn_step)
#define PG8_BPTR(u) ((const char*)g.Bt + (size_t)(u).pn * g.tB)
    Unit cur, nxt; int ui = 0;
    if (!S.next(0, cur)) return;
    f32x4 acc[2][2][4][2];
#pragma unroll
    for (int a = 0; a < 2; ++a)
#pragma unroll
        for (int b = 0; b < 2; ++b)
#pragma unroll
            for (int m = 0; m < 4; ++m)
#pragma unroll
                for (int n = 0; n < 2; ++n) acc[a][b][m][n] = (f32x4){0.f, 0.f, 0.f, 0.f};
    bf16x8 At[4][2], B0[2][2], B1[2][2];
    const char* cA = PG8_APTR(cur); const char* cB = PG8_BPTR(cur);
    {
        PG8_STAGE(PG8_SB(0, 0), cB, voffB); PG8_STAGE(PG8_SB(0, 1), cB + hstepB, voffB); PG8_STAGE(PG8_SA(0, 0), cA, voffA); PG8_STAGE(PG8_SA(0, 1), cA + hstepA, voffA);
        if (wr == 1) PG8_BAR;
        PG8_WAIT_V(2); PG8_BAR;
        PG8_STAGE(PG8_SB(1, 0), cB + kstep, voffB); PG8_STAGE(PG8_SA(1, 0), cA + kstep, voffA); PG8_STAGE(PG8_SB(1, 1), cB + hstepB + kstep, voffB);
        PG8_WAIT_V(6); PG8_BAR;
    }
    for (;;) {
        const bool has_next = S.next(ui + 1, nxt);
        const char* nA = has_next ? PG8_APTR(nxt) : cA; const char* nB = has_next ? PG8_BPTR(nxt) : cB;
        for (int t = 0; t < nt; t += 2) {
            const bool last = (t == nt - 2);
            const char* a1 = cA + (size_t)(t + 1) * kstep;
            const char* a2 = last ? nA : cA + (size_t)(t + 2) * kstep; const char* b2 = last ? nB : cB + (size_t)(t + 2) * kstep;
            const char* a3 = a2 + kstep; const char* b3 = b2 + kstep;
            PG8_LDB(B0, 0, 0); PG8_LDB(B1, 0, 1); PG8_SCHED; PG8_LDA(At, 0, 0); PG8_STAGE(PG8_SA(1, 1), a1 + hstepA, voffA);
            PG8_WAIT_V(8); PG8_WAIT_L(0); PG8_BAR; PG8_MMA(0, 0, At, B0); PG8_MMA(0, 1, At, B1); PG8_BAR; PG8_SCHED;
            PG8_LDA(At, 0, 1); PG8_STAGE(PG8_SB(0, 0), b2, voffB); PG8_STAGE(PG8_SB(0, 1), b2 + hstepB, voffB); PG8_STAGE(PG8_SA(0, 0), a2, voffA);
            PG8_WAIT_V(8); PG8_WAIT_L(0); PG8_BAR; PG8_MMA(1, 0, At, B0); PG8_MMA(1, 1, At, B1); PG8_BAR; PG8_SCHED;
            PG8_LDB(B0, 1, 0); PG8_LDB(B1, 1, 1); PG8_SCHED; PG8_LDA(At, 1, 0); PG8_STAGE(PG8_SA(0, 1), a2 + hstepA, voffA);
            PG8_WAIT_V(8); PG8_WAIT_L(0); PG8_BAR; PG8_MMA(0, 0, At, B0); PG8_MMA(0, 1, At, B1); PG8_BAR; PG8_SCHED;
            PG8_LDA(At, 1, 1); PG8_STAGE(PG8_SB(1, 0), b3, voffB); PG8_STAGE(PG8_SB(1, 1), b3 + hstepB, voffB); PG8_STAGE(PG8_SA(1, 0), a3, voffA);
            PG8_WAIT_V(8); PG8_WAIT_L(0); PG8_BAR; PG8_MMA(1, 0, At, B0); PG8_MMA(1, 1, At, B1); PG8_BAR; PG8_SCHED;
        }
        if constexpr (ALIGN_EPI) { if (wr == 0) PG8_BAR; }
        if constexpr (!Epi::AFTER_DRAIN) E(acc, cur, wr, wc, fr, fq);
        if (!has_next) break;
#pragma unroll
        for (int a = 0; a < 2; ++a)
#pragma unroll
            for (int b = 0; b < 2; ++b)
#pragma unroll
                for (int m = 0; m < 4; ++m)
#pragma unroll
                    for (int n = 0; n < 2; ++n) acc[a][b][m][n] = (f32x4){0.f, 0.f, 0.f, 0.f};
        cur = nxt; cA = nA; cB = nB; ++ui;
        if constexpr (ALIGN_EPI) { if (wr == 1) PG8_BAR; }
    }
    PG8_WAIT_V(0);
    if constexpr (!ALIGN_EPI) { if (wr == 0) PG8_BAR; }
    PG8_BAR;
    if constexpr (Epi::AFTER_DRAIN) E.fused(acc, cur, wr, wc, fr, fq, lds, wid, lane);
#undef PG8_SA
#undef PG8_SB
#undef PG8_STAGE
#undef PG8_LDA
#undef PG8_LDB
#undef PG8_MMA
#undef PG8_WAIT_V
#undef PG8_WAIT_L
#undef PG8_BAR
#undef PG8_SCHED
#undef PG8_APTR
#undef PG8_BPTR
}
}
constexpr int TH = 16384;
constexpr int DM = 1024, ZP = 2304, DFF = 4096, TQ = 8192;
constexpr size_t MiB = 1u << 20;
constexpr size_t WS_RSQ = 0, WS_RSKV = 64 * 1024, WS_ROPE = 128 * 1024;
constexpr size_t WS_AGG = 5 * MiB;
constexpr size_t WS_CARRY = 9 * MiB;
constexpr size_t WS_XBUF = 1 * MiB;
constexpr size_t WS_SQP = 1 * MiB + 512 * 1024;
constexpr size_t WS_CNT = 3 * MiB;
constexpr size_t WS_BAR = 4 * MiB;
constexpr size_t WS_YB = 5 * MiB;
constexpr size_t WS_W_INATT = 13 * MiB;
constexpr size_t WS_W_UQ = WS_W_INATT + (size_t)2304 * 1024 * 2;
constexpr size_t WS_W_UKV = WS_W_UQ + (size_t)768 * 384 * 2;
constexpr size_t WS_W_OUTATT = WS_W_UKV + (size_t)1024 * 256 * 2;
constexpr size_t WS_W_INREC = WS_W_OUTATT + 2 * MiB;
constexpr size_t WS_W_GATES = WS_W_INREC + 4 * MiB;
constexpr size_t WS_W_OUTREC = WS_W_GATES + 1 * MiB;
constexpr size_t WS_W_UP = WS_W_OUTREC + 2 * MiB;
constexpr size_t WS_W_DOWN = WS_W_UP + 32 * MiB;
constexpr size_t WS_W_END = WS_W_DOWN + 16 * MiB;
static_assert(WS_W_END <= 76 * MiB, "weights");
constexpr size_t WS_XN = 76 * MiB;
constexpr size_t WS_BIG = 108 * MiB;
constexpr size_t WS_Z = WS_BIG;
constexpr size_t WS_Q = WS_Z + 72 * MiB;
constexpr size_t WS_KN = WS_Q + 24 * MiB;
constexpr size_t WS_VTM = WS_KN + 16 * MiB;
constexpr size_t WS_VTN = WS_VTM + 16 * MiB;
constexpr size_t WS_KPE = WS_VTN + 16 * MiB;
static_assert(WS_KPE + 1 * MiB <= 256 * MiB, "L0 overlay");
constexpr size_t WS_ACT = WS_BIG;
constexpr size_t WS_GATE = WS_BIG;
constexpr size_t WS_XB = WS_BIG + 32 * MiB;
constexpr size_t WS_XBR = WS_BIG + 64 * MiB;
constexpr size_t WS_GQ = WS_XBR;
constexpr size_t WS_END = 256 * MiB;

using pg8::Unit;

struct EpiBf16 {
    static constexpr bool PERM = true, AFTER_DRAIN = false;
    bf16_t* O; int ldc; int split_cols; size_t split_stride;
    __device__ __forceinline__ void operator()(f32x4 (&acc)[2][2][4][2], const Unit& u, int wr, int wc, int fr, int fq) const {
        const int row0 = u.pm * 256 + wr * 64 + fr; int colt = u.pn * 256; bf16_t* base = O;
        if (split_cols) { const int t = colt / split_cols; base += (size_t)t * split_stride; colt -= t * split_cols; }
        const int col0 = colt + wc * 32 + 8 * fq;
#pragma unroll
        for (int ai = 0; ai < 2; ++ai)
#pragma unroll
            for (int m = 0; m < 4; ++m) { bf16_t* rowp = base + (size_t)(row0 + ai * 128 + m * 16) * ldc + col0;
#pragma unroll
                for (int bj = 0; bj < 2; ++bj) { const f32x4 v0 = acc[ai][bj][m][0], v1 = acc[ai][bj][m][1];
                    u32x4 w; w.x = cvt_pk_bf16(v0[0], v0[1]); w.y = cvt_pk_bf16(v0[2], v0[3]); w.z = cvt_pk_bf16(v1[0], v1[1]); w.w = cvt_pk_bf16(v1[2], v1[3]);
                    *(u32x4*)(rowp + bj * 128) = w; } }
    }
};

struct EpiZ {
    static constexpr bool PERM = true, AFTER_DRAIN = false;
    bf16_t* Z; bf16_t* VTn; float* SQ; float* SKV; bf16_t* KPE; const float2* rope; int smask;
    __device__ __forceinline__ void operator()(f32x4 (&acc)[2][2][4][2], const Unit& u, int wr, int wc, int fr, int fq) const {
        const int lane = fq * 16 + fr;
        const int row0 = u.pm * 256 + wr * 64 + fr; const int col0 = u.pn * 256 + wc * 32 + 8 * fq;
#pragma unroll
        for (int ai = 0; ai < 2; ++ai)
#pragma unroll
            for (int m = 0; m < 4; ++m) { const int row = row0 + ai * 128 + m * 16; bf16_t* rowp = Z + (size_t)row * ZP + col0;
#pragma unroll
                for (int bj = 0; bj < 2; ++bj) { const f32x4 v0 = acc[ai][bj][m][0], v1 = acc[ai][bj][m][1];
                    u32x4 w; w.x = cvt_pk_bf16(v0[0], v0[1]); w.y = cvt_pk_bf16(v0[2], v0[3]); w.z = cvt_pk_bf16(v1[0], v1[1]); w.w = cvt_pk_bf16(v1[2], v1[3]);
                    *(u32x4*)(rowp + bj * 128) = w;
                    const int c = col0 + bj * 128; const int g32 = (u.pn * 256 + bj * 128 + wc * 32) >> 5;
                    if (g32 < 20) {
                        float s = (v0[0] * v0[0] + v0[1] * v0[1]) + (v0[2] * v0[2] + v0[3] * v0[3]) + ((v1[0] * v1[0] + v1[1] * v1[1]) + (v1[2] * v1[2] + v1[3] * v1[3]));
                        s += bperm_f(lane ^ 16, s); s += bperm_f(lane ^ 32, s);
                        if (fq == 0) SQ[(size_t)row * 20 + g32] = s;
                    } else if (g32 == 20) {
                        const float2* rp = rope + (size_t)(row & smask) * 16 + 8 * (fq & 1);
                        float o[8];
#pragma unroll
                        for (int k = 0; k < 8; ++k) { const float mine = k < 4 ? v0[k] : v1[k - 4]; const float other = bperm_f(lane ^ 32, mine); const float2 cs = rp[k];
                            o[k] = fq < 2 ? mine * cs.x - other * cs.y : mine * cs.x + other * cs.y; }
                        u32x4 wk; wk.x = cvt_pk_bf16(o[0], o[1]); wk.y = cvt_pk_bf16(o[2], o[3]); wk.z = cvt_pk_bf16(o[4], o[5]); wk.w = cvt_pk_bf16(o[6], o[7]);
                        *(u32x4*)(KPE + (size_t)row * 32 + 8 * fq) = wk;
                    }
                    if (c >= 1696 && c < 2208) { bf16_t* vt = VTn + (size_t)(c - 1696) * TH + row;
                        vt[0] = (bf16_t)(w.x & 0xffffu); vt[TH] = (bf16_t)(w.x >> 16); vt[2 * TH] = (bf16_t)(w.y & 0xffffu); vt[3 * TH] = (bf16_t)(w.y >> 16);
                        vt[4 * TH] = (bf16_t)(w.z & 0xffffu); vt[5 * TH] = (bf16_t)(w.z >> 16); vt[6 * TH] = (bf16_t)(w.w & 0xffffu); vt[7 * TH] = (bf16_t)(w.w >> 16); } } }
    }
};

struct EpiQ {
    static constexpr bool PERM = false, AFTER_DRAIN = false;
    bf16_t* Q; const float* rsq; const float2* rope; int smask;
    __device__ __forceinline__ void operator()(f32x4 (&acc)[2][2][4][2], const Unit& u, int wr, int wc, int fr, int fq) const {
        const float SC = 0.10206207261596577f * 1.4426950408889634f;
        const int row0 = u.pm * 256 + wr * 64 + fr;
#pragma unroll
        for (int ai = 0; ai < 2; ++ai)
#pragma unroll
            for (int m = 0; m < 4; ++m) { const int row = row0 + ai * 128 + m * 16; float ssq = 0.f;
#pragma unroll
                for (int k = 0; k < 12; ++k) ssq += rsq[(size_t)row * 20 + k];
                const float rs = SC / sqrtf(ssq * (1.f / 384.f) + 1e-6f); const int pos = row & smask;
#pragma unroll
                for (int bj = 0; bj < 2; ++bj) { const int cg = u.pn * 256 + bj * 128 + wc * 32;
                    f32x4 v0 = acc[ai][bj][m][0] * rs, v1 = acc[ai][bj][m][1] * rs;
                    if ((cg % 96) == 64) {
                        const float2* rp = rope + (size_t)pos * 16 + 4 * fq;
#pragma unroll
                        for (int i = 0; i < 4; ++i) { const float2 cs = rp[i]; const float x1 = v0[i], x2 = v1[i]; v0[i] = x1 * cs.x - x2 * cs.y; v1[i] = x2 * cs.x + x1 * cs.y; }
                    }
                    bf16_t* p = Q + (size_t)row * 768 + cg + 4 * fq;
                    u32x2 w0; w0.x = cvt_pk_bf16(v0[0], v0[1]); w0.y = cvt_pk_bf16(v0[2], v0[3]); *(u32x2*)p = w0;
                    u32x2 w1; w1.x = cvt_pk_bf16(v1[0], v1[1]); w1.y = cvt_pk_bf16(v1[2], v1[3]); *(u32x2*)(p + 16) = w1; } }
    }
};

struct EpiKV {
    static constexpr bool PERM = true, AFTER_DRAIN = false;
    bf16_t* KN; bf16_t* VTm; const float* rskv;
    __device__ __forceinline__ void operator()(f32x4 (&acc)[2][2][4][2], const Unit& u, int wr, int wc, int fr, int fq) const {
        const int row0 = u.pm * 256 + wr * 64 + fr;
#pragma unroll
        for (int ai = 0; ai < 2; ++ai)
#pragma unroll
            for (int m = 0; m < 4; ++m) { const int row = row0 + ai * 128 + m * 16; float ssq = 0.f;
#pragma unroll
                for (int k = 12; k < 20; ++k) ssq += rskv[(size_t)row * 20 + k];
                const float rs = 1.0f / sqrtf(ssq * (1.f / 256.f) + 1e-6f);
#pragma unroll
                for (int bj = 0; bj < 2; ++bj) { const int c = u.pn * 256 + bj * 128 + wc * 32 + 8 * fq;
                    const f32x4 v0 = acc[ai][bj][m][0] * rs, v1 = acc[ai][bj][m][1] * rs;
                    u32x4 w; w.x = cvt_pk_bf16(v0[0], v0[1]); w.y = cvt_pk_bf16(v0[2], v0[3]); w.z = cvt_pk_bf16(v1[0], v1[1]); w.w = cvt_pk_bf16(v1[2], v1[3]);
                    const int h = c >> 7, j = c & 127;
                    if (j < 64) { *(u32x4*)(KN + (size_t)row * 512 + h * 64 + j) = w; }
                    else { bf16_t* vt = VTm + (size_t)(h * 64 + j - 64) * TH + row;
                        vt[0] = (bf16_t)(w.x & 0xffffu); vt[TH] = (bf16_t)(w.x >> 16); vt[2 * TH] = (bf16_t)(w.y & 0xffffu); vt[3 * TH] = (bf16_t)(w.y >> 16);
                        vt[4 * TH] = (bf16_t)(w.z & 0xffffu); vt[5 * TH] = (bf16_t)(w.z >> 16); vt[6 * TH] = (bf16_t)(w.w & 0xffffu); vt[7 * TH] = (bf16_t)(w.w >> 16); } } }
    }
};

struct EpiUp {
    static constexpr bool PERM = true, AFTER_DRAIN = false;
    bf16_t* ACT; bf16_t* YB; const float* cw; const float* cb;
    __device__ __forceinline__ void operator()(f32x4 (&acc)[2][2][4][2], const Unit& u, int wr, int wc, int fr_, int fq_) const {
        int fr = fr_, fq = fq_; asm volatile("" : "+v"(fr), "+v"(fq));
        const int lane = fq * 16 + fr;
        const int tok0 = u.pm * 256 + wr * 128 + 8 * fr;
        const int ch0 = u.pn * 128 + wc * 32 + 8 * fq;
        const int seg = u.pm * 2 + wr;
        if (fr == 0 || fr == 15) {
#pragma unroll
            for (int k = 0; k < 2; ++k) {
                const int slot = fr == 0 ? k : 2 + k;
                bf16_t* yb = YB + ((size_t)seg * 4 + slot) * 8192 + ch0;
#pragma unroll
                for (int bj = 0; bj < 2; ++bj) { const f32x4 v0 = fr == 0 ? acc[0][bj][k][0] : acc[1][bj][2 + k][0], v1 = fr == 0 ? acc[0][bj][k][1] : acc[1][bj][2 + k][1];
                    u32x4 w; w.x = cvt_pk_bf16(v0[0], v0[1]); w.y = cvt_pk_bf16(v0[2], v0[3]); w.z = cvt_pk_bf16(v1[0], v1[1]); w.w = cvt_pk_bf16(v1[2], v1[3]);
                    *(u32x4*)(yb + bj * 4096) = w; }
            }
        }
        const int src_up = (lane & ~15) | ((fr - 1) & 15), src_dn = (lane & ~15) | ((fr + 1) & 15);
#pragma unroll
        for (int n = 0; n < 2; ++n)
#pragma unroll
            for (int i = 0; i < 4; ++i) {
                float ug[8], uv[8];
#pragma unroll
                for (int bj = 0; bj < 2; ++bj) {
                    const int ch = bj * 4096 + ch0 + 4 * n + i;
                    const float w0 = cw[ch], w1 = cw[8192 + ch], w2 = cw[2 * 8192 + ch], b = cb[ch];
                    const float prev7 = bperm_f(src_up, acc[1][bj][3][n][i]);
                    const float next0 = bperm_f(src_dn, acc[0][bj][0][n][i]);
#pragma unroll
                    for (int q = 0; q < 8; ++q) {
                        const float v = acc[q >> 2][bj][q & 3][n][i];
                        const float up = q > 0 ? acc[(q - 1) >> 2][bj][(q - 1) & 3][n][i] : prev7;
                        const float dn = q < 7 ? acc[(q + 1) >> 2][bj][(q + 1) & 3][n][i] : next0;
                        const float r = w0 * up + w1 * v + w2 * dn + b;
                        if (bj == 0) ug[q] = r; else uv[q] = r;
                    }
                }
#pragma unroll
                for (int q = 0; q < 8; ++q) acc[q >> 2][0][q & 3][n][i] = gelu_tanh(ug[q]) * uv[q];
            }
#pragma unroll
        for (int ai = 0; ai < 2; ++ai)
#pragma unroll
            for (int m = 0; m < 4; ++m) { const f32x4 v0 = acc[ai][0][m][0], v1 = acc[ai][0][m][1];
                u32x4 w; w.x = cvt_pk_bf16(v0[0], v0[1]); w.y = cvt_pk_bf16(v0[2], v0[3]); w.z = cvt_pk_bf16(v1[0], v1[1]); w.w = cvt_pk_bf16(v1[2], v1[3]);
                *(u32x4*)(ACT + (size_t)(tok0 + 4 * ai + m) * DFF + ch0) = w; }
    }
};

struct EpiGates {
    static constexpr bool PERM = true, AFTER_DRAIN = false;
    bf16_t* G; const bf16_t* XBq; float2* AGGp; const float* gab_; const float* gxb_; const float* lam_;
    __device__ __forceinline__ void operator()(f32x4 (&acc)[2][2][4][2], const Unit& u, int wr, int wc, int fr_, int fq_) const {
        int fr = fr_, fq = fq_; asm volatile("" : "+v"(fr), "+v"(fq));
        const int lane = fq * 16 + fr;
        const int nblk = u.pn >> 1, e = u.pn & 1;
        const int tl0 = u.pm * 256 + wr * 128 + 8 * fr;
        const int d0 = wc * 32 + 8 * fq, ch0 = nblk * 128 + d0;
        u32x4 xbw[8];
#pragma unroll
        for (int q = 0; q < 8; ++q) xbw[q] = *(const u32x4*)(XBq + (size_t)(tl0 + q) * DM + ch0);
        unsigned law[8][4], bw[8][4];
#pragma unroll
        for (int k2 = 0; k2 < 4; ++k2) {
            const float2 gab = *(const float2*)(gab_ + e * 1024 + ch0 + 2 * k2), gxb = *(const float2*)(gxb_ + e * 1024 + ch0 + 2 * k2), lam = *(const float2*)(lam_ + e * 1024 + ch0 + 2 * k2);
            const float spl0 = log1pf(expf(-lam.x)), spl1 = log1pf(expf(-lam.y));
#pragma unroll
            for (int q = 0; q < 8; ++q) {
                const unsigned xb2 = k2 == 0 ? xbw[q].x : k2 == 1 ? xbw[q].y : k2 == 2 ? xbw[q].z : xbw[q].w;
                float l0, b0, l1, b1;
                lru_lb(acc[q >> 2][0][q & 3][k2 >> 1][2 * (k2 & 1)], acc[q >> 2][1][q & 3][k2 >> 1][2 * (k2 & 1)], gab.x, gxb.x, spl0, bflo(xb2), l0, b0);
                lru_lb(acc[q >> 2][0][q & 3][k2 >> 1][2 * (k2 & 1) + 1], acc[q >> 2][1][q & 3][k2 >> 1][2 * (k2 & 1) + 1], gab.y, gxb.y, spl1, bfhi(xb2), l1, b1);
                law[q][k2] = cvt_pk_bf16(l0, l1); bw[q][k2] = cvt_pk_bf16(b0, b1); }
        }
#pragma unroll
        for (int q = 0; q < 8; ++q) { bf16_t* rowp = G + (size_t)(tl0 + q) * 4096 + u.pn * 256 + d0;
            *(u32x4*)(rowp) = (u32x4){law[q][0], law[q][1], law[q][2], law[q][3]}; *(u32x4*)(rowp + 128) = (u32x4){bw[q][0], bw[q][1], bw[q][2], bw[q][3]}; }
        float Aagg[8], Bagg[8];
#pragma unroll
        for (int k2 = 0; k2 < 4; ++k2) {
            float A0 = 1.f, B0 = 0.f, A1 = 1.f, B1 = 0.f;
#pragma unroll
            for (int s = 0; s < 8; ++s) {
                const unsigned l2 = e ? law[7 - s][k2] : law[s][k2], b2 = e ? bw[7 - s][k2] : bw[s][k2];
                const float a0 = fexp2(bflo(l2)), a1 = fexp2(bfhi(l2));
                A0 *= a0; B0 = a0 * B0 + bflo(b2); A1 *= a1; B1 = a1 * B1 + bfhi(b2); }
            Aagg[2 * k2] = A0; Bagg[2 * k2] = B0; Aagg[2 * k2 + 1] = A1; Bagg[2 * k2 + 1] = B1;
        }
#pragma unroll
        for (int bit = 1; bit <= 2; bit <<= 1) {
            const bool me_first = e ? ((fr & bit) != 0) : ((fr & bit) == 0);
#pragma unroll
            for (int k = 0; k < 8; ++k) { const float Ao = bperm_f(lane ^ bit, Aagg[k]), Bo = bperm_f(lane ^ bit, Bagg[k]);
                const float An = Ao * Aagg[k], Bn = me_first ? Ao * Bagg[k] + Bo : Aagg[k] * Bo + Bagg[k];
                Aagg[k] = An; Bagg[k] = Bn; }
        }
        if ((fr & 3) == 0) { const int c = (tl0 >> 5);
            float2* dst = AGGp + (size_t)(c * 2 + e) * 1024 + ch0;
#pragma unroll
            for (int k = 0; k < 8; k += 2) *(f32x4*)(dst + k) = (f32x4){Aagg[k], Bagg[k], Aagg[k + 1], Bagg[k + 1]}; }
    }
};

struct EpiRms {
    static constexpr bool PERM = false, AFTER_DRAIN = true;
    float* x; bf16_t* xn; const float* gpost; const float* gnext; float* xbuf1; float* xbuf2; unsigned* cnt1; unsigned* cnt2;
    __device__ __forceinline__ void operator()(f32x4 (&)[2][2][4][2], const Unit&, int, int, int, int) const {}
    __device__ __forceinline__ void stats(const f32x4 (&v)[2][2][4][2], const Unit& u, int wr, int wc, int fr, int fq, LAS unsigned char* lds, int wid, int lane, float* xbuf, unsigned* cnt) const {
        LAS float* P = (LAS float*)lds; LAS float* Sx = (LAS float*)(lds + 4096);
#pragma unroll
        for (int ai = 0; ai < 2; ++ai)
#pragma unroll
            for (int m = 0; m < 4; ++m) { float s = 0.f;
#pragma unroll
                for (int bj = 0; bj < 2; ++bj)
#pragma unroll
                    for (int n = 0; n < 2; ++n) { const f32x4 t = v[ai][bj][m][n]; s += (t[0] * t[0] + t[1] * t[1]) + (t[2] * t[2] + t[3] * t[3]); }
                s += bperm_f(lane ^ 16, s); s += bperm_f(lane ^ 32, s);
                if (fq == 0) P[(ai * 128 + wr * 64 + m * 16 + fr) * 4 + wc] = s; }
        asm volatile("s_waitcnt lgkmcnt(0)" ::: "memory"); __builtin_amdgcn_s_barrier(); asm volatile("" ::: "memory");
        const int row = wid * 32 + (lane & 31);
        if (lane < 32) { const float t = (P[row * 4 + 0] + P[row * 4 + 1]) + (P[row * 4 + 2] + P[row * 4 + 3]);
            __hip_atomic_store(xbuf + (size_t)(u.pm * 256 + row) * 4 + u.pn, t, __ATOMIC_RELAXED, __HIP_MEMORY_SCOPE_AGENT); }
        asm volatile("s_waitcnt vmcnt(0)" ::: "memory");
        if (lane == 0) __hip_atomic_fetch_add(cnt + 64 * u.pm, 1u, __ATOMIC_RELAXED, __HIP_MEMORY_SCOPE_AGENT);
        if (wid == 0) { unsigned sp = 0;
            while ((unsigned)__builtin_amdgcn_readfirstlane(__hip_atomic_load(cnt + 64 * u.pm, __ATOMIC_RELAXED, __HIP_MEMORY_SCOPE_AGENT)) < 32u) { __builtin_amdgcn_s_sleep(2); if (++sp > (1u << 22)) break; }
            __builtin_amdgcn_fence(__ATOMIC_ACQUIRE, "agent"); }
        asm volatile("s_waitcnt vmcnt(0) lgkmcnt(0)" ::: "memory"); __builtin_amdgcn_s_barrier(); asm volatile("" ::: "memory");
        if (lane < 32) { const float* slot = xbuf + (size_t)(u.pm * 256 + row) * 4; float t = 0.f;
#pragma unroll
            for (int k = 0; k < 4; ++k) t += __hip_atomic_load(slot + k, __ATOMIC_RELAXED, __HIP_MEMORY_SCOPE_AGENT);
            Sx[row] = 1.0f / sqrtf(t * (1.f / 1024.f) + 1e-6f); }
        asm volatile("s_waitcnt lgkmcnt(0)" ::: "memory"); __builtin_amdgcn_s_barrier(); asm volatile("" ::: "memory");
    }
    __device__ __forceinline__ void fused(f32x4 (&acc)[2][2][4][2], const Unit& u, int wr, int wc, int fr, int fq, LAS unsigned char* lds, int wid, int lane) const {
        const LAS float* Sx = (const LAS float*)(lds + 4096);
        const int col0 = u.pn * 256 + wc * 32 + 4 * fq;
        stats(acc, u, wr, wc, fr, fq, lds, wid, lane, xbuf1, cnt1);
#pragma unroll
        for (int ai = 0; ai < 2; ++ai)
#pragma unroll
            for (int m = 0; m < 4; ++m) { const int r = ai * 128 + wr * 64 + m * 16 + fr; const float rs = Sx[r]; float* xr = x + (size_t)(u.pm * 256 + r) * DM + col0;
#pragma unroll
                for (int bj = 0; bj < 2; ++bj)
#pragma unroll
                    for (int n = 0; n < 2; ++n) { const f32x4 g = *(const f32x4*)(gpost + col0 + bj * 128 + n * 16); const f32x4 bs = *(const f32x4*)(xr + bj * 128 + n * 16);
                        const f32x4 o = bs + acc[ai][bj][m][n] * rs * g; acc[ai][bj][m][n] = o; *(f32x4*)(xr + bj * 128 + n * 16) = o; }
                if (m & 1) asm volatile("" ::: "memory"); }
        if (xn) {
            stats(acc, u, wr, wc, fr, fq, lds, wid, lane, xbuf2, cnt2);
#pragma unroll
            for (int ai = 0; ai < 2; ++ai)
#pragma unroll
                for (int m = 0; m < 4; ++m) { const int r = ai * 128 + wr * 64 + m * 16 + fr; const float rs = Sx[r]; bf16_t* xr = xn + (size_t)(u.pm * 256 + r) * DM + col0;
#pragma unroll
                    for (int bj = 0; bj < 2; ++bj)
#pragma unroll
                        for (int n = 0; n < 2; ++n) { const f32x4 g = *(const f32x4*)(gnext + col0 + bj * 128 + n * 16); const f32x4 o = acc[ai][bj][m][n] * rs * g;
                            u32x2 w; w.x = cvt_pk_bf16(o[0], o[1]); w.y = cvt_pk_bf16(o[2], o[3]); *(u32x2*)(xr + bj * 128 + n * 16) = w; } }
        }
    }
};
constexpr float EPS = 1e-6f;
constexpr float LOG2E = 1.4426950408889634f;

__device__ __forceinline__ void transpose_item(const float* W, int K, int N, bf16_t* WT, int row_off, const float* kscale, LAS float* scr, int item, int lane) {
    const int nblk = N / 32, kb = item / nblk, nb = item % nblk, k0 = 64 * kb, n0 = 32 * nb;
#pragma unroll 8
    for (int i = 0; i < 32; ++i) { const int kk = 2 * i + (lane >> 5); float v = W[(size_t)(k0 + kk) * N + n0 + (lane & 31)]; if (kscale) v *= kscale[k0 + kk]; scr[kk * 33 + (lane & 31)] = v; }
    asm volatile("s_waitcnt lgkmcnt(0)" ::: "memory");
    const int c = lane & 7;
#pragma unroll
    for (int j = 0; j < 4; ++j) { const int n = (lane >> 3) + 8 * j; const LAS float* s = scr + (8 * c) * 33 + n;
        u32x4 o; o.x = cvt_pk_bf16(s[0 * 33], s[1 * 33]); o.y = cvt_pk_bf16(s[2 * 33], s[3 * 33]); o.z = cvt_pk_bf16(s[4 * 33], s[5 * 33]); o.w = cvt_pk_bf16(s[6 * 33], s[7 * 33]);
        *(u32x4*)(WT + (size_t)(row_off + n0 + n) * K + k0 + 8 * c) = o; }
    asm volatile("s_waitcnt lgkmcnt(0)" ::: "memory");
}

__device__ __forceinline__ void xn_row(const float* xrow, const float* gain, bf16_t* orow, int lane) {
    const f32x4* xr = (const f32x4*)xrow + lane; const f32x4* gr = (const f32x4*)gain + lane;
    f32x4 v[4]; float s = 0.f;
#pragma unroll
    for (int j = 0; j < 4; ++j) { v[j] = xr[64 * j]; s += (v[j].x * v[j].x + v[j].y * v[j].y) + (v[j].z * v[j].z + v[j].w * v[j].w); }
    const float rs = 1.0f / sqrtf(wave_sum(s, lane) * (1.f / DM) + EPS);
    u32x2* o8 = (u32x2*)orow + lane;
#pragma unroll
    for (int j = 0; j < 4; ++j) { const f32x4 g = gr[64 * j]; u32x2 w; w.x = cvt_pk_bf16(v[j].x * rs * g.x, v[j].y * rs * g.y); w.y = cvt_pk_bf16(v[j].z * rs * g.z, v[j].w * rs * g.w); o8[64 * j] = w; }
}

__device__ __forceinline__ void res_row(const bf16_t* mrow, const float* xi, float* xo, const float* gpost, const float* gnext, bf16_t* xnrow, int lane) {
    const u32x2* mr = (const u32x2*)mrow + lane; const f32x4* xr = (const f32x4*)xi + lane; const f32x4* gp = (const f32x4*)gpost + lane;
    f32x4 mv[4]; float s = 0.f;
#pragma unroll
    for (int j = 0; j < 4; ++j) { const u32x2 w = mr[64 * j]; mv[j] = (f32x4){bflo(w.x), bfhi(w.x), bflo(w.y), bfhi(w.y)}; s += (mv[j].x * mv[j].x + mv[j].y * mv[j].y) + (mv[j].z * mv[j].z + mv[j].w * mv[j].w); }
    const float rs = 1.0f / sqrtf(wave_sum(s, lane) * (1.f / DM) + EPS);
    f32x4 x[4]; float s2 = 0.f;
#pragma unroll
    for (int j = 0; j < 4; ++j) { const f32x4 g = gp[64 * j]; x[j] = xr[64 * j] + mv[j] * rs * g; s2 += (x[j].x * x[j].x + x[j].y * x[j].y) + (x[j].z * x[j].z + x[j].w * x[j].w); }
    f32x4* xw = (f32x4*)xo + lane;
#pragma unroll
    for (int j = 0; j < 4; ++j) xw[64 * j] = x[j];
    if (gnext) {
        const float rs2 = 1.0f / sqrtf(wave_sum(s2, lane) * (1.f / DM) + EPS);
        const f32x4* gn = (const f32x4*)gnext + lane; u32x2* o8 = (u32x2*)xnrow + lane;
#pragma unroll
        for (int j = 0; j < 4; ++j) { const f32x4 g = gn[64 * j]; u32x2 w; w.x = cvt_pk_bf16(x[j].x * rs2 * g.x, x[j].y * rs2 * g.y); w.y = cvt_pk_bf16(x[j].z * rs2 * g.z, x[j].w * rs2 * g.w); o8[64 * j] = w; }
    }
}

__device__ __forceinline__ void res_row2(const bf16_t* m0, const bf16_t* m1, const float* xi0, const float* xi1, float* xo0, float* xo1, const float* gpost, const float* gnext, bf16_t* xn0, bf16_t* xn1, int lane) {
    const u32x2* mr0 = (const u32x2*)m0 + lane; const u32x2* mr1 = (const u32x2*)m1 + lane; const f32x4* xr0 = (const f32x4*)xi0 + lane; const f32x4* xr1 = (const f32x4*)xi1 + lane; const f32x4* gp = (const f32x4*)gpost + lane;
    u32x2 w0[4], w1[4]; f32x4 xa[4], xb[4], g[4];
#pragma unroll
    for (int j = 0; j < 4; ++j) { w0[j] = mr0[64 * j]; w1[j] = mr1[64 * j]; xa[j] = xr0[64 * j]; xb[j] = xr1[64 * j]; g[j] = gp[64 * j]; }
    f32x4 ma[4], mb[4]; float s0 = 0.f, s1 = 0.f;
#pragma unroll
    for (int j = 0; j < 4; ++j) { ma[j] = (f32x4){bflo(w0[j].x), bfhi(w0[j].x), bflo(w0[j].y), bfhi(w0[j].y)}; mb[j] = (f32x4){bflo(w1[j].x), bfhi(w1[j].x), bflo(w1[j].y), bfhi(w1[j].y)};
        s0 += (ma[j].x * ma[j].x + ma[j].y * ma[j].y) + (ma[j].z * ma[j].z + ma[j].w * ma[j].w); s1 += (mb[j].x * mb[j].x + mb[j].y * mb[j].y) + (mb[j].z * mb[j].z + mb[j].w * mb[j].w); }
    const float rs0 = 1.0f / sqrtf(wave_sum(s0, lane) * (1.f / DM) + EPS), rs1 = 1.0f / sqrtf(wave_sum(s1, lane) * (1.f / DM) + EPS);
    float t0 = 0.f, t1 = 0.f;
#pragma unroll
    for (int j = 0; j < 4; ++j) { xa[j] = xa[j] + ma[j] * rs0 * g[j]; xb[j] = xb[j] + mb[j] * rs1 * g[j];
        t0 += (xa[j].x * xa[j].x + xa[j].y * xa[j].y) + (xa[j].z * xa[j].z + xa[j].w * xa[j].w); t1 += (xb[j].x * xb[j].x + xb[j].y * xb[j].y) + (xb[j].z * xb[j].z + xb[j].w * xb[j].w); }
    f32x4* xw0 = (f32x4*)xo0 + lane; f32x4* xw1 = (f32x4*)xo1 + lane;
#pragma unroll
    for (int j = 0; j < 4; ++j) { xw0[64 * j] = xa[j]; xw1[64 * j] = xb[j]; }
    if (gnext) {
        const float q0 = 1.0f / sqrtf(wave_sum(t0, lane) * (1.f / DM) + EPS), q1 = 1.0f / sqrtf(wave_sum(t1, lane) * (1.f / DM) + EPS);
        const f32x4* gn = (const f32x4*)gnext + lane; u32x2* o0 = (u32x2*)xn0 + lane; u32x2* o1 = (u32x2*)xn1 + lane;
#pragma unroll
        for (int j = 0; j < 4; ++j) { const f32x4 h = gn[64 * j];
            u32x2 a; a.x = cvt_pk_bf16(xa[j].x * q0 * h.x, xa[j].y * q0 * h.y); a.y = cvt_pk_bf16(xa[j].z * q0 * h.z, xa[j].w * q0 * h.w); o0[64 * j] = a;
            u32x2 b; b.x = cvt_pk_bf16(xb[j].x * q1 * h.x, xb[j].y * q1 * h.y); b.y = cvt_pk_bf16(xb[j].z * q1 * h.z, xb[j].w * q1 * h.w); o1[64 * j] = b; }
    }
}

#define MLA_PACK(P, B) ((u32x4){cvt_pk_bf16(P[B], P[B + 1]), cvt_pk_bf16(P[B + 2], P[B + 3]), cvt_pk_bf16(P[B + 4], P[B + 5]), cvt_pk_bf16(P[B + 6], P[B + 7])})
__device__ __forceinline__ void mla_softmax(f32x16& p0, f32x16& p1, float& m_run, float& l_run, f32x16& o0, f32x16& o1) {
    float mx = fmaxf(p0[0], p1[0]);
#pragma unroll
    for (int r = 1; r < 16; ++r) mx = fmaxf(mx, fmaxf(p0[r], p1[r]));
    mx = xor32_max(mx);
    const float m_new = fmaxf(m_run, mx), alpha = fexp2(m_run - m_new); m_run = m_new;
    p0 = p0 - m_new; p1 = p1 - m_new;
#pragma unroll
    for (int r = 0; r < 16; ++r) { p0[r] = fexp2(p0[r]); p1[r] = fexp2(p1[r]); }
    const f32x16 ps = p0 + p1;
    const float ls = ((ps[0] + ps[1]) + (ps[2] + ps[3])) + ((ps[4] + ps[5]) + (ps[6] + ps[7])) + (((ps[8] + ps[9]) + (ps[10] + ps[11])) + ((ps[12] + ps[13]) + (ps[14] + ps[15])));
    l_run = l_run * alpha + ls;
    o0 = o0 * alpha; o1 = o1 * alpha;
}
__device__ __forceinline__ void mla_store(bf16_t* orow, const f32x16& o0, const f32x16& o1, float l_run) {
    const float inv = 1.0f / xor32_sum(l_run);
#pragma unroll
    for (int rg = 0; rg < 4; ++rg) {
        u32x2 w; w.x = cvt_pk_bf16(o0[4 * rg] * inv, o0[4 * rg + 1] * inv); w.y = cvt_pk_bf16(o0[4 * rg + 2] * inv, o0[4 * rg + 3] * inv); *(u32x2*)(orow + 8 * rg) = w;
        u32x2 w2; w2.x = cvt_pk_bf16(o1[4 * rg] * inv, o1[4 * rg + 1] * inv); w2.y = cvt_pk_bf16(o1[4 * rg + 2] * inv, o1[4 * rg + 3] * inv); *(u32x2*)(orow + 32 + 8 * rg) = w2;
    }
}
__device__ __forceinline__ void mla_unit(LAS unsigned char* lds, const bf16_t* Q, const bf16_t* KN, const bf16_t* KPE, const bf16_t* VT, bf16_t* AO, int tokbase, int S, int h, int qb, int tid) {
    constexpr int KBYTES = 12288, BUF = 20480;
    const int lane = tid & 63, wid = __builtin_amdgcn_readfirstlane(tid >> 6), r32 = lane & 31, hi = lane >> 5;
    const bf16_t* ks0 = KN + (size_t)(tokbase + lane) * 512 + h * 64 + 8 * wid;
    const bf16_t* ks1 = KPE + (size_t)(tokbase + lane) * 32 + 8 * (wid & 3);
    const bf16_t* vs = VT + (size_t)(h * 64 + lane) * TH + tokbase + 8 * wid;
#define MLA_DMA(T, B) do { LAS unsigned char* sb_ = lds + (B) * BUF; \
        __builtin_amdgcn_global_load_lds((const unsigned*)(ks0 + (size_t)(T) * (64 * 512)), (LAS unsigned*)(sb_ + wid * 1024), 16, 0, 0); \
        if (wid < 4) __builtin_amdgcn_global_load_lds((const unsigned*)(ks1 + (size_t)(T) * (64 * 32)), (LAS unsigned*)(sb_ + (8 + wid) * 1024), 16, 0, 0); \
        __builtin_amdgcn_global_load_lds((const unsigned*)(vs + (size_t)(T) * 64), (LAS unsigned*)(sb_ + KBYTES + wid * 1024), 16, 0, 0); } while (0)
#define MLA_WAITBAR_KEEP() do { if (wid < 4) asm volatile("s_waitcnt vmcnt(3)" ::: "memory"); else asm volatile("s_waitcnt vmcnt(2)" ::: "memory"); \
        asm volatile("s_waitcnt lgkmcnt(0)" ::: "memory"); __builtin_amdgcn_s_barrier(); asm volatile("" ::: "memory"); } while (0)
#define MLA_WAITBAR_ALL() do { asm volatile("s_waitcnt vmcnt(0) lgkmcnt(0)" ::: "memory"); __builtin_amdgcn_s_barrier(); asm volatile("" ::: "memory"); } while (0)
    const int NT = S / 64;
    const int qtokA = tokbase + 512 * qb + 64 * wid + r32, qtokB = qtokA + 32;
    bf16x8 qa[6], qbv[6];
#pragma unroll
    for (int d0 = 0; d0 < 6; ++d0) { qa[d0] = *(const bf16x8*)(Q + (size_t)qtokA * 768 + h * 96 + 16 * d0 + 8 * hi); qbv[d0] = *(const bf16x8*)(Q + (size_t)qtokB * 768 + h * 96 + 16 * d0 + 8 * hi); }
    asm volatile("s_waitcnt vmcnt(0)" ::: "memory");
    MLA_DMA(0, 0); MLA_DMA(1, 1);
    MLA_WAITBAR_ALL();
    f32x16 oa0, oa1, ob0, ob1;
#pragma unroll
    for (int r = 0; r < 16; ++r) { oa0[r] = 0.f; oa1[r] = 0.f; ob0[r] = 0.f; ob1[r] = 0.f; }
    float ma = -1e30f, la = 0.f, mb = -1e30f, lb = 0.f;
    for (int t = 0; t < NT; ++t) {
        if (t + 2 < NT) MLA_DMA(t + 2, (t + 2) & 3);
        const LAS unsigned char* kb = lds + (t & 3) * BUF; const LAS unsigned char* vb = kb + KBYTES;
        f32x16 pa0, pa1, pb0, pb1;
#pragma unroll
        for (int r = 0; r < 16; ++r) { pa0[r] = 0.f; pa1[r] = 0.f; pb0[r] = 0.f; pb1[r] = 0.f; }
#pragma unroll
        for (int d0 = 0; d0 < 6; ++d0) {
            const bf16x8 a0 = *(const LAS bf16x8*)(kb + (2 * d0 + hi) * 1024 + r32 * 16);
            const bf16x8 a1 = *(const LAS bf16x8*)(kb + (2 * d0 + hi) * 1024 + (32 + r32) * 16);
            pa0 = __builtin_amdgcn_mfma_f32_32x32x16_bf16(a0, qa[d0], pa0, 0, 0, 0);
            pa1 = __builtin_amdgcn_mfma_f32_32x32x16_bf16(a1, qa[d0], pa1, 0, 0, 0);
            pb0 = __builtin_amdgcn_mfma_f32_32x32x16_bf16(a0, qbv[d0], pb0, 0, 0, 0);
            pb1 = __builtin_amdgcn_mfma_f32_32x32x16_bf16(a1, qbv[d0], pb1, 0, 0, 0);
        }
        mla_softmax(pa0, pa1, ma, la, oa0, oa1);
        mla_softmax(pb0, pb1, mb, lb, ob0, ob1);
#pragma unroll
        for (int ks = 0; ks < 4; ++ks) {
            const u32x4 pwa = ks == 0 ? MLA_PACK(pa0, 0) : ks == 1 ? MLA_PACK(pa0, 8) : ks == 2 ? MLA_PACK(pa1, 0) : MLA_PACK(pa1, 8);
            const u32x4 pwb = ks == 0 ? MLA_PACK(pb0, 0) : ks == 1 ? MLA_PACK(pb0, 8) : ks == 2 ? MLA_PACK(pb1, 0) : MLA_PACK(pb1, 8);
            const bf16x8 paa = __builtin_bit_cast(bf16x8, pwa), pab = __builtin_bit_cast(bf16x8, pwb);
            const LAS unsigned char* vp = vb + (2 * ks) * 1024 + r32 * 16 + 8 * hi;
            const u32x2 a_lo = *(const LAS u32x2*)(vp), a_hi = *(const LAS u32x2*)(vp + 1024);
            const u32x2 b_lo = *(const LAS u32x2*)(vp + 512), b_hi = *(const LAS u32x2*)(vp + 1024 + 512);
            const bf16x8 vf0 = __builtin_bit_cast(bf16x8, ((u32x4){a_lo.x, a_lo.y, a_hi.x, a_hi.y}));
            const bf16x8 vf1 = __builtin_bit_cast(bf16x8, ((u32x4){b_lo.x, b_lo.y, b_hi.x, b_hi.y}));
            oa0 = __builtin_amdgcn_mfma_f32_32x32x16_bf16(vf0, paa, oa0, 0, 0, 0);
            oa1 = __builtin_amdgcn_mfma_f32_32x32x16_bf16(vf1, paa, oa1, 0, 0, 0);
            ob0 = __builtin_amdgcn_mfma_f32_32x32x16_bf16(vf0, pab, ob0, 0, 0, 0);
            ob1 = __builtin_amdgcn_mfma_f32_32x32x16_bf16(vf1, pab, ob1, 0, 0, 0);
        }
        if (t & 1) MLA_WAITBAR_ALL();
    }
#undef MLA_DMA
#undef MLA_WAITBAR_KEEP
#undef MLA_WAITBAR_ALL
    mla_store(AO + (size_t)qtokA * 1024 + h * 64 + 4 * hi, oa0, oa1, la);
    mla_store(AO + (size_t)qtokB * 1024 + h * 64 + 4 * hi, ob0, ob1, lb);
}

__device__ __forceinline__ unsigned na_vmask(int qc, int kh, int hi) {
    int cs = qc - 8; cs = cs < 0 ? 0 : cs; cs = cs > 48 ? 48 : cs; unsigned mk = 0u;
#pragma unroll
    for (int r = 0; r < 16; ++r) { const int kc = 32 * kh + (r & 3) + 8 * (r >> 2) + 4 * hi; mk |= ((kc >= cs) && (kc < cs + 16)) ? (1u << r) : 0u; }
    return mk;
}
__device__ __forceinline__ void na_qs(const bf16x8 (&kf)[4], const bf16x8 (&vf)[2][2], const bf16x8 (&qf)[4], const LAS float* brow, int qc, int kh, int hi, unsigned vmsel,
                                      float& m_run, float& l_run, f32x16& o0, f32x16& o1) {
    const float SCL = 0.125f * LOG2E;
    f32x16 p;
#pragma unroll
    for (int r = 0; r < 16; ++r) p[r] = 0.f;
#pragma unroll
    for (int d0 = 0; d0 < 4; ++d0) p = __builtin_amdgcn_mfma_f32_32x32x16_bf16(kf[d0], qf[d0], p, 0, 0, 0);
    unsigned vm = vmsel; asm volatile("" : "+v"(vm));
    float mx = -1e30f;
#pragma unroll
    for (int r = 0; r < 16; ++r) { const int kc = 32 * kh + (r & 3) + 8 * (r >> 2) + 4 * hi;
        int bi = kc - qc + 15; bi = bi < 0 ? 0 : bi; bi = bi > 30 ? 30 : bi;
        const float sc = p[r] * SCL + brow[bi]; p[r] = ((vm >> r) & 1u) ? sc : -1e30f; mx = fmaxf(mx, p[r]); }
    mx = xor32_max(mx);
    const float m_new = fmaxf(m_run, mx), alpha = fexp2(m_run - m_new); m_run = m_new;
    const float m_use = fmaxf(m_new, -1e20f);
    float ls = 0.f;
#pragma unroll
    for (int r = 0; r < 16; ++r) { const float e = fexp2(p[r] - m_use); p[r] = e; ls += e; }
    l_run = l_run * alpha + ls;
#pragma unroll
    for (int r = 0; r < 16; ++r) { o0[r] *= alpha; o1[r] *= alpha; }
#pragma unroll
    for (int k2 = 0; k2 < 2; ++k2) {
        u32x4 pw; pw.x = cvt_pk_bf16(p[8 * k2 + 0], p[8 * k2 + 1]); pw.y = cvt_pk_bf16(p[8 * k2 + 2], p[8 * k2 + 3]); pw.z = cvt_pk_bf16(p[8 * k2 + 4], p[8 * k2 + 5]); pw.w = cvt_pk_bf16(p[8 * k2 + 6], p[8 * k2 + 7]);
        const bf16x8 pa = __builtin_bit_cast(bf16x8, pw);
        o0 = __builtin_amdgcn_mfma_f32_32x32x16_bf16(vf[0][k2], pa, o0, 0, 0, 0);
        o1 = __builtin_amdgcn_mfma_f32_32x32x16_bf16(vf[1][k2], pa, o1, 0, 0, 0);
    }
}
__device__ __forceinline__ void na_store(bf16_t* orow, const f32x16& o0, const f32x16& o1, float l_run) {
    const float l = xor32_sum(l_run); const float inv = 1.0f / l;
#pragma unroll
    for (int rg = 0; rg < 4; ++rg) {
        u32x2 w; w.x = cvt_pk_bf16(o0[4 * rg] * inv, o0[4 * rg + 1] * inv); w.y = cvt_pk_bf16(o0[4 * rg + 2] * inv, o0[4 * rg + 3] * inv); *(u32x2*)(orow + 8 * rg) = w;
        u32x2 w2; w2.x = cvt_pk_bf16(o1[4 * rg] * inv, o1[4 * rg + 1] * inv); w2.y = cvt_pk_bf16(o1[4 * rg + 2] * inv, o1[4 * rg + 3] * inv); *(u32x2*)(orow + 32 + 8 * rg) = w2;
    }
}
__device__ __forceinline__ void na_unit(const LAS float* biasT, const bf16_t* Z, const bf16_t* VTn, bf16_t* AO, int tokbase, int S, int rr, int tid) {
    const int lane = tid & 63, h = tid >> 6, r32 = lane & 31, hi = lane >> 5;
    const int rows = S / 64; int rs = rr - 4; rs = rs < 0 ? 0 : rs; rs = rs > rows - 8 ? rows - 8 : rs;
    bf16x8 qfa[4], qfb[4];
#pragma unroll
    for (int d0 = 0; d0 < 4; ++d0) { qfa[d0] = *(const bf16x8*)(Z + (size_t)(tokbase + rr * 64 + r32) * ZP + 672 + h * 64 + 16 * d0 + 8 * hi);
                                      qfb[d0] = *(const bf16x8*)(Z + (size_t)(tokbase + rr * 64 + 32 + r32) * ZP + 672 + h * 64 + 16 * d0 + 8 * hi); }
    f32x16 oa0, oa1, ob0, ob1; float ma = -1e30f, mb = -1e30f, la = 0.f, lb = 0.f;
#pragma unroll
    for (int r = 0; r < 16; ++r) { oa0[r] = 0.f; oa1[r] = 0.f; ob0[r] = 0.f; ob1[r] = 0.f; }
    const unsigned va0 = na_vmask(r32, 0, hi), va1 = na_vmask(r32, 1, hi), vb0 = na_vmask(32 + r32, 0, hi), vb1 = na_vmask(32 + r32, 1, hi);
    const bf16_t* kbase = Z + (size_t)(tokbase + rs * 64 + r32) * ZP + 672 + 512 + h * 64 + 8 * hi;
    const bf16_t* vbase0 = VTn + (size_t)(h * 64 + r32) * TH + tokbase + rs * 64 + 4 * hi;
#define NA_LOADK(KF, IT) do { const int kr_ = (IT) >> 1, kh_ = (IT) & 1; const bf16_t* kp_ = kbase + (size_t)(kr_ * 64 + kh_ * 32) * ZP; \
        _Pragma("unroll") for (int d0 = 0; d0 < 4; ++d0) KF[d0] = *(const bf16x8*)(kp_ + 16 * d0); } while (0)
#define NA_LOADV(VF, IT) do { const int kr_ = (IT) >> 1, kh_ = (IT) & 1; const bf16_t* vp0_ = vbase0 + kr_ * 64 + kh_ * 32; const bf16_t* vp1_ = vp0_ + (size_t)32 * TH; \
        _Pragma("unroll") for (int k2 = 0; k2 < 2; ++k2) { const u32x2 lo = *(const u32x2*)(vp0_ + 16 * k2), hi2 = *(const u32x2*)(vp0_ + 16 * k2 + 8); VF[0][k2] = __builtin_bit_cast(bf16x8, ((u32x4){lo.x, lo.y, hi2.x, hi2.y})); \
            const u32x2 lo1 = *(const u32x2*)(vp1_ + 16 * k2), hi3 = *(const u32x2*)(vp1_ + 16 * k2 + 8); VF[1][k2] = __builtin_bit_cast(bf16x8, ((u32x4){lo1.x, lo1.y, hi3.x, hi3.y})); } } while (0)
    bf16x8 kf[4];
    NA_LOADK(kf, 0);
#pragma unroll 1
    for (int it = 0; it < 16; ++it) {
        const int kr = it >> 1, kh = it & 1;
        const LAS float* brow = biasT + (h * 15 + (rs + kr - rr + 7)) * 31;
        bf16x8 vf[2][2], kn[4];
        NA_LOADV(vf, it);
        const int itn = it + 1 < 16 ? it + 1 : 15;
        NA_LOADK(kn, itn);
        na_qs(kf, vf, qfa, brow, r32, kh, hi, kh ? va1 : va0, ma, la, oa0, oa1);
        na_qs(kf, vf, qfb, brow, 32 + r32, kh, hi, kh ? vb1 : vb0, mb, lb, ob0, ob1);
#pragma unroll
        for (int d0 = 0; d0 < 4; ++d0) kf[d0] = kn[d0];
    }
#undef NA_LOADK
#undef NA_LOADV
    na_store(AO + (size_t)(tokbase + rr * 64 + r32) * 1024 + 512 + h * 64 + 4 * hi, oa0, oa1, la);
    na_store(AO + (size_t)(tokbase + rr * 64 + 32 + r32) * 1024 + 512 + h * 64 + 4 * hi, ob0, ob1, lb);
}
#ifndef REP_SYNC
#define REP_SYNC 1
#endif
#ifndef REP_MLA
#define REP_MLA 1
#endif
#ifndef REP_NA
#define REP_NA 1
#endif
#ifndef REP_SCAN
#define REP_SCAN 1
#endif
#ifndef REP_UP
#define REP_UP 1
#endif
#ifndef REP_PASS
#define REP_PASS 1
#endif
#ifndef REP_GEMM
#define REP_GEMM 1
#endif
#define GSYNC() do { for (int r_ = 0; r_ < REP_SYNC; ++r_) xcd_barrier((unsigned*)(ap0->ws + WS_BAR), bst); } while (0)
constexpr int LDS_BYTES = 147456;
constexpr int NTHR = 512;
struct Args { const float* in[26]; float* out; unsigned char* ws; };


#define XB_TMO      128
#define XB_XCNT(j)  (256  + 64 * (j))
#define XB_XSUB(j)  (1280 + 64 * (j))
#define XB_XGEN(j)  (2304 + 64 * (j))
#define XB_TOP      3328
#define XB_TOPGEN   3392
#define XCD_BAR_WORDS 3456
#define XB_SPIN_CAP (1u << 22)
__device__ __forceinline__ unsigned xb_ld(unsigned* p)              { return __hip_atomic_load(p, __ATOMIC_RELAXED, __HIP_MEMORY_SCOPE_AGENT); }
__device__ __forceinline__ unsigned xb_add(unsigned* p, unsigned v) { return __hip_atomic_fetch_add(p, v, __ATOMIC_RELAXED, __HIP_MEMORY_SCOPE_AGENT); }
__device__ __forceinline__ unsigned xb_xcc_id() { return (unsigned)__builtin_amdgcn_s_getreg((3 << 11) | 20) & 0xFu; }
#define XB_SPIN(cond, bar) do { unsigned _sp = 0; while (cond) { __builtin_amdgcn_s_sleep(1); \
    if ((++_sp & 255u) == 0u) { if (xb_ld(&(bar)[XB_TMO])) break; if (_sp > XB_SPIN_CAP) { atomicAdd(&(bar)[XB_TMO], 1u); break; } } } } while (0)
__device__ __forceinline__ void xcd_barrier_complete(unsigned* bar, unsigned x, unsigned& nloc, unsigned& nx) {
    const unsigned G = gridDim.x;
    unsigned sum, cnt, mine, sp = 0u;
    for (;;) {
        sum = 0u; cnt = 0u; mine = 0u;
#pragma unroll
        for (unsigned j = 0; j < 16; ++j) { const unsigned c = xb_ld(&bar[XB_XCNT(j)]); sum += c; cnt += (c > 0u) ? 1u : 0u; mine = (j == x) ? c : mine; }
        if (sum == G) break;
        __builtin_amdgcn_s_sleep(1);
        if ((++sp & 255u) == 0u) { if (xb_ld(&bar[XB_TMO])) break; if (sp > XB_SPIN_CAP) { atomicAdd(&bar[XB_TMO], 1u); break; } }
    }
    nloc = mine > 0u ? mine : 1u; nx = cnt > 0u ? cnt : 1u;
}
__device__ __forceinline__ void xcd_barrier(unsigned* bar, volatile LAS unsigned* st) {
    asm volatile("s_waitcnt vmcnt(0)" ::: "memory");
    __syncthreads();
    if (threadIdx.x == 0) {
        __builtin_amdgcn_s_waitcnt(0);
        const unsigned x = xb_xcc_id();
        unsigned nloc = st[0], nx = st[1];
        if (nloc == 0u) { xcd_barrier_complete(bar, x, nloc, nx); st[0] = nloc; st[1] = nx; }
        const unsigned old = xb_add(&bar[XB_XSUB(x)], 1u);
        const unsigned gen = old / nloc;
        if (old + 1u == (gen + 1u) * nloc) {
            __builtin_amdgcn_fence(__ATOMIC_RELEASE, "agent");
            asm volatile("s_waitcnt vmcnt(0)" ::: "memory");
            const unsigned og = xb_add(&bar[XB_TOP], 1u);
            const unsigned tg = og / nx;
            if (og + 1u == (tg + 1u) * nx) xb_add(&bar[XB_TOPGEN], 1u);
            else XB_SPIN(xb_ld(&bar[XB_TOPGEN]) == tg, bar);
            __builtin_amdgcn_fence(__ATOMIC_ACQUIRE, "agent");
            xb_add(&bar[XB_XGEN(x)], 1u);
            asm volatile("s_waitcnt vmcnt(0)" ::: "memory");
        } else {
            XB_SPIN(xb_ld(&bar[XB_XGEN(x)]) == gen, bar);
            __builtin_amdgcn_fence(__ATOMIC_ACQUIRE, "agent");
            asm volatile("s_waitcnt vmcnt(0)" ::: "memory");
        }
    }
    __syncthreads();
}

__global__ void __launch_bounds__(NTHR, 2) mk_fwd(Args a) {
    extern __shared__ __attribute__((aligned(16))) unsigned char lds_raw[];
    LAS unsigned char* lds = (LAS unsigned char*)lds_raw;
    cg::grid_group grid = cg::this_grid();
    volatile LAS unsigned* bst = (volatile LAS unsigned*)(lds + LDS_BYTES - 64);
    if (threadIdx.x == 0) { bst[0] = 0u; bst[1] = 0u; }
    typedef const __attribute__((address_space(4))) Args* ArgP;
    ArgP ap0 = (ArgP)__builtin_amdgcn_kernarg_segment_ptr();
#define PH_BEGIN ArgP ap = ap0; asm volatile("" : "+s"(ap)); unsigned char* ws = ap->ws; (void)ws; int tid_ = threadIdx.x; asm volatile("" : "+v"(tid_)); const int tid = tid_, lane = tid & 63, wave = tid >> 6; int G_ = gridDim.x, bid_ = blockIdx.x; asm volatile("" : "+s"(G_), "+s"(bid_)); const int G = G_, bid = bid_; const int gw = bid * 8 + wave, NGW = G * 8; const int gt = bid * NTHR + tid, NGT = G * NTHR; (void)lane; (void)gw; (void)NGW; (void)gt; (void)NGT;
#define IN(k) (ap->in[k])
#define rsq ((float*)(ws + WS_RSQ))
#define rskv ((float*)(ws + WS_RSKV))
#define rope ((float2*)(ws + WS_ROPE))
#define AGG ((float2*)(ws + WS_AGG))
#define CARRY ((float*)(ws + WS_CARRY))
#define YB ((bf16_t*)(ws + WS_YB))
#define W_INATT ((bf16_t*)(ws + WS_W_INATT))
#define W_UQ ((bf16_t*)(ws + WS_W_UQ))
#define W_UKV ((bf16_t*)(ws + WS_W_UKV))
#define W_OUTATT ((bf16_t*)(ws + WS_W_OUTATT))
#define W_INREC ((bf16_t*)(ws + WS_W_INREC))
#define W_GATES ((bf16_t*)(ws + WS_W_GATES))
#define W_OUTREC ((bf16_t*)(ws + WS_W_OUTREC))
#define W_UP ((bf16_t*)(ws + WS_W_UP))
#define W_DOWN ((bf16_t*)(ws + WS_W_DOWN))
#define XN ((bf16_t*)(ws + WS_XN))
#define Zb ((bf16_t*)(ws + WS_Z))
#define Qb ((bf16_t*)(ws + WS_Q))
#define KN ((bf16_t*)(ws + WS_KN))
#define VTM ((bf16_t*)(ws + WS_VTM))
#define VTN ((bf16_t*)(ws + WS_VTN))
#define KPE ((bf16_t*)(ws + WS_KPE))
#define ACT ((bf16_t*)(ws + WS_ACT))
#define GATE ((bf16_t*)(ws + WS_GATE))
#define XB ((bf16_t*)(ws + WS_XB))
#define XBR ((bf16_t*)(ws + WS_XBR))
#define GQ ((bf16_t*)(ws + WS_GQ))
#define AO XN
#define Fb XN
#define YR XN
#define M0 Zb
#define M1 XBR
#define XIN (IN(half))
#define XST (ap->out + (size_t)half * TH * DM)
    { PH_BEGIN
    {
        LAS float* scr = (LAS float*)(lds + wave * 16384);
        constexpr int I_INATT = 16 * 69, I_UQ = 6 * 24, I_UKV = 4 * 32, I_SQ = 16 * 32, I_INREC = 16 * 64, I_UP = 16 * 256, I_DOWN = 64 * 32, I_GATE = 32 * 8;
        constexpr int NITEMS = I_INATT + I_UQ + I_UKV + 2 * I_SQ + I_INREC + 2 * I_UP + 2 * I_DOWN + I_GATE;
        for (int rep_ = 0; rep_ < REP_PASS; ++rep_)
        for (int it = gw; it < NITEMS; it += NGW) {
            int r = it;
            if (r < I_INATT) { transpose_item(IN(6), 1024, 2208, W_INATT, 0, nullptr, scr, r, lane); continue; } r -= I_INATT;
            if (r < I_UQ) { transpose_item(IN(8), 384, 768, W_UQ, 0, IN(7), scr, r, lane); continue; } r -= I_UQ;
            if (r < I_UKV) { transpose_item(IN(10), 256, 1024, W_UKV, 0, IN(9), scr, r, lane); continue; } r -= I_UKV;
            if (r < I_SQ) { transpose_item(IN(12), 1024, 1024, W_OUTATT, 0, nullptr, scr, r, lane); continue; } r -= I_SQ;
            if (r < I_SQ) { transpose_item(IN(21), 1024, 1024, W_OUTREC, 0, nullptr, scr, r, lane); continue; } r -= I_SQ;
            if (r < I_INREC) { transpose_item(IN(13), 1024, 2048, W_INREC, 0, nullptr, scr, r, lane); continue; } r -= I_INREC;
            if (r < 2 * I_UP) { const int li = r / I_UP; transpose_item(IN(22) + (size_t)li * 1024 * 8192, 1024, 8192, W_UP + (size_t)li * 8192 * 1024, 0, nullptr, scr, r % I_UP, lane); continue; } r -= 2 * I_UP;
            if (r < 2 * I_DOWN) { const int li = r / I_DOWN; transpose_item(IN(25) + (size_t)li * 4096 * 1024, 4096, 1024, W_DOWN + (size_t)li * 1024 * 4096, 0, nullptr, scr, r % I_DOWN, lane); continue; } r -= 2 * I_DOWN;
            { const int mat = r / 8, sub = r % 8; const int type = mat >> 4, e = (mat >> 3) & 1, n = mat & 7;
              transpose_item(IN(type ? 18 : 16) + (size_t)(e * 8 + n) * 128 * 128, 128, 128, W_GATES, n * 512 + e * 256 + type * 128, nullptr, scr, sub, lane); }
        }
        if (bid == 0) for (int i = tid; i < XCD_BAR_WORDS; i += NTHR) ((unsigned*)(ws + WS_BAR))[i] = 0u;
        for (int i = gt; i < 8 * 64 * 64; i += NGT) ((unsigned*)(ws + WS_CNT))[i] = 0u;
        for (int i = gt; i < 96 * 1024 / 8; i += NGT) ((u32x4*)(W_INATT + (size_t)2208 * 1024))[i] = (u32x4){0, 0, 0, 0};
        for (int m = gw; m < TH; m += NGW) xn_row(IN(0) + (size_t)m * DM, IN(2), XN + (size_t)m * DM, lane);
        for (int i = gt; i < 4096 * 16; i += NGT) { const int pos = i >> 4, j = i & 15;
            const double inv = exp2(-(double)j * (13.287712379549449 / 16.0));
            const double rev = (double)pos * inv * 0.15915494309189535; const float fr = (float)(rev - floor(rev));
            rope[i] = make_float2(__builtin_amdgcn_cosf(fr), __builtin_amdgcn_sinf(fr)); }
    }

    }
    grid.sync();
    if (threadIdx.x == 0) (void)xb_add((unsigned*)(ap0->ws + WS_BAR) + XB_XCNT(xb_xcc_id()), 1u);
    for (int half = 0; half < 2; ++half) {
        const int S = half ? 4096 : 2048, nseq = TH / S;
        if (half == 1 && gridDim.x != 256) {
                { PH_BEGIN
        for (int m = gw; m < TH; m += NGW) xn_row(XIN + (size_t)m * DM, IN(2), XN + (size_t)m * DM, lane);
        }
        GSYNC();
        }
        { PH_BEGIN
        { pg8::Gemm g = pg8::make_gemm(XN, DM, W_INATT, DM, DM); pg8::StaticOrder so; so.init(TH / 256, ZP / 256, G, bid);
          EpiZ E{Zb, VTN, (float*)(ws + WS_SQP), nullptr, KPE, rope, S - 1};
#ifndef NO_G1
for (int rep_ = 0; rep_ < REP_GEMM; ++rep_) pg8::gemm_phase<EpiZ>(lds, g, so, E);
#endif
 }
        }
        GSYNC();
        { PH_BEGIN
        { pg8::Gemm g = pg8::make_gemm(Zb, ZP, W_UQ, 384, 384); pg8::StaticOrder so; so.init(TH / 256, 3, G, bid);
          EpiQ E{Qb, (const float*)(ws + WS_SQP), rope, S - 1};
#ifndef NO_G2
for (int rep_ = 0; rep_ < REP_GEMM; ++rep_) pg8::gemm_phase<EpiQ>(lds, g, so, E);
#endif
 }
        { pg8::Gemm g = pg8::make_gemm(Zb + 384, ZP, W_UKV, 256, 256); pg8::StaticOrder so; so.init(TH / 256, 4, G, bid);
          EpiKV E{KN, VTM, (const float*)(ws + WS_SQP)};
#ifndef NO_G3
for (int rep_ = 0; rep_ < REP_GEMM; ++rep_) pg8::gemm_phase<EpiKV>(lds, g, so, E);
#endif
 }
        }
        GSYNC();
        { PH_BEGIN
        {
            LAS float* biasT = (LAS float*)(lds + 98304);
            for (int i = tid; i < 8 * 15 * 31; i += NTHR) biasT[i] = IN(11)[i] * LOG2E;
            __syncthreads();
            const int nqb = S / 512, nunits = nseq * 8 * nqb;
            const int vb = (G % 8 == 0) ? (bid % 8) * (G / 8) + bid / 8 : bid;
#ifdef DELAY_P4A
        { const unsigned long long t0_ = __builtin_amdgcn_s_memrealtime(); while (__builtin_amdgcn_s_memrealtime() - t0_ < 40000ull) __builtin_amdgcn_s_sleep(32); }
#endif
#ifndef NO_MLA
            for (int rep_ = 0; rep_ < REP_MLA; ++rep_) {
#ifdef REP_MLA_SYNC
            if (rep_ > 0) GSYNC();
#endif
#ifdef REP_DELAY
            if (rep_ > 0) { const unsigned long long t0_ = __builtin_amdgcn_s_memrealtime(); while (__builtin_amdgcn_s_memrealtime() - t0_ < 40000ull) __builtin_amdgcn_s_sleep(32); continue; }
#endif
            for (int u = vb; u < nunits; u += G) { const int qb = u % nqb, h = (u / nqb) & 7, s = u / (nqb * 8);
                mla_unit(lds, Qb, KN, KPE, VTM, AO, s * S, S, h, qb, tid); }
            }
#endif
#ifdef MLA_TWICE
            for (int u = vb; u < nunits; u += G) { const int qb = u % nqb, h = (u / nqb) & 7, s = u / (nqb * 8);
                mla_unit(lds, Qb, KN, KPE, VTM, AO, s * S, S, h, qb, tid); }
#endif
            const int rows = S / 64, nna = nseq * rows;
#ifdef DELAY_P4B
        { const unsigned long long t0_ = __builtin_amdgcn_s_memrealtime(); while (__builtin_amdgcn_s_memrealtime() - t0_ < 40000ull) __builtin_amdgcn_s_sleep(32); }
#endif
#ifdef RELOAD_BIAS
            __syncthreads();
            for (int i = tid; i < 8 * 15 * 31; i += NTHR) biasT[i] = IN(11)[i] * LOG2E;
            __syncthreads();
#endif
#ifndef NO_NA
            for (int rep_ = 0; rep_ < REP_NA; ++rep_)
            for (int u = vb; u < nna; u += G) na_unit(biasT, Zb, VTN, AO, (u / rows) * S, S, u % rows, tid);
#endif
        }
        }
        GSYNC();
        { PH_BEGIN
        { pg8::Gemm g = pg8::make_gemm(AO, DM, W_OUTATT, DM, DM); pg8::StaticOrder so; so.init(TH / 256, 4, G, bid);
          EpiBf16 E{M0, DM, 0, 0};
#ifndef NO_G4
for (int rep_ = 0; rep_ < REP_GEMM; ++rep_) pg8::gemm_phase<EpiBf16>(lds, g, so, E);
#endif
 }
        }
        GSYNC();
        { PH_BEGIN
        for (int m = gw; m < TH; m += 2 * NGW) { const int m2 = m + NGW; if (m2 < TH) res_row2(M0 + (size_t)m * DM, M0 + (size_t)m2 * DM, XIN + (size_t)m * DM, XIN + (size_t)m2 * DM, XST + (size_t)m * DM, XST + (size_t)m2 * DM, IN(3), IN(4), XN + (size_t)m * DM, XN + (size_t)m2 * DM, lane); else res_row(M0 + (size_t)m * DM, XIN + (size_t)m * DM, XST + (size_t)m * DM, IN(3), IN(4), XN + (size_t)m * DM, lane); }
        }
        GSYNC();

        for (int li = 0; li < 2; ++li) {
            if (li == 1) {
                { PH_BEGIN
                { pg8::Gemm g = pg8::make_gemm(XN, DM, W_INREC, DM, DM); pg8::StaticOrder so; so.init(TH / 256, 8, G, bid);
                  EpiBf16 E{GATE, DM, 1024, (size_t)(WS_XBR - WS_GATE) / 2};
#ifndef NO_G5
for (int rep_ = 0; rep_ < REP_GEMM; ++rep_) pg8::gemm_phase<EpiBf16>(lds, g, so, E);
#endif
 }
                }
                GSYNC();
                { PH_BEGIN
                for (int rep_ = 0; rep_ < REP_PASS; ++rep_)
                for (int i = gt; i < TH * 128; i += NGT) { const int t = i >> 7, c8 = (i & 127) * 8; const int pos = t & (S - 1);
                    float accv[8];
#pragma unroll
                    for (int j = 0; j < 8; ++j) accv[j] = IN(15)[c8 + j];
#pragma unroll
                    for (int k = 0; k < 4; ++k) { const int p2 = pos + k - 1; if (p2 < 0 || p2 >= S) continue;
                        const u32x4 w = *(const u32x4*)(XBR + (size_t)(t + k - 1) * DM + c8); const float* cwk = IN(14) + k * 1024 + c8;
                        accv[0] += cwk[0] * bflo(w.x); accv[1] += cwk[1] * bfhi(w.x); accv[2] += cwk[2] * bflo(w.y); accv[3] += cwk[3] * bfhi(w.y);
                        accv[4] += cwk[4] * bflo(w.z); accv[5] += cwk[5] * bfhi(w.z); accv[6] += cwk[6] * bflo(w.w); accv[7] += cwk[7] * bfhi(w.w); }
                    u32x4 o; o.x = cvt_pk_bf16(accv[0], accv[1]); o.y = cvt_pk_bf16(accv[2], accv[3]); o.z = cvt_pk_bf16(accv[4], accv[5]); o.w = cvt_pk_bf16(accv[6], accv[7]);
                    *(u32x4*)(XB + (size_t)t * DM + c8) = o; }
                }
                GSYNC();
                for (int qt = 0; qt < 2; ++qt) {
                    const int t0 = qt * TQ;
                    { PH_BEGIN
                    { pg8::Gemm g = pg8::make_gemm(XB + (size_t)t0 * DM, DM, W_GATES, 128, 128); g.a_pn_shift = 1; g.a_pn_step = 256; g.a_seg = 1; g.hA = (size_t)4 * DM * 2;
                      pg8::StaticOrder so; so.init(TQ / 256, 16, G, bid);
                      EpiGates E{GQ, XB + (size_t)t0 * DM, AGG, IN(17), IN(19), IN(20)};
                      pg8::gemm_phase<EpiGates>(lds, g, so, E);
 }
                    }
                    GSYNC();
                    { PH_BEGIN
                    { const int cps = S / 32, nsq = TQ / S;
                      for (int rep_ = 0; rep_ < REP_SCAN; ++rep_)
                      for (int i = gt; i < nsq * 2 * 1024; i += NGT) { const int ch = i & 1023, e = (i >> 10) & 1, sq = i >> 11;
                          float hcar = 0.f;
#pragma unroll 16
                          for (int k = 0; k < cps; ++k) { const int c = sq * cps + (e ? cps - 1 - k : k); const int idx = (c * 2 + e) * 1024 + ch;
                              CARRY[idx] = hcar; const float2 ab = AGG[idx]; hcar = ab.x * hcar + ab.y; } } }
                    }
                    GSYNC();
                    { PH_BEGIN
#ifndef NO_R6
                    for (int rep_ = 0; rep_ < REP_SCAN; ++rep_)
                    for (int i = gt; i < 256 * 512; i += NGT) { const int cp = i & 511, c = i >> 9; const int ch = 2 * cp, n = ch >> 7, d = ch & 127;
                        const bf16_t* gq0 = GQ + (size_t)(c * 32) * 4096 + n * 512 + d;
                        bf16_t* yr0 = YR + (size_t)(t0 + c * 32) * DM + ch; const bf16_t* gt0 = GATE + (size_t)(t0 + c * 32) * DM + ch;
                        unsigned hfw[32];
                        { const float2 hc2 = *(const float2*)(CARRY + (size_t)(c * 2 + 0) * 1024 + ch); float h0 = hc2.x, h1 = hc2.y;
#pragma unroll
                          for (int s = 0; s < 32; ++s) {
                            const unsigned l2 = *(const unsigned*)(gq0 + (size_t)s * 4096), b2 = *(const unsigned*)(gq0 + (size_t)s * 4096 + 128);
                            h0 = fexp2(bflo(l2)) * h0 + bflo(b2); h1 = fexp2(bfhi(l2)) * h1 + bfhi(b2);
                            hfw[s] = cvt_pk_bf16(h0, h1); } }
                        { const float2 hc2 = *(const float2*)(CARRY + (size_t)(c * 2 + 1) * 1024 + ch); float h0 = hc2.x, h1 = hc2.y;
                          unsigned lq[32], bq[32], gq_[32];
#pragma unroll
                          for (int s = 0; s < 32; ++s) { lq[s] = *(const unsigned*)(gq0 + (size_t)s * 4096 + 256); bq[s] = *(const unsigned*)(gq0 + (size_t)s * 4096 + 384); gq_[s] = *(const unsigned*)(gt0 + (size_t)s * DM); }
#pragma unroll
                          for (int s = 31; s >= 0; --s) {
                            const unsigned l2 = lq[s], b2 = bq[s];
                            h0 = fexp2(bflo(l2)) * h0 + bflo(b2); h1 = fexp2(bfhi(l2)) * h1 + bfhi(b2);
                            const unsigned g2 = gq_[s], f2 = hfw[s];
                            *(unsigned*)(yr0 + (size_t)s * DM) = cvt_pk_bf16((bflo(f2) + h0) * gelu_tanh(bflo(g2)), (bfhi(f2) + h1) * gelu_tanh(bfhi(g2))); } }
                    }
#endif
                    }
                    GSYNC();
                }
                { PH_BEGIN
                { pg8::Gemm g = pg8::make_gemm(YR, DM, W_OUTREC, DM, DM); pg8::StaticOrder so; so.init(TH / 256, 4, G, bid);
                  EpiBf16 E{M1, DM, 0, 0};
#ifndef NO_G7
for (int rep_ = 0; rep_ < REP_GEMM; ++rep_) pg8::gemm_phase<EpiBf16>(lds, g, so, E);
#endif
 }
                }
                GSYNC();
                { PH_BEGIN
                for (int m = gw; m < TH; m += 2 * NGW) { const int m2 = m + NGW; if (m2 < TH) res_row2(M1 + (size_t)m * DM, M1 + (size_t)m2 * DM, XST + (size_t)m * DM, XST + (size_t)m2 * DM, XST + (size_t)m * DM, XST + (size_t)m2 * DM, IN(3) + 1024, IN(4) + 1024, XN + (size_t)m * DM, XN + (size_t)m2 * DM, lane); else res_row(M1 + (size_t)m * DM, XST + (size_t)m * DM, XST + (size_t)m * DM, IN(3) + 1024, IN(4) + 1024, XN + (size_t)m * DM, lane); }
                }
                GSYNC();
            }
            { PH_BEGIN
            { pg8::Gemm g = pg8::make_gemm(XN, DM, W_UP + (size_t)li * 8192 * 1024, DM, DM);
              g.a_seg = 1; g.hA = (size_t)4 * DM * 2; g.tB = (size_t)128 * DM * 2; g.hB = (size_t)4096 * DM * 2;
              pg8::StaticOrder so; so.init(TH / 256, 32, G, bid);
#ifndef NO_UP
              EpiUp E{ACT, YB, IN(23) + (size_t)li * 3 * 8192, IN(24) + (size_t)li * 8192}; for (int rep_ = 0; rep_ < REP_UP; ++rep_) pg8::gemm_phase<EpiUp>(lds, g, so, E);
#endif
 }
            }
            GSYNC();
            { PH_BEGIN
            for (int rep_ = 0; rep_ < REP_PASS; ++rep_)
            for (int b = bid; b < 256; b += G) { const int seg = b >> 1, which = b & 1; const int t = seg * 128 + (which ? 127 : 0); const int pos = t & (S - 1);
                const float* cw = IN(23) + (size_t)li * 3 * 8192; const float* cb = IN(24) + (size_t)li * 8192;
                const bool hasp = which ? true : (pos != 0), hasn = which ? (pos != S - 1) : true;
                const bf16_t* yp = which ? YB + ((size_t)seg * 4 + 2) * 8192 : YB + ((size_t)(seg - 1) * 4 + 3) * 8192;
                const bf16_t* yc = YB + ((size_t)seg * 4 + (which ? 3 : 0)) * 8192;
                const bf16_t* yn = which ? YB + ((size_t)(seg + 1) * 4 + 0) * 8192 : YB + ((size_t)seg * 4 + 1) * 8192;
                for (int c = tid; c < 4096; c += NTHR) {
                    float u2[2];
#pragma unroll
                    for (int bj = 0; bj < 2; ++bj) { const int ch = bj * 4096 + c;
                        float r = cw[8192 + ch] * bf2f(yc[ch]) + cb[ch];
                        if (hasp) r += cw[ch] * bf2f(yp[ch]);
                        if (hasn) r += cw[2 * 8192 + ch] * bf2f(yn[ch]);
                        u2[bj] = r; }
                    ACT[(size_t)t * DFF + c] = f2bf(gelu_tanh(u2[0]) * u2[1]); } }
            }
            GSYNC();
            if (gridDim.x == 256) {
                { PH_BEGIN
                { pg8::Gemm g = pg8::make_gemm(ACT, DFF, W_DOWN + (size_t)li * 1024 * 4096, DFF, DFF); pg8::StaticOrder so; so.init(TH / 256, 4, G, bid);
                  const int use = half * 2 + li;
                  EpiRms E{XST, li == 0 ? XN : nullptr, IN(5) + li * 1024, IN(2) + 1024, (float*)(ws + WS_XBUF), (float*)(ws + WS_XBUF) + (size_t)TH * 4,
                           (unsigned*)(ws + WS_CNT) + (size_t)(use * 2) * 4096, (unsigned*)(ws + WS_CNT) + (size_t)(use * 2 + 1) * 4096};
                  pg8::gemm_phase<EpiRms>(lds, g, so, E); }
                if (half == 0 && li == 1)
                  { for (int m = gw; m < TH; m += NGW) xn_row(IN(1) + (size_t)m * DM, IN(2), XN + (size_t)m * DM, lane);
                  }
                }
                GSYNC();
            } else {
                { PH_BEGIN
                { pg8::Gemm g = pg8::make_gemm(ACT, DFF, W_DOWN + (size_t)li * 1024 * 4096, DFF, DFF); pg8::StaticOrder so; so.init(TH / 256, 4, G, bid);
                  EpiBf16 E{Fb, DM, 0, 0};
                  pg8::gemm_phase<EpiBf16>(lds, g, so, E); }
                }
                GSYNC();
                { PH_BEGIN
                for (int m = gw; m < TH; m += NGW) res_row(Fb + (size_t)m * DM, XST + (size_t)m * DM, XST + (size_t)m * DM, IN(5) + li * 1024, li == 0 ? IN(2) + 1024 : nullptr, XN + (size_t)m * DM, lane);
                }
                GSYNC();
            }
        }
    }
}

extern "C" void kernel_launch(void* const* d_in, const int* in_sizes, int n_in, void* d_out, int out_size, void* d_ws, size_t ws_size, hipStream_t stream) {
    static int grid = 0;
    if (grid == 0) {
        int dev = 0, cus = 0, per_cu = 0;
        (void)hipGetDevice(&dev);
        (void)hipDeviceGetAttribute(&cus, hipDeviceAttributeMultiprocessorCount, dev);
        (void)hipFuncSetAttribute((const void*)mk_fwd, hipFuncAttributeMaxDynamicSharedMemorySize, LDS_BYTES);
        (void)hipOccupancyMaxActiveBlocksPerMultiprocessor(&per_cu, (const void*)mk_fwd, NTHR, LDS_BYTES);
        if (per_cu < 1) per_cu = 1;
        grid = cus * per_cu;
        if (ws_size < WS_END || n_in != 26) { fprintf(stderr, "kernel_launch: unexpected ws_size %zu / n_in %d\n", ws_size, n_in); }
    }
    Args a{};
    for (int i = 0; i < 26; ++i) a.in[i] = (const float*)d_in[i];
    a.out = (float*)d_out; a.ws = (unsigned char*)d_ws;
    void* args[] = {&a};
    hipError_t e = hipLaunchCooperativeKernel((const void*)mk_fwd, dim3(grid), dim3(NTHR), args, LDS_BYTES, stream);
    if (e != hipSuccess) fprintf(stderr, "cooperative launch failed: %s (grid %d)\n", hipGetErrorString(e), grid);
}
```

```cpp
#include <hip/hip_runtime.h>
#include <hip/hip_cooperative_groups.h>
#include <cstdio>
#include <cstdint>
namespace cg = cooperative_groups;

#define LAS __attribute__((address_space(3)))
typedef unsigned short bf16_t;
typedef short bf16x8 __attribute__((ext_vector_type(8)));
typedef short s16x4 __attribute__((ext_vector_type(4)));
typedef float f32x4 __attribute__((ext_vector_type(4)));
typedef float f32x16 __attribute__((ext_vector_type(16)));
typedef unsigned u32x4 __attribute__((ext_vector_type(4)));
typedef unsigned u32x2 __attribute__((ext_vector_type(2)));

__device__ __forceinline__ unsigned cvt_pk_bf16(float lo, float hi) { unsigned r; asm volatile("v_cvt_pk_bf16_f32 %0, %1, %2" : "=v"(r) : "v"(lo), "v"(hi)); return r; }
__device__ __forceinline__ float bf2f(bf16_t v) { return __uint_as_float(((unsigned)v) << 16); }
__device__ __forceinline__ float bflo(unsigned w) { return __uint_as_float(w << 16); }
__device__ __forceinline__ float bfhi(unsigned w) { return __uint_as_float(w & 0xffff0000u); }
__device__ __forceinline__ bf16_t f2bf(float f) { return (bf16_t)(cvt_pk_bf16(f, 0.f) & 0xffffu); }
__device__ __forceinline__ float fexp2(float x) { return __builtin_amdgcn_exp2f(x); }
__device__ __forceinline__ float frcp(float x) { return __builtin_amdgcn_rcpf(x); }
__device__ __forceinline__ float gelu_tanh(float x) {
    const float u = x * (1.0f + 0.044715f * x * x) * (-2.0f * 0.7978845608028654f * 1.4426950408889634f);
    return x * frcp(1.0f + fexp2(u));
}
__device__ __forceinline__ float sigmoidf_(float x) { return frcp(1.0f + fexp2(-1.4426950408889634f * x)); }
__device__ __forceinline__ float bperm_f(int src_lane, float v) { return __int_as_float(__builtin_amdgcn_ds_bpermute(src_lane << 2, __float_as_int(v))); }
#define DPP_F(V, CTRL) __int_as_float(__builtin_amdgcn_mov_dpp(__float_as_int(V), (CTRL), 0xf, 0xf, true))
__device__ __forceinline__ float wave_sum(float v, int  ) {
    v += DPP_F(v, 0xB1);
    v += DPP_F(v, 0x4E);
    v += DPP_F(v, 0x141);
    v += DPP_F(v, 0x140);
    const int iv = __float_as_int(v);
    return (__int_as_float(__builtin_amdgcn_readlane(iv, 0)) + __int_as_float(__builtin_amdgcn_readlane(iv, 16))) + (__int_as_float(__builtin_amdgcn_readlane(iv, 32)) + __int_as_float(__builtin_amdgcn_readlane(iv, 48)));
}
__device__ __forceinline__ float xor32_max(float v) { auto rr = __builtin_amdgcn_permlane32_swap(__float_as_uint(v), __float_as_uint(v), false, false); return fmaxf(__uint_as_float(rr[0]), __uint_as_float(rr[1])); }
__device__ __forceinline__ float xor32_sum(float v) { auto rr = __builtin_amdgcn_permlane32_swap(__float_as_uint(v), __float_as_uint(v), false, false); return __uint_as_float(rr[0]) + __uint_as_float(rr[1]); }

__device__ __forceinline__ void lru_ab(float ga, float gx, float gab, float gxb, float spl  , float xb, float& a, float& b) {
    const float r = sigmoidf_(ga + gab), ii = sigmoidf_(gx + gxb);
    const float la2 = (-8.0f * 1.4426950408889634f) * r * spl;
    a = fexp2(la2);
    const float om = 1.0f - a * a;
    b = __builtin_amdgcn_sqrtf(om) * (ii * xb);
}


__device__ __forceinline__ void lru_lb(float ga, float gx, float gab, float gxb, float spl, float xb, float& la2, float& b) {
    const float r = sigmoidf_(ga + gab), ii = sigmoidf_(gx + gxb);
    la2 = (-8.0f * 1.4426950408889634f) * r * spl;
    const float a = fexp2(la2); const float om = 1.0f - a * a;
    b = __builtin_amdgcn_sqrtf(om) * (ii * xb);
}

namespace pg8 {
constexpr int BM = 256, BK = 64, HALF = 128, HTB = HALF * BK * 2, STAGE_BYTES = 8 * HTB, NXCD = 8, WGM = 8;
__host__ __device__ __forceinline__ int lds_byte(int r, int c) { const int st = (r >> 4) * 2 + (c >> 5), rr = r & 15, cc = c & 31, ob = rr * 64 + cc * 2; return st * 1024 + (ob ^ (((ob >> 9) & 1) << 5)); }
__host__ __device__ __forceinline__ void stage_rc(int b, int& R, int& C) { const int st = b / 1024, sb = b % 1024, swz = sb ^ (((sb >> 9) & 1) << 5); R = (st >> 1) * 16 + swz / 64; C = (st & 1) * 32 + (swz % 64) / 2; }
__host__ __device__ __forceinline__ int perm32(int rho) { const int n = rho >> 4, i = rho & 15; return 8 * (i >> 2) + 4 * n + (i & 3); }

struct Unit { int pm, pn; };
struct Gemm { const bf16_t* A; const bf16_t* Bt; int lda, ldb, K; size_t tA, hA, tB, hB; int a_seg; int a_pn_shift; size_t a_pn_step; };
__device__ __forceinline__ Gemm make_gemm(const bf16_t* A, int lda, const bf16_t* Bt, int ldb, int K) {
    Gemm g; g.A = A; g.Bt = Bt; g.lda = lda; g.ldb = ldb; g.K = K; g.tA = (size_t)256 * lda * 2; g.hA = (size_t)128 * lda * 2; g.tB = (size_t)256 * ldb * 2; g.hB = (size_t)128 * ldb * 2;
    g.a_seg = 0; g.a_pn_shift = 0; g.a_pn_step = 0; return g;
}

struct StaticOrder {
    int nM, nN, nwg, G, c;
    __device__ __forceinline__ void init(int nM_, int nN_, int G_, int c_) { nM = nM_; nN = nN_; nwg = nM * nN; G = G_; c = c_; }
    __device__ __forceinline__ bool next(int i, Unit& u) const {
        const long L = (long)i * G + c; if (L >= nwg) return false;
        int wgid = (int)L; { const int q = nwg / NXCD, r = nwg % NXCD, xcd = wgid % NXCD, off = wgid / NXCD; wgid = (xcd < r ? xcd * (q + 1) : r * (q + 1) + (xcd - r) * q) + off; }
        const int nig = WGM * nN, gid = wgid / nig, fm = gid * WGM, gsz = (nM - fm) < WGM ? (nM - fm) : WGM;
        u.pm = fm + ((wgid % nig) % gsz); u.pn = (wgid % nig) / gsz; return true;
    }
};

template <class Epi>
__device__ __forceinline__ void gemm_phase(LAS unsigned char* lds, const Gemm g, const StaticOrder& S, const Epi& E) {
    constexpr bool SP2 = true, ALIGN_EPI = true;
    int tid_ = threadIdx.x; asm volatile("" : "+v"(tid_));
    const int tid = tid_, wid = __builtin_amdgcn_readfirstlane(tid >> 6), lane = tid & 63, wr = wid >> 2, wc = wid & 3, fr = lane & 15, fq = lane >> 4;
    int K_ = g.K; asm volatile("" : "+s"(K_)); const int K = K_, nt = K / BK;
    unsigned voffA[2], voffB[2];
#pragma unroll
    for (int i = 0; i < 2; ++i) { int R, C; stage_rc(tid * 16 + i * 8192, R, C); const int Rb = Epi::PERM ? ((R & ~31) + perm32(R & 31)) : R;
        const int Ra = g.a_seg ? (128 * (R >> 6) + 8 * (R & 15) + ((R >> 4) & 3)) : R;
        voffA[i] = (unsigned)(Ra * g.lda + C) * 2u; voffB[i] = (unsigned)(Rb * g.ldb + C) * 2u; }
    const size_t kstep = (size_t)(BK * 2);
    const size_t hstepA = g.hA, hstepB = g.hB;
    const unsigned ldsw = (unsigned)wid * 1024u;
    const int aoff = lds_byte(wr * 64 + fr, fq * 8), boff = lds_byte(wc * 32 + fr, fq * 8);
#define PG8_SA(b, h) (((b) * 2 + (h)) * HTB)
#define PG8_SB(b, h) ((4 + (b) * 2 + (h)) * HTB)
#define PG8_STAGE(bufoff, gbase, voff) do { _Pragma("unroll") for (int _i = 0; _i < 2; ++_i) \
        __builtin_amdgcn_global_load_lds((const unsigned*)((const char*)(gbase) + (voff)[_i]), (LAS unsigned*)(lds + (bufoff) + ldsw + _i * 8192), 16, 0, 0); } while (0)
#define PG8_LDA(dst, b, h) do { _Pragma("unroll") for (int m = 0; m < 4; ++m) _Pragma("unroll") for (int k = 0; k < 2; ++k) dst[m][k] = *(const LAS bf16x8*)(lds + PG8_SA(b, h) + aoff + m * 2048 + k * 1024); } while (0)
#define PG8_LDB(dst, b, h) do { _Pragma("unroll") for (int n = 0; n < 2; ++n) _Pragma("unroll") for (int k = 0; k < 2; ++k) dst[n][k] = *(const LAS bf16x8*)(lds + PG8_SB(b, h) + boff + n * 2048 + k * 1024); } while (0)
#define PG8_MMA(ai, bj, At, Bt) do { __builtin_amdgcn_s_setprio(1); _Pragma("unroll") for (int m = 0; m < 4; ++m) _Pragma("unroll") for (int n = 0; n < 2; ++n) _Pragma("unroll") for (int k = 0; k < 2; ++k) \
        acc[ai][bj][m][n] = __builtin_amdgcn_mfma_f32_16x16x32_bf16(Bt[n][k], At[m][k], acc[ai][bj][m][n], 0, 0, 0); __builtin_amdgcn_s_setprio(0); } while (0)
#define PG8_WAIT_V(n) asm volatile("s_waitcnt vmcnt(" #n ")" ::: "memory")
#define PG8_WAIT_L(n) asm volatile("s_waitcnt lgkmcnt(" #n ")" ::: "memory")
#define PG8_BAR __builtin_amdgcn_s_barrier()
#define PG8_SCHED __builtin_amdgcn_sched_barrier(0)
#define PG8_APTR(u) ((const char*)g.A + (size_t)(u).pm * g.tA + (size_t)((u).pn >> g.a_pn_shift) * g.a_pn_step)
#define PG8_BPTR(u) ((const char*)g.Bt + (size_t)(u).pn * g.tB)
    Unit cur, nxt; int ui = 0;
    if (!S.next(0, cur)) return;
    f32x4 acc[2][2][4][2];
#pragma unroll
    for (int a = 0; a < 2; ++a)
#pragma unroll
        for (int b = 0; b < 2; ++b)
#pragma unroll
            for (int m = 0; m < 4; ++m)
#pragma unroll
                for (int n = 0; n < 2; ++n) acc[a][b][m][n] = (f32x4){0.f, 0.f, 0.f, 0.f};
    bf16x8 At[4][2], B0[2][2], B1[2][2];
    const char* cA = PG8_APTR(cur); const char* cB = PG8_BPTR(cur);
    {
        PG8_STAGE(PG8_SB(0, 0), cB, voffB); PG8_STAGE(PG8_SB(0, 1), cB + hstepB, voffB); PG8_STAGE(PG8_SA(0, 0), cA, voffA); PG8_STAGE(PG8_SA(0, 1), cA + hstepA, voffA);
        if (wr == 1) PG8_BAR;
        PG8_WAIT_V(2); PG8_BAR;
        PG8_STAGE(PG8_SB(1, 0), cB + kstep, voffB); PG8_STAGE(PG8_SA(1, 0), cA + kstep, voffA); PG8_STAGE(PG8_SB(1, 1), cB + hstepB + kstep, voffB);
        PG8_WAIT_V(6); PG8_BAR;
    }
    for (;;) {
        const bool has_next = S.next(ui + 1, nxt);
        const char* nA = has_next ? PG8_APTR(nxt) : cA; const char* nB = has_next ? PG8_BPTR(nxt) : cB;
        for (int t = 0; t < nt; t += 2) {
            const bool last = (t == nt - 2);
            const char* a1 = cA + (size_t)(t + 1) * kstep;
            const char* a2 = last ? nA : cA + (size_t)(t + 2) * kstep; const char* b2 = last ? nB : cB + (size_t)(t + 2) * kstep;
            const char* a3 = a2 + kstep; const char* b3 = b2 + kstep;
            PG8_LDB(B0, 0, 0); PG8_LDB(B1, 0, 1); PG8_SCHED; PG8_LDA(At, 0, 0); PG8_STAGE(PG8_SA(1, 1), a1 + hstepA, voffA);
            PG8_WAIT_V(8); PG8_WAIT_L(0); PG8_BAR; PG8_MMA(0, 0, At, B0); PG8_MMA(0, 1, At, B1); PG8_BAR; PG8_SCHED;
            PG8_LDA(At, 0, 1); PG8_STAGE(PG8_SB(0, 0), b2, voffB); PG8_STAGE(PG8_SB(0, 1), b2 + hstepB, voffB); PG8_STAGE(PG8_SA(0, 0), a2, voffA);
            PG8_WAIT_V(8); PG8_WAIT_L(0); PG8_BAR; PG8_MMA(1, 0, At, B0); PG8_MMA(1, 1, At, B1); PG8_BAR; PG8_SCHED;
            PG8_LDB(B0, 1, 0); PG8_LDB(B1, 1, 1); PG8_SCHED; PG8_LDA(At, 1, 0); PG8_STAGE(PG8_SA(0, 1), a2 + hstepA, voffA);
            PG8_WAIT_V(8); PG8_WAIT_L(0); PG8_BAR; PG8_MMA(0, 0, At, B0); PG8_MMA(0, 1, At, B1); PG8_BAR; PG8_SCHED;
            PG8_LDA(At, 1, 1); PG8_STAGE(PG8_SB(1, 0), b3, voffB); PG8_STAGE(PG8_SB(1, 1), b3 + hstepB, voffB); PG8_STAGE(PG8_SA(1, 0), a3, voffA);
            PG8_WAIT_V(8); PG8_WAIT_L(0); PG8_BAR; PG8_MMA(1, 0, At, B0); PG8_MMA(1, 1, At, B1); PG8_BAR; PG8_SCHED;
        }
        if constexpr (ALIGN_EPI) { if (wr == 0) PG8_BAR; }
        if constexpr (!Epi::AFTER_DRAIN) E(acc, cur, wr, wc, fr, fq);
        if (!has_next) break;
#pragma unroll
        for (int a = 0; a < 2; ++a)
#pragma unroll
            for (int b = 0; b < 2; ++b)
#pragma unroll
                for (int m = 0; m < 4; ++m)
#pragma unroll
                    for (int n = 0; n < 2; ++n) acc[a][b][m][n] = (f32x4){0.f, 0.f, 0.f, 0.f};
        cur = nxt; cA = nA; cB = nB; ++ui;
        if constexpr (ALIGN_EPI) { if (wr == 1) PG8_BAR; }
    }
    PG8_WAIT_V(0);
    if constexpr (!ALIGN_EPI) { if (wr == 0) PG8_BAR; }
    PG8_BAR;
    if constexpr (Epi::AFTER_DRAIN) E.fused(acc, cur, wr, wc, fr, fq, lds, wid, lane);
#undef PG8_SA
#undef PG8_SB
#undef PG8_STAGE
#undef PG8_LDA
#undef PG8_LDB
#undef PG8_MMA
#undef PG8_WAIT_V
#undef PG8_WAIT_L
#undef PG8_BAR
#undef PG8_SCHED
#undef PG8_APTR
#undef PG8_BPTR
}
}
constexpr int TH = 16384;
constexpr int DM = 1024, ZP = 2304, DFF = 4096, TQ = 8192;
constexpr size_t MiB = 1u << 20;
constexpr size_t WS_RSQ = 0, WS_RSKV = 64 * 1024, WS_ROPE = 128 * 1024;
constexpr size_t WS_AGG = 5 * MiB;
constexpr size_t WS_CARRY = 9 * MiB;
constexpr size_t WS_XBUF = 1 * MiB;
constexpr size_t WS_SQP = 1 * MiB + 512 * 1024;
constexpr size_t WS_CNT = 3 * MiB;
constexpr size_t WS_BAR = 4 * MiB;
constexpr size_t WS_YB = 5 * MiB;
constexpr size_t WS_W_INATT = 13 * MiB;
constexpr size_t WS_W_UQ = WS_W_INATT + (size_t)2304 * 1024 * 2;
constexpr size_t WS_W_UKV = WS_W_UQ + (size_t)768 * 384 * 2;
constexpr size_t WS_W_OUTATT = WS_W_UKV + (size_t)1024 * 256 * 2;
constexpr size_t WS_W_INREC = WS_W_OUTATT + 2 * MiB;
constexpr size_t WS_W_GATES = WS_W_INREC + 4 * MiB;
constexpr size_t WS_W_OUTREC = WS_W_GATES + 1 * MiB;
constexpr size_t WS_W_UP = WS_W_OUTREC + 2 * MiB;
constexpr size_t WS_W_DOWN = WS_W_UP + 32 * MiB;
constexpr size_t WS_W_END = WS_W_DOWN + 16 * MiB;
static_assert(WS_W_END <= 76 * MiB, "weights");
constexpr size_t WS_XN = 76 * MiB;
constexpr size_t WS_BIG = 108 * MiB;
constexpr size_t WS_Z = WS_BIG;
constexpr size_t WS_Q = WS_Z + 72 * MiB;
constexpr size_t WS_KN = WS_Q + 24 * MiB;
constexpr size_t WS_VTM = WS_KN + 16 * MiB;
constexpr size_t WS_VTN = WS_VTM + 16 * MiB;
constexpr size_t WS_KPE = WS_VTN + 16 * MiB;
static_assert(WS_KPE + 1 * MiB <= 256 * MiB, "L0 overlay");
constexpr size_t WS_ACT = WS_BIG;
constexpr size_t WS_GATE = WS_BIG;
constexpr size_t WS_XB = WS_BIG + 32 * MiB;
constexpr size_t WS_XBR = WS_BIG + 64 * MiB;
constexpr size_t WS_GQ = WS_XBR;
constexpr size_t WS_END = 256 * MiB;

using pg8::Unit;

struct EpiBf16 {
    static constexpr bool PERM = true, AFTER_DRAIN = false;
    bf16_t* O; int ldc; int split_cols; size_t split_stride;
    __device__ __forceinline__ void operator()(f32x4 (&acc)[2][2][4][2], const Unit& u, int wr, int wc, int fr, int fq) const {
        const int row0 = u.pm * 256 + wr * 64 + fr; int colt = u.pn * 256; bf16_t* base = O;
        if (split_cols) { const int t = colt / split_cols; base += (size_t)t * split_stride; colt -= t * split_cols; }
        const int col0 = colt + wc * 32 + 8 * fq;
#pragma unroll
        for (int ai = 0; ai < 2; ++ai)
#pragma unroll
            for (int m = 0; m < 4; ++m) { bf16_t* rowp = base + (size_t)(row0 + ai * 128 + m * 16) * ldc + col0;
#pragma unroll
                for (int bj = 0; bj < 2; ++bj) { const f32x4 v0 = acc[ai][bj][m][0], v1 = acc[ai][bj][m][1];
                    u32x4 w; w.x = cvt_pk_bf16(v0[0], v0[1]); w.y = cvt_pk_bf16(v0[2], v0[3]); w.z = cvt_pk_bf16(v1[0], v1[1]); w.w = cvt_pk_bf16(v1[2], v1[3]);
                    *(u32x4*)(rowp + bj * 128) = w; } }
    }
};

struct EpiZ {
    static constexpr bool PERM = true, AFTER_DRAIN = false;
    bf16_t* Z; bf16_t* VTn; float* SQ; float* SKV; bf16_t* KPE; const float2* rope; int smask;
    __device__ __forceinline__ void operator()(f32x4 (&acc)[2][2][4][2], const Unit& u, int wr, int wc, int fr, int fq) const {
        const int lane = fq * 16 + fr;
        const int row0 = u.pm * 256 + wr * 64 + fr; const int col0 = u.pn * 256 + wc * 32 + 8 * fq;
#pragma unroll
        for (int ai = 0; ai < 2; ++ai)
#pragma unroll
            for (int m = 0; m < 4; ++m) { const int row = row0 + ai * 128 + m * 16; bf16_t* rowp = Z + (size_t)row * ZP + col0;
#pragma unroll
                for (int bj = 0; bj < 2; ++bj) { const f32x4 v0 = acc[ai][bj][m][0], v1 = acc[ai][bj][m][1];
                    u32x4 w; w.x = cvt_pk_bf16(v0[0], v0[1]); w.y = cvt_pk_bf16(v0[2], v0[3]); w.z = cvt_pk_bf16(v1[0], v1[1]); w.w = cvt_pk_bf16(v1[2], v1[3]);
                    *(u32x4*)(rowp + bj * 128) = w;
                    const int c = col0 + bj * 128; const int g32 = (u.pn * 256 + bj * 128 + wc * 32) >> 5;
                    if (g32 < 20) {
                        float s = (v0[0] * v0[0] + v0[1] * v0[1]) + (v0[2] * v0[2] + v0[3] * v0[3]) + ((v1[0] * v1[0] + v1[1] * v1[1]) + (v1[2] * v1[2] + v1[3] * v1[3]));
                        s += bperm_f(lane ^ 16, s); s += bperm_f(lane ^ 32, s);
                        if (fq == 0) SQ[(size_t)row * 20 + g32] = s;
                    } else if (g32 == 20) {
                        const float2* rp = rope + (size_t)(row & smask) * 16 + 8 * (fq & 1);
                        float o[8];
#pragma unroll
                        for (int k = 0; k < 8; ++k) { const float mine = k < 4 ? v0[k] : v1[k - 4]; const float other = bperm_f(lane ^ 32, mine); const float2 cs = rp[k];
                            o[k] = fq < 2 ? mine * cs.x - other * cs.y : mine * cs.x + other * cs.y; }
                        u32x4 wk; wk.x = cvt_pk_bf16(o[0], o[1]); wk.y = cvt_pk_bf16(o[2], o[3]); wk.z = cvt_pk_bf16(o[4], o[5]); wk.w = cvt_pk_bf16(o[6], o[7]);
                        *(u32x4*)(KPE + (size_t)row * 32 + 8 * fq) = wk;
                    }
                    if (c >= 1696 && c < 2208) { bf16_t* vt = VTn + (size_t)(c - 1696) * TH + row;
                        vt[0] = (bf16_t)(w.x & 0xffffu); vt[TH] = (bf16_t)(w.x >> 16); vt[2 * TH] = (bf16_t)(w.y & 0xffffu); vt[3 * TH] = (bf16_t)(w.y >> 16);
                        vt[4 * TH] = (bf16_t)(w.z & 0xffffu); vt[5 * TH] = (bf16_t)(w.z >> 16); vt[6 * TH] = (bf16_t)(w.w & 0xffffu); vt[7 * TH] = (bf16_t)(w.w >> 16); } } }
    }
};

struct EpiQ {
    static constexpr bool PERM = false, AFTER_DRAIN = false;
    bf16_t* Q; const float* rsq; const float2* rope; int smask;
    __device__ __forceinline__ void operator()(f32x4 (&acc)[2][2][4][2], const Unit& u, int wr, int wc, int fr, int fq) const {
        const float SC = 0.10206207261596577f * 1.4426950408889634f;
        const int row0 = u.pm * 256 + wr * 64 + fr;
#pragma unroll
        for (int ai = 0; ai < 2; ++ai)
#pragma unroll
            for (int m = 0; m < 4; ++m) { const int row = row0 + ai * 128 + m * 16; float ssq = 0.f;
#pragma unroll
                for (int k = 0; k < 12; ++k) ssq += rsq[(size_t)row * 20 + k];
                const float rs = SC / sqrtf(ssq * (1.f / 384.f) + 1e-6f); const int pos = row & smask;
#pragma unroll
                for (int bj = 0; bj < 2; ++bj) { const int cg = u.pn * 256 + bj * 128 + wc * 32;
                    f32x4 v0 = acc[ai][bj][m][0] * rs, v1 = acc[ai][bj][m][1] * rs;
                    if ((cg % 96) == 64) {
                        const float2* rp = rope + (size_t)pos * 16 + 4 * fq;
#pragma unroll
                        for (int i = 0; i < 4; ++i) { const float2 cs = rp[i]; const float x1 = v0[i], x2 = v1[i]; v0[i] = x1 * cs.x - x2 * cs.y; v1[i] = x2 * cs.x + x1 * cs.y; }
                    }
                    bf16_t* p = Q + (size_t)row * 768 + cg + 4 * fq;
                    u32x2 w0; w0.x = cvt_pk_bf16(v0[0], v0[1]); w0.y = cvt_pk_bf16(v0[2], v0[3]); *(u32x2*)p = w0;
                    u32x2 w1; w1.x = cvt_pk_bf16(v1[0], v1[1]); w1.y = cvt_pk_bf16(v1[2], v1[3]); *(u32x2*)(p + 16) = w1; } }
    }
};

struct EpiKV {
    static constexpr bool PERM = true, AFTER_DRAIN = false;
    bf16_t* KN; bf16_t* VTm; const float* rskv;
    __device__ __forceinline__ void operator()(f32x4 (&acc)[2][2][4][2], const Unit& u, int wr, int wc, int fr, int fq) const {
        const int row0 = u.pm * 256 + wr * 64 + fr;
#pragma unroll
        for (int ai = 0; ai < 2; ++ai)
#pragma unroll
            for (int m = 0; m < 4; ++m) { const int row = row0 + ai * 128 + m * 16; float ssq = 0.f;
#pragma unroll
                for (int k = 12; k < 20; ++k) ssq += rskv[(size_t)row * 20 + k];
                const float rs = 1.0f / sqrtf(ssq * (1.f / 256.f) + 1e-6f);
#pragma unroll
                for (int bj = 0; bj < 2; ++bj) { const int c = u.pn * 256 + bj * 128 + wc * 32 + 8 * fq;
                    const f32x4 v0 = acc[ai][bj][m][0] * rs, v1 = acc[ai][bj][m][1] * rs;
                    u32x4 w; w.x = cvt_pk_bf16(v0[0], v0[1]); w.y = cvt_pk_bf16(v0[2], v0[3]); w.z = cvt_pk_bf16(v1[0], v1[1]); w.w = cvt_pk_bf16(v1[2], v1[3]);
                    const int h = c >> 7, j = c & 127;
                    if (j < 64) { *(u32x4*)(KN + (size_t)row * 512 + h * 64 + j) = w; }
                    else { bf16_t* vt = VTm + (size_t)(h * 64 + j - 64) * TH + row;
                        vt[0] = (bf16_t)(w.x & 0xffffu); vt[TH] = (bf16_t)(w.x >> 16); vt[2 * TH] = (bf16_t)(w.y & 0xffffu); vt[3 * TH] = (bf16_t)(w.y >> 16);
                        vt[4 * TH] = (bf16_t)(w.z & 0xffffu); vt[5 * TH] = (bf16_t)(w.z >> 16); vt[6 * TH] = (bf16_t)(w.w & 0xffffu); vt[7 * TH] = (bf16_t)(w.w >> 16); } } }
    }
};

struct EpiUp {
    static constexpr bool PERM = true, AFTER_DRAIN = false;
    bf16_t* ACT; bf16_t* YB; const float* cw; const float* cb;
    __device__ __forceinline__ void operator()(f32x4 (&acc)[2][2][4][2], const Unit& u, int wr, int wc, int fr_, int fq_) const {
        int fr = fr_, fq = fq_; asm volatile("" : "+v"(fr), "+v"(fq));
        const int lane = fq * 16 + fr;
        const int tok0 = u.pm * 256 + wr * 128 + 8 * fr;
        const int ch0 = u.pn * 128 + wc * 32 + 8 * fq;
        const int seg = u.pm * 2 + wr;
        if (fr == 0 || fr == 15) {
#pragma unroll
            for (int k = 0; k < 2; ++k) {
                const int slot = fr == 0 ? k : 2 + k;
                bf16_t* yb = YB + ((size_t)seg * 4 + slot) * 8192 + ch0;
#pragma unroll
                for (int bj = 0; bj < 2; ++bj) { const f32x4 v0 = fr == 0 ? acc[0][bj][k][0] : acc[1][bj][2 + k][0], v1 = fr == 0 ? acc[0][bj][k][1] : acc[1][bj][2 + k][1];
                    u32x4 w; w.x = cvt_pk_bf16(v0[0], v0[1]); w.y = cvt_pk_bf16(v0[2], v0[3]); w.z = cvt_pk_bf16(v1[0], v1[1]); w.w = cvt_pk_bf16(v1[2], v1[3]);
                    *(u32x4*)(yb + bj * 4096) = w; }
            }
        }
        const int src_up = (lane & ~15) | ((fr - 1) & 15), src_dn = (lane & ~15) | ((fr + 1) & 15);
#pragma unroll
        for (int n = 0; n < 2; ++n)
#pragma unroll
            for (int i = 0; i < 4; ++i) {
                float ug[8], uv[8];
#pragma unroll
                for (int bj = 0; bj < 2; ++bj) {
                    const int ch = bj * 4096 + ch0 + 4 * n + i;
                    const float w0 = cw[ch], w1 = cw[8192 + ch], w2 = cw[2 * 8192 + ch], b = cb[ch];
                    const float prev7 = bperm_f(src_up, acc[1][bj][3][n][i]);
                    const float next0 = bperm_f(src_dn, acc[0][bj][0][n][i]);
#pragma unroll
                    for (int q = 0; q < 8; ++q) {
                        const float v = acc[q >> 2][bj][q & 3][n][i];
                        const float up = q > 0 ? acc[(q - 1) >> 2][bj][(q - 1) & 3][n][i] : prev7;
                        const float dn = q < 7 ? acc[(q + 1) >> 2][bj][(q + 1) & 3][n][i] : next0;
                        const float r = w0 * up + w1 * v + w2 * dn + b;
                        if (bj == 0) ug[q] = r; else uv[q] = r;
                    }
                }
#pragma unroll
                for (int q = 0; q < 8; ++q) acc[q >> 2][0][q & 3][n][i] = gelu_tanh(ug[q]) * uv[q];
            }
#pragma unroll
        for (int ai = 0; ai < 2; ++ai)
#pragma unroll
            for (int m = 0; m < 4; ++m) { const f32x4 v0 = acc[ai][0][m][0], v1 = acc[ai][0][m][1];
                u32x4 w; w.x = cvt_pk_bf16(v0[0], v0[1]); w.y = cvt_pk_bf16(v0[2], v0[3]); w.z = cvt_pk_bf16(v1[0], v1[1]); w.w = cvt_pk_bf16(v1[2], v1[3]);
                *(u32x4*)(ACT + (size_t)(tok0 + 4 * ai + m) * DFF + ch0) = w; }
    }
};

struct EpiGates {
    static constexpr bool PERM = true, AFTER_DRAIN = false;
    bf16_t* G; const bf16_t* XBq; float2* AGGp; const float* gab_; const float* gxb_; const float* lam_;
    __device__ __forceinline__ void operator()(f32x4 (&acc)[2][2][4][2], const Unit& u, int wr, int wc, int fr_, int fq_) const {
        int fr = fr_, fq = fq_; asm volatile("" : "+v"(fr), "+v"(fq));
        const int lane = fq * 16 + fr;
        const int nblk = u.pn >> 1, e = u.pn & 1;
        const int tl0 = u.pm * 256 + wr * 128 + 8 * fr;
        const int d0 = wc * 32 + 8 * fq, ch0 = nblk * 128 + d0;
        u32x4 xbw[8];
#pragma unroll
        for (int q = 0; q < 8; ++q) xbw[q] = *(const u32x4*)(XBq + (size_t)(tl0 + q) * DM + ch0);
        unsigned law[8][4], bw[8][4];
#pragma unroll
        for (int k2 = 0; k2 < 4; ++k2) {
            const float2 gab = *(const float2*)(gab_ + e * 1024 + ch0 + 2 * k2), gxb = *(const float2*)(gxb_ + e * 1024 + ch0 + 2 * k2), lam = *(const float2*)(lam_ + e * 1024 + ch0 + 2 * k2);
            const float spl0 = log1pf(expf(-lam.x)), spl1 = log1pf(expf(-lam.y));
#pragma unroll
            for (int q = 0; q < 8; ++q) {
                const unsigned xb2 = k2 == 0 ? xbw[q].x : k2 == 1 ? xbw[q].y : k2 == 2 ? xbw[q].z : xbw[q].w;
                float l0, b0, l1, b1;
                lru_lb(acc[q >> 2][0][q & 3][k2 >> 1][2 * (k2 & 1)], acc[q >> 2][1][q & 3][k2 >> 1][2 * (k2 & 1)], gab.x, gxb.x, spl0, bflo(xb2), l0, b0);
                lru_lb(acc[q >> 2][0][q & 3][k2 >> 1][2 * (k2 & 1) + 1], acc[q >> 2][1][q & 3][k2 >> 1][2 * (k2 & 1) + 1], gab.y, gxb.y, spl1, bfhi(xb2), l1, b1);
                law[q][k2] = cvt_pk_bf16(l0, l1); bw[q][k2] = cvt_pk_bf16(b0, b1); }
        }
#pragma unroll
        for (int q = 0; q < 8; ++q) { bf16_t* rowp = G + (size_t)(tl0 + q) * 4096 + u.pn * 256 + d0;
            *(u32x4*)(rowp) = (u32x4){law[q][0], law[q][1], law[q][2], law[q][3]}; *(u32x4*)(rowp + 128) = (u32x4){bw[q][0], bw[q][1], bw[q][2], bw[q][3]}; }
        float Aagg[8], Bagg[8];
#pragma unroll
        for (int k2 = 0; k2 < 4; ++k2) {
            float A0 = 1.f, B0 = 0.f, A1 = 1.f, B1 = 0.f;
#pragma unroll
            for (int s = 0; s < 8; ++s) {
                const unsigned l2 = e ? law[7 - s][k2] : law[s][k2], b2 = e ? bw[7 - s][k2] : bw[s][k2];
                const float a0 = fexp2(bflo(l2)), a1 = fexp2(bfhi(l2));
                A0 *= a0; B0 = a0 * B0 + bflo(b2); A1 *= a1; B1 = a1 * B1 + bfhi(b2); }
            Aagg[2 * k2] = A0; Bagg[2 * k2] = B0; Aagg[2 * k2 + 1] = A1; Bagg[2 * k2 + 1] = B1;
        }
#pragma unroll
        for (int bit = 1; bit <= 2; bit <<= 1) {
            const bool me_first = e ? ((fr & bit) != 0) : ((fr & bit) == 0);
#pragma unroll
            for (int k = 0; k < 8; ++k) { const float Ao = bperm_f(lane ^ bit, Aagg[k]), Bo = bperm_f(lane ^ bit, Bagg[k]);
                const float An = Ao * Aagg[k], Bn = me_first ? Ao * Bagg[k] + Bo : Aagg[k] * Bo + Bagg[k];
                Aagg[k] = An; Bagg[k] = Bn; }
        }
        if ((fr & 3) == 0) { const int c = (tl0 >> 5);
            float2* dst = AGGp + (size_t)(c * 2 + e) * 1024 + ch0;
#pragma unroll
            for (int k = 0; k < 8; k += 2) *(f32x4*)(dst + k) = (f32x4){Aagg[k], Bagg[k], Aagg[k + 1], Bagg[k + 1]}; }
    }
};

struct EpiRms {
    static constexpr bool PERM = false, AFTER_DRAIN = true;
    float* x; bf16_t* xn; const float* gpost; const float* gnext; float* xbuf1; float* xbuf2; unsigned* cnt1; unsigned* cnt2;
    __device__ __forceinline__ void operator()(f32x4 (&)[2][2][4][2], const Unit&, int, int, int, int) const {}
    __device__ __forceinline__ void stats(const f32x4 (&v)[2][2][4][2], const Unit& u, int wr, int wc, int fr, int fq, LAS unsigned char* lds, int wid, int lane, float* xbuf, unsigned* cnt) const {
        LAS float* P = (LAS float*)lds; LAS float* Sx = (LAS float*)(lds + 4096);
#pragma unroll
        for (int ai = 0; ai < 2; ++ai)
#pragma unroll
            for (int m = 0; m < 4; ++m) { float s = 0.f;
#pragma unroll
                for (int bj = 0; bj < 2; ++bj)
#pragma unroll
                    for (int n = 0; n < 2; ++n) { const f32x4 t = v[ai][bj][m][n]; s += (t[0] * t[0] + t[1] * t[1]) + (t[2] * t[2] + t[3] * t[3]); }
                s += bperm_f(lane ^ 16, s); s += bperm_f(lane ^ 32, s);
                if (fq == 0) P[(ai * 128 + wr * 64 + m * 16 + fr) * 4 + wc] = s; }
        asm volatile("s_waitcnt lgkmcnt(0)" ::: "memory"); __builtin_amdgcn_s_barrier(); asm volatile("" ::: "memory");
        const int row = wid * 32 + (lane & 31);
        if (lane < 32) { const float t = (P[row * 4 + 0] + P[row * 4 + 1]) + (P[row * 4 + 2] + P[row * 4 + 3]);
            __hip_atomic_store(xbuf + (size_t)(u.pm * 256 + row) * 4 + u.pn, t, __ATOMIC_RELAXED, __HIP_MEMORY_SCOPE_AGENT); }
        asm volatile("s_waitcnt vmcnt(0)" ::: "memory");
        if (lane == 0) __hip_atomic_fetch_add(cnt + 64 * u.pm, 1u, __ATOMIC_RELAXED, __HIP_MEMORY_SCOPE_AGENT);
        if (wid == 0) { unsigned sp = 0;
            while ((unsigned)__builtin_amdgcn_readfirstlane(__hip_atomic_load(cnt + 64 * u.pm, __ATOMIC_RELAXED, __HIP_MEMORY_SCOPE_AGENT)) < 32u) { __builtin_amdgcn_s_sleep(2); if (++sp > (1u << 22)) break; }
            __builtin_amdgcn_fence(__ATOMIC_ACQUIRE, "agent"); }
        asm volatile("s_waitcnt vmcnt(0) lgkmcnt(0)" ::: "memory"); __builtin_amdgcn_s_barrier(); asm volatile("" ::: "memory");
        if (lane < 32) { const float* slot = xbuf + (size_t)(u.pm * 256 + row) * 4; float t = 0.f;
#pragma unroll
            for (int k = 0; k < 4; ++k) t += __hip_atomic_load(slot + k, __ATOMIC_RELAXED, __HIP_MEMORY_SCOPE_AGENT);
            Sx[row] = 1.0f / sqrtf(t * (1.f / 1024.f) + 1e-6f); }
        asm volatile("s_waitcnt lgkmcnt(0)" ::: "memory"); __builtin_amdgcn_s_barrier(); asm volatile("" ::: "memory");
    }
    __device__ __forceinline__ void fused(f32x4 (&acc)[2][2][4][2], const Unit& u, int wr, int wc, int fr, int fq, LAS unsigned char* lds, int wid, int lane) const {
        const LAS float* Sx = (const LAS float*)(lds + 4096);
        const int col0 = u.pn * 256 + wc * 32 + 4 * fq;
        stats(acc, u, wr, wc, fr, fq, lds, wid, lane, xbuf1, cnt1);
#pragma unroll
        for (int ai = 0; ai < 2; ++ai)
#pragma unroll
            for (int m = 0; m < 4; ++m) { const int r = ai * 128 + wr * 64 + m * 16 + fr; const float rs = Sx[r]; float* xr = x + (size_t)(u.pm * 256 + r) * DM + col0;
#pragma unroll
                for (int bj = 0; bj < 2; ++bj)
#pragma unroll
                    for (int n = 0; n < 2; ++n) { const f32x4 g = *(const f32x4*)(gpost + col0 + bj * 128 + n * 16); const f32x4 bs = *(const f32x4*)(xr + bj * 128 + n * 16);
                        const f32x4 o = bs + acc[ai][bj][m][n] * rs * g; acc[ai][bj][m][n] = o; *(f32x4*)(xr + bj * 128 + n * 16) = o; }
                if (m & 1) asm volatile("" ::: "memory"); }
        if (xn) {
            stats(acc, u, wr, wc, fr, fq, lds, wid, lane, xbuf2, cnt2);
#pragma unroll
            for (int ai = 0; ai < 2; ++ai)
#pragma unroll
                for (int m = 0; m < 4; ++m) { const int r = ai * 128 + wr * 64 + m * 16 + fr; const float rs = Sx[r]; bf16_t* xr = xn + (size_t)(u.pm * 256 + r) * DM + col0;
#pragma unroll
                    for (int bj = 0; bj < 2; ++bj)
#pragma unroll
                        for (int n = 0; n < 2; ++n) { const f32x4 g = *(const f32x4*)(gnext + col0 + bj * 128 + n * 16); const f32x4 o = acc[ai][bj][m][n] * rs * g;
                            u32x2 w; w.x = cvt_pk_bf16(o[0], o[1]); w.y = cvt_pk_bf16(o[2], o[3]); *(u32x2*)(xr + bj * 128 + n * 16) = w; } }
        }
    }
};
constexpr float EPS = 1e-6f;
constexpr float LOG2E = 1.4426950408889634f;

__device__ __forceinline__ void transpose_item(const float* W, int K, int N, bf16_t* WT, int row_off, const float* kscale, LAS float* scr, int item, int lane) {
    const int nblk = N / 32, kb = item / nblk, nb = item % nblk, k0 = 64 * kb, n0 = 32 * nb;
#pragma unroll 8
    for (int i = 0; i < 32; ++i) { const int kk = 2 * i + (lane >> 5); float v = W[(size_t)(k0 + kk) * N + n0 + (lane & 31)]; if (kscale) v *= kscale[k0 + kk]; scr[kk * 33 + (lane & 31)] = v; }
    asm volatile("s_waitcnt lgkmcnt(0)" ::: "memory");
    const int c = lane & 7;
#pragma unroll
    for (int j = 0; j < 4; ++j) { const int n = (lane >> 3) + 8 * j; const LAS float* s = scr + (8 * c) * 33 + n;
        u32x4 o; o.x = cvt_pk_bf16(s[0 * 33], s[1 * 33]); o.y = cvt_pk_bf16(s[2 * 33], s[3 * 33]); o.z = cvt_pk_bf16(s[4 * 33], s[5 * 33]); o.w = cvt_pk_bf16(s[6 * 33], s[7 * 33]);
        *(u32x4*)(WT + (size_t)(row_off + n0 + n) * K + k0 + 8 * c) = o; }
    asm volatile("s_waitcnt lgkmcnt(0)" ::: "memory");
}

__device__ __forceinline__ void xn_row(const float* xrow, const float* gain, bf16_t* orow, int lane) {
    const f32x4* xr = (const f32x4*)xrow + lane; const f32x4* gr = (const f32x4*)gain + lane;
    f32x4 v[4]; float s = 0.f;
#pragma unroll
    for (int j = 0; j < 4; ++j) { v[j] = xr[64 * j]; s += (v[j].x * v[j].x + v[j].y * v[j].y) + (v[j].z * v[j].z + v[j].w * v[j].w); }
    const float rs = 1.0f / sqrtf(wave_sum(s, lane) * (1.f / DM) + EPS);
    u32x2* o8 = (u32x2*)orow + lane;
#pragma unroll
    for (int j = 0; j < 4; ++j) { const f32x4 g = gr[64 * j]; u32x2 w; w.x = cvt_pk_bf16(v[j].x * rs * g.x, v[j].y * rs * g.y); w.y = cvt_pk_bf16(v[j].z * rs * g.z, v[j].w * rs * g.w); o8[64 * j] = w; }
}

__device__ __forceinline__ void res_row(const bf16_t* mrow, const float* xi, float* xo, const float* gpost, const float* gnext, bf16_t* xnrow, int lane) {
    const u32x2* mr = (const u32x2*)mrow + lane; const f32x4* xr = (const f32x4*)xi + lane; const f32x4* gp = (const f32x4*)gpost + lane;
    f32x4 mv[4]; float s = 0.f;
#pragma unroll
    for (int j = 0; j < 4; ++j) { const u32x2 w = mr[64 * j]; mv[j] = (f32x4){bflo(w.x), bfhi(w.x), bflo(w.y), bfhi(w.y)}; s += (mv[j].x * mv[j].x + mv[j].y * mv[j].y) + (mv[j].z * mv[j].z + mv[j].w * mv[j].w); }
    const float rs = 1.0f / sqrtf(wave_sum(s, lane) * (1.f / DM) + EPS);
    f32x4 x[4]; float s2 = 0.f;
#pragma unroll
    for (int j = 0; j < 4; ++j) { const f32x4 g = gp[64 * j]; x[j] = xr[64 * j] + mv[j] * rs * g; s2 += (x[j].x * x[j].x + x[j].y * x[j].y) + (x[j].z * x[j].z + x[j].w * x[j].w); }
    f32x4* xw = (f32x4*)xo + lane;
#pragma unroll
    for (int j = 0; j < 4; ++j) xw[64 * j] = x[j];
    if (gnext) {
        const float rs2 = 1.0f / sqrtf(wave_sum(s2, lane) * (1.f / DM) + EPS);
        const f32x4* gn = (const f32x4*)gnext + lane; u32x2* o8 = (u32x2*)xnrow + lane;
#pragma unroll
        for (int j = 0; j < 4; ++j) { const f32x4 g = gn[64 * j]; u32x2 w; w.x = cvt_pk_bf16(x[j].x * rs2 * g.x, x[j].y * rs2 * g.y); w.y = cvt_pk_bf16(x[j].z * rs2 * g.z, x[j].w * rs2 * g.w); o8[64 * j] = w; }
    }
}

__device__ __forceinline__ void res_row2(const bf16_t* m0, const bf16_t* m1, const float* xi0, const float* xi1, float* xo0, float* xo1, const float* gpost, const float* gnext, bf16_t* xn0, bf16_t* xn1, int lane) {
    const u32x2* mr0 = (const u32x2*)m0 + lane; const u32x2* mr1 = (const u32x2*)m1 + lane; const f32x4* xr0 = (const f32x4*)xi0 + lane; const f32x4* xr1 = (const f32x4*)xi1 + lane; const f32x4* gp = (const f32x4*)gpost + lane;
    u32x2 w0[4], w1[4]; f32x4 xa[4], xb[4], g[4];
#pragma unroll
    for (int j = 0; j < 4; ++j) { w0[j] = mr0[64 * j]; w1[j] = mr1[64 * j]; xa[j] = xr0[64 * j]; xb[j] = xr1[64 * j]; g[j] = gp[64 * j]; }
    f32x4 ma[4], mb[4]; float s0 = 0.f, s1 = 0.f;
#pragma unroll
    for (int j = 0; j < 4; ++j) { ma[j] = (f32x4){bflo(w0[j].x), bfhi(w0[j].x), bflo(w0[j].y), bfhi(w0[j].y)}; mb[j] = (f32x4){bflo(w1[j].x), bfhi(w1[j].x), bflo(w1[j].y), bfhi(w1[j].y)};
        s0 += (ma[j].x * ma[j].x + ma[j].y * ma[j].y) + (ma[j].z * ma[j].z + ma[j].w * ma[j].w); s1 += (mb[j].x * mb[j].x + mb[j].y * mb[j].y) + (mb[j].z * mb[j].z + mb[j].w * mb[j].w); }
    const float rs0 = 1.0f / sqrtf(wave_sum(s0, lane) * (1.f / DM) + EPS), rs1 = 1.0f / sqrtf(wave_sum(s1, lane) * (1.f / DM) + EPS);
    float t0 = 0.f, t1 = 0.f;
#pragma unroll
    for (int j = 0; j < 4; ++j) { xa[j] = xa[j] + ma[j] * rs0 * g[j]; xb[j] = xb[j] + mb[j] * rs1 * g[j];
        t0 += (xa[j].x * xa[j].x + xa[j].y * xa[j].y) + (xa[j].z * xa[j].z + xa[j].w * xa[j].w); t1 += (xb[j].x * xb[j].x + xb[j].y * xb[j].y) + (xb[j].z * xb[j].z + xb[j].w * xb[j].w); }
    f32x4* xw0 = (f32x4*)xo0 + lane; f32x4* xw1 = (f32x4*)xo1 + lane;
#pragma unroll
    for (int j = 0; j < 4; ++j) { xw0[64 * j] = xa[j]; xw1[64 * j] = xb[j]; }
    if (gnext) {
        const float q0 = 1.0f / sqrtf(wave_sum(t0, lane) * (1.f / DM) + EPS), q1 = 1.0f / sqrtf(wave_sum(t1, lane) * (1.f / DM) + EPS);
        const f32x4* gn = (const f32x4*)gnext + lane; u32x2* o0 = (u32x2*)xn0 + lane; u32x2* o1 = (u32x2*)xn1 + lane;
#pragma unroll
        for (int j = 0; j < 4; ++j) { const f32x4 h = gn[64 * j];
            u32x2 a; a.x = cvt_pk_bf16(xa[j].x * q0 * h.x, xa[j].y * q0 * h.y); a.y = cvt_pk_bf16(xa[j].z * q0 * h.z, xa[j].w * q0 * h.w); o0[64 * j] = a;
            u32x2 b; b.x = cvt_pk_bf16(xb[j].x * q1 * h.x, xb[j].y * q1 * h.y); b.y = cvt_pk_bf16(xb[j].z * q1 * h.z, xb[j].w * q1 * h.w); o1[64 * j] = b; }
    }
}

#define MLA_PACK(P, B) ((u32x4){cvt_pk_bf16(P[B], P[B + 1]), cvt_pk_bf16(P[B + 2], P[B + 3]), cvt_pk_bf16(P[B + 4], P[B + 5]), cvt_pk_bf16(P[B + 6], P[B + 7])})
__device__ __forceinline__ void mla_softmax(f32x16& p0, f32x16& p1, float& m_run, float& l_run, f32x16& o0, f32x16& o1) {
    float mx = fmaxf(p0[0], p1[0]);
#pragma unroll
    for (int r = 1; r < 16; ++r) mx = fmaxf(mx, fmaxf(p0[r], p1[r]));
    mx = xor32_max(mx);
    const float m_new = fmaxf(m_run, mx), alpha = fexp2(m_run - m_new); m_run = m_new;
    p0 = p0 - m_new; p1 = p1 - m_new;
#pragma unroll
    for (int r = 0; r < 16; ++r) { p0[r] = fexp2(p0[r]); p1[r] = fexp2(p1[r]); }
    const f32x16 ps = p0 + p1;
    const float ls = ((ps[0] + ps[1]) + (ps[2] + ps[3])) + ((ps[4] + ps[5]) + (ps[6] + ps[7])) + (((ps[8] + ps[9]) + (ps[10] + ps[11])) + ((ps[12] + ps[13]) + (ps[14] + ps[15])));
    l_run = l_run * alpha + ls;
    o0 = o0 * alpha; o1 = o1 * alpha;
}
__device__ __forceinline__ void mla_store(bf16_t* orow, const f32x16& o0, const f32x16& o1, float l_run) {
    const float inv = 1.0f / xor32_sum(l_run);
#pragma unroll
    for (int rg = 0; rg < 4; ++rg) {
        u32x2 w; w.x = cvt_pk_bf16(o0[4 * rg] * inv, o0[4 * rg + 1] * inv); w.y = cvt_pk_bf16(o0[4 * rg + 2] * inv, o0[4 * rg + 3] * inv); *(u32x2*)(orow + 8 * rg) = w;
        u32x2 w2; w2.x = cvt_pk_bf16(o1[4 * rg] * inv, o1[4 * rg + 1] * inv); w2.y = cvt_pk_bf16(o1[4 * rg + 2] * inv, o1[4 * rg + 3] * inv); *(u32x2*)(orow + 32 + 8 * rg) = w2;
    }
}
__device__ __forceinline__ void mla_unit(LAS unsigned char* lds, const bf16_t* Q, const bf16_t* KN, const bf16_t* KPE, const bf16_t* VT, bf16_t* AO, int tokbase, int S, int h, int qb, int tid) {
    constexpr int KBYTES = 12288, BUF = 20480;
    const int lane = tid & 63, wid = __builtin_amdgcn_readfirstlane(tid >> 6), r32 = lane & 31, hi = lane >> 5;
    const bf16_t* ks0 = KN + (size_t)(tokbase + lane) * 512 + h * 64 + 8 * wid;
    const bf16_t* ks1 = KPE + (size_t)(tokbase + lane) * 32 + 8 * (wid & 3);
    const bf16_t* vs = VT + (size_t)(h * 64 + lane) * TH + tokbase + 8 * wid;
#define MLA_DMA(T, B) do { LAS unsigned char* sb_ = lds + (B) * BUF; \
        __builtin_amdgcn_global_load_lds((const unsigned*)(ks0 + (size_t)(T) * (64 * 512)), (LAS unsigned*)(sb_ + wid * 1024), 16, 0, 0); \
        if (wid < 4) __builtin_amdgcn_global_load_lds((const unsigned*)(ks1 + (size_t)(T) * (64 * 32)), (LAS unsigned*)(sb_ + (8 + wid) * 1024), 16, 0, 0); \
        __builtin_amdgcn_global_load_lds((const unsigned*)(vs + (size_t)(T) * 64), (LAS unsigned*)(sb_ + KBYTES + wid * 1024), 16, 0, 0); } while (0)
#define MLA_WAITBAR_KEEP() do { if (wid < 4) asm volatile("s_waitcnt vmcnt(3)" ::: "memory"); else asm volatile("s_waitcnt vmcnt(2)" ::: "memory"); \
        asm volatile("s_waitcnt lgkmcnt(0)" ::: "memory"); __builtin_amdgcn_s_barrier(); asm volatile("" ::: "memory"); } while (0)
#define MLA_WAITBAR_ALL() do { asm volatile("s_waitcnt vmcnt(0) lgkmcnt(0)" ::: "memory"); __builtin_amdgcn_s_barrier(); asm volatile("" ::: "memory"); } while (0)
    const int NT = S / 64;
    const int qtokA = tokbase + 512 * qb + 64 * wid + r32, qtokB = qtokA + 32;
    bf16x8 qa[6], qbv[6];
#pragma unroll
    for (int d0 = 0; d0 < 6; ++d0) { qa[d0] = *(const bf16x8*)(Q + (size_t)qtokA * 768 + h * 96 + 16 * d0 + 8 * hi); qbv[d0] = *(const bf16x8*)(Q + (size_t)qtokB * 768 + h * 96 + 16 * d0 + 8 * hi); }
    asm volatile("s_waitcnt vmcnt(0)" ::: "memory");
    MLA_DMA(0, 0); MLA_DMA(1, 1);
    MLA_WAITBAR_ALL();
    f32x16 oa0, oa1, ob0, ob1;
#pragma unroll
    for (int r = 0; r < 16; ++r) { oa0[r] = 0.f; oa1[r] = 0.f; ob0[r] = 0.f; ob1[r] = 0.f; }
    float ma = -1e30f, la = 0.f, mb = -1e30f, lb = 0.f;
    for (int t = 0; t < NT; ++t) {
        if (t + 2 < NT) MLA_DMA(t + 2, (t + 2) & 3);
        const LAS unsigned char* kb = lds + (t & 3) * BUF; const LAS unsigned char* vb = kb + KBYTES;
        f32x16 pa0, pa1, pb0, pb1;
#pragma unroll
        for (int r = 0; r < 16; ++r) { pa0[r] = 0.f; pa1[r] = 0.f; pb0[r] = 0.f; pb1[r] = 0.f; }
#pragma unroll
        for (int d0 = 0; d0 < 6; ++d0) {
            const bf16x8 a0 = *(const LAS bf16x8*)(kb + (2 * d0 + hi) * 1024 + r32 * 16);
            const bf16x8 a1 = *(const LAS bf16x8*)(kb + (2 * d0 + hi) * 1024 + (32 + r32) * 16);
            pa0 = __builtin_amdgcn_mfma_f32_32x32x16_bf16(a0, qa[d0], pa0, 0, 0, 0);
            pa1 = __builtin_amdgcn_mfma_f32_32x32x16_bf16(a1, qa[d0], pa1, 0, 0, 0);
            pb0 = __builtin_amdgcn_mfma_f32_32x32x16_bf16(a0, qbv[d0], pb0, 0, 0, 0);
            pb1 = __builtin_amdgcn_mfma_f32_32x32x16_bf16(a1, qbv[d0], pb1, 0, 0, 0);
        }
        mla_softmax(pa0, pa1, ma, la, oa0, oa1);
        mla_softmax(pb0, pb1, mb, lb, ob0, ob1);
#pragma unroll
        for (int ks = 0; ks < 4; ++ks) {
            const u32x4 pwa = ks == 0 ? MLA_PACK(pa0, 0) : ks == 1 ? MLA_PACK(pa0, 8) : ks == 2 ? MLA_PACK(pa1, 0) : MLA_PACK(pa1, 8);
            const u32x4 pwb = ks == 0 ? MLA_PACK(pb0, 0) : ks == 1 ? MLA_PACK(pb0, 8) : ks == 2 ? MLA_PACK(pb1, 0) : MLA_PACK(pb1, 8);
            const bf16x8 paa = __builtin_bit_cast(bf16x8, pwa), pab = __builtin_bit_cast(bf16x8, pwb);
            const LAS unsigned char* vp = vb + (2 * ks) * 1024 + r32 * 16 + 8 * hi;
            const u32x2 a_lo = *(const LAS u32x2*)(vp), a_hi = *(const LAS u32x2*)(vp + 1024);
            const u32x2 b_lo = *(const LAS u32x2*)(vp + 512), b_hi = *(const LAS u32x2*)(vp + 1024 + 512);
            const bf16x8 vf0 = __builtin_bit_cast(bf16x8, ((u32x4){a_lo.x, a_lo.y, a_hi.x, a_hi.y}));
            const bf16x8 vf1 = __builtin_bit_cast(bf16x8, ((u32x4){b_lo.x, b_lo.y, b_hi.x, b_hi.y}));
            oa0 = __builtin_amdgcn_mfma_f32_32x32x16_bf16(vf0, paa, oa0, 0, 0, 0);
            oa1 = __builtin_amdgcn_mfma_f32_32x32x16_bf16(vf1, paa, oa1, 0, 0, 0);
            ob0 = __builtin_amdgcn_mfma_f32_32x32x16_bf16(vf0, pab, ob0, 0, 0, 0);
            ob1 = __builtin_amdgcn_mfma_f32_32x32x16_bf16(vf1, pab, ob1, 0, 0, 0);
        }
        if (t & 1) MLA_WAITBAR_ALL();
    }
#undef MLA_DMA
#undef MLA_WAITBAR_KEEP
#undef MLA_WAITBAR_ALL
    mla_store(AO + (size_t)qtokA * 1024 + h * 64 + 4 * hi, oa0, oa1, la);
    mla_store(AO + (size_t)qtokB * 1024 + h * 64 + 4 * hi, ob0, ob1, lb);
}

__device__ __forceinline__ unsigned na_vmask(int qc, int kh, int hi) {
    int cs = qc - 8; cs = cs < 0 ? 0 : cs; cs = cs > 48 ? 48 : cs; unsigned mk = 0u;
#pragma unroll
    for (int r = 0; r < 16; ++r) { const int kc = 32 * kh + (r & 3) + 8 * (r >> 2) + 4 * hi; mk |= ((kc >= cs) && (kc < cs + 16)) ? (1u << r) : 0u; }
    return mk;
}
__device__ __forceinline__ void na_qs(const bf16x8 (&kf)[4], const bf16x8 (&vf)[2][2], const bf16x8 (&qf)[4], const LAS float* brow, int qc, int kh, int hi, unsigned vmsel,
                                      float& m_run, float& l_run, f32x16& o0, f32x16& o1) {
    const float SCL = 0.125f * LOG2E;
    f32x16 p;
#pragma unroll
    for (int r = 0; r < 16; ++r) p[r] = 0.f;
#pragma unroll
    for (int d0 = 0; d0 < 4; ++d0) p = __builtin_amdgcn_mfma_f32_32x32x16_bf16(kf[d0], qf[d0], p, 0, 0, 0);
    unsigned vm = vmsel; asm volatile("" : "+v"(vm));
    float mx = -1e30f;
#pragma unroll
    for (int r = 0; r < 16; ++r) { const int kc = 32 * kh + (r & 3) + 8 * (r >> 2) + 4 * hi;
        int bi = kc - qc + 15; bi = bi < 0 ? 0 : bi; bi = bi > 30 ? 30 : bi;
        const float sc = p[r] * SCL + brow[bi]; p[r] = ((vm >> r) & 1u) ? sc : -1e30f; mx = fmaxf(mx, p[r]); }
    mx = xor32_max(mx);
    const float m_new = fmaxf(m_run, mx), alpha = fexp2(m_run - m_new); m_run = m_new;
    const float m_use = fmaxf(m_new, -1e20f);
    float ls = 0.f;
#pragma unroll
    for (int r = 0; r < 16; ++r) { const float e = fexp2(p[r] - m_use); p[r] = e; ls += e; }
    l_run = l_run * alpha + ls;
#pragma unroll
    for (int r = 0; r < 16; ++r) { o0[r] *= alpha; o1[r] *= alpha; }
#pragma unroll
    for (int k2 = 0; k2 < 2; ++k2) {
        u32x4 pw; pw.x = cvt_pk_bf16(p[8 * k2 + 0], p[8 * k2 + 1]); pw.y = cvt_pk_bf16(p[8 * k2 + 2], p[8 * k2 + 3]); pw.z = cvt_pk_bf16(p[8 * k2 + 4], p[8 * k2 + 5]); pw.w = cvt_pk_bf16(p[8 * k2 + 6], p[8 * k2 + 7]);
        const bf16x8 pa = __builtin_bit_cast(bf16x8, pw);
        o0 = __builtin_amdgcn_mfma_f32_32x32x16_bf16(vf[0][k2], pa, o0, 0, 0, 0);
        o1 = __builtin_amdgcn_mfma_f32_32x32x16_bf16(vf[1][k2], pa, o1, 0, 0, 0);
    }
}
__device__ __forceinline__ void na_store(bf16_t* orow, const f32x16& o0, const f32x16& o1, float l_run) {
    const float l = xor32_sum(l_run); const float inv = 1.0f / l;
#pragma unroll
    for (int rg = 0; rg < 4; ++rg) {
        u32x2 w; w.x = cvt_pk_bf16(o0[4 * rg] * inv, o0[4 * rg + 1] * inv); w.y = cvt_pk_bf16(o0[4 * rg + 2] * inv, o0[4 * rg + 3] * inv); *(u32x2*)(orow + 8 * rg) = w;
        u32x2 w2; w2.x = cvt_pk_bf16(o1[4 * rg] * inv, o1[4 * rg + 1] * inv); w2.y = cvt_pk_bf16(o1[4 * rg + 2] * inv, o1[4 * rg + 3] * inv); *(u32x2*)(orow + 32 + 8 * rg) = w2;
    }
}
__device__ __forceinline__ void na_unit(const LAS float* biasT, const bf16_t* Z, const bf16_t* VTn, bf16_t* AO, int tokbase, int S, int rr, int tid) {
    const int lane = tid & 63, h = tid >> 6, r32 = lane & 31, hi = lane >> 5;
    const int rows = S / 64; int rs = rr - 4; rs = rs < 0 ? 0 : rs; rs = rs > rows - 8 ? rows - 8 : rs;
    bf16x8 qfa[4], qfb[4];
#pragma unroll
    for (int d0 = 0; d0 < 4; ++d0) { qfa[d0] = *(const bf16x8*)(Z + (size_t)(tokbase + rr * 64 + r32) * ZP + 672 + h * 64 + 16 * d0 + 8 * hi);
                                      qfb[d0] = *(const bf16x8*)(Z + (size_t)(tokbase + rr * 64 + 32 + r32) * ZP + 672 + h * 64 + 16 * d0 + 8 * hi); }
    f32x16 oa0, oa1, ob0, ob1; float ma = -1e30f, mb = -1e30f, la = 0.f, lb = 0.f;
#pragma unroll
    for (int r = 0; r < 16; ++r) { oa0[r] = 0.f; oa1[r] = 0.f; ob0[r] = 0.f; ob1[r] = 0.f; }
    const unsigned va0 = na_vmask(r32, 0, hi), va1 = na_vmask(r32, 1, hi), vb0 = na_vmask(32 + r32, 0, hi), vb1 = na_vmask(32 + r32, 1, hi);
    const bf16_t* kbase = Z + (size_t)(tokbase + rs * 64 + r32) * ZP + 672 + 512 + h * 64 + 8 * hi;
    const bf16_t* vbase0 = VTn + (size_t)(h * 64 + r32) * TH + tokbase + rs * 64 + 4 * hi;
#define NA_LOADK(KF, IT) do { const int kr_ = (IT) >> 1, kh_ = (IT) & 1; const bf16_t* kp_ = kbase + (size_t)(kr_ * 64 + kh_ * 32) * ZP; \
        _Pragma("unroll") for (int d0 = 0; d0 < 4; ++d0) KF[d0] = *(const bf16x8*)(kp_ + 16 * d0); } while (0)
#define NA_LOADV(VF, IT) do { const int kr_ = (IT) >> 1, kh_ = (IT) & 1; const bf16_t* vp0_ = vbase0 + kr_ * 64 + kh_ * 32; const bf16_t* vp1_ = vp0_ + (size_t)32 * TH; \
        _Pragma("unroll") for (int k2 = 0; k2 < 2; ++k2) { const u32x2 lo = *(const u32x2*)(vp0_ + 16 * k2), hi2 = *(const u32x2*)(vp0_ + 16 * k2 + 8); VF[0][k2] = __builtin_bit_cast(bf16x8, ((u32x4){lo.x, lo.y, hi2.x, hi2.y})); \
            const u32x2 lo1 = *(const u32x2*)(vp1_ + 16 * k2), hi3 = *(const u32x2*)(vp1_ + 16 * k2 + 8); VF[1][k2] = __builtin_bit_cast(bf16x8, ((u32x4){lo1.x, lo1.y, hi3.x, hi3.y})); } } while (0)
    bf16x8 kf[4];
    NA_LOADK(kf, 0);
#pragma unroll 1
    for (int it = 0; it < 16; ++it) {
        const int kr = it >> 1, kh = it & 1;
        const LAS float* brow = biasT + (h * 15 + (rs + kr - rr + 7)) * 31;
        bf16x8 vf[2][2], kn[4];
        NA_LOADV(vf, it);
        const int itn = it + 1 < 16 ? it + 1 : 15;
        NA_LOADK(kn, itn);
        na_qs(kf, vf, qfa, brow, r32, kh, hi, kh ? va1 : va0, ma, la, oa0, oa1);
        na_qs(kf, vf, qfb, brow, 32 + r32, kh, hi, kh ? vb1 : vb0, mb, lb, ob0, ob1);
#pragma unroll
        for (int d0 = 0; d0 < 4; ++d0) kf[d0] = kn[d0];
    }
#undef NA_LOADK
#undef NA_LOADV
    na_store(AO + (size_t)(tokbase + rr * 64 + r32) * 1024 + 512 + h * 64 + 4 * hi, oa0, oa1, la);
    na_store(AO + (size_t)(tokbase + rr * 64 + 32 + r32) * 1024 + 512 + h * 64 + 4 * hi, ob0, ob1, lb);
}
#ifndef REP_SYNC
#define REP_SYNC 1
#endif
#ifndef REP_MLA
#define REP_MLA 1
#endif
#ifndef REP_NA
#define REP_NA 1
#endif
#ifndef REP_SCAN
#define REP_SCAN 1
#endif
#ifndef REP_UP
#define REP_UP 1
#endif
#ifndef REP_PASS
#define REP_PASS 1
#endif
#ifndef REP_GEMM
#define REP_GEMM 1
#endif
#define GSYNC() do { for (int r_ = 0; r_ < REP_SYNC; ++r_) xcd_barrier((unsigned*)(ap0->ws + WS_BAR), bst); } while (0)
constexpr int LDS_BYTES = 147456;
constexpr int NTHR = 512;
struct Args { const float* in[26]; float* out; unsigned char* ws; };


#define XB_TMO      128
#define XB_XCNT(j)  (256  + 64 * (j))
#define XB_XSUB(j)  (1280 + 64 * (j))
#define XB_XGEN(j)  (2304 + 64 * (j))
#define XB_TOP      3328
#define XB_TOPGEN   3392
#define XCD_BAR_WORDS 3456
#define XB_SPIN_CAP (1u << 22)
__device__ __forceinline__ unsigned xb_ld(unsigned* p)              { return __hip_atomic_load(p, __ATOMIC_RELAXED, __HIP_MEMORY_SCOPE_AGENT); }
__device__ __forceinline__ unsigned xb_add(unsigned* p, unsigned v) { return __hip_atomic_fetch_add(p, v, __ATOMIC_RELAXED, __HIP_MEMORY_SCOPE_AGENT); }
__device__ __forceinline__ unsigned xb_xcc_id() { return (unsigned)__builtin_amdgcn_s_getreg((3 << 11) | 20) & 0xFu; }
#define XB_SPIN(cond, bar) do { unsigned _sp = 0; while (cond) { __builtin_amdgcn_s_sleep(1); \
    if ((++_sp & 255u) == 0u) { if (xb_ld(&(bar)[XB_TMO])) break; if (_sp > XB_SPIN_CAP) { atomicAdd(&(bar)[XB_TMO], 1u); break; } } } } while (0)
__device__ __forceinline__ void xcd_barrier_complete(unsigned* bar, unsigned x, unsigned& nloc, unsigned& nx) {
    const unsigned G = gridDim.x;
    unsigned sum, cnt, mine, sp = 0u;
    for (;;) {
        sum = 0u; cnt = 0u; mine = 0u;
#pragma unroll
        for (unsigned j = 0; j < 16; ++j) { const unsigned c = xb_ld(&bar[XB_XCNT(j)]); sum += c; cnt += (c > 0u) ? 1u : 0u; mine = (j == x) ? c : mine; }
        if (sum == G) break;
        __builtin_amdgcn_s_sleep(1);
        if ((++sp & 255u) == 0u) { if (xb_ld(&bar[XB_TMO])) break; if (sp > XB_SPIN_CAP) { atomicAdd(&bar[XB_TMO], 1u); break; } }
    }
    nloc = mine > 0u ? mine : 1u; nx = cnt > 0u ? cnt : 1u;
}
__device__ __forceinline__ void xcd_barrier(unsigned* bar, volatile LAS unsigned* st) {
    asm volatile("s_waitcnt vmcnt(0)" ::: "memory");
    __syncthreads();
    if (threadIdx.x == 0) {
        __builtin_amdgcn_s_waitcnt(0);
        const unsigned x = xb_xcc_id();
        unsigned nloc = st[0], nx = st[1];
        if (nloc == 0u) { xcd_barrier_complete(bar, x, nloc, nx); st[0] = nloc; st[1] = nx; }
        const unsigned old = xb_add(&bar[XB_XSUB(x)], 1u);
        const unsigned gen = old / nloc;
        if (old + 1u == (gen + 1u) * nloc) {
            __builtin_amdgcn_fence(__ATOMIC_RELEASE, "agent");
            asm volatile("s_waitcnt vmcnt(0)" ::: "memory");
            const unsigned og = xb_add(&bar[XB_TOP], 1u);
            const unsigned tg = og / nx;
            if (og + 1u == (tg + 1u) * nx) xb_add(&bar[XB_TOPGEN], 1u);
            else XB_SPIN(xb_ld(&bar[XB_TOPGEN]) == tg, bar);
            __builtin_amdgcn_fence(__ATOMIC_ACQUIRE, "agent");
            xb_add(&bar[XB_XGEN(x)], 1u);
            asm volatile("s_waitcnt vmcnt(0)" ::: "memory");
        } else {
            XB_SPIN(xb_ld(&bar[XB_XGEN(x)]) == gen, bar);
            __builtin_amdgcn_fence(__ATOMIC_ACQUIRE, "agent");
            asm volatile("s_waitcnt vmcnt(0)" ::: "memory");
        }
    }
    __syncthreads();
}

__global__ void __launch_bounds__(NTHR, 2) mk_fwd(Args a) {
    extern __shared__ __attribute__((aligned(16))) unsigned char lds_raw[];
    LAS unsigned char* lds = (LAS unsigned char*)lds_raw;
    cg::grid_group grid = cg::this_grid();
    volatile LAS unsigned* bst = (volatile LAS unsigned*)(lds + LDS_BYTES - 64);
    if (threadIdx.x == 0) { bst[0] = 0u; bst[1] = 0u; }
    typedef const __attribute__((address_space(4))) Args* ArgP;
    ArgP ap0 = (ArgP)__builtin_amdgcn_kernarg_segment_ptr();
#define PH_BEGIN ArgP ap = ap0; asm volatile("" : "+s"(ap)); unsigned char* ws = ap->ws; (void)ws; int tid_ = threadIdx.x; asm volatile("" : "+v"(tid_)); const int tid = tid_, lane = tid & 63, wave = tid >> 6; int G_ = gridDim.x, bid_ = blockIdx.x; asm volatile("" : "+s"(G_), "+s"(bid_)); const int G = G_, bid = bid_; const int gw = bid * 8 + wave, NGW = G * 8; const int gt = bid * NTHR + tid, NGT = G * NTHR; (void)lane; (void)gw; (void)NGW; (void)gt; (void)NGT;
#define IN(k) (ap->in[k])
#define rsq ((float*)(ws + WS_RSQ))
#define rskv ((float*)(ws + WS_RSKV))
#define rope ((float2*)(ws + WS_ROPE))
#define AGG ((float2*)(ws + WS_AGG))
#define CARRY ((float*)(ws + WS_CARRY))
#define YB ((bf16_t*)(ws + WS_YB))
#define W_INATT ((bf16_t*)(ws + WS_W_INATT))
#define W_UQ ((bf16_t*)(ws + WS_W_UQ))
#define W_UKV ((bf16_t*)(ws + WS_W_UKV))
#define W_OUTATT ((bf16_t*)(ws + WS_W_OUTATT))
#define W_INREC ((bf16_t*)(ws + WS_W_INREC))
#define W_GATES ((bf16_t*)(ws + WS_W_GATES))
#define W_OUTREC ((bf16_t*)(ws + WS_W_OUTREC))
#define W_UP ((bf16_t*)(ws + WS_W_UP))
#define W_DOWN ((bf16_t*)(ws + WS_W_DOWN))
#define XN ((bf16_t*)(ws + WS_XN))
#define Zb ((bf16_t*)(ws + WS_Z))
#define Qb ((bf16_t*)(ws + WS_Q))
#define KN ((bf16_t*)(ws + WS_KN))
#define VTM ((bf16_t*)(ws + WS_VTM))
#define VTN ((bf16_t*)(ws + WS_VTN))
#define KPE ((bf16_t*)(ws + WS_KPE))
#define ACT ((bf16_t*)(ws + WS_ACT))
#define GATE ((bf16_t*)(ws + WS_GATE))
#define XB ((bf16_t*)(ws + WS_XB))
#define XBR ((bf16_t*)(ws + WS_XBR))
#define GQ ((bf16_t*)(ws + WS_GQ))
#define AO XN
#define Fb XN
#define YR XN
#define M0 Zb
#define M1 XBR
#define XIN (IN(half))
#define XST (ap->out + (size_t)half * TH * DM)
    { PH_BEGIN
    {
        LAS float* scr = (LAS float*)(lds + wave * 16384);
        constexpr int I_INATT = 16 * 69, I_UQ = 6 * 24, I_UKV = 4 * 32, I_SQ = 16 * 32, I_INREC = 16 * 64, I_UP = 16 * 256, I_DOWN = 64 * 32, I_GATE = 32 * 8;
        constexpr int NITEMS = I_INATT + I_UQ + I_UKV + 2 * I_SQ + I_INREC + 2 * I_UP + 2 * I_DOWN + I_GATE;
        for (int rep_ = 0; rep_ < REP_PASS; ++rep_)
        for (int it = gw; it < NITEMS; it += NGW) {
            int r = it;
            if (r < I_INATT) { transpose_item(IN(6), 1024, 2208, W_INATT, 0, nullptr, scr, r, lane); continue; } r -= I_INATT;
            if (r < I_UQ) { transpose_item(IN(8), 384, 768, W_UQ, 0, IN(7), scr, r, lane); continue; } r -= I_UQ;
            if (r < I_UKV) { transpose_item(IN(10), 256, 1024, W_UKV, 0, IN(9), scr, r, lane); continue; } r -= I_UKV;
            if (r < I_SQ) { transpose_item(IN(12), 1024, 1024, W_OUTATT, 0, nullptr, scr, r, lane); continue; } r -= I_SQ;
            if (r < I_SQ) { transpose_item(IN(21), 1024, 1024, W_OUTREC, 0, nullptr, scr, r, lane); continue; } r -= I_SQ;
            if (r < I_INREC) { transpose_item(IN(13), 1024, 2048, W_INREC, 0, nullptr, scr, r, lane); continue; } r -= I_INREC;
            if (r < 2 * I_UP) { const int li = r / I_UP; transpose_item(IN(22) + (size_t)li * 1024 * 8192, 1024, 8192, W_UP + (size_t)li * 8192 * 1024, 0, nullptr, scr, r % I_UP, lane); continue; } r -= 2 * I_UP;
            if (r < 2 * I_DOWN) { const int li = r / I_DOWN; transpose_item(IN(25) + (size_t)li * 4096 * 1024, 4096, 1024, W_DOWN + (size_t)li * 1024 * 4096, 0, nullptr, scr, r % I_DOWN, lane); continue; } r -= 2 * I_DOWN;
            { const int mat = r / 8, sub = r % 8; const int type = mat >> 4, e = (mat >> 3) & 1, n = mat & 7;
              transpose_item(IN(type ? 18 : 16) + (size_t)(e * 8 + n) * 128 * 128, 128, 128, W_GATES, n * 512 + e * 256 + type * 128, nullptr, scr, sub, lane); }
        }
        if (bid == 0) for (int i = tid; i < XCD_BAR_WORDS; i += NTHR) ((unsigned*)(ws + WS_BAR))[i] = 0u;
        for (int i = gt; i < 8 * 64 * 64; i += NGT) ((unsigned*)(ws + WS_CNT))[i] = 0u;
        for (int i = gt; i < 96 * 1024 / 8; i += NGT) ((u32x4*)(W_INATT + (size_t)2208 * 1024))[i] = (u32x4){0, 0, 0, 0};
        for (int m = gw; m < TH; m += NGW) xn_row(IN(0) + (size_t)m * DM, IN(2), XN + (size_t)m * DM, lane);
        for (int i = gt; i < 4096 * 16; i += NGT) { const int pos = i >> 4, j = i & 15;
            const double inv = exp2(-(double)j * (13.287712379549449 / 16.0));
            const double rev = (double)pos * inv * 0.15915494309189535; const float fr = (float)(rev - floor(rev));
            rope[i] = make_float2(__builtin_amdgcn_cosf(fr), __builtin_amdgcn_sinf(fr)); }
    }

    }
    grid.sync();
    if (threadIdx.x == 0) (void)xb_add((unsigned*)(ap0->ws + WS_BAR) + XB_XCNT(xb_xcc_id()), 1u);
    for (int half = 0; half < 2; ++half) {
        const int S = half ? 4096 : 2048, nseq = TH / S;
        if (half == 1 && gridDim.x != 256) {
                { PH_BEGIN
        for (int m = gw; m < TH; m += NGW) xn_row(XIN + (size_t)m * DM, IN(2), XN + (size_t)m * DM, lane);
        }
        GSYNC();
        }
        { PH_BEGIN
        { pg8::Gemm g = pg8::make_gemm(XN, DM, W_INATT, DM, DM); pg8::StaticOrder so; so.init(TH / 256, ZP / 256, G, bid);
          EpiZ E{Zb, VTN, (float*)(ws + WS_SQP), nullptr, KPE, rope, S - 1};
#ifndef NO_G1
for (int rep_ = 0; rep_ < REP_GEMM; ++rep_) pg8::gemm_phase<EpiZ>(lds, g, so, E);
#endif
 }
        }
        GSYNC();
        { PH_BEGIN
        { pg8::Gemm g = pg8::make_gemm(Zb, ZP, W_UQ, 384, 384); pg8::StaticOrder so; so.init(TH / 256, 3, G, bid);
          EpiQ E{Qb, (const float*)(ws + WS_SQP), rope, S - 1};
#ifndef NO_G2
for (int rep_ = 0; rep_ < REP_GEMM; ++rep_) pg8::gemm_phase<EpiQ>(lds, g, so, E);
#endif
 }
        { pg8::Gemm g = pg8::make_gemm(Zb + 384, ZP, W_UKV, 256, 256); pg8::StaticOrder so; so.init(TH / 256, 4, G, bid);
          EpiKV E{KN, VTM, (const float*)(ws + WS_SQP)};
#ifndef NO_G3
for (int rep_ = 0; rep_ < REP_GEMM; ++rep_) pg8::gemm_phase<EpiKV>(lds, g, so, E);
#endif
 }
        }
        GSYNC();
        { PH_BEGIN
        {
            LAS float* biasT = (LAS float*)(lds + 98304);
            for (int i = tid; i < 8 * 15 * 31; i += NTHR) biasT[i] = IN(11)[i] * LOG2E;
            __syncthreads();
            const int nqb = S / 512, nunits = nseq * 8 * nqb;
            const int vb = (G % 8 == 0) ? (bid % 8) * (G / 8) + bid / 8 : bid;
#ifdef DELAY_P4A
        { const unsigned long long t0_ = __builtin_amdgcn_s_memrealtime(); while (__builtin_amdgcn_s_memrealtime() - t0_ < 40000ull) __builtin_amdgcn_s_sleep(32); }
#endif
#ifndef NO_MLA
            for (int rep_ = 0; rep_ < REP_MLA; ++rep_) {
#ifdef REP_MLA_SYNC
            if (rep_ > 0) GSYNC();
#endif
#ifdef REP_DELAY
            if (rep_ > 0) { const unsigned long long t0_ = __builtin_amdgcn_s_memrealtime(); while (__builtin_amdgcn_s_memrealtime() - t0_ < 40000ull) __builtin_amdgcn_s_sleep(32); continue; }
#endif
            for (int u = vb; u < nunits; u += G) { const int qb = u % nqb, h = (u / nqb) & 7, s = u / (nqb * 8);
                mla_unit(lds, Qb, KN, KPE, VTM, AO, s * S, S, h, qb, tid); }
            }
#endif
#ifdef MLA_TWICE
            for (int u = vb; u < nunits; u += G) { const int qb = u % nqb, h = (u / nqb) & 7, s = u / (nqb * 8);
                mla_unit(lds, Qb, KN, KPE, VTM, AO, s * S, S, h, qb, tid); }
#endif
            const int rows = S / 64, nna = nseq * rows;
#ifdef DELAY_P4B
        { const unsigned long long t0_ = __builtin_amdgcn_s_memrealtime(); while (__builtin_amdgcn_s_memrealtime() - t0_ < 40000ull) __builtin_amdgcn_s_sleep(32); }
#endif
#ifdef RELOAD_BIAS
            __syncthreads();
            for (int i = tid; i < 8 * 15 * 31; i += NTHR) biasT[i] = IN(11)[i] * LOG2E;
            __syncthreads();
#endif
#ifndef NO_NA
            for (int rep_ = 0; rep_ < REP_NA; ++rep_)
            for (int u = vb; u < nna; u += G) na_unit(biasT, Zb, VTN, AO, (u / rows) * S, S, u % rows, tid);
#endif
        }
        }
        GSYNC();
        { PH_BEGIN
        { pg8::Gemm g = pg8::make_gemm(AO, DM, W_OUTATT, DM, DM); pg8::StaticOrder so; so.init(TH / 256, 4, G, bid);
          EpiBf16 E{M0, DM, 0, 0};
#ifndef NO_G4
for (int rep_ = 0; rep_ < REP_GEMM; ++rep_) pg8::gemm_phase<EpiBf16>(lds, g, so, E);
#endif
 }
        }
        GSYNC();
        { PH_BEGIN
        for (int m = gw; m < TH; m += 2 * NGW) { const int m2 = m + NGW; if (m2 < TH) res_row2(M0 + (size_t)m * DM, M0 + (size_t)m2 * DM, XIN + (size_t)m * DM, XIN + (size_t)m2 * DM, XST + (size_t)m * DM, XST + (size_t)m2 * DM, IN(3), IN(4), XN + (size_t)m * DM, XN + (size_t)m2 * DM, lane); else res_row(M0 + (size_t)m * DM, XIN + (size_t)m * DM, XST + (size_t)m * DM, IN(3), IN(4), XN + (size_t)m * DM, lane); }
        }
        GSYNC();

        for (int li = 0; li < 2; ++li) {
            if (li == 1) {
                { PH_BEGIN
                { pg8::Gemm g = pg8::make_gemm(XN, DM, W_INREC, DM, DM); pg8::StaticOrder so; so.init(TH / 256, 8, G, bid);
                  EpiBf16 E{GATE, DM, 1024, (size_t)(WS_XBR - WS_GATE) / 2};
#ifndef NO_G5
for (int rep_ = 0; rep_ < REP_GEMM; ++rep_) pg8::gemm_phase<EpiBf16>(lds, g, so, E);
#endif
 }
                }
                GSYNC();
                { PH_BEGIN
                for (int i0 = gt; i0 < TH * 128; i0 += 4 * NGT) {
                    u32x4 wv[4][4]; int tt[4], cc[4];
#pragma unroll
                    for (int u = 0; u < 4; ++u) { const int i = i0 + u * NGT; const int t = i >> 7, c8 = (i & 127) * 8; const int pos = t & (S - 1); tt[u] = t; cc[u] = c8;
#pragma unroll
                        for (int k = 0; k < 4; ++k) { const int p2 = pos + k - 1; wv[u][k] = (p2 < 0 || p2 >= S || i >= TH * 128) ? (u32x4){0u, 0u, 0u, 0u} : *(const u32x4*)(XBR + (size_t)(t + k - 1) * DM + c8); } }
#pragma unroll
                    for (int u = 0; u < 4; ++u) { if (i0 + u * NGT >= TH * 128) break; const int c8 = cc[u];
                        float accv[8];
#pragma unroll
                        for (int j = 0; j < 8; ++j) accv[j] = IN(15)[c8 + j];
#pragma unroll
                        for (int k = 0; k < 4; ++k) { const u32x4 w = wv[u][k]; const float* cwk = IN(14) + k * 1024 + c8;
                            accv[0] += cwk[0] * bflo(w.x); accv[1] += cwk[1] * bfhi(w.x); accv[2] += cwk[2] * bflo(w.y); accv[3] += cwk[3] * bfhi(w.y);
                            accv[4] += cwk[4] * bflo(w.z); accv[5] += cwk[5] * bfhi(w.z); accv[6] += cwk[6] * bflo(w.w); accv[7] += cwk[7] * bfhi(w.w); }
                        u32x4 o; o.x = cvt_pk_bf16(accv[0], accv[1]); o.y = cvt_pk_bf16(accv[2], accv[3]); o.z = cvt_pk_bf16(accv[4], accv[5]); o.w = cvt_pk_bf16(accv[6], accv[7]);
                        *(u32x4*)(XB + (size_t)tt[u] * DM + c8) = o; }
                }
                }
                GSYNC();
                for (int qt = 0; qt < 2; ++qt) {
                    const int t0 = qt * TQ;
                    { PH_BEGIN
                    { pg8::Gemm g = pg8::make_gemm(XB + (size_t)t0 * DM, DM, W_GATES, 128, 128); g.a_pn_shift = 1; g.a_pn_step = 256; g.a_seg = 1; g.hA = (size_t)4 * DM * 2;
                      pg8::StaticOrder so; so.init(TQ / 256, 16, G, bid);
                      EpiGates E{GQ, XB + (size_t)t0 * DM, AGG, IN(17), IN(19), IN(20)};
                      pg8::gemm_phase<EpiGates>(lds, g, so, E);
 }
                    }
                    GSYNC();
                    { PH_BEGIN
                    { const int cps = S / 32, nsq = TQ / S;
                      for (int rep_ = 0; rep_ < REP_SCAN; ++rep_)
                      for (int i = gt; i < nsq * 2 * 1024; i += NGT) { const int ch = i & 1023, e = (i >> 10) & 1, sq = i >> 11;
                          float hcar = 0.f;
#pragma unroll 16
                          for (int k = 0; k < cps; ++k) { const int c = sq * cps + (e ? cps - 1 - k : k); const int idx = (c * 2 + e) * 1024 + ch;
                              CARRY[idx] = hcar; const float2 ab = AGG[idx]; hcar = ab.x * hcar + ab.y; } } }
                    }
                    GSYNC();
                    { PH_BEGIN
#ifndef NO_R6
                    for (int rep_ = 0; rep_ < REP_SCAN; ++rep_)
                    for (int i = gt; i < 256 * 512; i += NGT) { const int cp = i & 511, c = i >> 9; const int ch = 2 * cp, n = ch >> 7, d = ch & 127;
                        const bf16_t* gq0 = GQ + (size_t)(c * 32) * 4096 + n * 512 + d;
                        bf16_t* yr0 = YR + (size_t)(t0 + c * 32) * DM + ch; const bf16_t* gt0 = GATE + (size_t)(t0 + c * 32) * DM + ch;
                        unsigned hfw[32];
                        { const float2 hc2 = *(const float2*)(CARRY + (size_t)(c * 2 + 0) * 1024 + ch); float h0 = hc2.x, h1 = hc2.y;
#pragma unroll
                          for (int s = 0; s < 32; ++s) {
                            const unsigned l2 = *(const unsigned*)(gq0 + (size_t)s * 4096), b2 = *(const unsigned*)(gq0 + (size_t)s * 4096 + 128);
                            h0 = fexp2(bflo(l2)) * h0 + bflo(b2); h1 = fexp2(bfhi(l2)) * h1 + bfhi(b2);
                            hfw[s] = cvt_pk_bf16(h0, h1); } }
                        { const float2 hc2 = *(const float2*)(CARRY + (size_t)(c * 2 + 1) * 1024 + ch); float h0 = hc2.x, h1 = hc2.y;
                          unsigned lq[32], bq[32], gq_[32];
#pragma unroll
                          for (int s = 0; s < 32; ++s) { lq[s] = *(const unsigned*)(gq0 + (size_t)s * 4096 + 256); bq[s] = *(const unsigned*)(gq0 + (size_t)s * 4096 + 384); gq_[s] = *(const unsigned*)(gt0 + (size_t)s * DM); }
#pragma unroll
                          for (int s = 31; s >= 0; --s) {
                            const unsigned l2 = lq[s], b2 = bq[s];
                            h0 = fexp2(bflo(l2)) * h0 + bflo(b2); h1 = fexp2(bfhi(l2)) * h1 + bfhi(b2);
                            const unsigned g2 = gq_[s], f2 = hfw[s];
                            *(unsigned*)(yr0 + (size_t)s * DM) = cvt_pk_bf16((bflo(f2) + h0) * gelu_tanh(bflo(g2)), (bfhi(f2) + h1) * gelu_tanh(bfhi(g2))); } }
                    }
#endif
                    }
                    GSYNC();
                }
                { PH_BEGIN
                { pg8::Gemm g = pg8::make_gemm(YR, DM, W_OUTREC, DM, DM); pg8::StaticOrder so; so.init(TH / 256, 4, G, bid);
                  EpiBf16 E{M1, DM, 0, 0};
#ifndef NO_G7
for (int rep_ = 0; rep_ < REP_GEMM; ++rep_) pg8::gemm_phase<EpiBf16>(lds, g, so, E);
#endif
 }
                }
                GSYNC();
                { PH_BEGIN
                for (int m = gw; m < TH; m += 2 * NGW) { const int m2 = m + NGW; if (m2 < TH) res_row2(M1 + (size_t)m * DM, M1 + (size_t)m2 * DM, XST + (size_t)m * DM, XST + (size_t)m2 * DM, XST + (size_t)m * DM, XST + (size_t)m2 * DM, IN(3) + 1024, IN(4) + 1024, XN + (size_t)m * DM, XN + (size_t)m2 * DM, lane); else res_row(M1 + (size_t)m * DM, XST + (size_t)m * DM, XST + (size_t)m * DM, IN(3) + 1024, IN(4) + 1024, XN + (size_t)m * DM, lane); }
                }
                GSYNC();
            }
            { PH_BEGIN
            { pg8::Gemm g = pg8::make_gemm(XN, DM, W_UP + (size_t)li * 8192 * 1024, DM, DM);
              g.a_seg = 1; g.hA = (size_t)4 * DM * 2; g.tB = (size_t)128 * DM * 2; g.hB = (size_t)4096 * DM * 2;
              pg8::StaticOrder so; so.init(TH / 256, 32, G, bid);
#ifndef NO_UP
              EpiUp E{ACT, YB, IN(23) + (size_t)li * 3 * 8192, IN(24) + (size_t)li * 8192}; for (int rep_ = 0; rep_ < REP_UP; ++rep_) pg8::gemm_phase<EpiUp>(lds, g, so, E);
#endif
 }
            }
            GSYNC();
            { PH_BEGIN
            for (int rep_ = 0; rep_ < REP_PASS; ++rep_)
            for (int b = bid; b < 256; b += G) { const int seg = b >> 1, which = b & 1; const int t = seg * 128 + (which ? 127 : 0); const int pos = t & (S - 1);
                const float* cw = IN(23) + (size_t)li * 3 * 8192; const float* cb = IN(24) + (size_t)li * 8192;
                const bool hasp = which ? true : (pos != 0), hasn = which ? (pos != S - 1) : true;
                const bf16_t* yp = which ? YB + ((size_t)seg * 4 + 2) * 8192 : YB + ((size_t)(seg - 1) * 4 + 3) * 8192;
                const bf16_t* yc = YB + ((size_t)seg * 4 + (which ? 3 : 0)) * 8192;
                const bf16_t* yn = which ? YB + ((size_t)(seg + 1) * 4 + 0) * 8192 : YB + ((size_t)seg * 4 + 1) * 8192;
                for (int c = tid; c < 4096; c += NTHR) {
                    float u2[2];
#pragma unroll
                    for (int bj = 0; bj < 2; ++bj) { const int ch = bj * 4096 + c;
                        float r = cw[8192 + ch] * bf2f(yc[ch]) + cb[ch];
                        if (hasp) r += cw[ch] * bf2f(yp[ch]);
                        if (hasn) r += cw[2 * 8192 + ch] * bf2f(yn[ch]);
                        u2[bj] = r; }
                    ACT[(size_t)t * DFF + c] = f2bf(gelu_tanh(u2[0]) * u2[1]); } }
            }
            GSYNC();
            if (gridDim.x == 256) {
                { PH_BEGIN
                { pg8::Gemm g = pg8::make_gemm(ACT, DFF, W_DOWN + (size_t)li * 1024 * 4096, DFF, DFF); pg8::StaticOrder so; so.init(TH / 256, 4, G, bid);
                  const int use = half * 2 + li;
                  EpiRms E{XST, li == 0 ? XN : nullptr, IN(5) + li * 1024, IN(2) + 1024, (float*)(ws + WS_XBUF), (float*)(ws + WS_XBUF) + (size_t)TH * 4,
                           (unsigned*)(ws + WS_CNT) + (size_t)(use * 2) * 4096, (unsigned*)(ws + WS_CNT) + (size_t)(use * 2 + 1) * 4096};
                  pg8::gemm_phase<EpiRms>(lds, g, so, E); }
                if (half == 0 && li == 1)
                  { for (int m = gw; m < TH; m += NGW) xn_row(IN(1) + (size_t)m * DM, IN(2), XN + (size_t)m * DM, lane);
                  }
                }
                GSYNC();
            } else {
                { PH_BEGIN
                { pg8::Gemm g = pg8::make_gemm(ACT, DFF, W_DOWN + (size_t)li * 1024 * 4096, DFF, DFF); pg8::StaticOrder so; so.init(TH / 256, 4, G, bid);
                  EpiBf16 E{Fb, DM, 0, 0};
                  pg8::gemm_phase<EpiBf16>(lds, g, so, E); }
                }
                GSYNC();
                { PH_BEGIN
                for (int m = gw; m < TH; m += NGW) res_row(Fb + (size_t)m * DM, XST + (size_t)m * DM, XST + (size_t)m * DM, IN(5) + li * 1024, li == 0 ? IN(2) + 1024 : nullptr, XN + (size_t)m * DM, lane);
                }
                GSYNC();
            }
        }
    }
}

extern "C" void kernel_launch(void* const* d_in, const int* in_sizes, int n_in, void* d_out, int out_size, void* d_ws, size_t ws_size, hipStream_t stream) {
    static int grid = 0;
    if (grid == 0) {
        int dev = 0, cus = 0, per_cu = 0;
        (void)hipGetDevice(&dev);
        (void)hipDeviceGetAttribute(&cus, hipDeviceAttributeMultiprocessorCount, dev);
        (void)hipFuncSetAttribute((const void*)mk_fwd, hipFuncAttributeMaxDynamicSharedMemorySize, LDS_BYTES);
        (void)hipOccupancyMaxActiveBlocksPerMultiprocessor(&per_cu, (const void*)mk_fwd, NTHR, LDS_BYTES);
        if (per_cu < 1) per_cu = 1;
        grid = cus * per_cu;
        if (ws_size < WS_END || n_in != 26) { fprintf(stderr, "kernel_launch: unexpected ws_size %zu / n_in %d\n", ws_size, n_in); }
    }
    Args a{};
    for (int i = 0; i < 26; ++i) a.in[i] = (const float*)d_in[i];
    a.out = (float*)d_out; a.ws = (unsigned char*)d_ws;
    void* args[] = {&a};
    hipError_t e = hipLaunchCooperativeKernel((const void*)mk_fwd, dim3(grid), dim3(NTHR), args, LDS_BYTES, stream);
    if (e != hipSuccess) fprintf(stderr, "cooperative launch failed: %s (grid %d)\n", hipGetErrorString(e), grid);
}
```

```cpp
#include <hip/hip_runtime.h>
#include <hip/hip_cooperative_groups.h>
#include <cstdio>
#include <cstdint>
namespace cg = cooperative_groups;

#define LAS __attribute__((address_space(3)))
typedef unsigned short bf16_t;
typedef short bf16x8 __attribute__((ext_vector_type(8)));
typedef short s16x4 __attribute__((ext_vector_type(4)));
typedef float f32x4 __attribute__((ext_vector_type(4)));
typedef float f32x16 __attribute__((ext_vector_type(16)));
typedef unsigned u32x4 __attribute__((ext_vector_type(4)));
typedef unsigned u32x2 __attribute__((ext_vector_type(2)));

__device__ __forceinline__ unsigned cvt_pk_bf16(float lo, float hi) { unsigned r; asm volatile("v_cvt_pk_bf16_f32 %0, %1, %2" : "=v"(r) : "v"(lo), "v"(hi)); return r; }
__device__ __forceinline__ float bf2f(bf16_t v) { return __uint_as_float(((unsigned)v) << 16); }
__device__ __forceinline__ float bflo(unsigned w) { return __uint_as_float(w << 16); }
__device__ __forceinline__ float bfhi(unsigned w) { return __uint_as_float(w & 0xffff0000u); }
__device__ __forceinline__ bf16_t f2bf(float f) { return (bf16_t)(cvt_pk_bf16(f, 0.f) & 0xffffu); }
__device__ __forceinline__ float fexp2(float x) { return __builtin_amdgcn_exp2f(x); }
__device__ __forceinline__ float frcp(float x) { return __builtin_amdgcn_rcpf(x); }
__device__ __forceinline__ float gelu_tanh(float x) {
    const float u = x * (1.0f + 0.044715f * x * x) * (-2.0f * 0.7978845608028654f * 1.4426950408889634f);
    return x * frcp(1.0f + fexp2(u));
}
__device__ __forceinline__ float sigmoidf_(float x) { return frcp(1.0f + fexp2(-1.4426950408889634f * x)); }
__device__ __forceinline__ float bperm_f(int src_lane, float v) { return __int_as_float(__builtin_amdgcn_ds_bpermute(src_lane << 2, __float_as_int(v))); }
#define DPP_F(V, CTRL) __int_as_float(__builtin_amdgcn_mov_dpp(__float_as_int(V), (CTRL), 0xf, 0xf, true))
__device__ __forceinline__ float wave_sum(float v, int  ) {
    v += DPP_F(v, 0xB1);
    v += DPP_F(v, 0x4E);
    v += DPP_F(v, 0x141);
    v += DPP_F(v, 0x140);
    const int iv = __float_as_int(v);
    return (__int_as_float(__builtin_amdgcn_readlane(iv, 0)) + __int_as_float(__builtin_amdgcn_readlane(iv, 16))) + (__int_as_float(__builtin_amdgcn_readlane(iv, 32)) + __int_as_float(__builtin_amdgcn_readlane(iv, 48)));
}
__device__ __forceinline__ float xor32_max(float v) { auto rr = __builtin_amdgcn_permlane32_swap(__float_as_uint(v), __float_as_uint(v), false, false); return fmaxf(__uint_as_float(rr[0]), __uint_as_float(rr[1])); }
__device__ __forceinline__ float xor32_sum(float v) { auto rr = __builtin_amdgcn_permlane32_swap(__float_as_uint(v), __float_as_uint(v), false, false); return __uint_as_float(rr[0]) + __uint_as_float(rr[1]); }

__device__ __forceinline__ void lru_ab(float ga, float gx, float gab, float gxb, float spl  , float xb, float& a, float& b) {
    const float r = sigmoidf_(ga + gab), ii = sigmoidf_(gx + gxb);
    const float la2 = (-8.0f * 1.4426950408889634f) * r * spl;
    a = fexp2(la2);
    const float om = 1.0f - a * a;
    b = __builtin_amdgcn_sqrtf(om) * (ii * xb);
}


__device__ __forceinline__ void lru_lb(float ga, float gx, float gab, float gxb, float spl, float xb, float& la2, float& b) {
    const float r = sigmoidf_(ga + gab), ii = sigmoidf_(gx + gxb);
    la2 = (-8.0f * 1.4426950408889634f) * r * spl;
    const float a = fexp2(la2); const float om = 1.0f - a * a;
    b = __builtin_amdgcn_sqrtf(om) * (ii * xb);
}

namespace pg8 {
constexpr int BM = 256, BK = 64, HALF = 128, HTB = HALF * BK * 2, STAGE_BYTES = 8 * HTB, NXCD = 8, WGM = 8;
__host__ __device__ __forceinline__ int lds_byte(int r, int c) { const int st = (r >> 4) * 2 + (c >> 5), rr = r & 15, cc = c & 31, ob = rr * 64 + cc * 2; return st * 1024 + (ob ^ (((ob >> 9) & 1) << 5)); }
__host__ __device__ __forceinline__ void stage_rc(int b, int& R, int& C) { const int st = b / 1024, sb = b % 1024, swz = sb ^ (((sb >> 9) & 1) << 5); R = (st >> 1) * 16 + swz / 64; C = (st & 1) * 32 + (swz % 64) / 2; }
__host__ __device__ __forceinline__ int perm32(int rho) { const int n = rho >> 4, i = rho & 15; return 8 * (i >> 2) + 4 * n + (i & 3); }

struct Unit { int pm, pn; };
struct Gemm { const bf16_t* A; const bf16_t* Bt; int lda, ldb, K; size_t tA, hA, tB, hB; int a_seg; int a_pn_shift; size_t a_pn_step; };
__device__ __forceinline__ Gemm make_gemm(const bf16_t* A, int lda, const bf16_t* Bt, int ldb, int K) {
    Gemm g; g.A = A; g.Bt = Bt; g.lda = lda; g.ldb = ldb; g.K = K; g.tA = (size_t)256 * lda * 2; g.hA = (size_t)128 * lda * 2; g.tB = (size_t)256 * ldb * 2; g.hB = (size_t)128 * ldb * 2;
    g.a_seg = 0; g.a_pn_shift = 0; g.a_pn_step = 0; return g;
}

struct StaticOrder {
    int nM, nN, nwg, G, c;
    __device__ __forceinline__ void init(int nM_, int nN_, int G_, int c_) { nM = nM_; nN = nN_; nwg = nM * nN; G = G_; c = c_; }
    __device__ __forceinline__ bool next(int i, Unit& u) const {
        const long L = (long)i * G + c; if (L >= nwg) return false;
        int wgid = (int)L; { const int q = nwg / NXCD, r = nwg % NXCD, xcd = wgid % NXCD, off = wgid / NXCD; wgid = (xcd < r ? xcd * (q + 1) : r * (q + 1) + (xcd - r) * q) + off; }
        const int nig = WGM * nN, gid = wgid / nig, fm = gid * WGM, gsz = (nM - fm) < WGM ? (nM - fm) : WGM;
        u.pm = fm + ((wgid % nig) % gsz); u.pn = (wgid % nig) / gsz; return true;
    }
};

template <class Epi>
__device__ __forceinline__ void gemm_phase(LAS unsigned char* lds, const Gemm g, const StaticOrder& S, const Epi& E) {
    constexpr bool SP2 = true, ALIGN_EPI = true;
    int tid_ = threadIdx.x; asm volatile("" : "+v"(tid_));
    const int tid = tid_, wid = __builtin_amdgcn_readfirstlane(tid >> 6), lane = tid & 63, wr = wid >> 2, wc = wid & 3, fr = lane & 15, fq = lane >> 4;
    int K_ = g.K; asm volatile("" : "+s"(K_)); const int K = K_, nt = K / BK;
    unsigned voffA[2], voffB[2];
#pragma unroll
    for (int i = 0; i < 2; ++i) { int R, C; stage_rc(tid * 16 + i * 8192, R, C); const int Rb = Epi::PERM ? ((R & ~31) + perm32(R & 31)) : R;
        const int Ra = g.a_seg ? (128 * (R >> 6) + 8 * (R & 15) + ((R >> 4) & 3)) : R;
        voffA[i] = (unsigned)(Ra * g.lda + C) * 2u; voffB[i] = (unsigned)(Rb * g.ldb + C) * 2u; }
    const size_t kstep = (size_t)(BK * 2);
    const size_t hstepA = g.hA, hstepB = g.hB;
    const unsigned ldsw = (unsigned)wid * 1024u;
    const int aoff = lds_byte(wr * 64 + fr, fq * 8), boff = lds_byte(wc * 32 + fr, fq * 8);
#define PG8_SA(b, h) (((b) * 2 + (h)) * HTB)
#define PG8_SB(b, h) ((4 + (b) * 2 + (h)) * HTB)
#define PG8_STAGE(bufoff, gbase, voff) do { _Pragma("unroll") for (int _i = 0; _i < 2; ++_i) \
        __builtin_amdgcn_global_load_lds((const unsigned*)((const char*)(gbase) + (voff)[_i]), (LAS unsigned*)(lds + (bufoff) + ldsw + _i * 8192), 16, 0, 0); } while (0)
#define PG8_LDA(dst, b, h) do { _Pragma("unroll") for (int m = 0; m < 4; ++m) _Pragma("unroll") for (int k = 0; k < 2; ++k) dst[m][k] = *(const LAS bf16x8*)(lds + PG8_SA(b, h) + aoff + m * 2048 + k * 1024); } while (0)
#define PG8_LDB(dst, b, h) do { _Pragma("unroll") for (int n = 0; n < 2; ++n) _Pragma("unroll") for (int k = 0; k < 2; ++k) dst[n][k] = *(const LAS bf16x8*)(lds + PG8_SB(b, h) + boff + n * 2048 + k * 1024); } while (0)
#define PG8_MMA(ai, bj, At, Bt) do { __builtin_amdgcn_s_setprio(1); _Pragma("unroll") for (int m = 0; m < 4; ++m) _Pragma("unroll") for (int n = 0; n < 2; ++n) _Pragma("unroll") for (int k = 0; k < 2; ++k) \
        acc[ai][bj][m][n] = __builtin_amdgcn_mfma_f32_16x16x32_bf16(Bt[n][k], At[m][k], acc[ai][bj][m][n], 0, 0, 0); __builtin_amdgcn_s_setprio(0); } while (0)
#define PG8_WAIT_V(n) asm volatile("s_waitcnt vmcnt(" #n ")" ::: "memory")
#define PG8_WAIT_L(n) asm volatile("s_waitcnt lgkmcnt(" #n ")" ::: "memory")
#define PG8_BAR __builtin_amdgcn_s_barrier()
#define PG8_SCHED __builtin_amdgcn_sched_barrier(0)
#define PG8_APTR(u) ((const char*)g.A + (size_t)(u).pm * g.tA + (size_t)((u).pn >> g.a_pn_shift) * g.a_pn_step)
#define PG8_BPTR(u) ((const char*)g.Bt + (size_t)(u).pn * g.tB)
    Unit cur, nxt; int ui = 0;
    if (!S.next(0, cur)) return;
    f32x4 acc[2][2][4][2];
#pragma unroll
    for (int a = 0; a < 2; ++a)
#pragma unroll
        for (int b = 0; b < 2; ++b)
#pragma unroll
            for (int m = 0; m < 4; ++m)
#pragma unroll
                for (int n = 0; n < 2; ++n) acc[a][b][m][n] = (f32x4){0.f, 0.f, 0.f, 0.f};
    bf16x8 At[4][2], B0[2][2], B1[2][2];
    const char* cA = PG8_APTR(cur); const char* cB = PG8_BPTR(cur);
    {
        PG8_STAGE(PG8_SB(0, 0), cB, voffB); PG8_STAGE(PG8_SB(0, 1), cB + hstepB, voffB); PG8_STAGE(PG8_SA(0, 0), cA, voffA); PG8_STAGE(PG8_SA(0, 1), cA + hstepA, voffA);
        if (wr == 1) PG8_BAR;
        PG8_WAIT_V(2); PG8_BAR;
        PG8_STAGE(PG8_SB(1, 0), cB + kstep, voffB); PG8_STAGE(PG8_SA(1, 0), cA + kstep, voffA); PG8_STAGE(PG8_SB(1, 1), cB + hstepB + kstep, voffB);
        PG8_WAIT_V(6); PG8_BAR;
    }
    for (;;) {
        const bool has_next = S.next(ui + 1, nxt);
        const char* nA = has_next ? PG8_APTR(nxt) : cA; const char* nB = has_next ? PG8_BPTR(nxt) : cB;
        for (int t = 0; t < nt; t += 2) {
            const bool last = (t == nt - 2);
            const char* a1 = cA + (size_t)(t + 1) * kstep;
            const char* a2 = last ? nA : cA + (size_t)(t + 2) * kstep; const char* b2 = last ? nB : cB + (size_t)(t + 2) * kstep;
            const char* a3 = a2 + kstep; const char* b3 = b2 + kstep;
            PG8_LDB(B0, 0, 0); PG8_LDB(B1, 0, 1); PG8_SCHED; PG8_LDA(At, 0, 0); PG8_STAGE(PG8_SA(1, 1), a1 + hstepA, voffA);
            PG8_WAIT_V(8); PG8_WAIT_L(0); PG8_BAR; PG8_MMA(0, 0, At, B0); PG8_MMA(0, 1, At, B1); PG8_BAR; PG8_SCHED;
            PG8_LDA(At, 0, 1); PG8_STAGE(PG8_SB(0, 0), b2, voffB); PG8_STAGE(PG8_SB(0, 1), b2 + hstepB, voffB); PG8_STAGE(PG8_SA(0, 0), a2, voffA);
            PG8_WAIT_V(8); PG8_WAIT_L(0); PG8_BAR; PG8_MMA(1, 0, At, B0); PG8_MMA(1, 1, At, B1); PG8_BAR; PG8_SCHED;
            PG8_LDB(B0, 1, 0); PG8_LDB(B1, 1, 1); PG8_SCHED; PG8_LDA(At, 1, 0); PG8_STAGE(PG8_SA(0, 1), a2 + hstepA, voffA);
            PG8_WAIT_V(8); PG8_WAIT_L(0); PG8_BAR; PG8_MMA(0, 0, At, B0); PG8_MMA(0, 1, At, B1); PG8_BAR; PG8_SCHED;
            PG8_LDA(At, 1, 1); PG8_STAGE(PG8_SB(1, 0), b3, voffB); PG8_STAGE(PG8_SB(1, 1), b3 + hstepB, voffB); PG8_STAGE(PG8_SA(1, 0), a3, voffA);
            PG8_WAIT_V(8); PG8_WAIT_L(0); PG8_BAR; PG8_MMA(1, 0, At, B0); PG8_MMA(1, 1, At, B1); PG8_BAR; PG8_SCHED;
        }
        if constexpr (ALIGN_EPI) { if (wr == 0) PG8_BAR; }
        if constexpr (!Epi::AFTER_DRAIN) E(acc, cur, wr, wc, fr, fq);
        if (!has_next) break;
#pragma unroll
        for (int a = 0; a < 2; ++a)
#pragma unroll
            for (int b = 0; b < 2; ++b)
#pragma unroll
                for (int m = 0; m < 4; ++m)
#pragma unroll
                    for (int n = 0; n < 2; ++n) acc[a][b][m][n] = (f32x4){0.f, 0.f, 0.f, 0.f};
        cur = nxt; cA = nA; cB = nB; ++ui;
        if constexpr (ALIGN_EPI) { if (wr == 1) PG8_BAR; }
    }
    PG8_WAIT_V(0);
    if constexpr (!ALIGN_EPI) { if (wr == 0) PG8_BAR; }
    PG8_BAR;
    if constexpr (Epi::AFTER_DRAIN) E.fused(acc, cur, wr, wc, fr, fq, lds, wid, lane);
#undef PG8_SA
#undef PG8_SB
#undef PG8_STAGE
#undef PG8_LDA
#undef PG8_LDB
#undef PG8_MMA
#undef PG8_WAIT_V
#undef PG8_WAIT_L
#undef PG8_BAR
#undef PG8_SCHED
#undef PG8_APTR
#undef PG8_BPTR
}
}
constexpr int TH = 16384;
constexpr int DM = 1024, ZP = 2304, DFF = 4096, TQ = 8192;
constexpr size_t MiB = 1u << 20;
constexpr size_t WS_RSQ = 0, WS_RSKV = 64 * 1024, WS_ROPE = 128 * 1024;
constexpr size_t WS_AGG = 5 * MiB;
constexpr size_t WS_CARRY = 9 * MiB;
constexpr size_t WS_XBUF = 1 * MiB;
constexpr size_t WS_SQP = 1 * MiB + 512 * 1024;
constexpr size_t WS_CNT = 3 * MiB;
constexpr size_t WS_BAR = 4 * MiB;
constexpr size_t WS_YB = 5 * MiB;
constexpr size_t WS_W_INATT = 13 * MiB;
constexpr size_t WS_W_UQ = WS_W_INATT + (size_t)2304 * 1024 * 2;
constexpr size_t WS_W_UKV = WS_W_UQ + (size_t)768 * 384 * 2;
constexpr size_t WS_W_OUTATT = WS_W_UKV + (size_t)1024 * 256 * 2;
constexpr size_t WS_W_INREC = WS_W_OUTATT + 2 * MiB;
constexpr size_t WS_W_GATES = WS_W_INREC + 4 * MiB;
constexpr size_t WS_W_OUTREC = WS_W_GATES + 1 * MiB;
constexpr size_t WS_W_UP = WS_W_OUTREC + 2 * MiB;
constexpr size_t WS_W_DOWN = WS_W_UP + 32 * MiB;
constexpr size_t WS_W_END = WS_W_DOWN + 16 * MiB;
static_assert(WS_W_END <= 76 * MiB, "weights");
constexpr size_t WS_XN = 76 * MiB;
constexpr size_t WS_BIG = 108 * MiB;
constexpr size_t WS_Z = WS_BIG;
constexpr size_t WS_Q = WS_Z + 72 * MiB;
constexpr size_t WS_KN = WS_Q + 24 * MiB;
constexpr size_t WS_VTM = WS_KN + 16 * MiB;
constexpr size_t WS_VTN = WS_VTM + 16 * MiB;
constexpr size_t WS_KPE = WS_VTN + 16 * MiB;
static_assert(WS_KPE + 1 * MiB <= 256 * MiB, "L0 overlay");
constexpr size_t WS_ACT = WS_BIG;
constexpr size_t WS_GATE = WS_BIG;
constexpr size_t WS_XB = WS_BIG + 32 * MiB;
constexpr size_t WS_XBR = WS_BIG + 64 * MiB;
constexpr size_t WS_GQ = WS_XBR;
constexpr size_t WS_END = 256 * MiB;

using pg8::Unit;

struct EpiBf16 {
    static constexpr bool PERM = true, AFTER_DRAIN = false;
    bf16_t* O; int ldc; int split_cols; size_t split_stride;
    __device__ __forceinline__ void operator()(f32x4 (&acc)[2][2][4][2], const Unit& u, int wr, int wc, int fr, int fq) const {
        const int row0 = u.pm * 256 + wr * 64 + fr; int colt = u.pn * 256; bf16_t* base = O;
        if (split_cols) { const int t = colt / split_cols; base += (size_t)t * split_stride; colt -= t * split_cols; }
        const int col0 = colt + wc * 32 + 8 * fq;
#pragma unroll
        for (int ai = 0; ai < 2; ++ai)
#pragma unroll
            for (int m = 0; m < 4; ++m) { bf16_t* rowp = base + (size_t)(row0 + ai * 128 + m * 16) * ldc + col0;
#pragma unroll
                for (int bj = 0; bj < 2; ++bj) { const f32x4 v0 = acc[ai][bj][m][0], v1 = acc[ai][bj][m][1];
                    u32x4 w; w.x = cvt_pk_bf16(v0[0], v0[1]); w.y = cvt_pk_bf16(v0[2], v0[3]); w.z = cvt_pk_bf16(v1[0], v1[1]); w.w = cvt_pk_bf16(v1[2], v1[3]);
                    *(u32x4*)(rowp + bj * 128) = w; } }
    }
};

struct EpiZ {
    static constexpr bool PERM = true, AFTER_DRAIN = false;
    bf16_t* Z; bf16_t* VTn; float* SQ; float* SKV; bf16_t* KPE; const float2* rope; int smask;
    __device__ __forceinline__ void operator()(f32x4 (&acc)[2][2][4][2], const Unit& u, int wr, int wc, int fr, int fq) const {
        const int lane = fq * 16 + fr;
        const int row0 = u.pm * 256 + wr * 64 + fr; const int col0 = u.pn * 256 + wc * 32 + 8 * fq;
#pragma unroll
        for (int ai = 0; ai < 2; ++ai)
#pragma unroll
            for (int m = 0; m < 4; ++m) { const int row = row0 + ai * 128 + m * 16; bf16_t* rowp = Z + (size_t)row * ZP + col0;
#pragma unroll
                for (int bj = 0; bj < 2; ++bj) { const f32x4 v0 = acc[ai][bj][m][0], v1 = acc[ai][bj][m][1];
                    u32x4 w; w.x = cvt_pk_bf16(v0[0], v0[1]); w.y = cvt_pk_bf16(v0[2], v0[3]); w.z = cvt_pk_bf16(v1[0], v1[1]); w.w = cvt_pk_bf16(v1[2], v1[3]);
                    *(u32x4*)(rowp + bj * 128) = w;
                    const int c = col0 + bj * 128; const int g32 = (u.pn * 256 + bj * 128 + wc * 32) >> 5;
                    if (g32 < 20) {
                        float s = (v0[0] * v0[0] + v0[1] * v0[1]) + (v0[2] * v0[2] + v0[3] * v0[3]) + ((v1[0] * v1[0] + v1[1] * v1[1]) + (v1[2] * v1[2] + v1[3] * v1[3]));
                        s += bperm_f(lane ^ 16, s); s += bperm_f(lane ^ 32, s);
                        if (fq == 0) SQ[(size_t)row * 20 + g32] = s;
                    } else if (g32 == 20) {
                        const float2* rp = rope + (size_t)(row & smask) * 16 + 8 * (fq & 1);
                        float o[8];
#pragma unroll
                        for (int k = 0; k < 8; ++k) { const float mine = k < 4 ? v0[k] : v1[k - 4]; const float other = bperm_f(lane ^ 32, mine); const float2 cs = rp[k];
                            o[k] = fq < 2 ? mine * cs.x - other * cs.y : mine * cs.x + other * cs.y; }
                        u32x4 wk; wk.x = cvt_pk_bf16(o[0], o[1]); wk.y = cvt_pk_bf16(o[2], o[3]); wk.z = cvt_pk_bf16(o[4], o[5]); wk.w = cvt_pk_bf16(o[6], o[7]);
                        *(u32x4*)(KPE + (size_t)row * 32 + 8 * fq) = wk;
                    }
                    if (c >= 1696 && c < 2208) { bf16_t* vt = VTn + (size_t)(c - 1696) * TH + row;
                        vt[0] = (bf16_t)(w.x & 0xffffu); vt[TH] = (bf16_t)(w.x >> 16); vt[2 * TH] = (bf16_t)(w.y & 0xffffu); vt[3 * TH] = (bf16_t)(w.y >> 16);
                        vt[4 * TH] = (bf16_t)(w.z & 0xffffu); vt[5 * TH] = (bf16_t)(w.z >> 16); vt[6 * TH] = (bf16_t)(w.w & 0xffffu); vt[7 * TH] = (bf16_t)(w.w >> 16); } } }
    }
};

struct EpiQ {
    static constexpr bool PERM = false, AFTER_DRAIN = false;
    bf16_t* Q; const float* rsq; const float2* rope; int smask;
    __device__ __forceinline__ void operator()(f32x4 (&acc)[2][2][4][2], const Unit& u, int wr, int wc, int fr, int fq) const {
        const float SC = 0.10206207261596577f * 1.4426950408889634f;
        const int row0 = u.pm * 256 + wr * 64 + fr;
#pragma unroll
        for (int ai = 0; ai < 2; ++ai)
#pragma unroll
            for (int m = 0; m < 4; ++m) { const int row = row0 + ai * 128 + m * 16; float ssq = 0.f;
#pragma unroll
                for (int k = 0; k < 12; ++k) ssq += rsq[(size_t)row * 20 + k];
                const float rs = SC / sqrtf(ssq * (1.f / 384.f) + 1e-6f); const int pos = row & smask;
#pragma unroll
                for (int bj = 0; bj < 2; ++bj) { const int cg = u.pn * 256 + bj * 128 + wc * 32;
                    f32x4 v0 = acc[ai][bj][m][0] * rs, v1 = acc[ai][bj][m][1] * rs;
                    if ((cg % 96) == 64) {
                        const float2* rp = rope + (size_t)pos * 16 + 4 * fq;
#pragma unroll
                        for (int i = 0; i < 4; ++i) { const float2 cs = rp[i]; const float x1 = v0[i], x2 = v1[i]; v0[i] = x1 * cs.x - x2 * cs.y; v1[i] = x2 * cs.x + x1 * cs.y; }
                    }
                    bf16_t* p = Q + (size_t)row * 768 + cg + 4 * fq;
                    u32x2 w0; w0.x = cvt_pk_bf16(v0[0], v0[1]); w0.y = cvt_pk_bf16(v0[2], v0[3]); *(u32x2*)p = w0;
                    u32x2 w1; w1.x = cvt_pk_bf16(v1[0], v1[1]); w1.y = cvt_pk_bf16(v1[2], v1[3]); *(u32x2*)(p + 16) = w1; } }
    }
};

struct EpiKV {
    static constexpr bool PERM = true, AFTER_DRAIN = false;
    bf16_t* KN; bf16_t* VTm; const float* rskv;
    __device__ __forceinline__ void operator()(f32x4 (&acc)[2][2][4][2], const Unit& u, int wr, int wc, int fr, int fq) const {
        const int row0 = u.pm * 256 + wr * 64 + fr;
#pragma unroll
        for (int ai = 0; ai < 2; ++ai)
#pragma unroll
            for (int m = 0; m < 4; ++m) { const int row = row0 + ai * 128 + m * 16; float ssq = 0.f;
#pragma unroll
                for (int k = 12; k < 20; ++k) ssq += rskv[(size_t)row * 20 + k];
                const float rs = 1.0f / sqrtf(ssq * (1.f / 256.f) + 1e-6f);
#pragma unroll
                for (int bj = 0; bj < 2; ++bj) { const int c = u.pn * 256 + bj * 128 + wc * 32 + 8 * fq;
                    const f32x4 v0 = acc[ai][bj][m][0] * rs, v1 = acc[ai][bj][m][1] * rs;
                    u32x4 w; w.x = cvt_pk_bf16(v0[0], v0[1]); w.y = cvt_pk_bf16(v0[2], v0[3]); w.z = cvt_pk_bf16(v1[0], v1[1]); w.w = cvt_pk_bf16(v1[2], v1[3]);
                    const int h = c >> 7, j = c & 127;
                    if (j < 64) { *(u32x4*)(KN + (size_t)row * 512 + h * 64 + j) = w; }
                    else { bf16_t* vt = VTm + (size_t)(h * 64 + j - 64) * TH + row;
                        vt[0] = (bf16_t)(w.x & 0xffffu); vt[TH] = (bf16_t)(w.x >> 16); vt[2 * TH] = (bf16_t)(w.y & 0xffffu); vt[3 * TH] = (bf16_t)(w.y >> 16);
                        vt[4 * TH] = (bf16_t)(w.z & 0xffffu); vt[5 * TH] = (bf16_t)(w.z >> 16); vt[6 * TH] = (bf16_t)(w.w & 0xffffu); vt[7 * TH] = (bf16_t)(w.w >> 16); } } }
    }
};

struct EpiUp {
    static constexpr bool PERM = true, AFTER_DRAIN = false;
    bf16_t* ACT; bf16_t* YB; const float* cw; const float* cb;
    __device__ __forceinline__ void operator()(f32x4 (&acc)[2][2][4][2], const Unit& u, int wr, int wc, int fr_, int fq_) const {
        int fr = fr_, fq = fq_; asm volatile("" : "+v"(fr), "+v"(fq));
        const int lane = fq * 16 + fr;
        const int tok0 = u.pm * 256 + wr * 128 + 8 * fr;
        const int ch0 = u.pn * 128 + wc * 32 + 8 * fq;
        const int seg = u.pm * 2 + wr;
        if (fr == 0 || fr == 15) {
#pragma unroll
            for (int k = 0; k < 2; ++k) {
                const int slot = fr == 0 ? k : 2 + k;
                bf16_t* yb = YB + ((size_t)seg * 4 + slot) * 8192 + ch0;
#pragma unroll
                for (int bj = 0; bj < 2; ++bj) { const f32x4 v0 = fr == 0 ? acc[0][bj][k][0] : acc[1][bj][2 + k][0], v1 = fr == 0 ? acc[0][bj][k][1] : acc[1][bj][2 + k][1];
                    u32x4 w; w.x = cvt_pk_bf16(v0[0], v0[1]); w.y = cvt_pk_bf16(v0[2], v0[3]); w.z = cvt_pk_bf16(v1[0], v1[1]); w.w = cvt_pk_bf16(v1[2], v1[3]);
                    *(u32x4*)(yb + bj * 4096) = w; }
            }
        }
        const int src_up = (lane & ~15) | ((fr - 1) & 15), src_dn = (lane & ~15) | ((fr + 1) & 15);
#pragma unroll
        for (int n = 0; n < 2; ++n)
#pragma unroll
            for (int i = 0; i < 4; ++i) {
                float ug[8], uv[8];
#pragma unroll
                for (int bj = 0; bj < 2; ++bj) {
                    const int ch = bj * 4096 + ch0 + 4 * n + i;
                    const float w0 = cw[ch], w1 = cw[8192 + ch], w2 = cw[2 * 8192 + ch], b = cb[ch];
                    const float prev7 = bperm_f(src_up, acc[1][bj][3][n][i]);
                    const float next0 = bperm_f(src_dn, acc[0][bj][0][n][i]);
#pragma unroll
                    for (int q = 0; q < 8; ++q) {
                        const float v = acc[q >> 2][bj][q & 3][n][i];
                        const float up = q > 0 ? acc[(q - 1) >> 2][bj][(q - 1) & 3][n][i] : prev7;
                        const float dn = q < 7 ? acc[(q + 1) >> 2][bj][(q + 1) & 3][n][i] : next0;
                        const float r = w0 * up + w1 * v + w2 * dn + b;
                        if (bj == 0) ug[q] = r; else uv[q] = r;
                    }
                }
#pragma unroll
                for (int q = 0; q < 8; ++q) acc[q >> 2][0][q & 3][n][i] = gelu_tanh(ug[q]) * uv[q];
            }
#pragma unroll
        for (int ai = 0; ai < 2; ++ai)
#pragma unroll
            for (int m = 0; m < 4; ++m) { const f32x4 v0 = acc[ai][0][m][0], v1 = acc[ai][0][m][1];
                u32x4 w; w.x = cvt_pk_bf16(v0[0], v0[1]); w.y = cvt_pk_bf16(v0[2], v0[3]); w.z = cvt_pk_bf16(v1[0], v1[1]); w.w = cvt_pk_bf16(v1[2], v1[3]);
                *(u32x4*)(ACT + (size_t)(tok0 + 4 * ai + m) * DFF + ch0) = w; }
    }
};

struct EpiGates {
    static constexpr bool PERM = true, AFTER_DRAIN = false;
    bf16_t* G; const bf16_t* XBq; float2* AGGp; const float* gab_; const float* gxb_; const float* lam_;
    __device__ __forceinline__ void operator()(f32x4 (&acc)[2][2][4][2], const Unit& u, int wr, int wc, int fr_, int fq_) const {
        int fr = fr_, fq = fq_; asm volatile("" : "+v"(fr), "+v"(fq));
        const int lane = fq * 16 + fr;
        const int nblk = u.pn >> 1, e = u.pn & 1;
        const int tl0 = u.pm * 256 + wr * 128 + 8 * fr;
        const int d0 = wc * 32 + 8 * fq, ch0 = nblk * 128 + d0;
        u32x4 xbw[8];
#pragma unroll
        for (int q = 0; q < 8; ++q) xbw[q] = *(const u32x4*)(XBq + (size_t)(tl0 + q) * DM + ch0);
        unsigned law[8][4], bw[8][4];
#pragma unroll
        for (int k2 = 0; k2 < 4; ++k2) {
            const float2 gab = *(const float2*)(gab_ + e * 1024 + ch0 + 2 * k2), gxb = *(const float2*)(gxb_ + e * 1024 + ch0 + 2 * k2), lam = *(const float2*)(lam_ + e * 1024 + ch0 + 2 * k2);
            const float spl0 = log1pf(expf(-lam.x)), spl1 = log1pf(expf(-lam.y));
#pragma unroll
            for (int q = 0; q < 8; ++q) {
                const unsigned xb2 = k2 == 0 ? xbw[q].x : k2 == 1 ? xbw[q].y : k2 == 2 ? xbw[q].z : xbw[q].w;
                float l0, b0, l1, b1;
                lru_lb(acc[q >> 2][0][q & 3][k2 >> 1][2 * (k2 & 1)], acc[q >> 2][1][q & 3][k2 >> 1][2 * (k2 & 1)], gab.x, gxb.x, spl0, bflo(xb2), l0, b0);
                lru_lb(acc[q >> 2][0][q & 3][k2 >> 1][2 * (k2 & 1) + 1], acc[q >> 2][1][q & 3][k2 >> 1][2 * (k2 & 1) + 1], gab.y, gxb.y, spl1, bfhi(xb2), l1, b1);
                law[q][k2] = cvt_pk_bf16(l0, l1); bw[q][k2] = cvt_pk_bf16(b0, b1); }
        }
#pragma unroll
        for (int q = 0; q < 8; ++q) { bf16_t* rowp = G + (size_t)(tl0 + q) * 4096 + u.pn * 256 + d0;
            *(u32x4*)(rowp) = (u32x4){law[q][0], law[q][1], law[q][2], law[q][3]}; *(u32x4*)(rowp + 128) = (u32x4){bw[q][0], bw[q][1], bw[q][2], bw[q][3]}; }
        float Aagg[8], Bagg[8];
#pragma unroll
        for (int k2 = 0; k2 < 4; ++k2) {
            float A0 = 1.f, B0 = 0.f, A1 = 1.f, B1 = 0.f;
#pragma unroll
            for (int s = 0; s < 8; ++s) {
                const unsigned l2 = e ? law[7 - s][k2] : law[s][k2], b2 = e ? bw[7 - s][k2] : bw[s][k2];
                const float a0 = fexp2(bflo(l2)), a1 = fexp2(bfhi(l2));
                A0 *= a0; B0 = a0 * B0 + bflo(b2); A1 *= a1; B1 = a1 * B1 + bfhi(b2); }
            Aagg[2 * k2] = A0; Bagg[2 * k2] = B0; Aagg[2 * k2 + 1] = A1; Bagg[2 * k2 + 1] = B1;
        }
#pragma unroll
        for (int bit = 1; bit <= 2; bit <<= 1) {
            const bool me_first = e ? ((fr & bit) != 0) : ((fr & bit) == 0);
#pragma unroll
            for (int k = 0; k < 8; ++k) { const float Ao = bperm_f(lane ^ bit, Aagg[k]), Bo = bperm_f(lane ^ bit, Bagg[k]);
                const float An = Ao * Aagg[k], Bn = me_first ? Ao * Bagg[k] + Bo : Aagg[k] * Bo + Bagg[k];
                Aagg[k] = An; Bagg[k] = Bn; }
        }
        if ((fr & 3) == 0) { const int c = (tl0 >> 5);
            float2* dst = AGGp + (size_t)(c * 2 + e) * 1024 + ch0;
#pragma unroll
            for (int k = 0; k < 8; k += 2) *(f32x4*)(dst + k) = (f32x4){Aagg[k], Bagg[k], Aagg[k + 1], Bagg[k + 1]}; }
    }
};

struct EpiRms {
    static constexpr bool PERM = false, AFTER_DRAIN = true;
    float* x; bf16_t* xn; const float* gpost; const float* gnext; float* xbuf1; float* xbuf2; unsigned* cnt1; unsigned* cnt2;
    __device__ __forceinline__ void operator()(f32x4 (&)[2][2][4][2], const Unit&, int, int, int, int) const {}
    __device__ __forceinline__ void stats(const f32x4 (&v)[2][2][4][2], const Unit& u, int wr, int wc, int fr, int fq, LAS unsigned char* lds, int wid, int lane, float* xbuf, unsigned* cnt) const {
        LAS float* P = (LAS float*)lds; LAS float* Sx = (LAS float*)(lds + 4096);
#pragma unroll
        for (int ai = 0; ai < 2; ++ai)
#pragma unroll
            for (int m = 0; m < 4; ++m) { float s = 0.f;
#pragma unroll
                for (int bj = 0; bj < 2; ++bj)
#pragma unroll
                    for (int n = 0; n < 2; ++n) { const f32x4 t = v[ai][bj][m][n]; s += (t[0] * t[0] + t[1] * t[1]) + (t[2] * t[2] + t[3] * t[3]); }
                s += bperm_f(lane ^ 16, s); s += bperm_f(lane ^ 32, s);
                if (fq == 0) P[(ai * 128 + wr * 64 + m * 16 + fr) * 4 + wc] = s; }
        asm volatile("s_waitcnt lgkmcnt(0)" ::: "memory"); __builtin_amdgcn_s_barrier(); asm volatile("" ::: "memory");
        const int row = wid * 32 + (lane & 31);
        if (lane < 32) { const float t = (P[row * 4 + 0] + P[row * 4 + 1]) + (P[row * 4 + 2] + P[row * 4 + 3]);
            __hip_atomic_store(xbuf + (size_t)(u.pm * 256 + row) * 4 + u.pn, t, __ATOMIC_RELAXED, __HIP_MEMORY_SCOPE_AGENT); }
        asm volatile("s_waitcnt vmcnt(0)" ::: "memory");
        if (lane == 0) __hip_atomic_fetch_add(cnt + 64 * u.pm, 1u, __ATOMIC_RELAXED, __HIP_MEMORY_SCOPE_AGENT);
        if (wid == 0) { unsigned sp = 0;
            while ((unsigned)__builtin_amdgcn_readfirstlane(__hip_atomic_load(cnt + 64 * u.pm, __ATOMIC_RELAXED, __HIP_MEMORY_SCOPE_AGENT)) < 32u) { __builtin_amdgcn_s_sleep(2); if (++sp > (1u << 22)) break; }
            __builtin_amdgcn_fence(__ATOMIC_ACQUIRE, "agent"); }
        asm volatile("s_waitcnt vmcnt(0) lgkmcnt(0)" ::: "memory"); __builtin_amdgcn_s_barrier(); asm volatile("" ::: "memory");
        if (lane < 32) { const float* slot = xbuf + (size_t)(u.pm * 256 + row) * 4; float t = 0.f;
#pragma unroll
            for (int k = 0; k < 4; ++k) t += __hip_atomic_load(slot + k, __ATOMIC_RELAXED, __HIP_MEMORY_SCOPE_AGENT);
            Sx[row] = 1.0f / sqrtf(t * (1.f / 1024.f) + 1e-6f); }
        asm volatile("s_waitcnt lgkmcnt(0)" ::: "memory"); __builtin_amdgcn_s_barrier(); asm volatile("" ::: "memory");
    }
    __device__ __forceinline__ void fused(f32x4 (&acc)[2][2][4][2], const Unit& u, int wr, int wc, int fr, int fq, LAS unsigned char* lds, int wid, int lane) const {
        const LAS float* Sx = (const LAS float*)(lds + 4096);
        const int col0 = u.pn * 256 + wc * 32 + 4 * fq;
        stats(acc, u, wr, wc, fr, fq, lds, wid, lane, xbuf1, cnt1);
#pragma unroll
        for (int ai = 0; ai < 2; ++ai)
#pragma unroll
            for (int m = 0; m < 4; ++m) { const int r = ai * 128 + wr * 64 + m * 16 + fr; const float rs = Sx[r]; float* xr = x + (size_t)(u.pm * 256 + r) * DM + col0;
#pragma unroll
                for (int bj = 0; bj < 2; ++bj)
#pragma unroll
                    for (int n = 0; n < 2; ++n) { const f32x4 g = *(const f32x4*)(gpost + col0 + bj * 128 + n * 16); const f32x4 bs = *(const f32x4*)(xr + bj * 128 + n * 16);
                        const f32x4 o = bs + acc[ai][bj][m][n] * rs * g; acc[ai][bj][m][n] = o; *(f32x4*)(xr + bj * 128 + n * 16) = o; }
                if (m & 1) asm volatile("" ::: "memory"); }
        if (xn) {
            stats(acc, u, wr, wc, fr, fq, lds, wid, lane, xbuf2, cnt2);
#pragma unroll
            for (int ai = 0; ai < 2; ++ai)
#pragma unroll
                for (int m = 0; m < 4; ++m) { const int r = ai * 128 + wr * 64 + m * 16 + fr; const float rs = Sx[r]; bf16_t* xr = xn + (size_t)(u.pm * 256 + r) * DM + col0;
#pragma unroll
                    for (int bj = 0; bj < 2; ++bj)
#pragma unroll
                        for (int n = 0; n < 2; ++n) { const f32x4 g = *(const f32x4*)(gnext + col0 + bj * 128 + n * 16); const f32x4 o = acc[ai][bj][m][n] * rs * g;
                            u32x2 w; w.x = cvt_pk_bf16(o[0], o[1]); w.y = cvt_pk_bf16(o[2], o[3]); *(u32x2*)(xr + bj * 128 + n * 16) = w; } }
        }
    }
};
constexpr float EPS = 1e-6f;
constexpr float LOG2E = 1.4426950408889634f;

__device__ __forceinline__ void transpose_item(const float* W, int K, int N, bf16_t* WT, int row_off, const float* kscale, LAS float* scr, int item, int lane) {
    const int nblk = N / 32, kb = item / nblk, nb = item % nblk, k0 = 64 * kb, n0 = 32 * nb;
#pragma unroll 8
    for (int i = 0; i < 32; ++i) { const int kk = 2 * i + (lane >> 5); float v = W[(size_t)(k0 + kk) * N + n0 + (lane & 31)]; if (kscale) v *= kscale[k0 + kk]; scr[kk * 33 + (lane & 31)] = v; }
    asm volatile("s_waitcnt lgkmcnt(0)" ::: "memory");
    const int c = lane & 7;
#pragma unroll
    for (int j = 0; j < 4; ++j) { const int n = (lane >> 3) + 8 * j; const LAS float* s = scr + (8 * c) * 33 + n;
        u32x4 o; o.x = cvt_pk_bf16(s[0 * 33], s[1 * 33]); o.y = cvt_pk_bf16(s[2 * 33], s[3 * 33]); o.z = cvt_pk_bf16(s[4 * 33], s[5 * 33]); o.w = cvt_pk_bf16(s[6 * 33], s[7 * 33]);
        *(u32x4*)(WT + (size_t)(row_off + n0 + n) * K + k0 + 8 * c) = o; }
    asm volatile("s_waitcnt lgkmcnt(0)" ::: "memory");
}

__device__ __forceinline__ void xn_row(const float* xrow, const float* gain, bf16_t* orow, int lane) {
    const f32x4* xr = (const f32x4*)xrow + lane; const f32x4* gr = (const f32x4*)gain + lane;
    f32x4 v[4]; float s = 0.f;
#pragma unroll
    for (int j = 0; j < 4; ++j) { v[j] = xr[64 * j]; s += (v[j].x * v[j].x + v[j].y * v[j].y) + (v[j].z * v[j].z + v[j].w * v[j].w); }
    const float rs = 1.0f / sqrtf(wave_sum(s, lane) * (1.f / DM) + EPS);
    u32x2* o8 = (u32x2*)orow + lane;
#pragma unroll
    for (int j = 0; j < 4; ++j) { const f32x4 g = gr[64 * j]; u32x2 w; w.x = cvt_pk_bf16(v[j].x * rs * g.x, v[j].y * rs * g.y); w.y = cvt_pk_bf16(v[j].z * rs * g.z, v[j].w * rs * g.w); o8[64 * j] = w; }
}

__device__ __forceinline__ void res_row(const bf16_t* mrow, const float* xi, float* xo, const float* gpost, const float* gnext, bf16_t* xnrow, int lane) {
    const u32x2* mr = (const u32x2*)mrow + lane; const f32x4* xr = (const f32x4*)xi + lane; const f32x4* gp = (const f32x4*)gpost + lane;
    f32x4 mv[4]; float s = 0.f;
#pragma unroll
    for (int j = 0; j < 4; ++j) { const u32x2 w = mr[64 * j]; mv[j] = (f32x4){bflo(w.x), bfhi(w.x), bflo(w.y), bfhi(w.y)}; s += (mv[j].x * mv[j].x + mv[j].y * mv[j].y) + (mv[j].z * mv[j].z + mv[j].w * mv[j].w); }
    const float rs = 1.0f / sqrtf(wave_sum(s, lane) * (1.f / DM) + EPS);
    f32x4 x[4]; float s2 = 0.f;
#pragma unroll
    for (int j = 0; j < 4; ++j) { const f32x4 g = gp[64 * j]; x[j] = xr[64 * j] + mv[j] * rs * g; s2 += (x[j].x * x[j].x + x[j].y * x[j].y) + (x[j].z * x[j].z + x[j].w * x[j].w); }
    f32x4* xw = (f32x4*)xo + lane;
#pragma unroll
    for (int j = 0; j < 4; ++j) xw[64 * j] = x[j];
    if (gnext) {
        const float rs2 = 1.0f / sqrtf(wave_sum(s2, lane) * (1.f / DM) + EPS);
        const f32x4* gn = (const f32x4*)gnext + lane; u32x2* o8 = (u32x2*)xnrow + lane;
#pragma unroll
        for (int j = 0; j < 4; ++j) { const f32x4 g = gn[64 * j]; u32x2 w; w.x = cvt_pk_bf16(x[j].x * rs2 * g.x, x[j].y * rs2 * g.y); w.y = cvt_pk_bf16(x[j].z * rs2 * g.z, x[j].w * rs2 * g.w); o8[64 * j] = w; }
    }
}

__device__ __forceinline__ void res_row2(const bf16_t* m0, const bf16_t* m1, const float* xi0, const float* xi1, float* xo0, float* xo1, const float* gpost, const float* gnext, bf16_t* xn0, bf16_t* xn1, int lane) {
    const u32x2* mr0 = (const u32x2*)m0 + lane; const u32x2* mr1 = (const u32x2*)m1 + lane; const f32x4* xr0 = (const f32x4*)xi0 + lane; const f32x4* xr1 = (const f32x4*)xi1 + lane; const f32x4* gp = (const f32x4*)gpost + lane;
    u32x2 w0[4], w1[4]; f32x4 xa[4], xb[4], g[4];
#pragma unroll
    for (int j = 0; j < 4; ++j) { w0[j] = mr0[64 * j]; w1[j] = mr1[64 * j]; xa[j] = xr0[64 * j]; xb[j] = xr1[64 * j]; g[j] = gp[64 * j]; }
    f32x4 ma[4], mb[4]; float s0 = 0.f, s1 = 0.f;
#pragma unroll
    for (int j = 0; j < 4; ++j) { ma[j] = (f32x4){bflo(w0[j].x), bfhi(w0[j].x), bflo(w0[j].y), bfhi(w0[j].y)}; mb[j] = (f32x4){bflo(w1[j].x), bfhi(w1[j].x), bflo(w1[j].y), bfhi(w1[j].y)};
        s0 += (ma[j].x * ma[j].x + ma[j].y * ma[j].y) + (ma[j].z * ma[j].z + ma[j].w * ma[j].w); s1 += (mb[j].x * mb[j].x + mb[j].y * mb[j].y) + (mb[j].z * mb[j].z + mb[j].w * mb[j].w); }
    const float rs0 = 1.0f / sqrtf(wave_sum(s0, lane) * (1.f / DM) + EPS), rs1 = 1.0f / sqrtf(wave_sum(s1, lane) * (1.f / DM) + EPS);
    float t0 = 0.f, t1 = 0.f;
#pragma unroll
    for (int j = 0; j < 4; ++j) { xa[j] = xa[j] + ma[j] * rs0 * g[j]; xb[j] = xb[j] + mb[j] * rs1 * g[j];
        t0 += (xa[j].x * xa[j].x + xa[j].y * xa[j].y) + (xa[j].z * xa[j].z + xa[j].w * xa[j].w); t1 += (xb[j].x * xb[j].x + xb[j].y * xb[j].y) + (xb[j].z * xb[j].z + xb[j].w * xb[j].w); }
    f32x4* xw0 = (f32x4*)xo0 + lane; f32x4* xw1 = (f32x4*)xo1 + lane;
#pragma unroll
    for (int j = 0; j < 4; ++j) { xw0[64 * j] = xa[j]; xw1[64 * j] = xb[j]; }
    if (gnext) {
        const float q0 = 1.0f / sqrtf(wave_sum(t0, lane) * (1.f / DM) + EPS), q1 = 1.0f / sqrtf(wave_sum(t1, lane) * (1.f / DM) + EPS);
        const f32x4* gn = (const f32x4*)gnext + lane; u32x2* o0 = (u32x2*)xn0 + lane; u32x2* o1 = (u32x2*)xn1 + lane;
#pragma unroll
        for (int j = 0; j < 4; ++j) { const f32x4 h = gn[64 * j];
            u32x2 a; a.x = cvt_pk_bf16(xa[j].x * q0 * h.x, xa[j].y * q0 * h.y); a.y = cvt_pk_bf16(xa[j].z * q0 * h.z, xa[j].w * q0 * h.w); o0[64 * j] = a;
            u32x2 b; b.x = cvt_pk_bf16(xb[j].x * q1 * h.x, xb[j].y * q1 * h.y); b.y = cvt_pk_bf16(xb[j].z * q1 * h.z, xb[j].w * q1 * h.w); o1[64 * j] = b; }
    }
}

#define MLA_PACK(P, B) ((u32x4){cvt_pk_bf16(P[B], P[B + 1]), cvt_pk_bf16(P[B + 2], P[B + 3]), cvt_pk_bf16(P[B + 4], P[B + 5]), cvt_pk_bf16(P[B + 6], P[B + 7])})
__device__ __forceinline__ void mla_softmax(f32x16& p0, f32x16& p1, float& m_run, float& l_run, f32x16& o0, f32x16& o1) {
    float mx = fmaxf(p0[0], p1[0]);
#pragma unroll
    for (int r = 1; r < 16; ++r) mx = fmaxf(mx, fmaxf(p0[r], p1[r]));
    mx = xor32_max(mx);
    const float m_new = fmaxf(m_run, mx), alpha = fexp2(m_run - m_new); m_run = m_new;
    p0 = p0 - m_new; p1 = p1 - m_new;
#pragma unroll
    for (int r = 0; r < 16; ++r) { p0[r] = fexp2(p0[r]); p1[r] = fexp2(p1[r]); }
    const f32x16 ps = p0 + p1;
    const float ls = ((ps[0] + ps[1]) + (ps[2] + ps[3])) + ((ps[4] + ps[5]) + (ps[6] + ps[7])) + (((ps[8] + ps[9]) + (ps[10] + ps[11])) + ((ps[12] + ps[13]) + (ps[14] + ps[15])));
    l_run = l_run * alpha + ls;
    o0 = o0 * alpha; o1 = o1 * alpha;
}
__device__ __forceinline__ void mla_store(bf16_t* orow, const f32x16& o0, const f32x16& o1, float l_run) {
    const float inv = 1.0f / xor32_sum(l_run);
#pragma unroll
    for (int rg = 0; rg < 4; ++rg) {
        u32x2 w; w.x = cvt_pk_bf16(o0[4 * rg] * inv, o0[4 * rg + 1] * inv); w.y = cvt_pk_bf16(o0[4 * rg + 2] * inv, o0[4 * rg + 3] * inv); *(u32x2*)(orow + 8 * rg) = w;
        u32x2 w2; w2.x = cvt_pk_bf16(o1[4 * rg] * inv, o1[4 * rg + 1] * inv); w2.y = cvt_pk_bf16(o1[4 * rg + 2] * inv, o1[4 * rg + 3] * inv); *(u32x2*)(orow + 32 + 8 * rg) = w2;
    }
}
__device__ __forceinline__ void mla_unit(LAS unsigned char* lds, const bf16_t* Q, const bf16_t* KN, const bf16_t* KPE, const bf16_t* VT, bf16_t* AO, int tokbase, int S, int h, int qb, int tid) {
    constexpr int KBYTES = 12288, BUF = 20480;
    const int lane = tid & 63, wid = __builtin_amdgcn_readfirstlane(tid >> 6), r32 = lane & 31, hi = lane >> 5;
    const bf16_t* ks0 = KN + (size_t)(tokbase + lane) * 512 + h * 64 + 8 * wid;
    const bf16_t* ks1 = KPE + (size_t)(tokbase + lane) * 32 + 8 * (wid & 3);
    const bf16_t* vs = VT + (size_t)(h * 64 + lane) * TH + tokbase + 8 * wid;
#define MLA_DMA(T, B) do { LAS unsigned char* sb_ = lds + (B) * BUF; \
        __builtin_amdgcn_global_load_lds((const unsigned*)(ks0 + (size_t)(T) * (64 * 512)), (LAS unsigned*)(sb_ + wid * 1024), 16, 0, 0); \
        if (wid < 4) __builtin_amdgcn_global_load_lds((const unsigned*)(ks1 + (size_t)(T) * (64 * 32)), (LAS unsigned*)(sb_ + (8 + wid) * 1024), 16, 0, 0); \
        __builtin_amdgcn_global_load_lds((const unsigned*)(vs + (size_t)(T) * 64), (LAS unsigned*)(sb_ + KBYTES + wid * 1024), 16, 0, 0); } while (0)
#define MLA_WAITBAR_KEEP() do { if (wid < 4) asm volatile("s_waitcnt vmcnt(3)" ::: "memory"); else asm volatile("s_waitcnt vmcnt(2)" ::: "memory"); \
        asm volatile("s_waitcnt lgkmcnt(0)" ::: "memory"); __builtin_amdgcn_s_barrier(); asm volatile("" ::: "memory"); } while (0)
#define MLA_WAITBAR_ALL() do { asm volatile("s_waitcnt vmcnt(0) lgkmcnt(0)" ::: "memory"); __builtin_amdgcn_s_barrier(); asm volatile("" ::: "memory"); } while (0)
    const int NT = S / 64;
    const int qtokA = tokbase + 512 * qb + 64 * wid + r32, qtokB = qtokA + 32;
    bf16x8 qa[6], qbv[6];
#pragma unroll
    for (int d0 = 0; d0 < 6; ++d0) { qa[d0] = *(const bf16x8*)(Q + (size_t)qtokA * 768 + h * 96 + 16 * d0 + 8 * hi); qbv[d0] = *(const bf16x8*)(Q + (size_t)qtokB * 768 + h * 96 + 16 * d0 + 8 * hi); }
    asm volatile("s_waitcnt vmcnt(0)" ::: "memory");
    MLA_DMA(0, 0); MLA_DMA(1, 1);
    MLA_WAITBAR_ALL();
    f32x16 oa0, oa1, ob0, ob1;
#pragma unroll
    for (int r = 0; r < 16; ++r) { oa0[r] = 0.f; oa1[r] = 0.f; ob0[r] = 0.f; ob1[r] = 0.f; }
    float ma = -1e30f, la = 0.f, mb = -1e30f, lb = 0.f;
    for (int t = 0; t < NT; ++t) {
        if (t + 2 < NT) MLA_DMA(t + 2, (t + 2) & 3);
        const LAS unsigned char* kb = lds + (t & 3) * BUF; const LAS unsigned char* vb = kb + KBYTES;
        f32x16 pa0, pa1, pb0, pb1;
#pragma unroll
        for (int r = 0; r < 16; ++r) { pa0[r] = 0.f; pa1[r] = 0.f; pb0[r] = 0.f; pb1[r] = 0.f; }
#pragma unroll
        for (int d0 = 0; d0 < 6; ++d0) {
            const bf16x8 a0 = *(const LAS bf16x8*)(kb + (2 * d0 + hi) * 1024 + r32 * 16);
            const bf16x8 a1 = *(const LAS bf16x8*)(kb + (2 * d0 + hi) * 1024 + (32 + r32) * 16);
            pa0 = __builtin_amdgcn_mfma_f32_32x32x16_bf16(a0, qa[d0], pa0, 0, 0, 0);
            pa1 = __builtin_amdgcn_mfma_f32_32x32x16_bf16(a1, qa[d0], pa1, 0, 0, 0);
            pb0 = __builtin_amdgcn_mfma_f32_32x32x16_bf16(a0, qbv[d0], pb0, 0, 0, 0);
            pb1 = __builtin_amdgcn_mfma_f32_32x32x16_bf16(a1, qbv[d0], pb1, 0, 0, 0);
        }
        mla_softmax(pa0, pa1, ma, la, oa0, oa1);
        mla_softmax(pb0, pb1, mb, lb, ob0, ob1);
#pragma unroll
        for (int ks = 0; ks < 4; ++ks) {
            const u32x4 pwa = ks == 0 ? MLA_PACK(pa0, 0) : ks == 1 ? MLA_PACK(pa0, 8) : ks == 2 ? MLA_PACK(pa1, 0) : MLA_PACK(pa1, 8);
            const u32x4 pwb = ks == 0 ? MLA_PACK(pb0, 0) : ks == 1 ? MLA_PACK(pb0, 8) : ks == 2 ? MLA_PACK(pb1, 0) : MLA_PACK(pb1, 8);
            const bf16x8 paa = __builtin_bit_cast(bf16x8, pwa), pab = __builtin_bit_cast(bf16x8, pwb);
            const LAS unsigned char* vp = vb + (2 * ks) * 1024 + r32 * 16 + 8 * hi;
            const u32x2 a_lo = *(const LAS u32x2*)(vp), a_hi = *(const LAS u32x2*)(vp + 1024);
            const u32x2 b_lo = *(const LAS u32x2*)(vp + 512), b_hi = *(const LAS u32x2*)(vp + 1024 + 512);
            const bf16x8 vf0 = __builtin_bit_cast(bf16x8, ((u32x4){a_lo.x, a_lo.y, a_hi.x, a_hi.y}));
            const bf16x8 vf1 = __builtin_bit_cast(bf16x8, ((u32x4){b_lo.x, b_lo.y, b_hi.x, b_hi.y}));
            oa0 = __builtin_amdgcn_mfma_f32_32x32x16_bf16(vf0, paa, oa0, 0, 0, 0);
            oa1 = __builtin_amdgcn_mfma_f32_32x32x16_bf16(vf1, paa, oa1, 0, 0, 0);
            ob0 = __builtin_amdgcn_mfma_f32_32x32x16_bf16(vf0, pab, ob0, 0, 0, 0);
            ob1 = __builtin_amdgcn_mfma_f32_32x32x16_bf16(vf1, pab, ob1, 0, 0, 0);
        }
        if (t & 1) MLA_WAITBAR_ALL();
    }
#undef MLA_DMA
#undef MLA_WAITBAR_KEEP
#undef MLA_WAITBAR_ALL
    mla_store(AO + (size_t)qtokA * 1024 + h * 64 + 4 * hi, oa0, oa1, la);
    mla_store(AO + (size_t)qtokB * 1024 + h * 64 + 4 * hi, ob0, ob1, lb);
}

__device__ __forceinline__ unsigned na_vmask(int qc, int kh, int hi) {
    int cs = qc - 8; cs = cs < 0 ? 0 : cs; cs = cs > 48 ? 48 : cs; unsigned mk = 0u;
#pragma unroll
    for (int r = 0; r < 16; ++r) { const int kc = 32 * kh + (r & 3) + 8 * (r >> 2) + 4 * hi; mk |= ((kc >= cs) && (kc < cs + 16)) ? (1u << r) : 0u; }
    return mk;
}
__device__ __forceinline__ void na_qs(const bf16x8 (&kf)[4], const bf16x8 (&vf)[2][2], const bf16x8 (&qf)[4], const LAS float* brow, int qc, int kh, int hi, unsigned vmsel,
                                      float& m_run, float& l_run, f32x16& o0, f32x16& o1) {
    const float SCL = 0.125f * LOG2E;
    f32x16 p;
#pragma unroll
    for (int r = 0; r < 16; ++r) p[r] = 0.f;
#pragma unroll
    for (int d0 = 0; d0 < 4; ++d0) p = __builtin_amdgcn_mfma_f32_32x32x16_bf16(kf[d0], qf[d0], p, 0, 0, 0);
    unsigned vm = vmsel; asm volatile("" : "+v"(vm));
    float mx = -1e30f;
#pragma unroll
    for (int r = 0; r < 16; ++r) { const int kc = 32 * kh + (r & 3) + 8 * (r >> 2) + 4 * hi;
        int bi = kc - qc + 15; bi = bi < 0 ? 0 : bi; bi = bi > 30 ? 30 : bi;
        const float sc = p[r] * SCL + brow[bi]; p[r] = ((vm >> r) & 1u) ? sc : -1e30f; mx = fmaxf(mx, p[r]); }
    mx = xor32_max(mx);
    const float m_new = fmaxf(m_run, mx), alpha = fexp2(m_run - m_new); m_run = m_new;
    const float m_use = fmaxf(m_new, -1e20f);
    float ls = 0.f;
#pragma unroll
    for (int r = 0; r < 16; ++r) { const float e = fexp2(p[r] - m_use); p[r] = e; ls += e; }
    l_run = l_run * alpha + ls;
#pragma unroll
    for (int r = 0; r < 16; ++r) { o0[r] *= alpha; o1[r] *= alpha; }
#pragma unroll
    for (int k2 = 0; k2 < 2; ++k2) {
        u32x4 pw; pw.x = cvt_pk_bf16(p[8 * k2 + 0], p[8 * k2 + 1]); pw.y = cvt_pk_bf16(p[8 * k2 + 2], p[8 * k2 + 3]); pw.z = cvt_pk_bf16(p[8 * k2 + 4], p[8 * k2 + 5]); pw.w = cvt_pk_bf16(p[8 * k2 + 6], p[8 * k2 + 7]);
        const bf16x8 pa = __builtin_bit_cast(bf16x8, pw);
        o0 = __builtin_amdgcn_mfma_f32_32x32x16_bf16(vf[0][k2], pa, o0, 0, 0, 0);
        o1 = __builtin_amdgcn_mfma_f32_32x32x16_bf16(vf[1][k2], pa, o1, 0, 0, 0);
    }
}
__device__ __forceinline__ void na_store(bf16_t* orow, const f32x16& o0, const f32x16& o1, float l_run) {
    const float l = xor32_sum(l_run); const float inv = 1.0f / l;
#pragma unroll
    for (int rg = 0; rg < 4; ++rg) {
        u32x2 w; w.x = cvt_pk_bf16(o0[4 * rg] * inv, o0[4 * rg + 1] * inv); w.y = cvt_pk_bf16(o0[4 * rg + 2] * inv, o0[4 * rg + 3] * inv); *(u32x2*)(orow + 8 * rg) = w;
        u32x2 w2; w2.x = cvt_pk_bf16(o1[4 * rg] * inv, o1[4 * rg + 1] * inv); w2.y = cvt_pk_bf16(o1[4 * rg + 2] * inv, o1[4 * rg + 3] * inv); *(u32x2*)(orow + 32 + 8 * rg) = w2;
    }
}
__device__ __forceinline__ void na_unit(const LAS float* biasT, const bf16_t* Z, const bf16_t* VTn, bf16_t* AO, int tokbase, int S, int rr, int tid) {
    const int lane = tid & 63, h = tid >> 6, r32 = lane & 31, hi = lane >> 5;
    const int rows = S / 64; int rs = rr - 4; rs = rs < 0 ? 0 : rs; rs = rs > rows - 8 ? rows - 8 : rs;
    bf16x8 qfa[4], qfb[4];
#pragma unroll
    for (int d0 = 0; d0 < 4; ++d0) { qfa[d0] = *(const bf16x8*)(Z + (size_t)(tokbase + rr * 64 + r32) * ZP + 672 + h * 64 + 16 * d0 + 8 * hi);
                                      qfb[d0] = *(const bf16x8*)(Z + (size_t)(tokbase + rr * 64 + 32 + r32) * ZP + 672 + h * 64 + 16 * d0 + 8 * hi); }
    f32x16 oa0, oa1, ob0, ob1; float ma = -1e30f, mb = -1e30f, la = 0.f, lb = 0.f;
#pragma unroll
    for (int r = 0; r < 16; ++r) { oa0[r] = 0.f; oa1[r] = 0.f; ob0[r] = 0.f; ob1[r] = 0.f; }
    const unsigned va0 = na_vmask(r32, 0, hi), va1 = na_vmask(r32, 1, hi), vb0 = na_vmask(32 + r32, 0, hi), vb1 = na_vmask(32 + r32, 1, hi);
    const bf16_t* kbase = Z + (size_t)(tokbase + rs * 64 + r32) * ZP + 672 + 512 + h * 64 + 8 * hi;
    const bf16_t* vbase0 = VTn + (size_t)(h * 64 + r32) * TH + tokbase + rs * 64 + 4 * hi;
#define NA_LOADK(KF, IT) do { const int kr_ = (IT) >> 1, kh_ = (IT) & 1; const bf16_t* kp_ = kbase + (size_t)(kr_ * 64 + kh_ * 32) * ZP; \
        _Pragma("unroll") for (int d0 = 0; d0 < 4; ++d0) KF[d0] = *(const bf16x8*)(kp_ + 16 * d0); } while (0)
#define NA_LOADV(VF, IT) do { const int kr_ = (IT) >> 1, kh_ = (IT) & 1; const bf16_t* vp0_ = vbase0 + kr_ * 64 + kh_ * 32; const bf16_t* vp1_ = vp0_ + (size_t)32 * TH; \
        _Pragma("unroll") for (int k2 = 0; k2 < 2; ++k2) { const u32x2 lo = *(const u32x2*)(vp0_ + 16 * k2), hi2 = *(const u32x2*)(vp0_ + 16 * k2 + 8); VF[0][k2] = __builtin_bit_cast(bf16x8, ((u32x4){lo.x, lo.y, hi2.x, hi2.y})); \
            const u32x2 lo1 = *(const u32x2*)(vp1_ + 16 * k2), hi3 = *(const u32x2*)(vp1_ + 16 * k2 + 8); VF[1][k2] = __builtin_bit_cast(bf16x8, ((u32x4){lo1.x, lo1.y, hi3.x, hi3.y})); } } while (0)
    bf16x8 kf[4];
    NA_LOADK(kf, 0);
#pragma unroll 1
    for (int it = 0; it < 16; ++it) {
        const int kr = it >> 1, kh = it & 1;
        const LAS float* brow = biasT + (h * 15 + (rs + kr - rr + 7)) * 31;
        bf16x8 vf[2][2], kn[4];
        NA_LOADV(vf, it);
        const int itn = it + 1 < 16 ? it + 1 : 15;
        NA_LOADK(kn, itn);
        na_qs(kf, vf, qfa, brow, r32, kh, hi, kh ? va1 : va0, ma, la, oa0, oa1);
        na_qs(kf, vf, qfb, brow, 32 + r32, kh, hi, kh ? vb1 : vb0, mb, lb, ob0, ob1);
#pragma unroll
        for (int d0 = 0; d0 < 4; ++d0) kf[d0] = kn[d0];
    }
#undef NA_LOADK
#undef NA_LOADV
    na_store(AO + (size_t)(tokbase + rr * 64 + r32) * 1024 + 512 + h * 64 + 4 * hi, oa0, oa1, la);
    na_store(AO + (size_t)(tokbase + rr * 64 + 32 + r32) * 1024 + 512 + h * 64 + 4 * hi, ob0, ob1, lb);
}
#ifndef REP_SYNC
#define REP_SYNC 1
#endif
#ifndef REP_MLA
#define REP_MLA 1
#endif
#ifndef REP_NA
#define REP_NA 1
#endif
#ifndef REP_SCAN
#define REP_SCAN 1
#endif
#ifndef REP_UP
#define REP_UP 1
#endif
#ifndef REP_PASS
#define REP_PASS 1
#endif
#ifndef REP_GEMM
#define REP_GEMM 1
#endif
#define GSYNC() do { for (int r_ = 0; r_ < REP_SYNC; ++r_) xcd_barrier((unsigned*)(ap0->ws + WS_BAR), bst); } while (0)
constexpr int LDS_BYTES = 147456;
constexpr int NTHR = 512;
struct Args { const float* in[26]; float* out; unsigned char* ws; };


#define XB_TMO      128
#define XB_XCNT(j)  (256  + 64 * (j))
#define XB_XSUB(j)  (1280 + 64 * (j))
#define XB_XGEN(j)  (2304 + 64 * (j))
#define XB_TOP      3328
#define XB_TOPGEN   3392
#define XCD_BAR_WORDS 3456
#define XB_SPIN_CAP (1u << 22)
__device__ __forceinline__ unsigned xb_ld(unsigned* p)              { return __hip_atomic_load(p, __ATOMIC_RELAXED, __HIP_MEMORY_SCOPE_AGENT); }
__device__ __forceinline__ unsigned xb_add(unsigned* p, unsigned v) { return __hip_atomic_fetch_add(p, v, __ATOMIC_RELAXED, __HIP_MEMORY_SCOPE_AGENT); }
__device__ __forceinline__ unsigned xb_xcc_id() { return (unsigned)__builtin_amdgcn_s_getreg((3 << 11) | 20) & 0xFu; }
#define XB_SPIN(cond, bar) do { unsigned _sp = 0; while (cond) { __builtin_amdgcn_s_sleep(1); \
    if ((++_sp & 255u) == 0u) { if (xb_ld(&(bar)[XB_TMO])) break; if (_sp > XB_SPIN_CAP) { atomicAdd(&(bar)[XB_TMO], 1u); break; } } } } while (0)
__device__ __forceinline__ void xcd_barrier_complete(unsigned* bar, unsigned x, unsigned& nloc, unsigned& nx) {
    const unsigned G = gridDim.x;
    unsigned sum, cnt, mine, sp = 0u;
    for (;;) {
        sum = 0u; cnt = 0u; mine = 0u;
#pragma unroll
        for (unsigned j = 0; j < 16; ++j) { const unsigned c = xb_ld(&bar[XB_XCNT(j)]); sum += c; cnt += (c > 0u) ? 1u : 0u; mine = (j == x) ? c : mine; }
        if (sum == G) break;
        __builtin_amdgcn_s_sleep(1);
        if ((++sp & 255u) == 0u) { if (xb_ld(&bar[XB_TMO])) break; if (sp > XB_SPIN_CAP) { atomicAdd(&bar[XB_TMO], 1u); break; } }
    }
    nloc = mine > 0u ? mine : 1u; nx = cnt > 0u ? cnt : 1u;
}
__device__ __forceinline__ void xcd_barrier(unsigned* bar, volatile LAS unsigned* st) {
    asm volatile("s_waitcnt vmcnt(0)" ::: "memory");
    __syncthreads();
    if (threadIdx.x == 0) {
        __builtin_amdgcn_s_waitcnt(0);
        const unsigned x = xb_xcc_id();
        unsigned nloc = st[0], nx = st[1];
        if (nloc == 0u) { xcd_barrier_complete(bar, x, nloc, nx); st[0] = nloc; st[1] = nx; }
        const unsigned old = xb_add(&bar[XB_XSUB(x)], 1u);
        const unsigned gen = old / nloc;
        if (old + 1u == (gen + 1u) * nloc) {
            __builtin_amdgcn_fence(__ATOMIC_RELEASE, "agent");
            asm volatile("s_waitcnt vmcnt(0)" ::: "memory");
            const unsigned og = xb_add(&bar[XB_TOP], 1u);
            const unsigned tg = og / nx;
            if (og + 1u == (tg + 1u) * nx) xb_add(&bar[XB_TOPGEN], 1u);
            else XB_SPIN(xb_ld(&bar[XB_TOPGEN]) == tg, bar);
            __builtin_amdgcn_fence(__ATOMIC_ACQUIRE, "agent");
            xb_add(&bar[XB_XGEN(x)], 1u);
            asm volatile("s_waitcnt vmcnt(0)" ::: "memory");
        } else {
            XB_SPIN(xb_ld(&bar[XB_XGEN(x)]) == gen, bar);
            __builtin_amdgcn_fence(__ATOMIC_ACQUIRE, "agent");
            asm volatile("s_waitcnt vmcnt(0)" ::: "memory");
        }
    }
    __syncthreads();
}

__global__ void __launch_bounds__(NTHR, 2) mk_fwd(Args a) {
    extern __shared__ __attribute__((aligned(16))) unsigned char lds_raw[];
    LAS unsigned char* lds = (LAS unsigned char*)lds_raw;
    cg::grid_group grid = cg::this_grid();
    volatile LAS unsigned* bst = (volatile LAS unsigned*)(lds + LDS_BYTES - 64);
    if (threadIdx.x == 0) { bst[0] = 0u; bst[1] = 0u; }
    typedef const __attribute__((address_space(4))) Args* ArgP;
    ArgP ap0 = (ArgP)__builtin_amdgcn_kernarg_segment_ptr();
#define PH_BEGIN ArgP ap = ap0; asm volatile("" : "+s"(ap)); unsigned char* ws = ap->ws; (void)ws; int tid_ = threadIdx.x; asm volatile("" : "+v"(tid_)); const int tid = tid_, lane = tid & 63, wave = tid >> 6; int G_ = gridDim.x, bid_ = blockIdx.x; asm volatile("" : "+s"(G_), "+s"(bid_)); const int G = G_, bid = bid_; const int gw = bid * 8 + wave, NGW = G * 8; const int gt = bid * NTHR + tid, NGT = G * NTHR; (void)lane; (void)gw; (void)NGW; (void)gt; (void)NGT;
#define IN(k) (ap->in[k])
#define rsq ((float*)(ws + WS_RSQ))
#define rskv ((float*)(ws + WS_RSKV))
#define rope ((float2*)(ws + WS_ROPE))
#define AGG ((float2*)(ws + WS_AGG))
#define CARRY ((float*)(ws + WS_CARRY))
#define YB ((bf16_t*)(ws + WS_YB))
#define W_INATT ((bf16_t*)(ws + WS_W_INATT))
#define W_UQ ((bf16_t*)(ws + WS_W_UQ))
#define W_UKV ((bf16_t*)(ws + WS_W_UKV))
#define W_OUTATT ((bf16_t*)(ws + WS_W_OUTATT))
#define W_INREC ((bf16_t*)(ws + WS_W_INREC))
#define W_GATES ((bf16_t*)(ws + WS_W_GATES))
#define W_OUTREC ((bf16_t*)(ws + WS_W_OUTREC))
#define W_UP ((bf16_t*)(ws + WS_W_UP))
#define W_DOWN ((bf16_t*)(ws + WS_W_DOWN))
#define XN ((bf16_t*)(ws + WS_XN))
#define Zb ((bf16_t*)(ws + WS_Z))
#define Qb ((bf16_t*)(ws + WS_Q))
#define KN ((bf16_t*)(ws + WS_KN))
#define VTM ((bf16_t*)(ws + WS_VTM))
#define VTN ((bf16_t*)(ws + WS_VTN))
#define KPE ((bf16_t*)(ws + WS_KPE))
#define ACT ((bf16_t*)(ws + WS_ACT))
#define GATE ((bf16_t*)(ws + WS_GATE))
#define XB ((bf16_t*)(ws + WS_XB))
#define XBR ((bf16_t*)(ws + WS_XBR))
#define GQ ((bf16_t*)(ws + WS_GQ))
#define AO XN
#define Fb XN
#define YR XN
#define M0 Zb
#define M1 XBR
#define XIN (IN(half))
#define XST (ap->out + (size_t)half * TH * DM)
    { PH_BEGIN
    {
        LAS float* scr = (LAS float*)(lds + wave * 16384);
        constexpr int I_INATT = 16 * 69, I_UQ = 6 * 24, I_UKV = 4 * 32, I_SQ = 16 * 32, I_INREC = 16 * 64, I_UP = 16 * 256, I_DOWN = 64 * 32, I_GATE = 32 * 8;
        constexpr int NITEMS = I_INATT + I_UQ + I_UKV + 2 * I_SQ + I_INREC + 2 * I_UP + 2 * I_DOWN + I_GATE;
        for (int rep_ = 0; rep_ < REP_PASS; ++rep_)
        for (int it = gw; it < NITEMS; it += NGW) {
            int r = it;
            if (r < I_INATT) { transpose_item(IN(6), 1024, 2208, W_INATT, 0, nullptr, scr, r, lane); continue; } r -= I_INATT;
            if (r < I_UQ) { transpose_item(IN(8), 384, 768, W_UQ, 0, IN(7), scr, r, lane); continue; } r -= I_UQ;
            if (r < I_UKV) { transpose_item(IN(10), 256, 1024, W_UKV, 0, IN(9), scr, r, lane); continue; } r -= I_UKV;
            if (r < I_SQ) { transpose_item(IN(12), 1024, 1024, W_OUTATT, 0, nullptr, scr, r, lane); continue; } r -= I_SQ;
            if (r < I_SQ) { transpose_item(IN(21), 1024, 1024, W_OUTREC, 0, nullptr, scr, r, lane); continue; } r -= I_SQ;
            if (r < I_INREC) { transpose_item(IN(13), 1024, 2048, W_INREC, 0, nullptr, scr, r, lane); continue; } r -= I_INREC;
            if (r < 2 * I_UP) { const int li = r / I_UP; transpose_item(IN(22) + (size_t)li * 1024 * 8192, 1024, 8192, W_UP + (size_t)li * 8192 * 1024, 0, nullptr, scr, r % I_UP, lane); continue; } r -= 2 * I_UP;
            if (r < 2 * I_DOWN) { const int li = r / I_DOWN; transpose_item(IN(25) + (size_t)li * 4096 * 1024, 4096, 1024, W_DOWN + (size_t)li * 1024 * 4096, 0, nullptr, scr, r % I_DOWN, lane); continue; } r -= 2 * I_DOWN;
            { const int mat = r / 8, sub = r % 8; const int type = mat >> 4, e = (mat >> 3) & 1, n = mat & 7;
              transpose_item(IN(type ? 18 : 16) + (size_t)(e * 8 + n) * 128 * 128, 128, 128, W_GATES, n * 512 + e * 256 + type * 128, nullptr, scr, sub, lane); }
        }
        if (bid == 0) for (int i = tid; i < XCD_BAR_WORDS; i += NTHR) ((unsigned*)(ws + WS_BAR))[i] = 0u;
        for (int i = gt; i < 8 * 64 * 64; i += NGT) ((unsigned*)(ws + WS_CNT))[i] = 0u;
        for (int i = gt; i < 96 * 1024 / 8; i += NGT) ((u32x4*)(W_INATT + (size_t)2208 * 1024))[i] = (u32x4){0, 0, 0, 0};
        for (int m = gw; m < TH; m += NGW) xn_row(IN(0) + (size_t)m * DM, IN(2), XN + (size_t)m * DM, lane);
        for (int i = gt; i < 4096 * 16; i += NGT) { const int pos = i >> 4, j = i & 15;
            const double inv = exp2(-(double)j * (13.287712379549449 / 16.0));
            const double rev = (double)pos * inv * 0.15915494309189535; const float fr = (float)(rev - floor(rev));
            rope[i] = make_float2(__builtin_amdgcn_cosf(fr), __builtin_amdgcn_sinf(fr)); }
    }

    }
    grid.sync();
    if (threadIdx.x == 0) (void)xb_add((unsigned*)(ap0->ws + WS_BAR) + XB_XCNT(xb_xcc_id()), 1u);
    for (int half = 0; half < 2; ++half) {
        const int S = half ? 4096 : 2048, nseq = TH / S;
        if (half == 1 && gridDim.x != 256) {
                { PH_BEGIN
        for (int m = gw; m < TH; m += NGW) xn_row(XIN + (size_t)m * DM, IN(2), XN + (size_t)m * DM, lane);
        }
        GSYNC();
        }
        { PH_BEGIN
        { pg8::Gemm g = pg8::make_gemm(XN, DM, W_INATT, DM, DM); pg8::StaticOrder so; so.init(TH / 256, ZP / 256, G, bid);
          EpiZ E{Zb, VTN, (float*)(ws + WS_SQP), nullptr, KPE, rope, S - 1};
#ifndef NO_G1
for (int rep_ = 0; rep_ < REP_GEMM; ++rep_) pg8::gemm_phase<EpiZ>(lds, g, so, E);
#endif
 }
        }
        GSYNC();
        { PH_BEGIN
        { pg8::Gemm g = pg8::make_gemm(Zb, ZP, W_UQ, 384, 384); pg8::StaticOrder so; so.init(TH / 256, 3, G, bid);
          EpiQ E{Qb, (const float*)(ws + WS_SQP), rope, S - 1};
#ifndef NO_G2
for (int rep_ = 0; rep_ < REP_GEMM; ++rep_) pg8::gemm_phase<EpiQ>(lds, g, so, E);
#endif
 }
        { pg8::Gemm g = pg8::make_gemm(Zb + 384, ZP, W_UKV, 256, 256); pg8::StaticOrder so; so.init(TH / 256, 4, G, bid);
          EpiKV E{KN, VTM, (const float*)(ws + WS_SQP)};
#ifndef NO_G3
for (int rep_ = 0; rep_ < REP_GEMM; ++rep_) pg8::gemm_phase<EpiKV>(lds, g, so, E);
#endif
 }
        }
        GSYNC();
        { PH_BEGIN
        {
            LAS float* biasT = (LAS float*)(lds + 98304);
            for (int i = tid; i < 8 * 15 * 31; i += NTHR) biasT[i] = IN(11)[i] * LOG2E;
            __syncthreads();
            const int nqb = S / 512, nunits = nseq * 8 * nqb;
            const int vb = (G % 8 == 0) ? (bid % 8) * (G / 8) + bid / 8 : bid;
#ifdef DELAY_P4A
        { const unsigned long long t0_ = __builtin_amdgcn_s_memrealtime(); while (__builtin_amdgcn_s_memrealtime() - t0_ < 40000ull) __builtin_amdgcn_s_sleep(32); }
#endif
#ifndef NO_MLA
            for (int rep_ = 0; rep_ < REP_MLA; ++rep_) {
#ifdef REP_MLA_SYNC
            if (rep_ > 0) GSYNC();
#endif
#ifdef REP_DELAY
            if (rep_ > 0) { const unsigned long long t0_ = __builtin_amdgcn_s_memrealtime(); while (__builtin_amdgcn_s_memrealtime() - t0_ < 40000ull) __builtin_amdgcn_s_sleep(32); continue; }
#endif
            for (int u = vb; u < nunits; u += G) { const int qb = u % nqb, h = (u / nqb) & 7, s = u / (nqb * 8);
                mla_unit(lds, Qb, KN, KPE, VTM, AO, s * S, S, h, qb, tid); }
            }
#endif
#ifdef MLA_TWICE
            for (int u = vb; u < nunits; u += G) { const int qb = u % nqb, h = (u / nqb) & 7, s = u / (nqb * 8);
                mla_unit(lds, Qb, KN, KPE, VTM, AO, s * S, S, h, qb, tid); }
#endif
            const int rows = S / 64, nna = nseq * rows;
#ifdef DELAY_P4B
        { const unsigned long long t0_ = __builtin_amdgcn_s_memrealtime(); while (__builtin_amdgcn_s_memrealtime() - t0_ < 40000ull) __builtin_amdgcn_s_sleep(32); }
#endif
#ifdef RELOAD_BIAS
            __syncthreads();
            for (int i = tid; i < 8 * 15 * 31; i += NTHR) biasT[i] = IN(11)[i] * LOG2E;
            __syncthreads();
#endif
#ifndef NO_NA
            for (int rep_ = 0; rep_ < REP_NA; ++rep_)
            for (int u = vb; u < nna; u += G) na_unit(biasT, Zb, VTN, AO, (u / rows) * S, S, u % rows, tid);
#endif
        }
        }
        GSYNC();
        { PH_BEGIN
        { pg8::Gemm g = pg8::make_gemm(AO, DM, W_OUTATT, DM, DM); pg8::StaticOrder so; so.init(TH / 256, 4, G, bid);
          EpiBf16 E{M0, DM, 0, 0};
#ifndef NO_G4
for (int rep_ = 0; rep_ < REP_GEMM; ++rep_) pg8::gemm_phase<EpiBf16>(lds, g, so, E);
#endif
 }
        }
        GSYNC();
        { PH_BEGIN
        for (int m = gw; m < TH; m += 2 * NGW) { const int m2 = m + NGW; if (m2 < TH) res_row2(M0 + (size_t)m * DM, M0 + (size_t)m2 * DM, XIN + (size_t)m * DM, XIN + (size_t)m2 * DM, XST + (size_t)m * DM, XST + (size_t)m2 * DM, IN(3), IN(4), XN + (size_t)m * DM, XN + (size_t)m2 * DM, lane); else res_row(M0 + (size_t)m * DM, XIN + (size_t)m * DM, XST + (size_t)m * DM, IN(3), IN(4), XN + (size_t)m * DM, lane); }
        }
        GSYNC();

        for (int li = 0; li < 2; ++li) {
            if (li == 1) {
                { PH_BEGIN
                { pg8::Gemm g = pg8::make_gemm(XN, DM, W_INREC, DM, DM); pg8::StaticOrder so; so.init(TH / 256, 8, G, bid);
                  EpiBf16 E{GATE, DM, 1024, (size_t)(WS_XBR - WS_GATE) / 2};
#ifndef NO_G5
for (int rep_ = 0; rep_ < REP_GEMM; ++rep_) pg8::gemm_phase<EpiBf16>(lds, g, so, E);
#endif
 }
                }
                GSYNC();
                { PH_BEGIN
                for (int i0 = gt; i0 < TH * 128; i0 += 4 * NGT) {
                    u32x4 wv[4][4]; int tt[4], cc[4];
#pragma unroll
                    for (int u = 0; u < 4; ++u) { const int i = i0 + u * NGT; const int t = i >> 7, c8 = (i & 127) * 8; const int pos = t & (S - 1); tt[u] = t; cc[u] = c8;
#pragma unroll
                        for (int k = 0; k < 4; ++k) { const int p2 = pos + k - 1; wv[u][k] = (p2 < 0 || p2 >= S || i >= TH * 128) ? (u32x4){0u, 0u, 0u, 0u} : *(const u32x4*)(XBR + (size_t)(t + k - 1) * DM + c8); } }
#pragma unroll
                    for (int u = 0; u < 4; ++u) { if (i0 + u * NGT >= TH * 128) break; const int c8 = cc[u];
                        float accv[8];
#pragma unroll
                        for (int j = 0; j < 8; ++j) accv[j] = IN(15)[c8 + j];
#pragma unroll
                        for (int k = 0; k < 4; ++k) { const u32x4 w = wv[u][k]; const float* cwk = IN(14) + k * 1024 + c8;
                            accv[0] += cwk[0] * bflo(w.x); accv[1] += cwk[1] * bfhi(w.x); accv[2] += cwk[2] * bflo(w.y); accv[3] += cwk[3] * bfhi(w.y);
                            accv[4] += cwk[4] * bflo(w.z); accv[5] += cwk[5] * bfhi(w.z); accv[6] += cwk[6] * bflo(w.w); accv[7] += cwk[7] * bfhi(w.w); }
                        u32x4 o; o.x = cvt_pk_bf16(accv[0], accv[1]); o.y = cvt_pk_bf16(accv[2], accv[3]); o.z = cvt_pk_bf16(accv[4], accv[5]); o.w = cvt_pk_bf16(accv[6], accv[7]);
                        *(u32x4*)(XB + (size_t)tt[u] * DM + c8) = o; }
                }
                }
                GSYNC();
                for (int qt = 0; qt < 2; ++qt) {
                    const int t0 = qt * TQ;
                    { PH_BEGIN
                    { pg8::Gemm g = pg8::make_gemm(XB + (size_t)t0 * DM, DM, W_GATES, 128, 128); g.a_pn_shift = 1; g.a_pn_step = 256; g.a_seg = 1; g.hA = (size_t)4 * DM * 2;
                      pg8::StaticOrder so; so.init(TQ / 256, 16, G, bid);
                      EpiGates E{GQ, XB + (size_t)t0 * DM, AGG, IN(17), IN(19), IN(20)};
                      pg8::gemm_phase<EpiGates>(lds, g, so, E);
 }
                    }
                    GSYNC();
                    { PH_BEGIN
                    { const int cps = S / 32, nsq = TQ / S;
                      for (int rep_ = 0; rep_ < REP_SCAN; ++rep_)
                      for (int i = gt; i < nsq * 2 * 1024; i += NGT) { const int ch = i & 1023, e = (i >> 10) & 1, sq = i >> 11;
                          float hcar = 0.f;
                          for (int k0 = 0; k0 < cps; k0 += 32) {
                              float2 ab[32];
#pragma unroll
                              for (int j = 0; j < 32; ++j) { const int k = k0 + j; const int c = sq * cps + (e ? cps - 1 - k : k); ab[j] = AGG[(c * 2 + e) * 1024 + ch]; }
#pragma unroll
                              for (int j = 0; j < 32; ++j) { const int k = k0 + j; const int c = sq * cps + (e ? cps - 1 - k : k); CARRY[(c * 2 + e) * 1024 + ch] = hcar; hcar = ab[j].x * hcar + ab[j].y; } } } }
                    }
                    GSYNC();
                    { PH_BEGIN
#ifndef NO_R6
                    for (int rep_ = 0; rep_ < REP_SCAN; ++rep_)
                    for (int i = gt; i < 256 * 512; i += NGT) { const int cp = i & 511, c = i >> 9; const int ch = 2 * cp, n = ch >> 7, d = ch & 127;
                        const bf16_t* gq0 = GQ + (size_t)(c * 32) * 4096 + n * 512 + d;
                        bf16_t* yr0 = YR + (size_t)(t0 + c * 32) * DM + ch; const bf16_t* gt0 = GATE + (size_t)(t0 + c * 32) * DM + ch;
                        unsigned hfw[32];
                        { const float2 hc2 = *(const float2*)(CARRY + (size_t)(c * 2 + 0) * 1024 + ch); float h0 = hc2.x, h1 = hc2.y;
#pragma unroll
                          for (int s = 0; s < 32; ++s) {
                            const unsigned l2 = *(const unsigned*)(gq0 + (size_t)s * 4096), b2 = *(const unsigned*)(gq0 + (size_t)s * 4096 + 128);
                            h0 = fexp2(bflo(l2)) * h0 + bflo(b2); h1 = fexp2(bfhi(l2)) * h1 + bfhi(b2);
                            hfw[s] = cvt_pk_bf16(h0, h1); } }
                        { const float2 hc2 = *(const float2*)(CARRY + (size_t)(c * 2 + 1) * 1024 + ch); float h0 = hc2.x, h1 = hc2.y;
                          unsigned lq[32], bq[32], gq_[32];
#pragma unroll
                          for (int s = 0; s < 32; ++s) { lq[s] = *(const unsigned*)(gq0 + (size_t)s * 4096 + 256); bq[s] = *(const unsigned*)(gq0 + (size_t)s * 4096 + 384); gq_[s] = *(const unsigned*)(gt0 + (size_t)s * DM); }
#pragma unroll
                          for (int s = 31; s >= 0; --s) {
                            const unsigned l2 = lq[s], b2 = bq[s];
                            h0 = fexp2(bflo(l2)) * h0 + bflo(b2); h1 = fexp2(bfhi(l2)) * h1 + bfhi(b2);
                            const unsigned g2 = gq_[s], f2 = hfw[s];
                            *(unsigned*)(yr0 + (size_t)s * DM) = cvt_pk_bf16((bflo(f2) + h0) * gelu_tanh(bflo(g2)), (bfhi(f2) + h1) * gelu_tanh(bfhi(g2))); } }
                    }
#endif
                    }
                    GSYNC();
                }
                { PH_BEGIN
                { pg8::Gemm g = pg8::make_gemm(YR, DM, W_OUTREC, DM, DM); pg8::StaticOrder so; so.init(TH / 256, 4, G, bid);
                  EpiBf16 E{M1, DM, 0, 0};
#ifndef NO_G7
for (int rep_ = 0; rep_ < REP_GEMM; ++rep_) pg8::gemm_phase<EpiBf16>(lds, g, so, E);
#endif
 }
                }
                GSYNC();
                { PH_BEGIN
                for (int m = gw; m < TH; m += 2 * NGW) { const int m2 = m + NGW; if (m2 < TH) res_row2(M1 + (size_t)m * DM, M1 + (size_t)m2 * DM, XST + (size_t)m * DM, XST + (size_t)m2 * DM, XST + (size_t)m * DM, XST + (size_t)m2 * DM, IN(3) + 1024, IN(4) + 1024, XN + (size_t)m * DM, XN + (size_t)m2 * DM, lane); else res_row(M1 + (size_t)m * DM, XST + (size_t)m * DM, XST + (size_t)m * DM, IN(3) + 1024, IN(4) + 1024, XN + (size_t)m * DM, lane); }
                }
                GSYNC();
            }
            { PH_BEGIN
            { pg8::Gemm g = pg8::make_gemm(XN, DM, W_UP + (size_t)li * 8192 * 1024, DM, DM);
              g.a_seg = 1; g.hA = (size_t)4 * DM * 2; g.tB = (size_t)128 * DM * 2; g.hB = (size_t)4096 * DM * 2;
              pg8::StaticOrder so; so.init(TH / 256, 32, G, bid);
#ifndef NO_UP
              EpiUp E{ACT, YB, IN(23) + (size_t)li * 3 * 8192, IN(24) + (size_t)li * 8192}; for (int rep_ = 0; rep_ < REP_UP; ++rep_) pg8::gemm_phase<EpiUp>(lds, g, so, E);
#endif
 }
            }
            GSYNC();
            { PH_BEGIN
            for (int rep_ = 0; rep_ < REP_PASS; ++rep_)
            for (int b = bid; b < 256; b += G) { const int seg = b >> 1, which = b & 1; const int t = seg * 128 + (which ? 127 : 0); const int pos = t & (S - 1);
                const float* cw = IN(23) + (size_t)li * 3 * 8192; const float* cb = IN(24) + (size_t)li * 8192;
                const bool hasp = which ? true : (pos != 0), hasn = which ? (pos != S - 1) : true;
                const bf16_t* yp = which ? YB + ((size_t)seg * 4 + 2) * 8192 : YB + ((size_t)(seg - 1) * 4 + 3) * 8192;
                const bf16_t* yc = YB + ((size_t)seg * 4 + (which ? 3 : 0)) * 8192;
                const bf16_t* yn = which ? YB + ((size_t)(seg + 1) * 4 + 0) * 8192 : YB + ((size_t)seg * 4 + 1) * 8192;
                for (int c = tid; c < 4096; c += NTHR) {
                    float u2[2];
#pragma unroll
                    for (int bj = 0; bj < 2; ++bj) { const int ch = bj * 4096 + c;
                        float r = cw[8192 + ch] * bf2f(yc[ch]) + cb[ch];
                        if (hasp) r += cw[ch] * bf2f(yp[ch]);
                        if (hasn) r += cw[2 * 8192 + ch] * bf2f(yn[ch]);
                        u2[bj] = r; }
                    ACT[(size_t)t * DFF + c] = f2bf(gelu_tanh(u2[0]) * u2[1]); } }
            }
            GSYNC();
            if (gridDim.x == 256) {
                { PH_BEGIN
                { pg8::Gemm g = pg8::make_gemm(ACT, DFF, W_DOWN + (size_t)li * 1024 * 4096, DFF, DFF); pg8::StaticOrder so; so.init(TH / 256, 4, G, bid);
                  const int use = half * 2 + li;
                  EpiRms E{XST, li == 0 ? XN : nullptr, IN(5) + li * 1024, IN(2) + 1024, (float*)(ws + WS_XBUF), (float*)(ws + WS_XBUF) + (size_t)TH * 4,
                           (unsigned*)(ws + WS_CNT) + (size_t)(use * 2) * 4096, (unsigned*)(ws + WS_CNT) + (size_t)(use * 2 + 1) * 4096};
                  pg8::gemm_phase<EpiRms>(lds, g, so, E); }
                if (half == 0 && li == 1)
                  { for (int m = gw; m < TH; m += NGW) xn_row(IN(1) + (size_t)m * DM, IN(2), XN + (size_t)m * DM, lane);
                  }
                }
                GSYNC();
            } else {
                { PH_BEGIN
                { pg8::Gemm g = pg8::make_gemm(ACT, DFF, W_DOWN + (size_t)li * 1024 * 4096, DFF, DFF); pg8::StaticOrder so; so.init(TH / 256, 4, G, bid);
                  EpiBf16 E{Fb, DM, 0, 0};
                  pg8::gemm_phase<EpiBf16>(lds, g, so, E); }
                }
                GSYNC();
                { PH_BEGIN
                for (int m = gw; m < TH; m += NGW) res_row(Fb + (size_t)m * DM, XST + (size_t)m * DM, XST + (size_t)m * DM, IN(5) + li * 1024, li == 0 ? IN(2) + 1024 : nullptr, XN + (size_t)m * DM, lane);
                }
                GSYNC();
            }
        }
    }
}

extern "C" void kernel_launch(void* const* d_in, const int* in_sizes, int n_in, void* d_out, int out_size, void* d_ws, size_t ws_size, hipStream_t stream) {
    static int grid = 0;
    if (grid == 0) {
        int dev = 0, cus = 0, per_cu = 0;
        (void)hipGetDevice(&dev);
        (void)hipDeviceGetAttribute(&cus, hipDeviceAttributeMultiprocessorCount, dev);
        (void)hipFuncSetAttribute((const void*)mk_fwd, hipFuncAttributeMaxDynamicSharedMemorySize, LDS_BYTES);
        (void)hipOccupancyMaxActiveBlocksPerMultiprocessor(&per_cu, (const void*)mk_fwd, NTHR, LDS_BYTES);
        if (per_cu < 1) per_cu = 1;
        grid = cus * per_cu;
        if (ws_size < WS_END || n_in != 26) { fprintf(stderr, "kernel_launch: unexpected ws_size %zu / n_in %d\n", ws_size, n_in); }
    }
    Args a{};
    for (int i = 0; i < 26; ++i) a.in[i] = (const float*)d_in[i];
    a.out = (float*)d_out; a.ws = (unsigned char*)d_ws;
    void* args[] = {&a};
    hipError_t e = hipLaunchCooperativeKernel((const void*)mk_fwd, dim3(grid), dim3(NTHR), args, LDS_BYTES, stream);
    if (e != hipSuccess) fprintf(stderr, "cooperative launch failed: %s (grid %d)\n", hipGetErrorString(e), grid);
}
```

```cpp
#include <hip/hip_runtime.h>
#include <hip/hip_cooperative_groups.h>
#include <cstdio>
#include <cstdint>
namespace cg = cooperative_groups;

#define LAS __attribute__((address_space(3)))
typedef unsigned short bf16_t;
typedef short bf16x8 __attribute__((ext_vector_type(8)));
typedef short s16x4 __attribute__((ext_vector_type(4)));
typedef float f32x4 __attribute__((ext_vector_type(4)));
typedef float f32x16 __attribute__((ext_vector_type(16)));
typedef unsigned u32x4 __attribute__((ext_vector_type(4)));
typedef unsigned u32x2 __attribute__((ext_vector_type(2)));

__device__ __forceinline__ unsigned cvt_pk_bf16(float lo, float hi) { unsigned r; asm volatile("v_cvt_pk_bf16_f32 %0, %1, %2" : "=v"(r) : "v"(lo), "v"(hi)); return r; }
__device__ __forceinline__ float bf2f(bf16_t v) { return __uint_as_float(((unsigned)v) << 16); }
__device__ __forceinline__ float bflo(unsigned w) { return __uint_as_float(w << 16); }
__device__ __forceinline__ float bfhi(unsigned w) { return __uint_as_float(w & 0xffff0000u); }
__device__ __forceinline__ bf16_t f2bf(float f) { return (bf16_t)(cvt_pk_bf16(f, 0.f) & 0xffffu); }
__device__ __forceinline__ float fexp2(float x) { return __builtin_amdgcn_exp2f(x); }
__device__ __forceinline__ float frcp(float x) { return __builtin_amdgcn_rcpf(x); }
__device__ __forceinline__ float gelu_tanh(float x) {
    const float u = x * (1.0f + 0.044715f * x * x) * (-2.0f * 0.7978845608028654f * 1.4426950408889634f);
    return x * frcp(1.0f + fexp2(u));
}
__device__ __forceinline__ float sigmoidf_(float x) { return frcp(1.0f + fexp2(-1.4426950408889634f * x)); }
__device__ __forceinline__ float bperm_f(int src_lane, float v) { return __int_as_float(__builtin_amdgcn_ds_bpermute(src_lane << 2, __float_as_int(v))); }
#define DPP_F(V, CTRL) __int_as_float(__builtin_amdgcn_mov_dpp(__float_as_int(V), (CTRL), 0xf, 0xf, true))
__device__ __forceinline__ float wave_sum(float v, int  ) {
    v += DPP_F(v, 0xB1);
    v += DPP_F(v, 0x4E);
    v += DPP_F(v, 0x141);
    v += DPP_F(v, 0x140);
    const int iv = __float_as_int(v);
    return (__int_as_float(__builtin_amdgcn_readlane(iv, 0)) + __int_as_float(__builtin_amdgcn_readlane(iv, 16))) + (__int_as_float(__builtin_amdgcn_readlane(iv, 32)) + __int_as_float(__builtin_amdgcn_readlane(iv, 48)));
}
__device__ __forceinline__ float xor32_max(float v) { auto rr = __builtin_amdgcn_permlane32_swap(__float_as_uint(v), __float_as_uint(v), false, false); return fmaxf(__uint_as_float(rr[0]), __uint_as_float(rr[1])); }
__device__ __forceinline__ float xor32_sum(float v) { auto rr = __builtin_amdgcn_permlane32_swap(__float_as_uint(v), __float_as_uint(v), false, false); return __uint_as_float(rr[0]) + __uint_as_float(rr[1]); }

__device__ __forceinline__ void lru_ab(float ga, float gx, float gab, float gxb, float spl  , float xb, float& a, float& b) {
    const float r = sigmoidf_(ga + gab), ii = sigmoidf_(gx + gxb);
    const float la2 = (-8.0f * 1.4426950408889634f) * r * spl;
    a = fexp2(la2);
    const float om = 1.0f - a * a;
    b = __builtin_amdgcn_sqrtf(om) * (ii * xb);
}


__device__ __forceinline__ void lru_lb(float ga, float gx, float gab, float gxb, float spl, float xb, float& la2, float& b) {
    const float r = sigmoidf_(ga + gab), ii = sigmoidf_(gx + gxb);
    la2 = (-8.0f * 1.4426950408889634f) * r * spl;
    const float a = fexp2(la2); const float om = 1.0f - a * a;
    b = __builtin_amdgcn_sqrtf(om) * (ii * xb);
}

namespace pg8 {
constexpr int BM = 256, BK = 64, HALF = 128, HTB = HALF * BK * 2, STAGE_BYTES = 8 * HTB, NXCD = 8, WGM = 8;
__host__ __device__ __forceinline__ int lds_byte(int r, int c) { const int st = (r >> 4) * 2 + (c >> 5), rr = r & 15, cc = c & 31, ob = rr * 64 + cc * 2; return st * 1024 + (ob ^ (((ob >> 9) & 1) << 5)); }
__host__ __device__ __forceinline__ void stage_rc(int b, int& R, int& C) { const int st = b / 1024, sb = b % 1024, swz = sb ^ (((sb >> 9) & 1) << 5); R = (st >> 1) * 16 + swz / 64; C = (st & 1) * 32 + (swz % 64) / 2; }
__host__ __device__ __forceinline__ int perm32(int rho) { const int n = rho >> 4, i = rho & 15; return 8 * (i >> 2) + 4 * n + (i & 3); }

struct Unit { int pm, pn; };
struct Gemm { const bf16_t* A; const bf16_t* Bt; int lda, ldb, K; size_t tA, hA, tB, hB; int a_seg; int a_pn_shift; size_t a_pn_step; };
__device__ __forceinline__ Gemm make_gemm(const bf16_t* A, int lda, const bf16_t* Bt, int ldb, int K) {
    Gemm g; g.A = A; g.Bt = Bt; g.lda = lda; g.ldb = ldb; g.K = K; g.tA = (size_t)256 * lda * 2; g.hA = (size_t)128 * lda * 2; g.tB = (size_t)256 * ldb * 2; g.hB = (size_t)128 * ldb * 2;
    g.a_seg = 0; g.a_pn_shift = 0; g.a_pn_step = 0; return g;
}

struct StaticOrder {
    int nM, nN, nwg, G, c;
    __device__ __forceinline__ void init(int nM_, int nN_, int G_, int c_) { nM = nM_; nN = nN_; nwg = nM * nN; G = G_; c = c_; }
    __device__ __forceinline__ bool next(int i, Unit& u) const {
        const long L = (long)i * G + c; if (L >= nwg) return false;
        int wgid = (int)L; { const int q = nwg / NXCD, r = nwg % NXCD, xcd = wgid % NXCD, off = wgid / NXCD; wgid = (xcd < r ? xcd * (q + 1) : r * (q + 1) + (xcd - r) * q) + off; }
        const int nig = WGM * nN, gid = wgid / nig, fm = gid * WGM, gsz = (nM - fm) < WGM ? (nM - fm) : WGM;
        u.pm = fm + ((wgid % nig) % gsz); u.pn = (wgid % nig) / gsz; return true;
    }
};

template <class Epi>
__device__ __forceinline__ void gemm_phase(LAS unsigned char* lds, const Gemm g, const StaticOrder& S, const Epi& E) {
    constexpr bool SP2 = true, ALIGN_EPI = true;
    int tid_ = threadIdx.x; asm volatile("" : "+v"(tid_));
    const int tid = tid_, wid = __builtin_amdgcn_readfirstlane(tid >> 6), lane = tid & 63, wr = wid >> 2, wc = wid & 3, fr = lane & 15, fq = lane >> 4;
    int K_ = g.K; asm volatile("" : "+s"(K_)); const int K = K_, nt = K / BK;
    unsigned voffA[2], voffB[2];
#pragma unroll
    for (int i = 0; i < 2; ++i) { int R, C; stage_rc(tid * 16 + i * 8192, R, C); const int Rb = Epi::PERM ? ((R & ~31) + perm32(R & 31)) : R;
        const int Ra = g.a_seg ? (128 * (R >> 6) + 8 * (R & 15) + ((R >> 4) & 3)) : R;
        voffA[i] = (unsigned)(Ra * g.lda + C) * 2u; voffB[i] = (unsigned)(Rb * g.ldb + C) * 2u; }
    const size_t kstep = (size_t)(BK * 2);
    const size_t hstepA = g.hA, hstepB = g.hB;
    const unsigned ldsw = (unsigned)wid * 1024u;
    const int aoff = lds_byte(wr * 64 + fr, fq * 8), boff = lds_byte(wc * 32 + fr, fq * 8);
#define PG8_SA(b, h) (((b) * 2 + (h)) * HTB)
#define PG8_SB(b, h) ((4 + (b) * 2 + (h)) * HTB)
#define PG8_STAGE(bufoff, gbase, voff) do { _Pragma("unroll") for (int _i = 0; _i < 2; ++_i) \
        __builtin_amdgcn_global_load_lds((const unsigned*)((const char*)(gbase) + (voff)[_i]), (LAS unsigned*)(lds + (bufoff) + ldsw + _i * 8192), 16, 0, 0); } while (0)
#define PG8_LDA(dst, b, h) do { _Pragma("unroll") for (int m = 0; m < 4; ++m) _Pragma("unroll") for (int k = 0; k < 2; ++k) dst[m][k] = *(const LAS bf16x8*)(lds + PG8_SA(b, h) + aoff + m * 2048 + k * 1024); } while (0)
#define PG8_LDB(dst, b, h) do { _Pragma("unroll") for (int n = 0; n < 2; ++n) _Pragma("unroll") for (int k = 0; k < 2; ++k) dst[n][k] = *(const LAS bf16x8*)(lds + PG8_SB(b, h) + boff + n * 2048 + k * 1024); } while (0)
#define PG8_MMA(ai, bj, At, Bt) do { __builtin_amdgcn_s_setprio(1); _Pragma("unroll") for (int m = 0; m < 4; ++m) _Pragma("unroll") for (int n = 0; n < 2; ++n) _Pragma("unroll") for (int k = 0; k < 2; ++k) \
        acc[ai][bj][m][n] = __builtin_amdgcn_mfma_f32_16x16x32_bf16(Bt[n][k], At[m][k], acc[ai][bj][m][n], 0, 0, 0); __builtin_amdgcn_s_setprio(0); } while (0)
#define PG8_WAIT_V(n) asm volatile("s_waitcnt vmcnt(" #n ")" ::: "memory")
#define PG8_WAIT_L(n) asm volatile("s_waitcnt lgkmcnt(" #n ")" ::: "memory")
#define PG8_BAR __builtin_amdgcn_s_barrier()
#define PG8_SCHED __builtin_amdgcn_sched_barrier(0)
#define PG8_APTR(u) ((const char*)g.A + (size_t)(u).pm * g.tA + (size_t)((u).pn >> g.a_pn_shift) * g.a_pn_step)
#define PG8_BPTR(u) ((const char*)g.Bt + (size_t)(u).pn * g.tB)
    Unit cur, nxt; int ui = 0;
    if (!S.next(0, cur)) return;
    f32x4 acc[2][2][4][2];
#pragma unroll
    for (int a = 0; a < 2; ++a)
#pragma unroll
        for (int b = 0; b < 2; ++b)
#pragma unroll
            for (int m = 0; m < 4; ++m)
#pragma unroll
                for (int n = 0; n < 2; ++n) acc[a][b][m][n] = (f32x4){0.f, 0.f, 0.f, 0.f};
    bf16x8 At[4][2], B0[2][2], B1[2][2];
    const char* cA = PG8_APTR(cur); const char* cB = PG8_BPTR(cur);
    {
        PG8_STAGE(PG8_SB(0, 0), cB, voffB); PG8_STAGE(PG8_SB(0, 1), cB + hstepB, voffB); PG8_STAGE(PG8_SA(0, 0), cA, voffA); PG8_STAGE(PG8_SA(0, 1), cA + hstepA, voffA);
        if (wr == 1) PG8_BAR;
        PG8_WAIT_V(2); PG8_BAR;
        PG8_STAGE(PG8_SB(1, 0), cB + kstep, voffB); PG8_STAGE(PG8_SA(1, 0), cA + kstep, voffA); PG8_STAGE(PG8_SB(1, 1), cB + hstepB + kstep, voffB);
        PG8_WAIT_V(6); PG8_BAR;
    }
    for (;;) {
        const bool has_next = S.next(ui + 1, nxt);
        const char* nA = has_next ? PG8_APTR(nxt) : cA; const char* nB = has_next ? PG8_BPTR(nxt) : cB;
        for (int t = 0; t < nt; t += 2) {
            const bool last = (t == nt - 2);
            const char* a1 = cA + (size_t)(t + 1) * kstep;
            const char* a2 = last ? nA : cA + (size_t)(t + 2) * kstep; const char* b2 = last ? nB : cB + (size_t)(t + 2) * kstep;
            const char* a3 = a2 + kstep; const char* b3 = b2 + kstep;
            PG8_LDB(B0, 0, 0); PG8_LDB(B1, 0, 1); PG8_SCHED; PG8_LDA(At, 0, 0); PG8_STAGE(PG8_SA(1, 1), a1 + hstepA, voffA);
            PG8_WAIT_V(8); PG8_WAIT_L(0); PG8_BAR; PG8_MMA(0, 0, At, B0); PG8_MMA(0, 1, At, B1); PG8_BAR; PG8_SCHED;
            PG8_LDA(At, 0, 1); PG8_STAGE(PG8_SB(0, 0), b2, voffB); PG8_STAGE(PG8_SB(0, 1), b2 + hstepB, voffB); PG8_STAGE(PG8_SA(0, 0), a2, voffA);
            PG8_WAIT_V(8); PG8_WAIT_L(0); PG8_BAR; PG8_MMA(1, 0, At, B0); PG8_MMA(1, 1, At, B1); PG8_BAR; PG8_SCHED;
            PG8_LDB(B0, 1, 0); PG8_LDB(B1, 1, 1); PG8_SCHED; PG8_LDA(At, 1, 0); PG8_STAGE(PG8_SA(0, 1), a2 + hstepA, voffA);
            PG8_WAIT_V(8); PG8_WAIT_L(0); PG8_BAR; PG8_MMA(0, 0, At, B0); PG8_MMA(0, 1, At, B1); PG8_BAR; PG8_SCHED;
            PG8_LDA(At, 1, 1); PG8_STAGE(PG8_SB(1, 0), b3, voffB); PG8_STAGE(PG8_SB(1, 1), b3 + hstepB, voffB); PG8_STAGE(PG8_SA(1, 0), a3, voffA);
            PG8_WAIT_V(8); PG8_WAIT_L(0); PG8_BAR; PG8_MMA(1, 0, At, B0); PG8_MMA(1, 1, At, B1); PG8_BAR; PG8_SCHED;
        }
        if constexpr (ALIGN_EPI) { if (wr == 0) PG8_BAR; }
        if constexpr (!Epi::AFTER_DRAIN) E(acc, cur, wr, wc, fr, fq);
        if (!has_next) break;
#pragma unroll
        for (int a = 0; a < 2; ++a)
#pragma unroll
            for (int b = 0; b < 2; ++b)
#pragma unroll
                for (int m = 0; m < 4; ++m)
#pragma unroll
                    for (int n = 0; n < 2; ++n) acc[a][b][m][n] = (f32x4){0.f, 0.f, 0.f, 0.f};
        cur = nxt; cA = nA; cB = nB; ++ui;
        if constexpr (ALIGN_EPI) { if (wr == 1) PG8_BAR; }
    }
    PG8_WAIT_V(0);
    if constexpr (!ALIGN_EPI) { if (wr == 0) PG8_BAR; }
    PG8_BAR;
    if constexpr (Epi::AFTER_DRAIN) E.fused(acc, cur, wr, wc, fr, fq, lds, wid, lane);
#undef PG8_SA
#undef PG8_SB
#undef PG8_STAGE
#undef PG8_LDA
#undef PG8_LDB
#undef PG8_MMA
#undef PG8_WAIT_V
#undef PG8_WAIT_L
#undef PG8_BAR
#undef PG8_SCHED
#undef PG8_APTR
#undef PG8_BPTR
}
}
constexpr int TH = 16384;
constexpr int DM = 1024, ZP = 2304, DFF = 4096, TQ = 8192;
constexpr size_t MiB = 1u << 20;
constexpr size_t WS_RSQ = 0, WS_RSKV = 64 * 1024, WS_ROPE = 128 * 1024;
constexpr size_t WS_AGG = 5 * MiB;
constexpr size_t WS_CARRY = 9 * MiB;
constexpr size_t WS_XBUF = 1 * MiB;
constexpr size_t WS_SQP = 1 * MiB + 512 * 1024;
constexpr size_t WS_CNT = 3 * MiB;
constexpr size_t WS_BAR = 4 * MiB;
constexpr size_t WS_YB = 5 * MiB;
constexpr size_t WS_W_INATT = 13 * MiB;
constexpr size_t WS_W_UQ = WS_W_INATT + (size_t)2304 * 1024 * 2;
constexpr size_t WS_W_UKV = WS_W_UQ + (size_t)768 * 384 * 2;
constexpr size_t WS_W_OUTATT = WS_W_UKV + (size_t)1024 * 256 * 2;
constexpr size_t WS_W_INREC = WS_W_OUTATT + 2 * MiB;
constexpr size_t WS_W_GATES = WS_W_INREC + 4 * MiB;
constexpr size_t WS_W_OUTREC = WS_W_GATES + 1 * MiB;
constexpr size_t WS_W_UP = WS_W_OUTREC + 2 * MiB;
constexpr size_t WS_W_DOWN = WS_W_UP + 32 * MiB;
constexpr size_t WS_W_END = WS_W_DOWN + 16 * MiB;
static_assert(WS_W_END <= 76 * MiB, "weights");
constexpr size_t WS_XN = 76 * MiB;
constexpr size_t WS_BIG = 108 * MiB;
constexpr size_t WS_Z = WS_BIG;
constexpr size_t WS_Q = WS_Z + 72 * MiB;
constexpr size_t WS_KN = WS_Q + 24 * MiB;
constexpr size_t WS_VTM = WS_KN + 16 * MiB;
constexpr size_t WS_VTN = WS_VTM + 16 * MiB;
constexpr size_t WS_KPE = WS_VTN + 16 * MiB;
static_assert(WS_KPE + 1 * MiB <= 256 * MiB, "L0 overlay");
constexpr size_t WS_ACT = WS_BIG;
constexpr size_t WS_GATE = WS_BIG;
constexpr size_t WS_XB = WS_BIG + 32 * MiB;
constexpr size_t WS_XBR = WS_BIG + 64 * MiB;
constexpr size_t WS_GQ = WS_XBR;
constexpr size_t WS_END = 256 * MiB;

using pg8::Unit;

struct EpiBf16 {
    static constexpr bool PERM = true, AFTER_DRAIN = false;
    bf16_t* O; int ldc; int split_cols; size_t split_stride;
    __device__ __forceinline__ void operator()(f32x4 (&acc)[2][2][4][2], const Unit& u, int wr, int wc, int fr, int fq) const {
        const int row0 = u.pm * 256 + wr * 64 + fr; int colt = u.pn * 256; bf16_t* base = O;
        if (split_cols) { const int t = colt / split_cols; base += (size_t)t * split_stride; colt -= t * split_cols; }
        const int col0 = colt + wc * 32 + 8 * fq;
#pragma unroll
        for (int ai = 0; ai < 2; ++ai)
#pragma unroll
            for (int m = 0; m < 4; ++m) { bf16_t* rowp = base + (size_t)(row0 + ai * 128 + m * 16) * ldc + col0;
#pragma unroll
                for (int bj = 0; bj < 2; ++bj) { const f32x4 v0 = acc[ai][bj][m][0], v1 = acc[ai][bj][m][1];
                    u32x4 w; w.x = cvt_pk_bf16(v0[0], v0[1]); w.y = cvt_pk_bf16(v0[2], v0[3]); w.z = cvt_pk_bf16(v1[0], v1[1]); w.w = cvt_pk_bf16(v1[2], v1[3]);
                    *(u32x4*)(rowp + bj * 128) = w; } }
    }
};

struct EpiZ {
    static constexpr bool PERM = true, AFTER_DRAIN = false;
    bf16_t* Z; bf16_t* VTn; float* SQ; float* SKV; bf16_t* KPE; const float2* rope; int smask;
    __device__ __forceinline__ void operator()(f32x4 (&acc)[2][2][4][2], const Unit& u, int wr, int wc, int fr, int fq) const {
        const int lane = fq * 16 + fr;
        const int row0 = u.pm * 256 + wr * 64 + fr; const int col0 = u.pn * 256 + wc * 32 + 8 * fq;
#pragma unroll
        for (int ai = 0; ai < 2; ++ai)
#pragma unroll
            for (int m = 0; m < 4; ++m) { const int row = row0 + ai * 128 + m * 16; bf16_t* rowp = Z + (size_t)row * ZP + col0;
#pragma unroll
                for (int bj = 0; bj < 2; ++bj) { const f32x4 v0 = acc[ai][bj][m][0], v1 = acc[ai][bj][m][1];
                    u32x4 w; w.x = cvt_pk_bf16(v0[0], v0[1]); w.y = cvt_pk_bf16(v0[2], v0[3]); w.z = cvt_pk_bf16(v1[0], v1[1]); w.w = cvt_pk_bf16(v1[2], v1[3]);
                    *(u32x4*)(rowp + bj * 128) = w;
                    const int c = col0 + bj * 128; const int g32 = (u.pn * 256 + bj * 128 + wc * 32) >> 5;
                    if (g32 < 20) {
                        float s = (v0[0] * v0[0] + v0[1] * v0[1]) + (v0[2] * v0[2] + v0[3] * v0[3]) + ((v1[0] * v1[0] + v1[1] * v1[1]) + (v1[2] * v1[2] + v1[3] * v1[3]));
                        s += bperm_f(lane ^ 16, s); s += bperm_f(lane ^ 32, s);
                        if (fq == 0) SQ[(size_t)row * 20 + g32] = s;
                    } else if (g32 == 20) {
                        const float2* rp = rope + (size_t)(row & smask) * 16 + 8 * (fq & 1);
                        float o[8];
#pragma unroll
                        for (int k = 0; k < 8; ++k) { const float mine = k < 4 ? v0[k] : v1[k - 4]; const float other = bperm_f(lane ^ 32, mine); const float2 cs = rp[k];
                            o[k] = fq < 2 ? mine * cs.x - other * cs.y : mine * cs.x + other * cs.y; }
                        u32x4 wk; wk.x = cvt_pk_bf16(o[0], o[1]); wk.y = cvt_pk_bf16(o[2], o[3]); wk.z = cvt_pk_bf16(o[4], o[5]); wk.w = cvt_pk_bf16(o[6], o[7]);
                        *(u32x4*)(KPE + (size_t)row * 32 + 8 * fq) = wk;
                    }
                    if (c >= 1696 && c < 2208) { bf16_t* vt = VTn + (size_t)(c - 1696) * TH + row;
                        vt[0] = (bf16_t)(w.x & 0xffffu); vt[TH] = (bf16_t)(w.x >> 16); vt[2 * TH] = (bf16_t)(w.y & 0xffffu); vt[3 * TH] = (bf16_t)(w.y >> 16);
                        vt[4 * TH] = (bf16_t)(w.z & 0xffffu); vt[5 * TH] = (bf16_t)(w.z >> 16); vt[6 * TH] = (bf16_t)(w.w & 0xffffu); vt[7 * TH] = (bf16_t)(w.w >> 16); } } }
    }
};

struct EpiQ {
    static constexpr bool PERM = false, AFTER_DRAIN = false;
    bf16_t* Q; const float* rsq; const float2* rope; int smask;
    __device__ __forceinline__ void operator()(f32x4 (&acc)[2][2][4][2], const Unit& u, int wr, int wc, int fr, int fq) const {
        const float SC = 0.10206207261596577f * 1.4426950408889634f;
        const int row0 = u.pm * 256 + wr * 64 + fr;
#pragma unroll
        for (int ai = 0; ai < 2; ++ai)
#pragma unroll
            for (int m = 0; m < 4; ++m) { const int row = row0 + ai * 128 + m * 16; float ssq = 0.f;
#pragma unroll
                for (int k = 0; k < 12; ++k) ssq += rsq[(size_t)row * 20 + k];
                const float rs = SC / sqrtf(ssq * (1.f / 384.f) + 1e-6f); const int pos = row & smask;
#pragma unroll
                for (int bj = 0; bj < 2; ++bj) { const int cg = u.pn * 256 + bj * 128 + wc * 32;
                    f32x4 v0 = acc[ai][bj][m][0] * rs, v1 = acc[ai][bj][m][1] * rs;
                    if ((cg % 96) == 64) {
                        const float2* rp = rope + (size_t)pos * 16 + 4 * fq;
#pragma unroll
                        for (int i = 0; i < 4; ++i) { const float2 cs = rp[i]; const float x1 = v0[i], x2 = v1[i]; v0[i] = x1 * cs.x - x2 * cs.y; v1[i] = x2 * cs.x + x1 * cs.y; }
                    }
                    bf16_t* p = Q + (size_t)row * 768 + cg + 4 * fq;
                    u32x2 w0; w0.x = cvt_pk_bf16(v0[0], v0[1]); w0.y = cvt_pk_bf16(v0[2], v0[3]); *(u32x2*)p = w0;
                    u32x2 w1; w1.x = cvt_pk_bf16(v1[0], v1[1]); w1.y = cvt_pk_bf16(v1[2], v1[3]); *(u32x2*)(p + 16) = w1; } }
    }
};

struct EpiKV {
    static constexpr bool PERM = true, AFTER_DRAIN = false;
    bf16_t* KN; bf16_t* VTm; const float* rskv;
    __device__ __forceinline__ void operator()(f32x4 (&acc)[2][2][4][2], const Unit& u, int wr, int wc, int fr, int fq) const {
        const int row0 = u.pm * 256 + wr * 64 + fr;
#pragma unroll
        for (int ai = 0; ai < 2; ++ai)
#pragma unroll
            for (int m = 0; m < 4; ++m) { const int row = row0 + ai * 128 + m * 16; float ssq = 0.f;
#pragma unroll
                for (int k = 12; k < 20; ++k) ssq += rskv[(size_t)row * 20 + k];
                const float rs = 1.0f / sqrtf(ssq * (1.f / 256.f) + 1e-6f);
#pragma unroll
                for (int bj = 0; bj < 2; ++bj) { const int c = u.pn * 256 + bj * 128 + wc * 32 + 8 * fq;
                    const f32x4 v0 = acc[ai][bj][m][0] * rs, v1 = acc[ai][bj][m][1] * rs;
                    u32x4 w; w.x = cvt_pk_bf16(v0[0], v0[1]); w.y = cvt_pk_bf16(v0[2], v0[3]); w.z = cvt_pk_bf16(v1[0], v1[1]); w.w = cvt_pk_bf16(v1[2], v1[3]);
                    const int h = c >> 7, j = c & 127;
                    if (j < 64) { *(u32x4*)(KN + (size_t)row * 512 + h * 64 + j) = w; }
                    else { bf16_t* vt = VTm + (size_t)(h * 64 + j - 64) * TH + row;
                        vt[0] = (bf16_t)(w.x & 0xffffu); vt[TH] = (bf16_t)(w.x >> 16); vt[2 * TH] = (bf16_t)(w.y & 0xffffu); vt[3 * TH] = (bf16_t)(w.y >> 16);
                        vt[4 * TH] = (bf16_t)(w.z & 0xffffu); vt[5 * TH] = (bf16_t)(w.z >> 16); vt[6 * TH] = (bf16_t)(w.w & 0xffffu); vt[7 * TH] = (bf16_t)(w.w >> 16); } } }
    }
};

struct EpiUp {
    static constexpr bool PERM = true, AFTER_DRAIN = false;
    bf16_t* ACT; bf16_t* YB; const float* cw; const float* cb;
    __device__ __forceinline__ void operator()(f32x4 (&acc)[2][2][4][2], const Unit& u, int wr, int wc, int fr_, int fq_) const {
        int fr = fr_, fq = fq_; asm volatile("" : "+v"(fr), "+v"(fq));
        const int lane = fq * 16 + fr;
        const int tok0 = u.pm * 256 + wr * 128 + 8 * fr;
        const int ch0 = u.pn * 128 + wc * 32 + 8 * fq;
        const int seg = u.pm * 2 + wr;
        if (fr == 0 || fr == 15) {
#pragma unroll
            for (int k = 0; k < 2; ++k) {
                const int slot = fr == 0 ? k : 2 + k;
                bf16_t* yb = YB + ((size_t)seg * 4 + slot) * 8192 + ch0;
#pragma unroll
                for (int bj = 0; bj < 2; ++bj) { const f32x4 v0 = fr == 0 ? acc[0][bj][k][0] : acc[1][bj][2 + k][0], v1 = fr == 0 ? acc[0][bj][k][1] : acc[1][bj][2 + k][1];
                    u32x4 w; w.x = cvt_pk_bf16(v0[0], v0[1]); w.y = cvt_pk_bf16(v0[2], v0[3]); w.z = cvt_pk_bf16(v1[0], v1[1]); w.w = cvt_pk_bf16(v1[2], v1[3]);
                    *(u32x4*)(yb + bj * 4096) = w; }
            }
        }
        const int src_up = (lane & ~15) | ((fr - 1) & 15), src_dn = (lane & ~15) | ((fr + 1) & 15);
#pragma unroll
        for (int n = 0; n < 2; ++n)
#pragma unroll
            for (int i = 0; i < 4; ++i) {
                float ug[8], uv[8];
#pragma unroll
                for (int bj = 0; bj < 2; ++bj) {
                    const int ch = bj * 4096 + ch0 + 4 * n + i;
                    const float w0 = cw[ch], w1 = cw[8192 + ch], w2 = cw[2 * 8192 + ch], b = cb[ch];
                    const float prev7 = bperm_f(src_up, acc[1][bj][3][n][i]);
                    const float next0 = bperm_f(src_dn, acc[0][bj][0][n][i]);
#pragma unroll
                    for (int q = 0; q < 8; ++q) {
                        const float v = acc[q >> 2][bj][q & 3][n][i];
                        const float up = q > 0 ? acc[(q - 1) >> 2][bj][(q - 1) & 3][n][i] : prev7;
                        const float dn = q < 7 ? acc[(q + 1) >> 2][bj][(q + 1) & 3][n][i] : next0;
                        const float r = w0 * up + w1 * v + w2 * dn + b;
                        if (bj == 0) ug[q] = r; else uv[q] = r;
                    }
                }
#pragma unroll
                for (int q = 0; q < 8; ++q) acc[q >> 2][0][q & 3][n][i] = gelu_tanh(ug[q]) * uv[q];
            }
#pragma unroll
        for (int ai = 0; ai < 2; ++ai)
#pragma unroll
            for (int m = 0; m < 4; ++m) { const f32x4 v0 = acc[ai][0][m][0], v1 = acc[ai][0][m][1];
                u32x4 w; w.x = cvt_pk_bf16(v0[0], v0[1]); w.y = cvt_pk_bf16(v0[2], v0[3]); w.z = cvt_pk_bf16(v1[0], v1[1]); w.w = cvt_pk_bf16(v1[2], v1[3]);
                *(u32x4*)(ACT + (size_t)(tok0 + 4 * ai + m) * DFF + ch0) = w; }
    }
};

struct EpiGates {
    static constexpr bool PERM = true, AFTER_DRAIN = false;
    bf16_t* G; const bf16_t* XBq; float2* AGGp; const float* gab_; const float* gxb_; const float* lam_;
    __device__ __forceinline__ void operator()(f32x4 (&acc)[2][2][4][2], const Unit& u, int wr, int wc, int fr_, int fq_) const {
        int fr = fr_, fq = fq_; asm volatile("" : "+v"(fr), "+v"(fq));
        const int lane = fq * 16 + fr;
        const int nblk = u.pn >> 1, e = u.pn & 1;
        const int tl0 = u.pm * 256 + wr * 128 + 8 * fr;
        const int d0 = wc * 32 + 8 * fq, ch0 = nblk * 128 + d0;
        u32x4 xbw[8];
#pragma unroll
        for (int q = 0; q < 8; ++q) xbw[q] = *(const u32x4*)(XBq + (size_t)(tl0 + q) * DM + ch0);
        unsigned law[8][4], bw[8][4];
#pragma unroll
        for (int k2 = 0; k2 < 4; ++k2) {
            const float2 gab = *(const float2*)(gab_ + e * 1024 + ch0 + 2 * k2), gxb = *(const float2*)(gxb_ + e * 1024 + ch0 + 2 * k2), lam = *(const float2*)(lam_ + e * 1024 + ch0 + 2 * k2);
            const float spl0 = log1pf(expf(-lam.x)), spl1 = log1pf(expf(-lam.y));
#pragma unroll
            for (int q = 0; q < 8; ++q) {
                const unsigned xb2 = k2 == 0 ? xbw[q].x : k2 == 1 ? xbw[q].y : k2 == 2 ? xbw[q].z : xbw[q].w;
                float l0, b0, l1, b1;
                lru_lb(acc[q >> 2][0][q & 3][k2 >> 1][2 * (k2 & 1)], acc[q >> 2][1][q & 3][k2 >> 1][2 * (k2 & 1)], gab.x, gxb.x, spl0, bflo(xb2), l0, b0);
                lru_lb(acc[q >> 2][0][q & 3][k2 >> 1][2 * (k2 & 1) + 1], acc[q >> 2][1][q & 3][k2 >> 1][2 * (k2 & 1) + 1], gab.y, gxb.y, spl1, bfhi(xb2), l1, b1);
                law[q][k2] = cvt_pk_bf16(l0, l1); bw[q][k2] = cvt_pk_bf16(b0, b1); }
        }
#pragma unroll
        for (int q = 0; q < 8; ++q) { bf16_t* rowp = G + (size_t)(tl0 + q) * 4096 + u.pn * 256 + d0;
            *(u32x4*)(rowp) = (u32x4){law[q][0], law[q][1], law[q][2], law[q][3]}; *(u32x4*)(rowp + 128) = (u32x4){bw[q][0], bw[q][1], bw[q][2], bw[q][3]}; }
        float Aagg[8], Bagg[8];
#pragma unroll
        for (int k2 = 0; k2 < 4; ++k2) {
            float A0 = 1.f, B0 = 0.f, A1 = 1.f, B1 = 0.f;
#pragma unroll
            for (int s = 0; s < 8; ++s) {
                const unsigned l2 = e ? law[7 - s][k2] : law[s][k2], b2 = e ? bw[7 - s][k2] : bw[s][k2];
                const float a0 = fexp2(bflo(l2)), a1 = fexp2(bfhi(l2));
                A0 *= a0; B0 = a0 * B0 + bflo(b2); A1 *= a1; B1 = a1 * B1 + bfhi(b2); }
            Aagg[2 * k2] = A0; Bagg[2 * k2] = B0; Aagg[2 * k2 + 1] = A1; Bagg[2 * k2 + 1] = B1;
        }
#pragma unroll
        for (int bit = 1; bit <= 2; bit <<= 1) {
            const bool me_first = e ? ((fr & bit) != 0) : ((fr & bit) == 0);
#pragma unroll
            for (int k = 0; k < 8; ++k) { const float Ao = bperm_f(lane ^ bit, Aagg[k]), Bo = bperm_f(lane ^ bit, Bagg[k]);
                const float An = Ao * Aagg[k], Bn = me_first ? Ao * Bagg[k] + Bo : Aagg[k] * Bo + Bagg[k];
                Aagg[k] = An; Bagg[k] = Bn; }
        }
        if ((fr & 3) == 0) { const int c = (tl0 >> 5);
            float2* dst = AGGp + (size_t)(c * 2 + e) * 1024 + ch0;
#pragma unroll
            for (int k = 0; k < 8; k += 2) *(f32x4*)(dst + k) = (f32x4){Aagg[k], Bagg[k], Aagg[k + 1], Bagg[k + 1]}; }
    }
};

struct EpiRms {
    static constexpr bool PERM = false, AFTER_DRAIN = true;
    float* x; bf16_t* xn; const float* gpost; const float* gnext; float* xbuf1; float* xbuf2; unsigned* cnt1; unsigned* cnt2;
    __device__ __forceinline__ void operator()(f32x4 (&)[2][2][4][2], const Unit&, int, int, int, int) const {}
    __device__ __forceinline__ void stats(const f32x4 (&v)[2][2][4][2], const Unit& u, int wr, int wc, int fr, int fq, LAS unsigned char* lds, int wid, int lane, float* xbuf, unsigned* cnt) const {
        LAS float* P = (LAS float*)lds; LAS float* Sx = (LAS float*)(lds + 4096);
#pragma unroll
        for (int ai = 0; ai < 2; ++ai)
#pragma unroll
            for (int m = 0; m < 4; ++m) { float s = 0.f;
#pragma unroll
                for (int bj = 0; bj < 2; ++bj)
#pragma unroll
                    for (int n = 0; n < 2; ++n) { const f32x4 t = v[ai][bj][m][n]; s += (t[0] * t[0] + t[1] * t[1]) + (t[2] * t[2] + t[3] * t[3]); }
                s += bperm_f(lane ^ 16, s); s += bperm_f(lane ^ 32, s);
                if (fq == 0) P[(ai * 128 + wr * 64 + m * 16 + fr) * 4 + wc] = s; }
        asm volatile("s_waitcnt lgkmcnt(0)" ::: "memory"); __builtin_amdgcn_s_barrier(); asm volatile("" ::: "memory");
        const int row = wid * 32 + (lane & 31);
        if (lane < 32) { const float t = (P[row * 4 + 0] + P[row * 4 + 1]) + (P[row * 4 + 2] + P[row * 4 + 3]);
            __hip_atomic_store(xbuf + (size_t)(u.pm * 256 + row) * 4 + u.pn, t, __ATOMIC_RELAXED, __HIP_MEMORY_SCOPE_AGENT); }
        asm volatile("s_waitcnt vmcnt(0)" ::: "memory");
        if (lane == 0) __hip_atomic_fetch_add(cnt + 64 * u.pm, 1u, __ATOMIC_RELAXED, __HIP_MEMORY_SCOPE_AGENT);
        if (wid == 0) { unsigned sp = 0;
            while ((unsigned)__builtin_amdgcn_readfirstlane(__hip_atomic_load(cnt + 64 * u.pm, __ATOMIC_RELAXED, __HIP_MEMORY_SCOPE_AGENT)) < 32u) { __builtin_amdgcn_s_sleep(2); if (++sp > (1u << 22)) break; }
            __builtin_amdgcn_fence(__ATOMIC_ACQUIRE, "agent"); }
        asm volatile("s_waitcnt vmcnt(0) lgkmcnt(0)" ::: "memory"); __builtin_amdgcn_s_barrier(); asm volatile("" ::: "memory");
        if (lane < 32) { const float* slot = xbuf + (size_t)(u.pm * 256 + row) * 4; float t = 0.f;
#pragma unroll
            for (int k = 0; k < 4; ++k) t += __hip_atomic_load(slot + k, __ATOMIC_RELAXED, __HIP_MEMORY_SCOPE_AGENT);
            Sx[row] = 1.0f / sqrtf(t * (1.f / 1024.f) + 1e-6f); }
        asm volatile("s_waitcnt lgkmcnt(0)" ::: "memory"); __builtin_amdgcn_s_barrier(); asm volatile("" ::: "memory");
    }
    __device__ __forceinline__ void fused(f32x4 (&acc)[2][2][4][2], const Unit& u, int wr, int wc, int fr, int fq, LAS unsigned char* lds, int wid, int lane) const {
        const LAS float* Sx = (const LAS float*)(lds + 4096);
        const int col0 = u.pn * 256 + wc * 32 + 4 * fq;
        stats(acc, u, wr, wc, fr, fq, lds, wid, lane, xbuf1, cnt1);
#pragma unroll
        for (int ai = 0; ai < 2; ++ai)
#pragma unroll
            for (int m = 0; m < 4; ++m) { const int r = ai * 128 + wr * 64 + m * 16 + fr; const float rs = Sx[r]; float* xr = x + (size_t)(u.pm * 256 + r) * DM + col0;
#pragma unroll
                for (int bj = 0; bj < 2; ++bj)
#pragma unroll
                    for (int n = 0; n < 2; ++n) { const f32x4 g = *(const f32x4*)(gpost + col0 + bj * 128 + n * 16); const f32x4 bs = *(const f32x4*)(xr + bj * 128 + n * 16);
                        const f32x4 o = bs + acc[ai][bj][m][n] * rs * g; acc[ai][bj][m][n] = o; *(f32x4*)(xr + bj * 128 + n * 16) = o; }
                if (m & 1) asm volatile("" ::: "memory"); }
        if (xn) {
            stats(acc, u, wr, wc, fr, fq, lds, wid, lane, xbuf2, cnt2);
#pragma unroll
            for (int ai = 0; ai < 2; ++ai)
#pragma unroll
                for (int m = 0; m < 4; ++m) { const int r = ai * 128 + wr * 64 + m * 16 + fr; const float rs = Sx[r]; bf16_t* xr = xn + (size_t)(u.pm * 256 + r) * DM + col0;
#pragma unroll
                    for (int bj = 0; bj < 2; ++bj)
#pragma unroll
                        for (int n = 0; n < 2; ++n) { const f32x4 g = *(const f32x4*)(gnext + col0 + bj * 128 + n * 16); const f32x4 o = acc[ai][bj][m][n] * rs * g;
                            u32x2 w; w.x = cvt_pk_bf16(o[0], o[1]); w.y = cvt_pk_bf16(o[2], o[3]); *(u32x2*)(xr + bj * 128 + n * 16) = w; } }
        }
    }
};
constexpr float EPS = 1e-6f;
constexpr float LOG2E = 1.4426950408889634f;

__device__ __forceinline__ void transpose_item(const float* W, int K, int N, bf16_t* WT, int row_off, const float* kscale, LAS float* scr, int item, int lane) {
    const int nblk = N / 32, kb = item / nblk, nb = item % nblk, k0 = 64 * kb, n0 = 32 * nb;
#pragma unroll 8
    for (int i = 0; i < 32; ++i) { const int kk = 2 * i + (lane >> 5); float v = W[(size_t)(k0 + kk) * N + n0 + (lane & 31)]; if (kscale) v *= kscale[k0 + kk]; scr[kk * 33 + (lane & 31)] = v; }
    asm volatile("s_waitcnt lgkmcnt(0)" ::: "memory");
    const int c = lane & 7;
#pragma unroll
    for (int j = 0; j < 4; ++j) { const int n = (lane >> 3) + 8 * j; const LAS float* s = scr + (8 * c) * 33 + n;
        u32x4 o; o.x = cvt_pk_bf16(s[0 * 33], s[1 * 33]); o.y = cvt_pk_bf16(s[2 * 33], s[3 * 33]); o.z = cvt_pk_bf16(s[4 * 33], s[5 * 33]); o.w = cvt_pk_bf16(s[6 * 33], s[7 * 33]);
        *(u32x4*)(WT + (size_t)(row_off + n0 + n) * K + k0 + 8 * c) = o; }
    asm volatile("s_waitcnt lgkmcnt(0)" ::: "memory");
}

__device__ __forceinline__ void xn_row(const float* xrow, const float* gain, bf16_t* orow, int lane) {
    const f32x4* xr = (const f32x4*)xrow + lane; const f32x4* gr = (const f32x4*)gain + lane;
    f32x4 v[4]; float s = 0.f;
#pragma unroll
    for (int j = 0; j < 4; ++j) { v[j] = xr[64 * j]; s += (v[j].x * v[j].x + v[j].y * v[j].y) + (v[j].z * v[j].z + v[j].w * v[j].w); }
    const float rs = 1.0f / sqrtf(wave_sum(s, lane) * (1.f / DM) + EPS);
    u32x2* o8 = (u32x2*)orow + lane;
#pragma unroll
    for (int j = 0; j < 4; ++j) { const f32x4 g = gr[64 * j]; u32x2 w; w.x = cvt_pk_bf16(v[j].x * rs * g.x, v[j].y * rs * g.y); w.y = cvt_pk_bf16(v[j].z * rs * g.z, v[j].w * rs * g.w); o8[64 * j] = w; }
}

__device__ __forceinline__ void res_row(const bf16_t* mrow, const float* xi, float* xo, const float* gpost, const float* gnext, bf16_t* xnrow, int lane) {
    const u32x2* mr = (const u32x2*)mrow + lane; const f32x4* xr = (const f32x4*)xi + lane; const f32x4* gp = (const f32x4*)gpost + lane;
    f32x4 mv[4]; float s = 0.f;
#pragma unroll
    for (int j = 0; j < 4; ++j) { const u32x2 w = mr[64 * j]; mv[j] = (f32x4){bflo(w.x), bfhi(w.x), bflo(w.y), bfhi(w.y)}; s += (mv[j].x * mv[j].x + mv[j].y * mv[j].y) + (mv[j].z * mv[j].z + mv[j].w * mv[j].w); }
    const float rs = 1.0f / sqrtf(wave_sum(s, lane) * (1.f / DM) + EPS);
    f32x4 x[4]; float s2 = 0.f;
#pragma unroll
    for (int j = 0; j < 4; ++j) { const f32x4 g = gp[64 * j]; x[j] = xr[64 * j] + mv[j] * rs * g; s2 += (x[j].x * x[j].x + x[j].y * x[j].y) + (x[j].z * x[j].z + x[j].w * x[j].w); }
    f32x4* xw = (f32x4*)xo + lane;
#pragma unroll
    for (int j = 0; j < 4; ++j) xw[64 * j] = x[j];
    if (gnext) {
        const float rs2 = 1.0f / sqrtf(wave_sum(s2, lane) * (1.f / DM) + EPS);
        const f32x4* gn = (const f32x4*)gnext + lane; u32x2* o8 = (u32x2*)xnrow + lane;
#pragma unroll
        for (int j = 0; j < 4; ++j) { const f32x4 g = gn[64 * j]; u32x2 w; w.x = cvt_pk_bf16(x[j].x * rs2 * g.x, x[j].y * rs2 * g.y); w.y = cvt_pk_bf16(x[j].z * rs2 * g.z, x[j].w * rs2 * g.w); o8[64 * j] = w; }
    }
}

__device__ __forceinline__ void res_row2(const bf16_t* m0, const bf16_t* m1, const float* xi0, const float* xi1, float* xo0, float* xo1, const float* gpost, const float* gnext, bf16_t* xn0, bf16_t* xn1, int lane) {
    const u32x2* mr0 = (const u32x2*)m0 + lane; const u32x2* mr1 = (const u32x2*)m1 + lane; const f32x4* xr0 = (const f32x4*)xi0 + lane; const f32x4* xr1 = (const f32x4*)xi1 + lane; const f32x4* gp = (const f32x4*)gpost + lane;
    u32x2 w0[4], w1[4]; f32x4 xa[4], xb[4], g[4];
#pragma unroll
    for (int j = 0; j < 4; ++j) { w0[j] = mr0[64 * j]; w1[j] = mr1[64 * j]; xa[j] = xr0[64 * j]; xb[j] = xr1[64 * j]; g[j] = gp[64 * j]; }
    f32x4 ma[4], mb[4]; float s0 = 0.f, s1 = 0.f;
#pragma unroll
    for (int j = 0; j < 4; ++j) { ma[j] = (f32x4){bflo(w0[j].x), bfhi(w0[j].x), bflo(w0[j].y), bfhi(w0[j].y)}; mb[j] = (f32x4){bflo(w1[j].x), bfhi(w1[j].x), bflo(w1[j].y), bfhi(w1[j].y)};
        s0 += (ma[j].x * ma[j].x + ma[j].y * ma[j].y) + (ma[j].z * ma[j].z + ma[j].w * ma[j].w); s1 += (mb[j].x * mb[j].x + mb[j].y * mb[j].y) + (mb[j].z * mb[j].z + mb[j].w * mb[j].w); }
    const float rs0 = 1.0f / sqrtf(wave_sum(s0, lane) * (1.f / DM) + EPS), rs1 = 1.0f / sqrtf(wave_sum(s1, lane) * (1.f / DM) + EPS);
    float t0 = 0.f, t1 = 0.f;
#pragma unroll
    for (int j = 0; j < 4; ++j) { xa[j] = xa[j] + ma[j] * rs0 * g[j]; xb[j] = xb[j] + mb[j] * rs1 * g[j];
        t0 += (xa[j].x * xa[j].x + xa[j].y * xa[j].y) + (xa[j].z * xa[j].z + xa[j].w * xa[j].w); t1 += (xb[j].x * xb[j].x + xb[j].y * xb[j].y) + (xb[j].z * xb[j].z + xb[j].w * xb[j].w); }
    f32x4* xw0 = (f32x4*)xo0 + lane; f32x4* xw1 = (f32x4*)xo1 + lane;
#pragma unroll
    for (int j = 0; j < 4; ++j) { xw0[64 * j] = xa[j]; xw1[64 * j] = xb[j]; }
    if (gnext) {
        const float q0 = 1.0f / sqrtf(wave_sum(t0, lane) * (1.f / DM) + EPS), q1 = 1.0f / sqrtf(wave_sum(t1, lane) * (1.f / DM) + EPS);
        const f32x4* gn = (const f32x4*)gnext + lane; u32x2* o0 = (u32x2*)xn0 + lane; u32x2* o1 = (u32x2*)xn1 + lane;
#pragma unroll
        for (int j = 0; j < 4; ++j) { const f32x4 h = gn[64 * j];
            u32x2 a; a.x = cvt_pk_bf16(xa[j].x * q0 * h.x, xa[j].y * q0 * h.y); a.y = cvt_pk_bf16(xa[j].z * q0 * h.z, xa[j].w * q0 * h.w); o0[64 * j] = a;
            u32x2 b; b.x = cvt_pk_bf16(xb[j].x * q1 * h.x, xb[j].y * q1 * h.y); b.y = cvt_pk_bf16(xb[j].z * q1 * h.z, xb[j].w * q1 * h.w); o1[64 * j] = b; }
    }
}

#define MLA_PACK(P, B) ((u32x4){cvt_pk_bf16(P[B], P[B + 1]), cvt_pk_bf16(P[B + 2], P[B + 3]), cvt_pk_bf16(P[B + 4], P[B + 5]), cvt_pk_bf16(P[B + 6], P[B + 7])})
__device__ __forceinline__ void mla_softmax(f32x16& p0, f32x16& p1, float& m_run, float& l_run, f32x16& o0, f32x16& o1) {
    float mx = fmaxf(p0[0], p1[0]);
#pragma unroll
    for (int r = 1; r < 16; ++r) mx = fmaxf(mx, fmaxf(p0[r], p1[r]));
    mx = xor32_max(mx);
    const float m_new = fmaxf(m_run, mx), alpha = fexp2(m_run - m_new); m_run = m_new;
    p0 = p0 - m_new; p1 = p1 - m_new;
#pragma unroll
    for (int r = 0; r < 16; ++r) { p0[r] = fexp2(p0[r]); p1[r] = fexp2(p1[r]); }
    const f32x16 ps = p0 + p1;
    const float ls = ((ps[0] + ps[1]) + (ps[2] + ps[3])) + ((ps[4] + ps[5]) + (ps[6] + ps[7])) + (((ps[8] + ps[9]) + (ps[10] + ps[11])) + ((ps[12] + ps[13]) + (ps[14] + ps[15])));
    l_run = l_run * alpha + ls;
    o0 = o0 * alpha; o1 = o1 * alpha;
}
__device__ __forceinline__ void mla_store(bf16_t* orow, const f32x16& o0, const f32x16& o1, float l_run) {
    const float inv = 1.0f / xor32_sum(l_run);
#pragma unroll
    for (int rg = 0; rg < 4; ++rg) {
        u32x2 w; w.x = cvt_pk_bf16(o0[4 * rg] * inv, o0[4 * rg + 1] * inv); w.y = cvt_pk_bf16(o0[4 * rg + 2] * inv, o0[4 * rg + 3] * inv); *(u32x2*)(orow + 8 * rg) = w;
        u32x2 w2; w2.x = cvt_pk_bf16(o1[4 * rg] * inv, o1[4 * rg + 1] * inv); w2.y = cvt_pk_bf16(o1[4 * rg + 2] * inv, o1[4 * rg + 3] * inv); *(u32x2*)(orow + 32 + 8 * rg) = w2;
    }
}
__device__ __forceinline__ void mla_unit(LAS unsigned char* lds, const bf16_t* Q, const bf16_t* KN, const bf16_t* KPE, const bf16_t* VT, bf16_t* AO, int tokbase, int S, int h, int qb, int tid) {
    constexpr int KBYTES = 12288, BUF = 20480;
    const int lane = tid & 63, wid = __builtin_amdgcn_readfirstlane(tid >> 6), r32 = lane & 31, hi = lane >> 5;
    const bf16_t* ks0 = KN + (size_t)(tokbase + lane) * 512 + h * 64 + 8 * wid;
    const bf16_t* ks1 = KPE + (size_t)(tokbase + lane) * 32 + 8 * (wid & 3);
    const bf16_t* vs = VT + (size_t)(h * 64 + lane) * TH + tokbase + 8 * wid;
#define MLA_DMA(T, B) do { LAS unsigned char* sb_ = lds + (B) * BUF; \
        __builtin_amdgcn_global_load_lds((const unsigned*)(ks0 + (size_t)(T) * (64 * 512)), (LAS unsigned*)(sb_ + wid * 1024), 16, 0, 0); \
        if (wid < 4) __builtin_amdgcn_global_load_lds((const unsigned*)(ks1 + (size_t)(T) * (64 * 32)), (LAS unsigned*)(sb_ + (8 + wid) * 1024), 16, 0, 0); \
        __builtin_amdgcn_global_load_lds((const unsigned*)(vs + (size_t)(T) * 64), (LAS unsigned*)(sb_ + KBYTES + wid * 1024), 16, 0, 0); } while (0)
#define MLA_WAITBAR_KEEP() do { if (wid < 4) asm volatile("s_waitcnt vmcnt(3)" ::: "memory"); else asm volatile("s_waitcnt vmcnt(2)" ::: "memory"); \
        asm volatile("s_waitcnt lgkmcnt(0)" ::: "memory"); __builtin_amdgcn_s_barrier(); asm volatile("" ::: "memory"); } while (0)
#define MLA_WAITBAR_ALL() do { asm volatile("s_waitcnt vmcnt(0) lgkmcnt(0)" ::: "memory"); __builtin_amdgcn_s_barrier(); asm volatile("" ::: "memory"); } while (0)
    const int NT = S / 64;
    const int qtokA = tokbase + 512 * qb + 64 * wid + r32, qtokB = qtokA + 32;
    bf16x8 qa[6], qbv[6];
#pragma unroll
    for (int d0 = 0; d0 < 6; ++d0) { qa[d0] = *(const bf16x8*)(Q + (size_t)qtokA * 768 + h * 96 + 16 * d0 + 8 * hi); qbv[d0] = *(const bf16x8*)(Q + (size_t)qtokB * 768 + h * 96 + 16 * d0 + 8 * hi); }
    asm volatile("s_waitcnt vmcnt(0)" ::: "memory");
    MLA_DMA(0, 0); MLA_DMA(1, 1);
    MLA_WAITBAR_ALL();
    f32x16 oa0, oa1, ob0, ob1;
#pragma unroll
    for (int r = 0; r < 16; ++r) { oa0[r] = 0.f; oa1[r] = 0.f; ob0[r] = 0.f; ob1[r] = 0.f; }
    float ma = -1e30f, la = 0.f, mb = -1e30f, lb = 0.f;
    for (int t = 0; t < NT; ++t) {
        if (t + 2 < NT) MLA_DMA(t + 2, (t + 2) & 3);
        const LAS unsigned char* kb = lds + (t & 3) * BUF; const LAS unsigned char* vb = kb + KBYTES;
        f32x16 pa0, pa1, pb0, pb1;
#pragma unroll
        for (int r = 0; r < 16; ++r) { pa0[r] = 0.f; pa1[r] = 0.f; pb0[r] = 0.f; pb1[r] = 0.f; }
#pragma unroll
        for (int d0 = 0; d0 < 6; ++d0) {
            const bf16x8 a0 = *(const LAS bf16x8*)(kb + (2 * d0 + hi) * 1024 + r32 * 16);
            const bf16x8 a1 = *(const LAS bf16x8*)(kb + (2 * d0 + hi) * 1024 + (32 + r32) * 16);
            pa0 = __builtin_amdgcn_mfma_f32_32x32x16_bf16(a0, qa[d0], pa0, 0, 0, 0);
            pa1 = __builtin_amdgcn_mfma_f32_32x32x16_bf16(a1, qa[d0], pa1, 0, 0, 0);
            pb0 = __builtin_amdgcn_mfma_f32_32x32x16_bf16(a0, qbv[d0], pb0, 0, 0, 0);
            pb1 = __builtin_amdgcn_mfma_f32_32x32x16_bf16(a1, qbv[d0], pb1, 0, 0, 0);
        }
        mla_softmax(pa0, pa1, ma, la, oa0, oa1);
        mla_softmax(pb0, pb1, mb, lb, ob0, ob1);
#pragma unroll
        for (int ks = 0; ks < 4; ++ks) {
            const u32x4 pwa = ks == 0 ? MLA_PACK(pa0, 0) : ks == 1 ? MLA_PACK(pa0, 8) : ks == 2 ? MLA_PACK(pa1, 0) : MLA_PACK(pa1, 8);
            const u32x4 pwb = ks == 0 ? MLA_PACK(pb0, 0) : ks == 1 ? MLA_PACK(pb0, 8) : ks == 2 ? MLA_PACK(pb1, 0) : MLA_PACK(pb1, 8);
            const bf16x8 paa = __builtin_bit_cast(bf16x8, pwa), pab = __builtin_bit_cast(bf16x8, pwb);
            const LAS unsigned char* vp = vb + (2 * ks) * 1024 + r32 * 16 + 8 * hi;
            const u32x2 a_lo = *(const LAS u32x2*)(vp), a_hi = *(const LAS u32x2*)(vp + 1024);
            const u32x2 b_lo = *(const LAS u32x2*)(vp + 512), b_hi = *(const LAS u32x2*)(vp + 1024 + 512);
            const bf16x8 vf0 = __builtin_bit_cast(bf16x8, ((u32x4){a_lo.x, a_lo.y, a_hi.x, a_hi.y}));
            const bf16x8 vf1 = __builtin_bit_cast(bf16x8, ((u32x4){b_lo.x, b_lo.y, b_hi.x, b_hi.y}));
            oa0 = __builtin_amdgcn_mfma_f32_32x32x16_bf16(vf0, paa, oa0, 0, 0, 0);
            oa1 = __builtin_amdgcn_mfma_f32_32x32x16_bf16(vf1, paa, oa1, 0, 0, 0);
            ob0 = __builtin_amdgcn_mfma_f32_32x32x16_bf16(vf0, pab, ob0, 0, 0, 0);
            ob1 = __builtin_amdgcn_mfma_f32_32x32x16_bf16(vf1, pab, ob1, 0, 0, 0);
        }
        if (t & 1) MLA_WAITBAR_ALL();
    }
#undef MLA_DMA
#undef MLA_WAITBAR_KEEP
#undef MLA_WAITBAR_ALL
    mla_store(AO + (size_t)qtokA * 1024 + h * 64 + 4 * hi, oa0, oa1, la);
    mla_store(AO + (size_t)qtokB * 1024 + h * 64 + 4 * hi, ob0, ob1, lb);
}

__device__ __forceinline__ unsigned na_vmask(int qc, int kh, int hi) {
    int cs = qc - 8; cs = cs < 0 ? 0 : cs; cs = cs > 48 ? 48 : cs; unsigned mk = 0u;
#pragma unroll
    for (int r = 0; r < 16; ++r) { const int kc = 32 * kh + (r & 3) + 8 * (r >> 2) + 4 * hi; mk |= ((kc >= cs) && (kc < cs + 16)) ? (1u << r) : 0u; }
    return mk;
}
__device__ __forceinline__ void na_qs(const bf16x8 (&kf)[4], const bf16x8 (&vf)[2][2], const bf16x8 (&qf)[4], const LAS float* brow, int qc, int kh, int hi, unsigned vmsel,
                                      float& m_run, float& l_run, f32x16& o0, f32x16& o1) {
    const float SCL = 0.125f * LOG2E;
    f32x16 p;
#pragma unroll
    for (int r = 0; r < 16; ++r) p[r] = 0.f;
#pragma unroll
    for (int d0 = 0; d0 < 4; ++d0) p = __builtin_amdgcn_mfma_f32_32x32x16_bf16(kf[d0], qf[d0], p, 0, 0, 0);
    unsigned vm = vmsel; asm volatile("" : "+v"(vm));
    float mx = -1e30f;
#pragma unroll
    for (int r = 0; r < 16; ++r) { const int kc = 32 * kh + (r & 3) + 8 * (r >> 2) + 4 * hi;
        int bi = kc - qc + 15; bi = bi < 0 ? 0 : bi; bi = bi > 30 ? 30 : bi;
        const float sc = p[r] * SCL + brow[bi]; p[r] = ((vm >> r) & 1u) ? sc : -1e30f; mx = fmaxf(mx, p[r]); }
    mx = xor32_max(mx);
    const float m_new = fmaxf(m_run, mx), alpha = fexp2(m_run - m_new); m_run = m_new;
    const float m_use = fmaxf(m_new, -1e20f);
    float ls = 0.f;
#pragma unroll
    for (int r = 0; r < 16; ++r) { const float e = fexp2(p[r] - m_use); p[r] = e; ls += e; }
    l_run = l_run * alpha + ls;
#pragma unroll
    for (int r = 0; r < 16; ++r) { o0[r] *= alpha; o1[r] *= alpha; }
#pragma unroll
    for (int k2 = 0; k2 < 2; ++k2) {
        u32x4 pw; pw.x = cvt_pk_bf16(p[8 * k2 + 0], p[8 * k2 + 1]); pw.y = cvt_pk_bf16(p[8 * k2 + 2], p[8 * k2 + 3]); pw.z = cvt_pk_bf16(p[8 * k2 + 4], p[8 * k2 + 5]); pw.w = cvt_pk_bf16(p[8 * k2 + 6], p[8 * k2 + 7]);
        const bf16x8 pa = __builtin_bit_cast(bf16x8, pw);
        o0 = __builtin_amdgcn_mfma_f32_32x32x16_bf16(vf[0][k2], pa, o0, 0, 0, 0);
        o1 = __builtin_amdgcn_mfma_f32_32x32x16_bf16(vf[1][k2], pa, o1, 0, 0, 0);
    }
}
__device__ __forceinline__ void na_store(bf16_t* orow, const f32x16& o0, const f32x16& o1, float l_run) {
    const float l = xor32_sum(l_run); const float inv = 1.0f / l;
#pragma unroll
    for (int rg = 0; rg < 4; ++rg) {
        u32x2 w; w.x = cvt_pk_bf16(o0[4 * rg] * inv, o0[4 * rg + 1] * inv); w.y = cvt_pk_bf16(o0[4 * rg + 2] * inv, o0[4 * rg + 3] * inv); *(u32x2*)(orow + 8 * rg) = w;
        u32x2 w2; w2.x = cvt_pk_bf16(o1[4 * rg] * inv, o1[4 * rg + 1] * inv); w2.y = cvt_pk_bf16(o1[4 * rg + 2] * inv, o1[4 * rg + 3] * inv); *(u32x2*)(orow + 32 + 8 * rg) = w2;
    }
}
__device__ __forceinline__ void na_unit(const LAS float* biasT, const bf16_t* Z, const bf16_t* VTn, bf16_t* AO, int tokbase, int S, int rr, int tid) {
    const int lane = tid & 63, h = tid >> 6, r32 = lane & 31, hi = lane >> 5;
    const int rows = S / 64; int rs = rr - 4; rs = rs < 0 ? 0 : rs; rs = rs > rows - 8 ? rows - 8 : rs;
    bf16x8 qfa[4], qfb[4];
#pragma unroll
    for (int d0 = 0; d0 < 4; ++d0) { qfa[d0] = *(const bf16x8*)(Z + (size_t)(tokbase + rr * 64 + r32) * ZP + 672 + h * 64 + 16 * d0 + 8 * hi);
                                      qfb[d0] = *(const bf16x8*)(Z + (size_t)(tokbase + rr * 64 + 32 + r32) * ZP + 672 + h * 64 + 16 * d0 + 8 * hi); }
    f32x16 oa0, oa1, ob0, ob1; float ma = -1e30f, mb = -1e30f, la = 0.f, lb = 0.f;
#pragma unroll
    for (int r = 0; r < 16; ++r) { oa0[r] = 0.f; oa1[r] = 0.f; ob0[r] = 0.f; ob1[r] = 0.f; }
    const unsigned va0 = na_vmask(r32, 0, hi), va1 = na_vmask(r32, 1, hi), vb0 = na_vmask(32 + r32, 0, hi), vb1 = na_vmask(32 + r32, 1, hi);
    const bf16_t* kbase = Z + (size_t)(tokbase + rs * 64 + r32) * ZP + 672 + 512 + h * 64 + 8 * hi;
    const bf16_t* vbase0 = VTn + (size_t)(h * 64 + r32) * TH + tokbase + rs * 64 + 4 * hi;
#define NA_LOADK(KF, IT) do { const int kr_ = (IT) >> 1, kh_ = (IT) & 1; const bf16_t* kp_ = kbase + (size_t)(kr_ * 64 + kh_ * 32) * ZP; \
        _Pragma("unroll") for (int d0 = 0; d0 < 4; ++d0) KF[d0] = *(const bf16x8*)(kp_ + 16 * d0); } while (0)
#define NA_LOADV(VF, IT) do { const int kr_ = (IT) >> 1, kh_ = (IT) & 1; const bf16_t* vp0_ = vbase0 + kr_ * 64 + kh_ * 32; const bf16_t* vp1_ = vp0_ + (size_t)32 * TH; \
        _Pragma("unroll") for (int k2 = 0; k2 < 2; ++k2) { const u32x2 lo = *(const u32x2*)(vp0_ + 16 * k2), hi2 = *(const u32x2*)(vp0_ + 16 * k2 + 8); VF[0][k2] = __builtin_bit_cast(bf16x8, ((u32x4){lo.x, lo.y, hi2.x, hi2.y})); \
            const u32x2 lo1 = *(const u32x2*)(vp1_ + 16 * k2), hi3 = *(const u32x2*)(vp1_ + 16 * k2 + 8); VF[1][k2] = __builtin_bit_cast(bf16x8, ((u32x4){lo1.x, lo1.y, hi3.x, hi3.y})); } } while (0)
    bf16x8 kf[4];
    NA_LOADK(kf, 0);
#pragma unroll 1
    for (int it = 0; it < 16; ++it) {
        const int kr = it >> 1, kh = it & 1;
        const LAS float* brow = biasT + (h * 15 + (rs + kr - rr + 7)) * 31;
        bf16x8 vf[2][2], kn[4];
        NA_LOADV(vf, it);
        const int itn = it + 1 < 16 ? it + 1 : 15;
        NA_LOADK(kn, itn);
        na_qs(kf, vf, qfa, brow, r32, kh, hi, kh ? va1 : va0, ma, la, oa0, oa1);
        na_qs(kf, vf, qfb, brow, 32 + r32, kh, hi, kh ? vb1 : vb0, mb, lb, ob0, ob1);
#pragma unroll
        for (int d0 = 0; d0 < 4; ++d0) kf[d0] = kn[d0];
    }
#undef NA_LOADK
#undef NA_LOADV
    na_store(AO + (size_t)(tokbase + rr * 64 + r32) * 1024 + 512 + h * 64 + 4 * hi, oa0, oa1, la);
    na_store(AO + (size_t)(tokbase + rr * 64 + 32 + r32) * 1024 + 512 + h * 64 + 4 * hi, ob0, ob1, lb);
}
#ifndef REP_SYNC
#define REP_SYNC 1
#endif
#ifndef REP_MLA
#define REP_MLA 1
#endif
#ifndef REP_NA
#define REP_NA 1
#endif
#ifndef REP_SCAN
#define REP_SCAN 1
#endif
#ifndef REP_UP
#define REP_UP 1
#endif
#ifndef REP_PASS
#define REP_PASS 1
#endif
#ifndef REP_GEMM
#define REP_GEMM 1
#endif
#define GSYNC() do { for (int r_ = 0; r_ < REP_SYNC; ++r_) xcd_barrier((unsigned*)(ap0->ws + WS_BAR), bst); } while (0)
constexpr int LDS_BYTES = 147456;
constexpr int NTHR = 512;
struct Args { const float* in[26]; float* out; unsigned char* ws; };


#define XB_TMO      128
#define XB_XCNT(j)  (256  + 64 * (j))
#define XB_XSUB(j)  (1280 + 64 * (j))
#define XB_XGEN(j)  (2304 + 64 * (j))
#define XB_TOP      3328
#define XB_TOPGEN   3392
#define XCD_BAR_WORDS 3456
#define XB_SPIN_CAP (1u << 22)
__device__ __forceinline__ unsigned xb_ld(unsigned* p)              { return __hip_atomic_load(p, __ATOMIC_RELAXED, __HIP_MEMORY_SCOPE_AGENT); }
__device__ __forceinline__ unsigned xb_add(unsigned* p, unsigned v) { return __hip_atomic_fetch_add(p, v, __ATOMIC_RELAXED, __HIP_MEMORY_SCOPE_AGENT); }
__device__ __forceinline__ unsigned xb_xcc_id() { return (unsigned)__builtin_amdgcn_s_getreg((3 << 11) | 20) & 0xFu; }
#define XB_SPIN(cond, bar) do { unsigned _sp = 0; while (cond) { __builtin_amdgcn_s_sleep(1); \
    if ((++_sp & 255u) == 0u) { if (xb_ld(&(bar)[XB_TMO])) break; if (_sp > XB_SPIN_CAP) { atomicAdd(&(bar)[XB_TMO], 1u); break; } } } } while (0)
__device__ __forceinline__ void xcd_barrier_complete(unsigned* bar, unsigned x, unsigned& nloc, unsigned& nx) {
    const unsigned G = gridDim.x;
    unsigned sum, cnt, mine, sp = 0u;
    for (;;) {
        sum = 0u; cnt = 0u; mine = 0u;
#pragma unroll
        for (unsigned j = 0; j < 16; ++j) { const unsigned c = xb_ld(&bar[XB_XCNT(j)]); sum += c; cnt += (c > 0u) ? 1u : 0u; mine = (j == x) ? c : mine; }
        if (sum == G) break;
        __builtin_amdgcn_s_sleep(1);
        if ((++sp & 255u) == 0u) { if (xb_ld(&bar[XB_TMO])) break; if (sp > XB_SPIN_CAP) { atomicAdd(&bar[XB_TMO], 1u); break; } }
    }
    nloc = mine > 0u ? mine : 1u; nx = cnt > 0u ? cnt : 1u;
}
__device__ __forceinline__ void xcd_barrier(unsigned* bar, volatile LAS unsigned* st) {
    asm volatile("s_waitcnt vmcnt(0)" ::: "memory");
    __syncthreads();
    if (threadIdx.x == 0) {
        __builtin_amdgcn_s_waitcnt(0);
        const unsigned x = xb_xcc_id();
        unsigned nloc = st[0], nx = st[1];
        if (nloc == 0u) { xcd_barrier_complete(bar, x, nloc, nx); st[0] = nloc; st[1] = nx; }
        const unsigned old = xb_add(&bar[XB_XSUB(x)], 1u);
        const unsigned gen = old / nloc;
        if (old + 1u == (gen + 1u) * nloc) {
            __builtin_amdgcn_fence(__ATOMIC_RELEASE, "agent");
            asm volatile("s_waitcnt vmcnt(0)" ::: "memory");
            const unsigned og = xb_add(&bar[XB_TOP], 1u);
            const unsigned tg = og / nx;
            if (og + 1u == (tg + 1u) * nx) xb_add(&bar[XB_TOPGEN], 1u);
            else XB_SPIN(xb_ld(&bar[XB_TOPGEN]) == tg, bar);
            __builtin_amdgcn_fence(__ATOMIC_ACQUIRE, "agent");
            xb_add(&bar[XB_XGEN(x)], 1u);
            asm volatile("s_waitcnt vmcnt(0)" ::: "memory");
        } else {
            XB_SPIN(xb_ld(&bar[XB_XGEN(x)]) == gen, bar);
            __builtin_amdgcn_fence(__ATOMIC_ACQUIRE, "agent");
            asm volatile("s_waitcnt vmcnt(0)" ::: "memory");
        }
    }
    __syncthreads();
}

__global__ void __launch_bounds__(NTHR, 2) mk_fwd(Args a) {
    extern __shared__ __attribute__((aligned(16))) unsigned char lds_raw[];
    LAS unsigned char* lds = (LAS unsigned char*)lds_raw;
    cg::grid_group grid = cg::this_grid();
    volatile LAS unsigned* bst = (volatile LAS unsigned*)(lds + LDS_BYTES - 64);
    if (threadIdx.x == 0) { bst[0] = 0u; bst[1] = 0u; }
    typedef const __attribute__((address_space(4))) Args* ArgP;
    ArgP ap0 = (ArgP)__builtin_amdgcn_kernarg_segment_ptr();
#define PH_BEGIN ArgP ap = ap0; asm volatile("" : "+s"(ap)); unsigned char* ws = ap->ws; (void)ws; int tid_ = threadIdx.x; asm volatile("" : "+v"(tid_)); const int tid = tid_, lane = tid & 63, wave = tid >> 6; int G_ = gridDim.x, bid_ = blockIdx.x; asm volatile("" : "+s"(G_), "+s"(bid_)); const int G = G_, bid = bid_; const int gw = bid * 8 + wave, NGW = G * 8; const int gt = bid * NTHR + tid, NGT = G * NTHR; (void)lane; (void)gw; (void)NGW; (void)gt; (void)NGT;
#define IN(k) (ap->in[k])
#define rsq ((float*)(ws + WS_RSQ))
#define rskv ((float*)(ws + WS_RSKV))
#define rope ((float2*)(ws + WS_ROPE))
#define AGG ((float2*)(ws + WS_AGG))
#define CARRY ((float*)(ws + WS_CARRY))
#define YB ((bf16_t*)(ws + WS_YB))
#define W_INATT ((bf16_t*)(ws + WS_W_INATT))
#define W_UQ ((bf16_t*)(ws + WS_W_UQ))
#define W_UKV ((bf16_t*)(ws + WS_W_UKV))
#define W_OUTATT ((bf16_t*)(ws + WS_W_OUTATT))
#define W_INREC ((bf16_t*)(ws + WS_W_INREC))
#define W_GATES ((bf16_t*)(ws + WS_W_GATES))
#define W_OUTREC ((bf16_t*)(ws + WS_W_OUTREC))
#define W_UP ((bf16_t*)(ws + WS_W_UP))
#define W_DOWN ((bf16_t*)(ws + WS_W_DOWN))
#define XN ((bf16_t*)(ws + WS_XN))
#define Zb ((bf16_t*)(ws + WS_Z))
#define Qb ((bf16_t*)(ws + WS_Q))
#define KN ((bf16_t*)(ws + WS_KN))
#define VTM ((bf16_t*)(ws + WS_VTM))
#define VTN ((bf16_t*)(ws + WS_VTN))
#define KPE ((bf16_t*)(ws + WS_KPE))
#define ACT ((bf16_t*)(ws + WS_ACT))
#define GATE ((bf16_t*)(ws + WS_GATE))
#define XB ((bf16_t*)(ws + WS_XB))
#define XBR ((bf16_t*)(ws + WS_XBR))
#define GQ ((bf16_t*)(ws + WS_GQ))
#define AO XN
#define Fb XN
#define YR XN
#define M0 Zb
#define M1 XBR
#define XIN (IN(half))
#define XST (ap->out + (size_t)half * TH * DM)
    { PH_BEGIN
    {
        LAS float* scr = (LAS float*)(lds + wave * 16384);
        constexpr int I_INATT = 16 * 69, I_UQ = 6 * 24, I_UKV = 4 * 32, I_SQ = 16 * 32, I_INREC = 16 * 64, I_UP = 16 * 256, I_DOWN = 64 * 32, I_GATE = 32 * 8;
        constexpr int NITEMS = I_INATT + I_UQ + I_UKV + 2 * I_SQ + I_INREC + 2 * I_UP + 2 * I_DOWN + I_GATE;
        for (int rep_ = 0; rep_ < REP_PASS; ++rep_)
        for (int it = gw; it < NITEMS; it += NGW) {
            int r = it;
            if (r < I_INATT) { transpose_item(IN(6), 1024, 2208, W_INATT, 0, nullptr, scr, r, lane); continue; } r -= I_INATT;
            if (r < I_UQ) { transpose_item(IN(8), 384, 768, W_UQ, 0, IN(7), scr, r, lane); continue; } r -= I_UQ;
            if (r < I_UKV) { transpose_item(IN(10), 256, 1024, W_UKV, 0, IN(9), scr, r, lane); continue; } r -= I_UKV;
            if (r < I_SQ) { transpose_item(IN(12), 1024, 1024, W_OUTATT, 0, nullptr, scr, r, lane); continue; } r -= I_SQ;
            if (r < I_SQ) { transpose_item(IN(21), 1024, 1024, W_OUTREC, 0, nullptr, scr, r, lane); continue; } r -= I_SQ;
            if (r < I_INREC) { transpose_item(IN(13), 1024, 2048, W_INREC, 0, nullptr, scr, r, lane); continue; } r -= I_INREC;
            if (r < 2 * I_UP) { const int li = r / I_UP; transpose_item(IN(22) + (size_t)li * 1024 * 8192, 1024, 8192, W_UP + (size_t)li * 8192 * 1024, 0, nullptr, scr, r % I_UP, lane); continue; } r -= 2 * I_UP;
            if (r < 2 * I_DOWN) { const int li = r / I_DOWN; transpose_item(IN(25) + (size_t)li * 4096 * 1024, 4096, 1024, W_DOWN + (size_t)li * 1024 * 4096, 0, nullptr, scr, r % I_DOWN, lane); continue; } r -= 2 * I_DOWN;
            { const int mat = r / 8, sub = r % 8; const int type = mat >> 4, e = (mat >> 3) & 1, n = mat & 7;
              transpose_item(IN(type ? 18 : 16) + (size_t)(e * 8 + n) * 128 * 128, 128, 128, W_GATES, n * 512 + e * 256 + type * 128, nullptr, scr, sub, lane); }
        }
        if (bid == 0) for (int i = tid; i < XCD_BAR_WORDS; i += NTHR) ((unsigned*)(ws + WS_BAR))[i] = 0u;
        for (int i = gt; i < 8 * 64 * 64; i += NGT) ((unsigned*)(ws + WS_CNT))[i] = 0u;
        for (int i = gt; i < 96 * 1024 / 8; i += NGT) ((u32x4*)(W_INATT + (size_t)2208 * 1024))[i] = (u32x4){0, 0, 0, 0};
        for (int m = gw; m < TH; m += NGW) xn_row(IN(0) + (size_t)m * DM, IN(2), XN + (size_t)m * DM, lane);
        for (int i = gt; i < 4096 * 16; i += NGT) { const int pos = i >> 4, j = i & 15;
            const double inv = exp2(-(double)j * (13.287712379549449 / 16.0));
            const double rev = (double)pos * inv * 0.15915494309189535; const float fr = (float)(rev - floor(rev));
            rope[i] = make_float2(__builtin_amdgcn_cosf(fr), __builtin_amdgcn_sinf(fr)); }
    }

    }
    grid.sync();
    if (threadIdx.x == 0) (void)xb_add((unsigned*)(ap0->ws + WS_BAR) + XB_XCNT(xb_xcc_id()), 1u);
    for (int half = 0; half < 2; ++half) {
        const int S = half ? 4096 : 2048, nseq = TH / S;
        if (half == 1 && gridDim.x != 256) {
                { PH_BEGIN
        for (int m = gw; m < TH; m += NGW) xn_row(XIN + (size_t)m * DM, IN(2), XN + (size_t)m * DM, lane);
        }
        GSYNC();
        }
        { PH_BEGIN
        { pg8::Gemm g = pg8::make_gemm(XN, DM, W_INATT, DM, DM); pg8::StaticOrder so; so.init(TH / 256, ZP / 256, G, bid);
          EpiZ E{Zb, VTN, (float*)(ws + WS_SQP), nullptr, KPE, rope, S - 1};
#ifndef NO_G1
for (int rep_ = 0; rep_ < REP_GEMM; ++rep_) pg8::gemm_phase<EpiZ>(lds, g, so, E);
#endif
 }
        }
        GSYNC();
        { PH_BEGIN
        { pg8::Gemm g = pg8::make_gemm(Zb, ZP, W_UQ, 384, 384); pg8::StaticOrder so; so.init(TH / 256, 3, G, bid);
          EpiQ E{Qb, (const float*)(ws + WS_SQP), rope, S - 1};
#ifndef NO_G2
for (int rep_ = 0; rep_ < REP_GEMM; ++rep_) pg8::gemm_phase<EpiQ>(lds, g, so, E);
#endif
 }
        { pg8::Gemm g = pg8::make_gemm(Zb + 384, ZP, W_UKV, 256, 256); pg8::StaticOrder so; so.init(TH / 256, 4, G, bid);
          EpiKV E{KN, VTM, (const float*)(ws + WS_SQP)};
#ifndef NO_G3
for (int rep_ = 0; rep_ < REP_GEMM; ++rep_) pg8::gemm_phase<EpiKV>(lds, g, so, E);
#endif
 }
        }
        GSYNC();
        { PH_BEGIN
        {
            LAS float* biasT = (LAS float*)(lds + 98304);
            for (int i = tid; i < 8 * 15 * 31; i += NTHR) biasT[i] = IN(11)[i] * LOG2E;
            __syncthreads();
            const int nqb = S / 512, nunits = nseq * 8 * nqb;
            const int vb = (G % 8 == 0) ? (bid % 8) * (G / 8) + bid / 8 : bid;
#ifdef DELAY_P4A
        { const unsigned long long t0_ = __builtin_amdgcn_s_memrealtime(); while (__builtin_amdgcn_s_memrealtime() - t0_ < 40000ull) __builtin_amdgcn_s_sleep(32); }
#endif
#ifndef NO_MLA
            for (int rep_ = 0; rep_ < REP_MLA; ++rep_) {
#ifdef REP_MLA_SYNC
            if (rep_ > 0) GSYNC();
#endif
#ifdef REP_DELAY
            if (rep_ > 0) { const unsigned long long t0_ = __builtin_amdgcn_s_memrealtime(); while (__builtin_amdgcn_s_memrealtime() - t0_ < 40000ull) __builtin_amdgcn_s_sleep(32); continue; }
#endif
            for (int u = vb; u < nunits; u += G) { const int qb = u % nqb, h = (u / nqb) & 7, s = u / (nqb * 8);
                mla_unit(lds, Qb, KN, KPE, VTM, AO, s * S, S, h, qb, tid); }
            }
#endif
#ifdef MLA_TWICE
            for (int u = vb; u < nunits; u += G) { const int qb = u % nqb, h = (u / nqb) & 7, s = u / (nqb * 8);
                mla_unit(lds, Qb, KN, KPE, VTM, AO, s * S, S, h, qb, tid); }
#endif
            const int rows = S / 64, nna = nseq * rows;
#ifdef DELAY_P4B
        { const unsigned long long t0_ = __builtin_amdgcn_s_memrealtime(); while (__builtin_amdgcn_s_memrealtime() - t0_ < 40000ull) __builtin_amdgcn_s_sleep(32); }
#endif
#ifdef RELOAD_BIAS
            __syncthreads();
            for (int i = tid; i < 8 * 15 * 31; i += NTHR) biasT[i] = IN(11)[i] * LOG2E;
            __syncthreads();
#endif
#ifndef NO_NA
            for (int rep_ = 0; rep_ < REP_NA; ++rep_)
            for (int u = vb; u < nna; u += G) na_unit(biasT, Zb, VTN, AO, (u / rows) * S, S, u % rows, tid);
#endif
        }
        }
        GSYNC();
        { PH_BEGIN
        { pg8::Gemm g = pg8::make_gemm(AO, DM, W_OUTATT, DM, DM); pg8::StaticOrder so; so.init(TH / 256, 4, G, bid);
          EpiBf16 E{M0, DM, 0, 0};
#ifndef NO_G4
for (int rep_ = 0; rep_ < REP_GEMM; ++rep_) pg8::gemm_phase<EpiBf16>(lds, g, so, E);
#endif
 }
        }
        GSYNC();
        { PH_BEGIN
        for (int m = gw; m < TH; m += 2 * NGW) { const int m2 = m + NGW; if (m2 < TH) res_row2(M0 + (size_t)m * DM, M0 + (size_t)m2 * DM, XIN + (size_t)m * DM, XIN + (size_t)m2 * DM, XST + (size_t)m * DM, XST + (size_t)m2 * DM, IN(3), IN(4), XN + (size_t)m * DM, XN + (size_t)m2 * DM, lane); else res_row(M0 + (size_t)m * DM, XIN + (size_t)m * DM, XST + (size_t)m * DM, IN(3), IN(4), XN + (size_t)m * DM, lane); }
        }
        GSYNC();

        for (int li = 0; li < 2; ++li) {
            if (li == 1) {
                { PH_BEGIN
                { pg8::Gemm g = pg8::make_gemm(XN, DM, W_INREC, DM, DM); pg8::StaticOrder so; so.init(TH / 256, 8, G, bid);
                  EpiBf16 E{GATE, DM, 1024, (size_t)(WS_XBR - WS_GATE) / 2};
#ifndef NO_G5
for (int rep_ = 0; rep_ < REP_GEMM; ++rep_) pg8::gemm_phase<EpiBf16>(lds, g, so, E);
#endif
 }
                }
                GSYNC();
                { PH_BEGIN
                for (int i0 = gt; i0 < TH * 128; i0 += 4 * NGT) {
                    u32x4 wv[4][4]; int tt[4], cc[4];
#pragma unroll
                    for (int u = 0; u < 4; ++u) { const int i = i0 + u * NGT; const int t = i >> 7, c8 = (i & 127) * 8; const int pos = t & (S - 1); tt[u] = t; cc[u] = c8;
#pragma unroll
                        for (int k = 0; k < 4; ++k) { const int p2 = pos + k - 1; wv[u][k] = (p2 < 0 || p2 >= S || i >= TH * 128) ? (u32x4){0u, 0u, 0u, 0u} : *(const u32x4*)(XBR + (size_t)(t + k - 1) * DM + c8); } }
#pragma unroll
                    for (int u = 0; u < 4; ++u) { if (i0 + u * NGT >= TH * 128) break; const int c8 = cc[u];
                        float accv[8];
#pragma unroll
                        for (int j = 0; j < 8; ++j) accv[j] = IN(15)[c8 + j];
#pragma unroll
                        for (int k = 0; k < 4; ++k) { const u32x4 w = wv[u][k]; const float* cwk = IN(14) + k * 1024 + c8;
                            accv[0] += cwk[0] * bflo(w.x); accv[1] += cwk[1] * bfhi(w.x); accv[2] += cwk[2] * bflo(w.y); accv[3] += cwk[3] * bfhi(w.y);
                            accv[4] += cwk[4] * bflo(w.z); accv[5] += cwk[5] * bfhi(w.z); accv[6] += cwk[6] * bflo(w.w); accv[7] += cwk[7] * bfhi(w.w); }
                        u32x4 o; o.x = cvt_pk_bf16(accv[0], accv[1]); o.y = cvt_pk_bf16(accv[2], accv[3]); o.z = cvt_pk_bf16(accv[4], accv[5]); o.w = cvt_pk_bf16(accv[6], accv[7]);
                        *(u32x4*)(XB + (size_t)tt[u] * DM + c8) = o; }
                }
                }
                GSYNC();
                for (int qt = 0; qt < 2; ++qt) {
                    const int t0 = qt * TQ;
                    { PH_BEGIN
                    { pg8::Gemm g = pg8::make_gemm(XB + (size_t)t0 * DM, DM, W_GATES, 128, 128); g.a_pn_shift = 1; g.a_pn_step = 256; g.a_seg = 1; g.hA = (size_t)4 * DM * 2;
                      pg8::StaticOrder so; so.init(TQ / 256, 16, G, bid);
                      EpiGates E{GQ, XB + (size_t)t0 * DM, AGG, IN(17), IN(19), IN(20)};
                      pg8::gemm_phase<EpiGates>(lds, g, so, E);
 }
                    }
                    GSYNC();
                    { PH_BEGIN
                    { const int cps = S / 32, nsq = TQ / S;
                      for (int rep_ = 0; rep_ < REP_SCAN; ++rep_)
                      for (int i = gt; i < nsq * 2 * 1024; i += NGT) { const int ch = i & 1023, e = (i >> 10) & 1, sq = i >> 11;
                          float hcar = 0.f;
                          for (int k0 = 0; k0 < cps; k0 += 32) {
                              float2 ab[32];
#pragma unroll
                              for (int j = 0; j < 32; ++j) { const int k = k0 + j; const int c = sq * cps + (e ? cps - 1 - k : k); ab[j] = AGG[(c * 2 + e) * 1024 + ch]; }
#pragma unroll
                              for (int j = 0; j < 32; ++j) { const int k = k0 + j; const int c = sq * cps + (e ? cps - 1 - k : k); CARRY[(c * 2 + e) * 1024 + ch] = hcar; hcar = ab[j].x * hcar + ab[j].y; } } } }
                    }
                    GSYNC();
                    { PH_BEGIN
#ifndef NO_R6
                    for (int rep_ = 0; rep_ < REP_SCAN; ++rep_)
                    for (int i = gt; i < 256 * 512; i += NGT) { const int cp = i & 511, c = i >> 9; const int ch = 2 * cp, n = ch >> 7, d = ch & 127;
                        const bf16_t* gq0 = GQ + (size_t)(c * 32) * 4096 + n * 512 + d;
                        bf16_t* yr0 = YR + (size_t)(t0 + c * 32) * DM + ch; const bf16_t* gt0 = GATE + (size_t)(t0 + c * 32) * DM + ch;
                        unsigned hfw[32];
                        { const float2 hc2 = *(const float2*)(CARRY + (size_t)(c * 2 + 0) * 1024 + ch); float h0 = hc2.x, h1 = hc2.y;
#pragma unroll
                          for (int s = 0; s < 32; ++s) {
                            const unsigned l2 = *(const unsigned*)(gq0 + (size_t)s * 4096), b2 = *(const unsigned*)(gq0 + (size_t)s * 4096 + 128);
                            h0 = fexp2(bflo(l2)) * h0 + bflo(b2); h1 = fexp2(bfhi(l2)) * h1 + bfhi(b2);
                            hfw[s] = cvt_pk_bf16(h0, h1); } }
                        { const float2 hc2 = *(const float2*)(CARRY + (size_t)(c * 2 + 1) * 1024 + ch); float h0 = hc2.x, h1 = hc2.y;
                          unsigned lq[32], bq[32], gq_[32];
#pragma unroll
                          for (int s = 0; s < 32; ++s) { lq[s] = *(const unsigned*)(gq0 + (size_t)s * 4096 + 256); bq[s] = *(const unsigned*)(gq0 + (size_t)s * 4096 + 384); gq_[s] = *(const unsigned*)(gt0 + (size_t)s * DM); }
#pragma unroll
                          for (int s = 31; s >= 0; --s) {
                            const unsigned l2 = lq[s], b2 = bq[s];
                            h0 = fexp2(bflo(l2)) * h0 + bflo(b2); h1 = fexp2(bfhi(l2)) * h1 + bfhi(b2);
                            const unsigned g2 = gq_[s], f2 = hfw[s];
                            *(unsigned*)(yr0 + (size_t)s * DM) = cvt_pk_bf16((bflo(f2) + h0) * gelu_tanh(bflo(g2)), (bfhi(f2) + h1) * gelu_tanh(bfhi(g2))); } }
                    }
#endif
                    }
                    GSYNC();
                }
                { PH_BEGIN
                { pg8::Gemm g = pg8::make_gemm(YR, DM, W_OUTREC, DM, DM); pg8::StaticOrder so; so.init(TH / 256, 4, G, bid);
                  EpiBf16 E{M1, DM, 0, 0};
#ifndef NO_G7
for (int rep_ = 0; rep_ < REP_GEMM; ++rep_) pg8::gemm_phase<EpiBf16>(lds, g, so, E);
#endif
 }
                }
                GSYNC();
                { PH_BEGIN
                for (int m = gw; m < TH; m += 2 * NGW) { const int m2 = m + NGW; if (m2 < TH) res_row2(M1 + (size_t)m * DM, M1 + (size_t)m2 * DM, XST + (size_t)m * DM, XST + (size_t)m2 * DM, XST + (size_t)m * DM, XST + (size_t)m2 * DM, IN(3) + 1024, IN(4) + 1024, XN + (size_t)m * DM, XN + (size_t)m2 * DM, lane); else res_row(M1 + (size_t)m * DM, XST + (size_t)m * DM, XST + (size_t)m * DM, IN(3) + 1024, IN(4) + 1024, XN + (size_t)m * DM, lane); }
                }
                GSYNC();
            }
            { PH_BEGIN
            { pg8::Gemm g = pg8::make_gemm(XN, DM, W_UP + (size_t)li * 8192 * 1024, DM, DM);
              g.a_seg = 1; g.hA = (size_t)4 * DM * 2; g.tB = (size_t)128 * DM * 2; g.hB = (size_t)4096 * DM * 2;
              pg8::StaticOrder so; so.init(TH / 256, 32, G, bid);
#ifndef NO_UP
              EpiUp E{ACT, YB, IN(23) + (size_t)li * 3 * 8192, IN(24) + (size_t)li * 8192}; for (int rep_ = 0; rep_ < REP_UP; ++rep_) pg8::gemm_phase<EpiUp>(lds, g, so, E);
#endif
 }
            }
            GSYNC();
            { PH_BEGIN
            for (int rep_ = 0; rep_ < REP_PASS; ++rep_)
            for (int b = bid; b < 256; b += G) { const int seg = b >> 1, which = b & 1; const int t = seg * 128 + (which ? 127 : 0); const int pos = t & (S - 1);
                const float* cw = IN(23) + (size_t)li * 3 * 8192; const float* cb = IN(24) + (size_t)li * 8192;
                const bool hasp = which ? true : (pos != 0), hasn = which ? (pos != S - 1) : true;
                const bf16_t* yp = which ? YB + ((size_t)seg * 4 + 2) * 8192 : YB + ((size_t)(seg - 1) * 4 + 3) * 8192;
                const bf16_t* yc = YB + ((size_t)seg * 4 + (which ? 3 : 0)) * 8192;
                const bf16_t* yn = which ? YB + ((size_t)(seg + 1) * 4 + 0) * 8192 : YB + ((size_t)seg * 4 + 1) * 8192;
                bf16_t res[8];
#pragma unroll
                for (int it = 0; it < 8; ++it) { const int c = tid + it * NTHR;
                    float u2[2];
#pragma unroll
                    for (int bj = 0; bj < 2; ++bj) { const int ch = bj * 4096 + c;
                        float r = cw[8192 + ch] * bf2f(yc[ch]) + cb[ch];
                        if (hasp) r += cw[ch] * bf2f(yp[ch]);
                        if (hasn) r += cw[2 * 8192 + ch] * bf2f(yn[ch]);
                        u2[bj] = r; }
                    res[it] = f2bf(gelu_tanh(u2[0]) * u2[1]); }
#pragma unroll
                for (int it = 0; it < 8; ++it) ACT[(size_t)t * DFF + tid + it * NTHR] = res[it]; }
            }
            GSYNC();
            if (gridDim.x == 256) {
                { PH_BEGIN
                { pg8::Gemm g = pg8::make_gemm(ACT, DFF, W_DOWN + (size_t)li * 1024 * 4096, DFF, DFF); pg8::StaticOrder so; so.init(TH / 256, 4, G, bid);
                  const int use = half * 2 + li;
                  EpiRms E{XST, li == 0 ? XN : nullptr, IN(5) + li * 1024, IN(2) + 1024, (float*)(ws + WS_XBUF), (float*)(ws + WS_XBUF) + (size_t)TH * 4,
                           (unsigned*)(ws + WS_CNT) + (size_t)(use * 2) * 4096, (unsigned*)(ws + WS_CNT) + (size_t)(use * 2 + 1) * 4096};
                  pg8::gemm_phase<EpiRms>(lds, g, so, E); }
                if (half == 0 && li == 1)
                  { for (int m = gw; m < TH; m += NGW) xn_row(IN(1) + (size_t)m * DM, IN(2), XN + (size_t)m * DM, lane);
                  }
                }
                GSYNC();
            } else {
                { PH_BEGIN
                { pg8::Gemm g = pg8::make_gemm(ACT, DFF, W_DOWN + (size_t)li * 1024 * 4096, DFF, DFF); pg8::StaticOrder so; so.init(TH / 256, 4, G, bid);
                  EpiBf16 E{Fb, DM, 0, 0};
                  pg8::gemm_phase<EpiBf16>(lds, g, so, E); }
                }
                GSYNC();
                { PH_BEGIN
                for (int m = gw; m < TH; m += NGW) res_row(Fb + (size_t)m * DM, XST + (size_t)m * DM, XST + (size_t)m * DM, IN(5) + li * 1024, li == 0 ? IN(2) + 1024 : nullptr, XN + (size_t)m * DM, lane);
                }
                GSYNC();
            }
        }
    }
}

extern "C" void kernel_launch(void* const* d_in, const int* in_sizes, int n_in, void* d_out, int out_size, void* d_ws, size_t ws_size, hipStream_t stream) {
    static int grid = 0;
    if (grid == 0) {
        int dev = 0, cus = 0, per_cu = 0;
        (void)hipGetDevice(&dev);
        (void)hipDeviceGetAttribute(&cus, hipDeviceAttributeMultiprocessorCount, dev);
        (void)hipFuncSetAttribute((const void*)mk_fwd, hipFuncAttributeMaxDynamicSharedMemorySize, LDS_BYTES);
        (void)hipOccupancyMaxActiveBlocksPerMultiprocessor(&per_cu, (const void*)mk_fwd, NTHR, LDS_BYTES);
        if (per_cu < 1) per_cu = 1;
        grid = cus * per_cu;
        if (ws_size < WS_END || n_in != 26) { fprintf(stderr, "kernel_launch: unexpected ws_size %zu / n_in %d\n", ws_size, n_in); }
    }
    Args a{};
    for (int i = 0; i < 26; ++i) a.in[i] = (const float*)d_in[i];
    a.out = (float*)d_out; a.ws = (unsigned char*)d_ws;
    void* args[] = {&a};
    hipError_t e = hipLaunchCooperativeKernel((const void*)mk_fwd, dim3(grid), dim3(NTHR), args, LDS_BYTES, stream);
    if (e != hipSuccess) fprintf(stderr, "cooperative launch failed: %s (grid %d)\n", hipGetErrorString(e), grid);
}
```
